# Optimizing an MI355X kernel written in HIP

```python
import math
import jax, jax.numpy as jnp
from jax import lax
import numpy as np

D_MODEL = 1024
BATCH = 8
SEQ = 4096
DEPTH = 2

GRID_W = 64
CTX_LEN = 256
MIX_WIDTH = 2 * D_MODEL

SSD_WIDTH = D_MODEL
SSD_HEADDIM = 64
SSD_HEADS = SSD_WIDTH // SSD_HEADDIM
SSD_GROUPS = 2
SSD_HPG = SSD_HEADS // SSD_GROUPS
SSD_STATE = 128
SSD_GN = SSD_GROUPS * SSD_STATE
SSD_CONV_DIM = SSD_WIDTH + 2 * SSD_GN
SSD_CONV_K = 5
SSD_CHUNK = 128

GLA_WIDTH = D_MODEL // 2
GLA_HEADS = 4
GLA_DK = GLA_WIDTH // (2 * GLA_HEADS)
GLA_DV = GLA_WIDTH // GLA_HEADS
GLA_RANK = 16
GLA_TAU = 16.0
GLA_CHUNK = 64

S5_WIDTH = D_MODEL // 2
S5_GROUP = 16
S5_GROUPS = S5_WIDTH // S5_GROUP
S5_STATE = 64

IN_SIZES = (SSD_WIDTH, SSD_CONV_DIM, 2 * SSD_HEADS,
            GLA_HEADS * GLA_DK, GLA_HEADS * GLA_DK, GLA_WIDTH, GLA_WIDTH, 2 * GLA_RANK,
            S5_WIDTH, S5_WIDTH)
IN_DIM = sum(IN_SIZES)
EPS = 1e-6

kernel_name = "hymba_style_ssd_gla_s5_prefix_dit"


def rmsnorm(x, w):
    xf = x.astype(jnp.float32)
    y = xf * lax.rsqrt(jnp.mean(xf * xf, axis=-1, keepdims=True) + EPS)
    return (y * w.astype(jnp.float32)).astype(x.dtype)


def split_in_proj(p):
    parts, start = [], 0
    for size in IN_SIZES:
        parts.append(p[..., start:start + size])
        start += size
    return parts


def dwconv_centred(x, w, b):
    k, ch = w.shape
    y = lax.conv_general_dilated(x, w[:, None, :].astype(x.dtype), window_strides=(1,),
                                 padding=[(k // 2, k // 2)],
                                 dimension_numbers=("NWC", "WIO", "NWC"),
                                 feature_group_count=ch)
    return y + b.astype(x.dtype)


def to_col_major(u, rows):
    bsz, length, d = u.shape
    return u.reshape(bsz, rows, GRID_W, d).transpose(0, 2, 1, 3).reshape(bsz, length, d)


def from_col_major(u, rows):
    bsz, length, d = u.shape
    return u.reshape(bsz, GRID_W, rows, d).transpose(0, 2, 1, 3).reshape(bsz, length, d)


def bidirectional(scan_fwd, scan_bwd, ctx_args, lat_args, h0):
    flip = lambda t: jnp.flip(t, axis=1)
    y_cf, h_cf = scan_fwd(*ctx_args, h0)
    y_lf, _ = scan_fwd(*lat_args, h_cf)
    y_cb, h_cb = scan_bwd(*[flip(t) for t in ctx_args], h0)
    y_lb, _ = scan_bwd(*[flip(t) for t in lat_args], h_cb)
    return y_cf + flip(y_cb), y_lf + flip(y_lb)


def segsum(a):
    t = a.shape[-1]
    cs = jnp.cumsum(a, axis=-1)
    diff = cs[..., :, None] - cs[..., None, :]
    return jnp.where(jnp.tril(jnp.ones((t, t), bool)), diff, -jnp.inf)


def ssd_scan(x, da, bm, cm, h0):
    bsz, length, g, r, p = x.shape
    n = bm.shape[-1]
    nc = length // SSD_CHUNK
    x = x.reshape(bsz, nc, SSD_CHUNK, g, r, p)
    bm = bm.reshape(bsz, nc, SSD_CHUNK, g, n)
    cm = cm.reshape(bsz, nc, SSD_CHUNK, g, n)
    da = da.reshape(bsz, nc, SSD_CHUNK, g, r).transpose(0, 3, 4, 1, 2)
    acs = jnp.cumsum(da, axis=-1)
    decay = jnp.exp(segsum(da))
    cb = jnp.einsum("bclgn,bcsgn->bgcls", cm, bm)
    y_diag = jnp.einsum("bgrcls,bcsgrp->bclgrp", cb[:, :, None] * decay, x)
    decay_states = jnp.exp(acs[..., -1:] - acs)
    states = jnp.einsum("bclgn,bgrcl,bclgrp->bcgrpn", bm, decay_states, x)

    def step(h, inp):
        dec, st = inp
        return h * dec[..., None, None] + st, h

    h_fin, h_prev = lax.scan(step, h0, (jnp.exp(acs[..., -1]).transpose(3, 0, 1, 2),
                                        states.transpose(1, 0, 2, 3, 4, 5)))
    y_off = jnp.einsum("bclgn,cbgrpn,bgrcl->bclgrp", cm, h_prev, jnp.exp(acs))
    return (y_diag + y_off).reshape(bsz, length, g, r, p), h_fin


def gla_scan(q, k, v, g, s0):
    bsz, length, h, dk = q.shape
    dv = v.shape[-1]
    nc = length // GLA_CHUNK
    q = q.reshape(bsz, nc, GLA_CHUNK, h, dk)
    k = k.reshape(bsz, nc, GLA_CHUNK, h, dk)
    v = v.reshape(bsz, nc, GLA_CHUNK, h, dv)
    b = jnp.cumsum(g.reshape(bsz, nc, GLA_CHUNK, h, dk), axis=2)
    b_last = b[:, :, -1]
    qe = q * jnp.exp(b)
    ke = k * jnp.exp(-b)
    kd = k * jnp.exp(b_last[:, :, None] - b)
    lower = jnp.tril(jnp.ones((GLA_CHUNK, GLA_CHUNK), bool))
    attn = jnp.where(lower, jnp.einsum("bcthd,bcshd->bchts", qe, ke), 0.0)
    o = jnp.einsum("bchts,bcshv->bcthv", attn, v)
    upd = jnp.einsum("bcshd,bcshv->bchdv", kd, v)

    def step(s, inp):
        dec, u = inp
        return s * dec[..., None] + u, s

    s_fin, s_prev = lax.scan(step, s0, (jnp.exp(b_last).transpose(1, 0, 2, 3),
                                        upd.transpose(1, 0, 2, 3, 4)))
    o = o + jnp.einsum("bcthd,cbhdv->bcthv", qe, s_prev)
    return o.reshape(bsz, length, h, dv), s_fin


def s5_scan(bu, h0, lam_bar):
    bu = bu.at[:, 0].add(lam_bar * h0)
    a = jnp.broadcast_to(lam_bar, bu.shape)

    def combine(e1, e2):
        a1, b1 = e1
        a2, b2 = e2
        return a1 * a2, a2 * b1 + b2

    _, h = lax.associative_scan(combine, (a, bu), axis=1)
    return h


def ssd_branch(z_c, xbc_c, dt_c, z_l, xbc_l, dt_l, conv_w, conv_b, a_log, dt_bias, d_skip, norm_w):
    f32 = jnp.float32
    a_neg = -jnp.exp(a_log.astype(f32))

    def prep(xbc, dt):
        bsz, length = xbc.shape[:2]
        xbc = jax.nn.silu(dwconv_centred(xbc, conv_w, conv_b)).astype(f32)
        xs = xbc[..., :SSD_WIDTH].reshape(bsz, length, SSD_GROUPS, SSD_HPG, SSD_HEADDIM)
        bm = xbc[..., SSD_WIDTH:SSD_WIDTH + SSD_GN].reshape(bsz, length, SSD_GROUPS, SSD_STATE)
        cm = xbc[..., SSD_WIDTH + SSD_GN:].reshape(bsz, length, SSD_GROUPS, SSD_STATE)
        dt = jax.nn.softplus(dt.astype(f32).reshape(bsz, length, 2, SSD_HEADS) + dt_bias.astype(f32))
        return xs, bm, cm, dt.reshape(bsz, length, 2, SSD_GROUPS, SSD_HPG)

    def make_scan(d):
        a_d = a_neg[d].reshape(SSD_GROUPS, SSD_HPG)

        def scan_fn(xs, bm, cm, dt, h0):
            dt_d = dt[:, :, d]
            return ssd_scan(xs * dt_d[..., None], dt_d * a_d, bm, cm, h0)
        return scan_fn

    ctx_args = prep(xbc_c, dt_c)
    lat_args = prep(xbc_l, dt_l)
    h0 = jnp.zeros((xbc_c.shape[0], SSD_GROUPS, SSD_HPG, SSD_HEADDIM, SSD_STATE), f32)
    y_c, y_l = bidirectional(make_scan(0), make_scan(1), ctx_args, lat_args, h0)
    dsk = d_skip.astype(f32).reshape(SSD_GROUPS, SSD_HPG, 1)

    def finish(y, xs, z):
        bsz, length = z.shape[:2]
        y = (y + dsk * xs).reshape(bsz, length, SSD_WIDTH) * jax.nn.silu(z.astype(f32))
        y = y.reshape(bsz, length, SSD_GROUPS, SSD_WIDTH // SSD_GROUPS)
        y = y * lax.rsqrt(jnp.mean(y * y, axis=-1, keepdims=True) + EPS)
        return (y.reshape(bsz, length, SSD_WIDTH) * norm_w.astype(f32)).astype(z.dtype)

    return finish(y_c, ctx_args[0], z_c), finish(y_l, lat_args[0], z_l)


def gla_branch(q_c, k_c, v_c, lr_c, gate_c, q_l, k_l, v_l, lr_l, gate_l, w_lr, b_lr, norm_w):
    f32 = jnp.float32

    def prep(q, k, v, lr):
        bsz, length = q.shape[:2]
        q = q.astype(f32).reshape(bsz, length, GLA_HEADS, GLA_DK) * GLA_DK ** -0.5
        k = k.astype(f32).reshape(bsz, length, GLA_HEADS, GLA_DK)
        v = v.astype(f32).reshape(bsz, length, GLA_HEADS, GLA_DV)
        lr = lr.astype(f32).reshape(bsz, length, 2, GLA_RANK)
        logit = jnp.einsum("blxr,xrk->blxk", lr, w_lr.astype(f32)) + b_lr.astype(f32)
        g = jax.nn.log_sigmoid(logit) / GLA_TAU
        return q, k, v, g.reshape(bsz, length, 2, GLA_HEADS, GLA_DK)

    def make_scan(d):
        def scan_fn(q, k, v, g, s0):
            return gla_scan(q, k, v, g[:, :, d], s0)
        return scan_fn

    ctx_args = prep(q_c, k_c, v_c, lr_c)
    lat_args = prep(q_l, k_l, v_l, lr_l)
    s0 = jnp.zeros((q_c.shape[0], GLA_HEADS, GLA_DK, GLA_DV), f32)
    o_c, o_l = bidirectional(make_scan(0), make_scan(1), ctx_args, lat_args, s0)

    def finish(o, gate):
        bsz, length = gate.shape[:2]
        o = o * lax.rsqrt(jnp.mean(o * o, axis=-1, keepdims=True) + EPS) * norm_w.astype(f32)
        return (o.reshape(bsz, length, GLA_WIDTH) * jax.nn.silu(gate.astype(f32))).astype(gate.dtype)

    return finish(o_c, gate_c), finish(o_l, gate_l)


def s5_branch(u_c, gate_c, u_l, gate_l, lam_re, lam_im, log_step, b_re, b_im, c_re, c_im,
              d_skip, glu_w, glu_b):
    f32 = jnp.float32
    bmat = lax.complex(b_re.astype(f32), b_im.astype(f32))

    def make_scan(d):
        lam = lax.complex(lam_re[d].astype(f32), lam_im[d].astype(f32))
        lam_bar = jnp.exp(lam * jnp.exp(log_step[d].astype(f32))[:, None])
        b_bar = ((lam_bar - 1.0) / lam)[..., None] * bmat
        cmat = lax.complex(c_re[d].astype(f32), c_im[d].astype(f32))

        def scan_fn(u, h0):
            bu = jnp.einsum("blgh,gph->blgp", u.astype(jnp.complex64), b_bar)
            h = s5_scan(bu, h0, lam_bar)
            return jnp.einsum("blgp,ghp->blgh", h, cmat).real, h[:, -1]
        return scan_fn

    def prep(u):
        bsz, length = u.shape[:2]
        return (u.astype(f32).reshape(bsz, length, S5_GROUPS, S5_GROUP),)

    ctx_args = prep(u_c)
    lat_args = prep(u_l)
    h0 = jnp.zeros((u_c.shape[0], S5_GROUPS, S5_STATE), jnp.complex64)
    y_c, y_l = bidirectional(make_scan(0), make_scan(1), ctx_args, lat_args, h0)
    dsk = d_skip.astype(f32).reshape(S5_GROUPS, S5_GROUP)

    def finish(y, u, gate):
        bsz, length = gate.shape[:2]
        y = jax.nn.gelu((y + dsk * u).reshape(bsz, length, S5_WIDTH))
        pr = y @ glu_w.astype(f32) + glu_b.astype(f32)
        y = pr[..., :S5_WIDTH] * jax.nn.sigmoid(pr[..., S5_WIDTH:])
        return (y * jax.nn.silu(gate.astype(f32))).astype(gate.dtype)

    return finish(y_c, ctx_args[0], gate_c), finish(y_l, lat_args[0], gate_l)


def setup_inputs(seed: int = 0) -> dict:
    key = jax.random.key(seed)
    ks = iter(jax.random.split(key, 40))
    f32 = jnp.float32
    nrm = lambda shape, s: s * jax.random.normal(next(ks), shape, f32)
    x = nrm((BATCH, SEQ, D_MODEL), 1.0)
    c = nrm((BATCH, D_MODEL), 1.0)
    ctx = nrm((BATCH, CTX_LEN, D_MODEL), 1.0)
    c_ctx = nrm((D_MODEL,), 1.0)
    norm_w = 1.0 + nrm((DEPTH, D_MODEL), 0.02)
    mod_w = nrm((DEPTH, D_MODEL, 3 * D_MODEL), 0.5 * D_MODEL ** -0.5)
    mod_b = nrm((DEPTH, 3 * D_MODEL), 0.02)
    w_in = nrm((DEPTH, D_MODEL, IN_DIM), D_MODEL ** -0.5)
    w_out = nrm((DEPTH, MIX_WIDTH, D_MODEL), MIX_WIDTH ** -0.5)
    ssd_conv_w = nrm((DEPTH, SSD_CONV_K, SSD_CONV_DIM), SSD_CONV_K ** -0.5)
    ssd_conv_b = nrm((DEPTH, SSD_CONV_DIM), 0.02)
    ssd_a_log = jnp.log(jax.random.uniform(next(ks), (DEPTH, 2, SSD_HEADS), f32, 1.0, 16.0))
    dt0 = jnp.exp(jax.random.uniform(next(ks), (DEPTH, 2, SSD_HEADS), f32,
                                     math.log(1e-3), math.log(1e-1)))
    ssd_dt_bias = dt0 + jnp.log(-jnp.expm1(-dt0))
    ssd_d = 1.0 + nrm((DEPTH, SSD_HEADS), 0.1)
    ssd_norm_w = 1.0 + nrm((DEPTH, SSD_WIDTH), 0.02)
    gla_w_lr = nrm((DEPTH, 2, GLA_RANK, GLA_HEADS * GLA_DK), GLA_RANK ** -0.5)
    gla_b_lr = nrm((DEPTH, 2, GLA_HEADS * GLA_DK), 0.5)
    gla_norm_w = 1.0 + nrm((DEPTH, GLA_DV), 0.02)
    s5_lam_re = -0.5 + nrm((DEPTH, 2, S5_GROUPS, S5_STATE), 0.01)
    s5_lam_im = jnp.pi * jnp.arange(S5_STATE, dtype=f32) + nrm((DEPTH, 2, S5_GROUPS, S5_STATE), 0.01)
    s5_log_step = jax.random.uniform(next(ks), (DEPTH, 2, S5_GROUPS), f32,
                                     math.log(1e-3), math.log(1e-1))
    s5_b_re = nrm((DEPTH, S5_GROUPS, S5_STATE, S5_GROUP), (2 * S5_GROUP) ** -0.5)
    s5_b_im = nrm((DEPTH, S5_GROUPS, S5_STATE, S5_GROUP), (2 * S5_GROUP) ** -0.5)
    s5_c_re = nrm((DEPTH, 2, S5_GROUPS, S5_GROUP, S5_STATE), (2 * S5_STATE) ** -0.5)
    s5_c_im = nrm((DEPTH, 2, S5_GROUPS, S5_GROUP, S5_STATE), (2 * S5_STATE) ** -0.5)
    s5_d = nrm((DEPTH, S5_WIDTH), 1.0)
    s5_glu_w = nrm((DEPTH, S5_WIDTH, 2 * S5_WIDTH), S5_WIDTH ** -0.5)
    s5_glu_b = nrm((DEPTH, 2 * S5_WIDTH), 0.02)
    final_norm_w = 1.0 + nrm((D_MODEL,), 0.02)
    return {"x": x, "c": c, "ctx": ctx, "c_ctx": c_ctx, "norm_w": norm_w, "mod_w": mod_w,
            "mod_b": mod_b, "w_in": w_in, "w_out": w_out, "ssd_conv_w": ssd_conv_w,
            "ssd_conv_b": ssd_conv_b, "ssd_a_log": ssd_a_log, "ssd_dt_bias": ssd_dt_bias,
            "ssd_d": ssd_d, "ssd_norm_w": ssd_norm_w, "gla_w_lr": gla_w_lr, "gla_b_lr": gla_b_lr,
            "gla_norm_w": gla_norm_w, "s5_lam_re": s5_lam_re, "s5_lam_im": s5_lam_im,
            "s5_log_step": s5_log_step, "s5_b_re": s5_b_re, "s5_b_im": s5_b_im,
            "s5_c_re": s5_c_re, "s5_c_im": s5_c_im, "s5_d": s5_d, "s5_glu_w": s5_glu_w,
            "s5_glu_b": s5_glu_b, "final_norm_w": final_norm_w}


def reference(x, c, ctx, c_ctx, norm_w, mod_w, mod_b, w_in, w_out, ssd_conv_w, ssd_conv_b,
              ssd_a_log, ssd_dt_bias, ssd_d, ssd_norm_w, gla_w_lr, gla_b_lr, gla_norm_w,
              s5_lam_re, s5_lam_im, s5_log_step, s5_b_re, s5_b_im, s5_c_re, s5_c_im, s5_d,
              s5_glu_w, s5_glu_b, final_norm_w):
    length = x.shape[1]
    rows = length // GRID_W
    h_lat, h_ctx = x, ctx
    for l in range(DEPTH):
        col_major = (l % 2 == 1)
        mod = jax.nn.silu(c) @ mod_w[l] + mod_b[l]
        shift, scale, gate = jnp.split(mod, 3, axis=-1)
        mod_c = jax.nn.silu(c_ctx) @ mod_w[l] + mod_b[l]
        shift_c, scale_c, gate_c = jnp.split(mod_c, 3, axis=-1)
        u_lat = rmsnorm(h_lat, norm_w[l]) * (1.0 + scale[:, None]) + shift[:, None]
        u_ctx = rmsnorm(h_ctx, norm_w[l]) * (1.0 + scale_c) + shift_c
        if col_major:
            u_lat = to_col_major(u_lat, rows)
        (z_c, xbc_c, dt_c, q_c, k_c, v_c, gg_c, lr_c, u5_c, sg_c) = split_in_proj(u_ctx @ w_in[l])
        (z_l, xbc_l, dt_l, q_l, k_l, v_l, gg_l, lr_l, u5_l, sg_l) = split_in_proj(u_lat @ w_in[l])
        ssd_c, ssd_l = ssd_branch(z_c, xbc_c, dt_c, z_l, xbc_l, dt_l, ssd_conv_w[l], ssd_conv_b[l],
                                  ssd_a_log[l], ssd_dt_bias[l], ssd_d[l], ssd_norm_w[l])
        gla_c, gla_l = gla_branch(q_c, k_c, v_c, lr_c, gg_c, q_l, k_l, v_l, lr_l, gg_l,
                                  gla_w_lr[l], gla_b_lr[l], gla_norm_w[l])
        s5_c, s5_l = s5_branch(u5_c, sg_c, u5_l, sg_l, s5_lam_re[l], s5_lam_im[l], s5_log_step[l],
                               s5_b_re[l], s5_b_im[l], s5_c_re[l], s5_c_im[l], s5_d[l],
                               s5_glu_w[l], s5_glu_b[l])
        out_lat = jnp.concatenate([ssd_l, gla_l, s5_l], axis=-1) @ w_out[l]
        if col_major:
            out_lat = from_col_major(out_lat, rows)
        h_lat = h_lat + gate[:, None] * out_lat
        if l < DEPTH - 1:
            out_ctx = jnp.concatenate([ssd_c, gla_c, s5_c], axis=-1) @ w_out[l]
            h_ctx = h_ctx + gate_c * out_ctx
    return rmsnorm(h_lat, final_norm_w)
```

```cpp
#include <hip/hip_runtime.h>
#include <hip/hip_cooperative_groups.h>
#include <cstdio>
namespace cg = cooperative_groups;

typedef unsigned short u16;
using bf16x8 = __attribute__((ext_vector_type(8))) short;
using bf16x4 = __attribute__((ext_vector_type(4))) short;
using f32x4 = __attribute__((ext_vector_type(4))) float;
using f32x16 = __attribute__((ext_vector_type(16))) float;
using u32x4 = __attribute__((ext_vector_type(4))) unsigned;
#define DI __device__ __forceinline__

constexpr int DM = 1024, NLAT = 32768, NCTX = 2048, NTOK = 34816, IND = 5184, MIXW = 2048;
constexpr int C_XBC = 1024, C_BM = 2048, C_CM = 2304, C_DT = 2560, C_Q = 2592, C_K = 2848, C_V = 3104, C_GG = 3616,
              C_LR = 4128, C_U5 = 4160, C_SG = 4672;
constexpr float EPSF = 1e-6f;
constexpr int SMEM_BYTES = 81920;
constexpr int NPHASE = 16;

constexpr size_t WS_P = 0;
constexpr size_t WS_Y = WS_P + (size_t)NTOK * IND * 2;
constexpr size_t WS_WIN = WS_Y + (size_t)NTOK * MIXW * 2;
constexpr size_t WS_WOUT = WS_WIN + (size_t)IND * DM * 2;
constexpr size_t WS_GLU = WS_WOUT + (size_t)DM * MIXW * 2;
constexpr size_t WS_HCTX = WS_GLU + (size_t)1024 * 512 * 2;
constexpr size_t WS_MOD = WS_HCTX + (size_t)NCTX * DM * 4;
constexpr size_t WS_SSQ = WS_MOD + (size_t)2 * 9 * 3072 * 4;
constexpr size_t WS_S5C = WS_SSQ + (size_t)NTOK * 16 * 4;
constexpr size_t WS_G5C = WS_S5C + (size_t)128 * 8704;
constexpr size_t WS_S5ST = WS_G5C + (size_t)NCTX * 512 * 2;
constexpr size_t WS_BAR = WS_S5ST + (size_t)512 * 128 * 4;
constexpr size_t WS_RS = WS_BAR + 16384;
constexpr size_t WS_END = WS_RS + (size_t)NTOK * 2 * 4;

struct Params {
  const float* in[29];
  float* out;
  unsigned char* ws;
  int ph_lo, ph_hi;
};

DI int opq(int i) { asm volatile("" : "+s"(i)); return i; }
DI int opaque_tid() { int t = threadIdx.x; asm volatile("" : "+v"(t)); return t; }
typedef __bf16 hbf16x2 __attribute__((ext_vector_type(2)));
typedef float hf32x2 __attribute__((ext_vector_type(2)));
DI u16 f2bf(float x) { __bf16 h = (__bf16)x; return __builtin_bit_cast(u16, h); }
DI float bf2f(u16 h) { return __uint_as_float(((unsigned)h) << 16); }
DI unsigned pack2(float a, float b) { hf32x2 v = {a, b}; return __builtin_bit_cast(unsigned, __builtin_convertvector(v, hbf16x2)); }
DI float bflo(unsigned v) { return __uint_as_float(v << 16); }
DI float bfhi(unsigned v) { return __uint_as_float(v & 0xffff0000u); }
DI float rcpf(float x) { return __builtin_amdgcn_rcpf(x); }
DI float siluf(float x) { return x * rcpf(1.f + __expf(-x)); }
DI float logsigf(float x) { return fminf(x, 0.f) - __logf(1.f + __expf(-fabsf(x))); }
DI float softplusf(float v) { return fmaxf(v, 0.f) + log1pf(__expf(-fabsf(v))); }
DI f32x4 mfma16(bf16x8 a, bf16x8 b, f32x4 c) { return __builtin_amdgcn_mfma_f32_16x16x32_bf16(a, b, c, 0, 0, 0); }
DI f32x16 mfma32(bf16x8 a, bf16x8 b, f32x16 c) { return __builtin_amdgcn_mfma_f32_32x32x16_bf16(a, b, c, 0, 0, 0); }
DI void wave_lds_sync() { asm volatile("s_waitcnt lgkmcnt(0)" ::: "memory"); }
DI unsigned pin(unsigned v) { asm volatile("" : "+v"(v)); return v; }
DI void pin4(u32x4& v) { asm volatile("" : "+v"(v)); }
#define DPPF(v, old, ctrl, rmask) __builtin_bit_cast(float, __builtin_amdgcn_update_dpp(__builtin_bit_cast(int, (float)(old)), __builtin_bit_cast(int, (float)(v)), (ctrl), (rmask), 0xf, false))
DI float row16_sum(float v) {
  v += DPPF(v, 0.f, 0xB1, 0xf);
  v += DPPF(v, 0.f, 0x4E, 0xf);
  v += DPPF(v, 0.f, 0x141, 0xf);
  v += DPPF(v, 0.f, 0x140, 0xf);
  return v;
}
DI float wave_incl_scan(float v) {
  v += DPPF(v, 0.f, 0x111, 0xf);
  v += DPPF(v, 0.f, 0x112, 0xf);
  v += DPPF(v, 0.f, 0x114, 0xf);
  v += DPPF(v, 0.f, 0x118, 0xf);
  v += DPPF(v, 0.f, 0x142, 0xa);
  v += DPPF(v, 0.f, 0x143, 0xc);
  return v;
}
DI bf16x8 ld8(const u16* p) { return *reinterpret_cast<const bf16x8*>(p); }
DI bf16x8 ld44(const u16* p0, const u16* p1) {
  bf16x4 a = *reinterpret_cast<const bf16x4*>(p0), b = *reinterpret_cast<const bf16x4*>(p1);
  return __builtin_shufflevector(a, b, 0, 1, 2, 3, 4, 5, 6, 7);
}
DI bf16x8 packacc(const f32x4& a, const f32x4& b) {
  uint4 u; u.x = pack2(a[0], a[1]); u.y = pack2(a[2], a[3]); u.z = pack2(b[0], b[1]); u.w = pack2(b[2], b[3]);
  return __builtin_bit_cast(bf16x8, u);
}

__device__ void phase_prep(const Params& p, unsigned char* smem) {
  float* sc = (float*)smem;
  float* red = sc + 9 * 1024;
  const int tid = opaque_tid();
  float* modb = (float*)(p.ws + WS_MOD);
  bool filled = false;
  for (int it = blockIdx.x; it < 96 + 128; it += gridDim.x) {
    if (it < 96) {
      if (!filled) {
        for (int idx = tid; idx < 9216; idx += 256) {
          int r = idx >> 10, k = idx & 1023;
          float v = r < 8 ? p.in[opq(1)][r * 1024 + k] : p.in[opq(3)][k];
          sc[idx] = siluf(v);
        }
        filled = true;
        __syncthreads();
      }
      const int l = it / 48, j0 = (it % 48) * 64, kg = tid >> 6, jj = tid & 63;
      float a[9];
#pragma unroll
      for (int r = 0; r < 9; ++r) a[r] = 0.f;
      const float* W = p.in[opq(5)] + (size_t)l * 1024 * 3072 + j0 + jj;
      for (int k = kg * 256; k < kg * 256 + 256; ++k) {
        float wv = W[(size_t)k * 3072];
#pragma unroll
        for (int r = 0; r < 9; ++r) a[r] += sc[r * 1024 + k] * wv;
      }
#pragma unroll
      for (int r = 0; r < 9; ++r) red[(kg * 9 + r) * 64 + jj] = a[r];
      __syncthreads();
      for (int idx = tid; idx < 576; idx += 256) {
        int r = idx >> 6, j = idx & 63;
        float s = red[(0 * 9 + r) * 64 + j] + red[(1 * 9 + r) * 64 + j] + red[(2 * 9 + r) * 64 + j] + red[(3 * 9 + r) * 64 + j];
        modb[(l * 9 + r) * 3072 + j0 + j] = s + p.in[opq(6)][l * 3072 + j0 + j];
      }
      __syncthreads();
    } else {
      const int q = it - 96, l = q >> 6, d = (q >> 5) & 1, g = q & 31;
      unsigned char* base = p.ws + WS_S5C + (size_t)q * 8704;
      u16* BbarM = (u16*)base;
      u16* CmT = (u16*)(base + 4096);
      float* lamb = (float*)(base + 8192);
      const float st = expf(p.in[opq(20)][(l * 2 + d) * 32 + g]);
      for (int idx = tid; idx < 1024; idx += 256) {
        const int pp = idx >> 4, hh = idx & 15;
        const int li = ((l * 2 + d) * 32 + g) * 64 + pp;
        const float lre = p.in[opq(18)][li], lim = p.in[opq(19)][li];
        const float a = lre * st, bb = lim * st;
        const float ea = expf(a), sn = sinf(bb), cs = cosf(bb), s2 = sinf(0.5f * bb);
        const float lbre = ea * cs, lbim = ea * sn;
        const float nre = expm1f(a) * cs - 2.f * s2 * s2, nim = lbim;
        const float den = lre * lre + lim * lim;
        const float cre = (nre * lre + nim * lim) / den, cim = (nim * lre - nre * lim) / den;
        const int bi = ((l * 32 + g) * 64 + pp) * 16 + hh;
        const float bre = p.in[opq(21)][bi], bim = p.in[opq(22)][bi];
        BbarM[(2 * pp) * 16 + hh] = f2bf(cre * bre - cim * bim);
        BbarM[(2 * pp + 1) * 16 + hh] = f2bf(cre * bim + cim * bre);
        const int cidx = (((l * 2 + d) * 32 + g) * 16 + hh) * 64 + pp;
        CmT[hh * 128 + 2 * pp] = f2bf(p.in[opq(23)][cidx]);
        CmT[hh * 128 + 2 * pp + 1] = f2bf(-p.in[opq(24)][cidx]);
        if (hh == 0) { lamb[2 * pp] = lbre; lamb[2 * pp + 1] = lbim; }
      }
    }
  }
}

__device__ void phase_pre(const Params& p, int l, unsigned char* smem) {
  const int tid = opaque_tid(), lane = tid & 63, w = tid >> 6;
  const float* hl = l == 0 ? p.in[opq(0)] : p.out;
  const float* hc = l == 0 ? p.in[opq(2)] : (const float*)(p.ws + WS_HCTX);
  const float* nw = p.in[opq(4)] + l * 1024;
  const float* modb = (const float*)(p.ws + WS_MOD) + l * 9 * 3072;
  u16* U = (u16*)(p.ws + WS_Y);
  const bool cm = (l & 1);
  for (int r = blockIdx.x * 4 + w; r < NTOK; r += gridDim.x * 4) {
    const float* src; const float* mrow;
    if (r < NLAT) {
      int b = r >> 12, sp = r & 4095;
      int s = cm ? (((sp & 63) << 6) | (sp >> 6)) : sp;
      src = hl + ((size_t)(b * 4096 + s)) * 1024; mrow = modb + b * 3072;
    } else { src = hc + (size_t)(r - NLAT) * 1024; mrow = modb + 8 * 3072; }
    float4 v[4]; float ss = 0.f;
#pragma unroll
    for (int q = 0; q < 4; ++q) {
      v[q] = *reinterpret_cast<const float4*>(src + lane * 4 + q * 256);
      ss += v[q].x * v[q].x + v[q].y * v[q].y + v[q].z * v[q].z + v[q].w * v[q].w;
    }
#pragma unroll
    for (int o = 32; o > 0; o >>= 1) ss += __shfl_xor(ss, o);
    const float rs = rsqrtf(ss * (1.f / 1024.f) + EPSF);
#pragma unroll
    for (int q = 0; q < 4; ++q) {
      const int col = lane * 4 + q * 256;
      float4 n4 = *reinterpret_cast<const float4*>(nw + col);
      float4 sh = *reinterpret_cast<const float4*>(mrow + col);
      float4 s4 = *reinterpret_cast<const float4*>(mrow + 1024 + col);
      float u0 = v[q].x * rs * n4.x * (1.f + s4.x) + sh.x;
      float u1 = v[q].y * rs * n4.y * (1.f + s4.y) + sh.y;
      float u2 = v[q].z * rs * n4.z * (1.f + s4.z) + sh.z;
      float u3 = v[q].w * rs * n4.w * (1.f + s4.w) + sh.w;
      uint2 o; o.x = pack2(u0, u1); o.y = pack2(u2, u3);
      *reinterpret_cast<uint2*>(U + (size_t)r * 1024 + col) = o;
    }
  }
  float* tile = (float*)smem;
  for (int t = blockIdx.x; t < 1296 + 512 + 128; t += gridDim.x) {
    const float* src; int sld, k0, n0, kind; u16* dst; int dld;
    if (t < 1296) { kind = 0; k0 = (t / 81) * 64; n0 = (t % 81) * 64; src = p.in[opq(7)] + (size_t)l * 1024 * IND; sld = IND; dst = (u16*)(p.ws + WS_WIN); dld = 1024; }
    else if (t < 1808) { int q = t - 1296; kind = 1; k0 = (q / 16) * 64; n0 = (q % 16) * 64; src = p.in[opq(8)] + (size_t)l * 2048 * 1024; sld = 1024; dst = (u16*)(p.ws + WS_WOUT); dld = 2048; }
    else { int q = t - 1808; kind = 2; k0 = (q / 16) * 64; n0 = (q % 16) * 64; src = p.in[opq(26)] + (size_t)l * 512 * 1024; sld = 1024; dst = (u16*)(p.ws + WS_GLU); dld = 512; }
    __syncthreads();
#pragma unroll
    for (int rr = 0; rr < 4; ++rr) {
      int i = (tid >> 4) + 16 * rr, j = (tid & 15) * 4;
      float4 v = *reinterpret_cast<const float4*>(src + (size_t)(k0 + i) * sld + n0 + j);
      if (kind == 1 && k0 + i < 1024) { float s = p.in[opq(14)][l * 1024 + k0 + i]; v.x *= s; v.y *= s; v.z *= s; v.w *= s; }
      tile[i * 65 + j] = v.x; tile[i * 65 + j + 1] = v.y; tile[i * 65 + j + 2] = v.z; tile[i * 65 + j + 3] = v.w;
    }
    __syncthreads();
#pragma unroll
    for (int rr = 0; rr < 2; ++rr) {
      int n = (tid >> 3) + 32 * rr, i0 = (tid & 7) * 8;
      uint4 o;
      o.x = pack2(tile[(i0 + 0) * 65 + n], tile[(i0 + 1) * 65 + n]);
      o.y = pack2(tile[(i0 + 2) * 65 + n], tile[(i0 + 3) * 65 + n]);
      o.z = pack2(tile[(i0 + 4) * 65 + n], tile[(i0 + 5) * 65 + n]);
      o.w = pack2(tile[(i0 + 6) * 65 + n], tile[(i0 + 7) * 65 + n]);
      int drow = n0 + n;
      if (kind == 2) { int o_ = n0 + n, half = o_ >> 9, rem = o_ & 511; drow = (rem >> 6) * 128 + ((rem & 63) >> 4) * 32 + half * 16 + (rem & 15); }
      *reinterpret_cast<uint4*>(dst + (size_t)drow * dld + k0 + i0) = o;
    }
  }
}

template <int BN, int MODE>
__device__ void gemm_tile(const Params& p, int l, const u16* __restrict__ A, int lda, const u16* __restrict__ Bt, int ldb,
                          int K, int m0, int n0, unsigned char* smem) {
  constexpr int WN = BN / 2, NF = WN / 16, NBL = BN * 8 / 256;
  u16* As = (u16*)smem;
  u16* Bs = As + 128 * 64;
  const int tid = opaque_tid(), lane = tid & 63, w = tid >> 6, wr = w >> 1, wc = w & 1, fr = lane & 15, fq = lane >> 4;
  f32x4 acc[4][NF];
#pragma unroll
  for (int m = 0; m < 4; ++m)
#pragma unroll
    for (int n = 0; n < NF; ++n) acc[m][n] = f32x4{0.f, 0.f, 0.f, 0.f};
  constexpr int STAGE = (128 + BN) * 64;
  u32x4 ra[4], rb[NBL];
  const int nk = K / 64;
#define GLOAD(KT) do { const int k0_ = (KT) * 64; \
    _Pragma("unroll") for (int i = 0; i < 4; ++i) { int id = tid + 256 * i; ra[i] = *reinterpret_cast<const u32x4*>(A + (size_t)(m0 + (id >> 3)) * lda + k0_ + (id & 7) * 8); } \
    _Pragma("unroll") for (int i = 0; i < NBL; ++i) { int id = tid + 256 * i; rb[i] = *reinterpret_cast<const u32x4*>(Bt + (size_t)(n0 + (id >> 3)) * ldb + k0_ + (id & 7) * 8); } } while (0)
#define LSTORE(OFF) do { \
    _Pragma("unroll") for (int i = 0; i < 4; ++i) { int id = tid + 256 * i; *reinterpret_cast<u32x4*>(As + (OFF) + (id >> 3) * 64 + (((id & 7) ^ ((id >> 4) & 7)) * 8)) = ra[i]; } \
    _Pragma("unroll") for (int i = 0; i < NBL; ++i) { int id = tid + 256 * i; *reinterpret_cast<u32x4*>(Bs + (OFF) + (id >> 3) * 64 + (((id & 7) ^ ((id >> 4) & 7)) * 8)) = rb[i]; } } while (0)
#define COMPUTE(OFF) do { \
    _Pragma("unroll") for (int kk = 0; kk < 2; ++kk) { \
      bf16x8 af[4], bfr[NF]; \
      _Pragma("unroll") for (int m = 0; m < 4; ++m) af[m] = ld8(As + (OFF) + (wr * 64 + m * 16 + fr) * 64 + (((kk * 4 + fq) ^ (fr >> 1)) * 8)); \
      _Pragma("unroll") for (int n = 0; n < NF; ++n) bfr[n] = ld8(Bs + (OFF) + (wc * WN + n * 16 + fr) * 64 + (((kk * 4 + fq) ^ (fr >> 1)) * 8)); \
      __builtin_amdgcn_s_setprio(1); \
      _Pragma("unroll") for (int m = 0; m < 4; ++m) \
        _Pragma("unroll") for (int n = 0; n < NF; ++n) acc[m][n] = mfma16(bfr[n], af[m], acc[m][n]);     \
      __builtin_amdgcn_s_setprio(0); } } while (0)
  float f0[4], f1[4];
  if constexpr (MODE == 2) {
    const float* rsb = (const float*)(p.ws + WS_RS);
#pragma unroll
    for (int m = 0; m < 4; ++m) {
      const float2 r2 = *reinterpret_cast<const float2*>(rsb + (size_t)(m0 + wr * 64 + m * 16 + fr) * 2);
      f0[m] = r2.x * rcpf(r2.y); f1[m] = r2.y;
    }
  }
  GLOAD(0);
  __syncthreads();
  LSTORE(0);
  if (nk > 1) GLOAD(1);
  __syncthreads();
  for (int kt = 0; kt < nk; ++kt) {
    const int cur = (kt & 1) * STAGE, nxt = STAGE - cur;
    COMPUTE(cur);
    if constexpr (MODE == 2) {
      if (kt == 7 || kt == 15) {
#pragma unroll
        for (int m = 0; m < 4; ++m)
#pragma unroll
          for (int n = 0; n < NF; ++n)
#pragma unroll
            for (int j = 0; j < 4; ++j) acc[m][n][j] *= (kt == 7) ? f0[m] : f1[m];
      }
    }
    if (kt + 1 < nk) {
      LSTORE(nxt);
      if (kt + 2 < nk) GLOAD(kt + 2);
    }
    __syncthreads();
  }
#undef GLOAD
#undef LSTORE
#undef COMPUTE
  if constexpr (MODE == 0) {
    u16* P = (u16*)(p.ws + WS_P);
    constexpr int SLD = WN + 8;
    u16* stg = (u16*)smem + w * 16 * SLD;
    constexpr int CPR = WN / 8;
    __syncthreads();
#pragma unroll
    for (int m = 0; m < 4; ++m) {
      wave_lds_sync();
#pragma unroll
      for (int n = 0; n < NF; ++n) {
        uint2 o; o.x = pack2(acc[m][n][0], acc[m][n][1]); o.y = pack2(acc[m][n][2], acc[m][n][3]);
        *reinterpret_cast<uint2*>(stg + fr * SLD + n * 16 + fq * 4) = o;
      }
      wave_lds_sync();
      for (int id = lane; id < 16 * CPR; id += 64) {
        int row = id / CPR, ch = id % CPR;
        uint4 v = *reinterpret_cast<const uint4*>(stg + row * SLD + ch * 8);
        *reinterpret_cast<uint4*>(P + (size_t)(m0 + wr * 64 + m * 16 + row) * IND + n0 + wc * WN + ch * 8) = v;
      }
    }
  } else if constexpr (MODE == 1) {
    const u16* P = (const u16*)(p.ws + WS_P);
    u16* Y = (u16*)(p.ws + WS_Y);
    const float* gb = p.in[opq(27)] + l * 1024;
    const int tn = n0 >> 7;
#pragma unroll
    for (int q = 0; q < 2; ++q) {
      const int oc = tn * 64 + (wc * 2 + q) * 16 + fq * 4;
      const f32x4 b0 = *reinterpret_cast<const f32x4*>(gb + oc), b1 = *reinterpret_cast<const f32x4*>(gb + 512 + oc);
#pragma unroll
      for (int m = 0; m < 4; ++m) {
        const size_t row = (size_t)(m0 + wr * 64 + m * 16 + fr);
        const uint2 sgv = *reinterpret_cast<const uint2*>(P + row * IND + C_SG + oc);
        const float sg[4] = {bflo(sgv.x), bfhi(sgv.x), bflo(sgv.y), bfhi(sgv.y)};
        float y[4];
#pragma unroll
        for (int j = 0; j < 4; ++j) {
          const float val = acc[m][2 * q][j] + b0[j], gt = acc[m][2 * q + 1][j] + b1[j];
          y[j] = val * rcpf(1.f + __expf(-gt)) * siluf(sg[j]);
        }
        uint2 o; o.x = pack2(y[0], y[1]); o.y = pack2(y[2], y[3]);
        *reinterpret_cast<uint2*>(Y + row * MIXW + 1536 + oc) = o;
      }
    }
  } else {
    const float* modb = (const float*)(p.ws + WS_MOD) + l * 9 * 3072;
    const bool cm = (l & 1);
    const float* hs = l == 0 ? p.in[opq(0)] : p.out;
    float* stg = (float*)smem + w * (16 * 68);
    __syncthreads();
#pragma unroll
    for (int m = 0; m < 4; ++m) {
#pragma unroll
      for (int n = 0; n < NF; ++n) *reinterpret_cast<f32x4*>(stg + fr * 68 + n * 16 + fq * 4) = acc[m][n];
      wave_lds_sync();
#pragma unroll
      for (int k = 0; k < 4; ++k) {
        const int id = lane + 64 * k, rowi = id >> 4, ch = id & 15;
        const f32x4 a = *reinterpret_cast<const f32x4*>(stg + rowi * 68 + ch * 4);
        const int r = m0 + wr * 64 + m * 16 + rowi, col = n0 + wc * WN + ch * 4;
        const float* src; float* dst; const float* gt;
        if (r < NLAT) {
          const int b = r >> 12, sp = r & 4095;
          const int sq = cm ? (((sp & 63) << 6) | (sp >> 6)) : sp;
          const size_t idx = ((size_t)(b * 4096 + sq)) * 1024 + col;
          src = hs + idx; dst = p.out + idx; gt = modb + b * 3072 + 2048 + col;
        } else {
          const size_t idx = (size_t)(r - NLAT) * 1024 + col;
          src = p.in[opq(2)] + idx; dst = (float*)(p.ws + WS_HCTX) + idx; gt = modb + 8 * 3072 + 2048 + col;
        }
        const f32x4 h = *reinterpret_cast<const f32x4*>(src), gv = *reinterpret_cast<const f32x4*>(gt);
        f32x4 o;
        o[0] = h[0] + gv[0] * a[0]; o[1] = h[1] + gv[1] * a[1]; o[2] = h[2] + gv[2] * a[2]; o[3] = h[3] + gv[3] * a[3];
        *reinterpret_cast<f32x4*>(dst) = o;
      }
      wave_lds_sync();
    }
  }
  __syncthreads();
}

__device__ void phase_conv(const Params& p, int l) {
  u16* P = (u16*)(p.ws + WS_P);
  const float* cw = p.in[opq(9)] + (size_t)l * 5 * 1536;
  const float* cb = p.in[opq(10)] + l * 1536;
  const int tid = opaque_tid(), cq = tid & 7, sgi = tid >> 3;
  for (int it = blockIdx.x; it < 768; it += gridDim.x) {
    const bool isctx = it >= 384;
    const int q = isctx ? it - 384 : it, b = q / 48, cgp = q % 48;
    const int L = isctx ? 256 : 4096, seg = L / 32, rowbase = isctx ? NLAT + b * 256 : b * 4096;
    const int ch = cgp * 32 + cq * 4;
    float4 wk[5];
#pragma unroll
    for (int k = 0; k < 5; ++k) wk[k] = *reinterpret_cast<const float4*>(cw + k * 1536 + ch);
    const float4 bias = *reinterpret_cast<const float4*>(cb + ch);
    u16* rp = P + (size_t)rowbase * IND + C_XBC + ch;
    const int a = sgi * seg;
    auto ld = [&](int sp) -> float4 {
      float4 r = make_float4(0.f, 0.f, 0.f, 0.f);
      if (sp >= 0 && sp < L) {
        uint2 v = *reinterpret_cast<const uint2*>(rp + (size_t)sp * IND);
        r.x = bflo(v.x); r.y = bfhi(v.x); r.z = bflo(v.y); r.w = bfhi(v.y);
      }
      return r;
    };
    float4 r0 = ld(a - 2), r1 = ld(a - 1), r2 = ld(a), r3 = ld(a + 1);
    const float4 e0 = ld(a + seg), e1 = ld(a + seg + 1);
    __syncthreads();
    auto ldraw = [&](int sp) -> uint2 {
      uint2 v = make_uint2(0u, 0u);
      if (sp < a + seg) v = *reinterpret_cast<const uint2*>(rp + (size_t)sp * IND);
      return v;
    };
    uint2 nraw[8];
#pragma unroll
    for (int j = 0; j < 8; ++j) nraw[j] = ldraw(a + 2 + j);
    for (int t0 = a; t0 < a + seg; t0 += 8) {
      uint2 cur[8];
#pragma unroll
      for (int j = 0; j < 8; ++j) cur[j] = nraw[j];
      if (t0 + 8 < a + seg) {
#pragma unroll
        for (int j = 0; j < 8; ++j) nraw[j] = ldraw(t0 + 10 + j);
      }
#pragma unroll
      for (int j = 0; j < 8; ++j) {
        const int sp = t0 + 2 + j;
        float4 r4;
        if (sp < a + seg) {
          const unsigned c0_ = pin(cur[j].x), c1_ = pin(cur[j].y);
          r4 = make_float4(bflo(c0_), bfhi(c0_), bflo(c1_), bfhi(c1_));
        } else r4 = (sp == a + seg) ? e0 : e1;
        float o0 = bias.x + wk[0].x * r0.x + wk[1].x * r1.x + wk[2].x * r2.x + wk[3].x * r3.x + wk[4].x * r4.x;
        float o1 = bias.y + wk[0].y * r0.y + wk[1].y * r1.y + wk[2].y * r2.y + wk[3].y * r3.y + wk[4].y * r4.y;
        float o2 = bias.z + wk[0].z * r0.z + wk[1].z * r1.z + wk[2].z * r2.z + wk[3].z * r3.z + wk[4].z * r4.z;
        float o3 = bias.w + wk[0].w * r0.w + wk[1].w * r1.w + wk[2].w * r2.w + wk[3].w * r3.w + wk[4].w * r4.w;
        uint2 o; o.x = pack2(siluf(o0), siluf(o1)); o.y = pack2(siluf(o2), siluf(o3));
        *reinterpret_cast<uint2*>(rp + (size_t)(t0 + j) * IND) = o;
        r0 = r1; r1 = r2; r2 = r3; r3 = r4;
      }
    }
    __syncthreads();
  }
}


__device__ void ssd_item(const Params& p, int l, int part, int item, unsigned char* smem) {
  u16* Bs = (u16*)smem;
  u16* Ms = Bs;
  u16* Cs = (u16*)(smem + 17408);
  u16* BT = (u16*)(smem + 34816);
  u16* xT = (u16*)(smem + 53248);
  u16* xwT = (u16*)(smem + 62464);
  float* dts = (float*)(smem + 71680);
  float* acs = dts + 64;
  float* wts = acs + 64;
  float* ssql = wts + 64;
  float* tots = ssql + 256;
  u16* ystg = (u16*)(smem + 73600);
  const int tid0 = opaque_tid();
  const int b = item >> 5, hd = (item >> 1) & 15, dir = item & 1, g = hd >> 3;
  u16* P = (u16*)(p.ws + WS_P);
  u16* Y = (u16*)(p.ws + WS_Y);
  float* ssq = (float*)(p.ws + WS_SSQ);
  float* stsave = (float*)(p.ws + WS_WIN) + (size_t)item * 8192;
  const float Dsk = p.in[opq(13)][l * 16 + hd];
  f32x4 hacc[8];
  if (part == 1) {
#pragma unroll
    for (int i = 0; i < 8; ++i) hacc[i] = *reinterpret_cast<const f32x4*>(stsave + (i * 256 + tid0) * 4);
  } else {
#pragma unroll
    for (int i = 0; i < 8; ++i) hacc[i] = f32x4{0.f, 0.f, 0.f, 0.f};
  }
  const int nseg = part == 0 ? 3 : 1;
  for (int seg = 0; seg < nseg; ++seg) {
    bool isctx; int sdir, ci0, ci1, mode;
    if (part == 1) { isctx = false; sdir = dir; ci0 = 32; ci1 = 64; mode = 2; }
    else if (seg == 0) { if (!(dir == 0 && l == 0)) continue; isctx = true; sdir = 1; ci0 = 0; ci1 = 4; mode = 1; }
    else if (seg == 1) { isctx = true; sdir = dir; ci0 = 0; ci1 = 4; mode = (dir == 0 && l == 0) ? 2 : 0; }
    else { isctx = false; sdir = dir; ci0 = 0; ci1 = 32; mode = 1; }
    if (part == 0 && seg <= 1) {
#pragma unroll
      for (int i = 0; i < 8; ++i) hacc[i] = f32x4{0.f, 0.f, 0.f, 0.f};
    }
    __threadfence();
    __syncthreads();
    const float aneg = -expf(p.in[opq(11)][(l * 2 + sdir) * 16 + hd]);
    const float dtb = p.in[opq(12)][(l * 2 + sdir) * 16 + hd];
    const int nch = isctx ? 4 : 64;
    const int rowbase = isctx ? NLAT + b * 256 : b * 4096;
#pragma unroll
    for (int i = 0; i < 8; ++i) asm volatile("" : "+v"(hacc[i]));
    u32x4 rx[2], rbm[4], rcm[4];
    unsigned rawdt = 0u;
    {
      const int tid = tid0, lane = tid & 63, w = tid >> 6;
      const int cL = (sdir ? nch - 1 - ci0 : ci0) * 64;
#pragma unroll
      for (int k = 0; k < 2; ++k) {
        const int id = tid + 256 * k, pch = id >> 6, i = id & 63;
        const int tau = sdir ? cL + 63 - i : cL + i;
        rx[k] = *reinterpret_cast<const u32x4*>(P + (size_t)(rowbase + tau) * IND + C_XBC + hd * 64 + pch * 8);
      }
#pragma unroll
      for (int k = 0; k < 4; ++k) {
        const int id = tid + 256 * k, nc = id >> 6, i = id & 63;
        const int tau = sdir ? cL + 63 - i : cL + i;
        rbm[k] = *reinterpret_cast<const u32x4*>(P + (size_t)(rowbase + tau) * IND + C_BM + g * 128 + nc * 8);
      }
#pragma unroll
      for (int k = 0; k < 4; ++k) {
        const int id = tid + 256 * k, i = id >> 4, nc = id & 15;
        const int tau = sdir ? cL + 63 - i : cL + i;
        rcm[k] = *reinterpret_cast<const u32x4*>(P + (size_t)(rowbase + tau) * IND + C_CM + g * 128 + nc * 8);
      }
      rawdt = P[(size_t)(rowbase + (sdir ? cL + 63 - lane : cL + lane)) * IND + C_DT + sdir * 16 + hd];
    }
    for (int ci = ci0; ci < ci1; ++ci) {
      const int c0 = (sdir ? nch - 1 - ci : ci) * 64;
      int tid = tid0;
      asm volatile("" : "+v"(tid));
      const int lane = tid & 63, w = tid >> 6, fr = lane & 15, fq = lane >> 4;
      __syncthreads();
      if (w == 0) {
        float dt = softplusf(bflo(pin(rawdt)) + dtb);
        const float cs = wave_incl_scan(dt * aneg);
        const float tot = __builtin_bit_cast(float, __builtin_amdgcn_readlane(__builtin_bit_cast(int, cs), 63));
        dts[lane] = dt; acs[lane] = cs; wts[lane] = __expf(tot - cs);
        if (lane == 0) tots[0] = tot;
      }
      pin4(rbm[0]); pin4(rbm[1]); pin4(rbm[2]); pin4(rbm[3]);
#pragma unroll
      for (int k = 0; k < 4; ++k) {
        const int id = tid + 256 * k, nc = id >> 6, i = id & 63;
        *reinterpret_cast<u32x4*>(Bs + i * 136 + nc * 8) = rbm[k];
#pragma unroll
        for (int e = 0; e < 4; ++e) {
          BT[(nc * 8 + 2 * e) * 72 + i] = (u16)(rbm[k][e] & 0xffffu);
          BT[(nc * 8 + 2 * e + 1) * 72 + i] = (u16)(rbm[k][e] >> 16);
        }
      }
#pragma unroll
      for (int k = 0; k < 4; ++k) {
        const int id = tid + 256 * k, i = id >> 4, nc = id & 15;
        *reinterpret_cast<u32x4*>(Cs + i * 136 + nc * 8) = rcm[k];
      }
      __syncthreads();
      pin4(rx[0]); pin4(rx[1]);
#pragma unroll
      for (int k = 0; k < 2; ++k) {
        const int id = tid + 256 * k, pch = id >> 6, i = id & 63;
        const float dt = dts[i], wt = wts[i];
#pragma unroll
        for (int e = 0; e < 4; ++e) {
          float x0 = bflo(rx[k][e]) * dt, x1 = bfhi(rx[k][e]) * dt;
          xT[(pch * 8 + 2 * e) * 72 + i] = f2bf(x0); xT[(pch * 8 + 2 * e + 1) * 72 + i] = f2bf(x1);
          xwT[(pch * 8 + 2 * e) * 72 + i] = f2bf(x0 * wt); xwT[(pch * 8 + 2 * e + 1) * 72 + i] = f2bf(x1 * wt);
        }
      }
      u32x4 tmpv[2] = {u32x4{0u, 0u, 0u, 0u}, u32x4{0u, 0u, 0u, 0u}};
      uint2 zr[4];
#pragma unroll
      for (int e = 0; e < 4; ++e) zr[e] = make_uint2(0u, 0u);
      if (mode == 2) {
        const int qs = (w * 4 + fq) * 16 + (15 - fr);
        const u16* tp = Y + (size_t)(rowbase + c0 + (qs >> 2)) * MIXW + hd * 64 + (qs & 3) * 16;
        tmpv[0] = *reinterpret_cast<const u32x4*>(tp); tmpv[1] = *reinterpret_cast<const u32x4*>(tp + 8);
#pragma unroll
        for (int tt = 0; tt < 4; ++tt) {
          const int t = tt * 16 + fr;
          const size_t row = (size_t)(rowbase + (sdir ? c0 + 63 - t : c0 + t));
          zr[tt] = *reinterpret_cast<const uint2*>(P + row * IND + hd * 64 + w * 16 + fq * 4);
        }
      }
      if (ci + 1 < ci1) {
        const int cL = (sdir ? nch - 2 - ci : ci + 1) * 64;
#pragma unroll
        for (int k = 0; k < 2; ++k) {
          const int id = tid + 256 * k, pch = id >> 6, i = id & 63;
          const int tau = sdir ? cL + 63 - i : cL + i;
          rx[k] = *reinterpret_cast<const u32x4*>(P + (size_t)(rowbase + tau) * IND + C_XBC + hd * 64 + pch * 8);
        }
#pragma unroll
        for (int k = 0; k < 4; ++k) {
          const int id = tid + 256 * k, nc = id >> 6, i = id & 63;
          const int tau = sdir ? cL + 63 - i : cL + i;
          rbm[k] = *reinterpret_cast<const u32x4*>(P + (size_t)(rowbase + tau) * IND + C_BM + g * 128 + nc * 8);
        }
#pragma unroll
        for (int k = 0; k < 4; ++k) {
          const int id = tid + 256 * k, i = id >> 4, nc = id & 15;
          const int tau = sdir ? cL + 63 - i : cL + i;
          rcm[k] = *reinterpret_cast<const u32x4*>(P + (size_t)(rowbase + tau) * IND + C_CM + g * 128 + nc * 8);
        }
        rawdt = P[(size_t)(rowbase + (sdir ? cL + 63 - lane : cL + lane)) * IND + C_DT + sdir * 16 + hd];
      }
      __syncthreads();
      f32x4 gacc[4];
#pragma unroll
      for (int i = 0; i < 4; ++i) gacc[i] = f32x4{0.f, 0.f, 0.f, 0.f};
#pragma unroll
      for (int kk = 0; kk < 4; ++kk) {
        bf16x8 a = ld8(Bs + (w * 16 + fr) * 136 + kk * 32 + fq * 8);
#pragma unroll
        for (int tb = 0; tb < 4; ++tb) {
          bf16x8 bb = ld8(Cs + (tb * 16 + fr) * 136 + kk * 32 + fq * 8);
          gacc[tb] = mfma16(a, bb, gacc[tb]);
        }
      }
      asm volatile("" : "+v"(tmpv[0]), "+v"(tmpv[1]));
      __syncthreads();
#pragma unroll
      for (int tb = 0; tb < 4; ++tb) {
        const int t = tb * 16 + fr;
        const float at = acs[t];
        float mv[4];
#pragma unroll
        for (int j = 0; j < 4; ++j) {
          const int s = w * 16 + fq * 4 + j;
          mv[j] = (s <= t) ? gacc[tb][j] * __expf(at - acs[s]) : 0.f;
        }
        uint2 o; o.x = pack2(mv[0], mv[1]); o.y = pack2(mv[2], mv[3]);
        *reinterpret_cast<uint2*>(Ms + t * 72 + w * 16 + fq * 4) = o;
      }
      f32x4 yd[4], yo[4];
#pragma unroll
      for (int i = 0; i < 4; ++i) { yd[i] = f32x4{0.f, 0.f, 0.f, 0.f}; yo[i] = f32x4{0.f, 0.f, 0.f, 0.f}; }
#pragma unroll
      for (int kk = 0; kk < 4; ++kk) {
        bf16x8 hb = packacc(hacc[2 * kk], hacc[2 * kk + 1]);
#pragma unroll
        for (int tt = 0; tt < 4; ++tt) {
          const u16* cr = Cs + (tt * 16 + fr) * 136 + fq * 4;
          bf16x8 a = ld44(cr + (2 * kk) * 16, cr + (2 * kk + 1) * 16);
          yo[tt] = mfma16(hb, a, yo[tt]);
        }
      }
      const float etot = __expf(tots[0]);
#pragma unroll
      for (int nb = 0; nb < 8; ++nb) { hacc[nb][0] *= etot; hacc[nb][1] *= etot; hacc[nb][2] *= etot; hacc[nb][3] *= etot; }
#pragma unroll
      for (int kk = 0; kk < 2; ++kk) {
        bf16x8 bb = ld8(xwT + (w * 16 + fr) * 72 + kk * 32 + fq * 8);
#pragma unroll
        for (int nb = 0; nb < 8; ++nb) {
          bf16x8 a = ld8(BT + (nb * 16 + fr) * 72 + kk * 32 + fq * 8);
          hacc[nb] = mfma16(a, bb, hacc[nb]);
        }
      }
      __syncthreads();
#pragma unroll
      for (int kk = 0; kk < 2; ++kk) {
        bf16x8 bb = ld8(xT + (w * 16 + fr) * 72 + kk * 32 + fq * 8);
#pragma unroll
        for (int tt = 0; tt < 4; ++tt) {
          bf16x8 a = ld8(Ms + (tt * 16 + fr) * 72 + kk * 32 + fq * 8);
          yd[tt] = mfma16(bb, a, yd[tt]);
        }
      }
      if (mode != 0) {
        float ea[4];
#pragma unroll
        for (int tt = 0; tt < 4; ++tt) ea[tt] = __expf(acs[tt * 16 + fr]);
        if (mode == 1) {
          u32x4 o0, o1;
#pragma unroll
          for (int tt = 0; tt < 4; ++tt) {
            float v[4];
#pragma unroll
            for (int j = 0; j < 4; ++j) v[j] = yd[tt][j] + ea[tt] * yo[tt][j];
            const unsigned a2 = pack2(v[0], v[1]), b2 = pack2(v[2], v[3]);
            if (tt == 0) { o0[0] = a2; o0[1] = b2; } else if (tt == 1) { o0[2] = a2; o0[3] = b2; }
            else if (tt == 2) { o1[0] = a2; o1[1] = b2; } else { o1[2] = a2; o1[3] = b2; }
          }
          const int qs = (w * 4 + fq) * 16 + fr;
          u16* tp = Y + (size_t)(rowbase + c0 + (qs >> 2)) * MIXW + hd * 64 + (qs & 3) * 16;
          *reinterpret_cast<u32x4*>(tp) = o0; *reinterpret_cast<u32x4*>(tp + 8) = o1;
        } else {
          float xsv[16], rdt[4], val[16];
#pragma unroll
          for (int tt = 0; tt < 4; ++tt) {
            rdt[tt] = rcpf(dts[tt * 16 + fr]);
#pragma unroll
            for (int j = 0; j < 4; ++j) xsv[tt * 4 + j] = bf2f(xT[(w * 16 + fq * 4 + j) * 72 + tt * 16 + fr]);
          }
          float sq[4];
#pragma unroll
          for (int tt = 0; tt < 4; ++tt) {
            const int t = tt * 16 + fr;
            const uint2 zw = zr[tt];
            const unsigned z01 = pin(zw.x), z23 = pin(zw.y);
            const float zz[4] = {bflo(z01), bfhi(z01), bflo(z23), bfhi(z23)};
            const int et = 3 - tt;
            const unsigned p01 = tmpv[et >> 1][(et & 1) * 2], p23 = tmpv[et >> 1][(et & 1) * 2 + 1];
            const float yf[4] = {bflo(p01), bfhi(p01), bflo(p23), bfhi(p23)};
            float s2 = 0.f;
#pragma unroll
            for (int j = 0; j < 4; ++j) {
              const float yv = yd[tt][j] + ea[tt] * yo[tt][j];
              const float vv = (yf[j] + yv + Dsk * xsv[tt * 4 + j] * rdt[tt]) * siluf(zz[j]);
              val[tt * 4 + j] = vv; s2 += vv * vv;
            }
            sq[tt] = s2;
            uint2 o; o.x = pack2(val[tt * 4], val[tt * 4 + 1]); o.y = pack2(val[tt * 4 + 2], val[tt * 4 + 3]);
            const int c = w * 2 + (fq >> 1);
            *reinterpret_cast<uint2*>(ystg + t * 64 + ((c ^ ((t >> 2) & 7)) << 3) + (fq & 1) * 4) = o;
          }
#pragma unroll
          for (int tt = 0; tt < 4; ++tt) {
            sq[tt] += __shfl_xor(sq[tt], 16); sq[tt] += __shfl_xor(sq[tt], 32);
          }
          if (fq == 0) {
#pragma unroll
            for (int tt = 0; tt < 4; ++tt) ssql[w * 64 + tt * 16 + fr] = sq[tt];
          }
          __syncthreads();
#pragma unroll
          for (int k = 0; k < 2; ++k) {
            const int id = tid + 256 * k, t = id >> 3, c = id & 7;
            const u32x4 v = *reinterpret_cast<const u32x4*>(ystg + t * 64 + ((c ^ ((t >> 2) & 7)) << 3));
            const size_t row = (size_t)(rowbase + (sdir ? c0 + 63 - t : c0 + t));
            *reinterpret_cast<u32x4*>(Y + row * MIXW + hd * 64 + c * 8) = v;
          }
          if (tid < 64) {
            const size_t row = (size_t)(rowbase + (sdir ? c0 + 63 - tid : c0 + tid));
            ssq[row * 16 + hd] = ssql[tid] + ssql[64 + tid] + ssql[128 + tid] + ssql[192 + tid];
          }
        }
      }
    }
  }
  if (part == 0) {
#pragma unroll
    for (int i = 0; i < 8; ++i) *reinterpret_cast<f32x4*>(stsave + (i * 256 + tid0) * 4) = hacc[i];
  }
}

__device__ void gla_item(const Params& p, int l, int part, int item, unsigned char* smem) {
  u16* qe = (u16*)smem;
  u16* ke = (u16*)(smem + 9216);
  u16* kdT = (u16*)(smem + 18432);
  u16* vT = (u16*)(smem + 27648);
  u16* at = (u16*)(smem + 46080);
  float* gl = (float*)(smem + 55296);
  float* red = (float*)(smem + 71936);
  const int tid0 = opaque_tid();
  const int b = item >> 3, h = (item >> 1) & 3, dir = item & 1;
  u16* P = (u16*)(p.ws + WS_P);
  u16* Y = (u16*)(p.ws + WS_Y);
  float* stsave = (float*)(p.ws + WS_WIN) + (size_t)(256 + item) * 8192;
  f32x4 sacc[4][2];
  if (part == 1) {
#pragma unroll
    for (int i = 0; i < 8; ++i) sacc[i >> 1][i & 1] = *reinterpret_cast<const f32x4*>(stsave + (i * 256 + tid0) * 4);
  } else {
#pragma unroll
    for (int i = 0; i < 8; ++i) sacc[i >> 1][i & 1] = f32x4{0.f, 0.f, 0.f, 0.f};
  }
  const int nseg = part == 0 ? 3 : 1;
  for (int seg = 0; seg < nseg; ++seg) {
    bool isctx; int sdir, ci0, ci1, mode;
    if (part == 1) { isctx = false; sdir = dir; ci0 = 32; ci1 = 64; mode = 2; }
    else if (seg == 0) { if (!(dir == 0 && l == 0)) continue; isctx = true; sdir = 1; ci0 = 0; ci1 = 4; mode = 1; }
    else if (seg == 1) { isctx = true; sdir = dir; ci0 = 0; ci1 = 4; mode = (dir == 0 && l == 0) ? 2 : 0; }
    else { isctx = false; sdir = dir; ci0 = 0; ci1 = 32; mode = 1; }
    if (part == 0 && seg <= 1) {
#pragma unroll
      for (int i = 0; i < 8; ++i) sacc[i >> 1][i & 1] = f32x4{0.f, 0.f, 0.f, 0.f};
    }
    __threadfence();
    __syncthreads();
    const int nch = isctx ? 4 : 64;
    const int rowbase = isctx ? NLAT + b * 256 : b * 4096;
#pragma unroll
    for (int i = 0; i < 8; ++i) asm volatile("" : "+v"(sacc[i >> 1][i & 1]));
    u32x4 rq[2], rk[2], rv[4], rlr;
    bf16x8 Bw;
    float bl;
    {
      const int tid = tid0;
      const int dcol = h * 64 + 32 * ((tid >> 6) & 1) + (tid & 31), kb = 8 * ((tid & 63) >> 5);
      const float* wlp = p.in[opq(15)] + ((size_t)((l * 2 + sdir) * 16 + kb)) * 256 + dcol;
      u32x4 bw;
#pragma unroll
      for (int e = 0; e < 4; ++e) bw[e] = pack2(wlp[(2 * e) * 256], wlp[(2 * e + 1) * 256]);
      Bw = __builtin_bit_cast(bf16x8, bw);
      bl = p.in[opq(16)][(l * 2 + sdir) * 256 + dcol];
      asm volatile("" : "+v"(Bw), "+v"(bl));
      const int cL = (sdir ? nch - 1 - ci0 : ci0) * 64;
#pragma unroll
      for (int k = 0; k < 2; ++k) {
        const int id = tid + 256 * k, i = id >> 3, dc = id & 7;
        const int tau = sdir ? cL + 63 - i : cL + i;
        rq[k] = *reinterpret_cast<const u32x4*>(P + (size_t)(rowbase + tau) * IND + C_Q + h * 64 + dc * 8);
      }
#pragma unroll
      for (int k = 0; k < 2; ++k) {
        const int id = tid + 256 * k, dc = id >> 6, i = id & 63;
        const int tau = sdir ? cL + 63 - i : cL + i;
        rk[k] = *reinterpret_cast<const u32x4*>(P + (size_t)(rowbase + tau) * IND + C_K + h * 64 + dc * 8);
      }
#pragma unroll
      for (int k = 0; k < 4; ++k) {
        const int id = tid + 256 * k, ec = id >> 6, i = id & 63;
        const int tau = sdir ? cL + 63 - i : cL + i;
        rv[k] = *reinterpret_cast<const u32x4*>(P + (size_t)(rowbase + tau) * IND + C_V + h * 128 + ec * 8);
      }
      {
        const int i = 32 * (tid >> 7) + (tid & 31), hf = (tid & 63) >> 5;
        const int tau = sdir ? cL + 63 - i : cL + i;
        rlr = *reinterpret_cast<const u32x4*>(P + (size_t)(rowbase + tau) * IND + C_LR + sdir * 16 + hf * 8);
      }
    }
    for (int ci = ci0; ci < ci1; ++ci) {
      const int c0 = (sdir ? nch - 1 - ci : ci) * 64;
      int tid = tid0;
      asm volatile("" : "+v"(tid));
      const int lane = tid & 63, w = tid >> 6, fr = lane & 15, fq = lane >> 4, d = tid & 63, iq = tid >> 6;
      __syncthreads();
      pin4(rlr);
      {
        const int th = w >> 1, dh = w & 1;
        f32x16 z;
#pragma unroll
        for (int r = 0; r < 16; ++r) z[r] = 0.f;
        const f32x16 lg = mfma32(__builtin_bit_cast(bf16x8, rlr), Bw, z);
#pragma unroll
        for (int r = 0; r < 16; ++r) {
          const int t = 32 * th + (r & 3) + 8 * (r >> 2) + 4 * (lane >> 5);
          gl[t * 65 + 32 * dh + (lane & 31)] = logsigf(lg[r] + bl) * (1.f / 16.f);
        }
      }
      __syncthreads();
      {
        float vals[16];
#pragma unroll
        for (int ii = 0; ii < 16; ++ii) vals[ii] = gl[(iq * 16 + ii) * 65 + d];
        float run = 0.f;
#pragma unroll
        for (int ii = 0; ii < 16; ++ii) { run += vals[ii]; gl[(iq * 16 + ii) * 65 + d] = run; }
        red[iq * 64 + d] = run;
      }
      __syncthreads();
      {
        float off = 0.f;
        for (int q = 0; q < iq; ++q) off += red[q * 64 + d];
        if (iq > 0) {
#pragma unroll 4
          for (int ii = 0; ii < 16; ++ii) gl[(iq * 16 + ii) * 65 + d] += off;
        }
      }
      __syncthreads();
      pin4(rq[0]); pin4(rq[1]); pin4(rk[0]); pin4(rk[1]); pin4(rv[0]); pin4(rv[1]); pin4(rv[2]); pin4(rv[3]);
#pragma unroll
      for (int k = 0; k < 2; ++k) {
        const int id = tid + 256 * k, i = id >> 3, dc = id & 7;
        u32x4 oo;
#pragma unroll
        for (int e = 0; e < 4; ++e) {
          float b0 = gl[i * 65 + dc * 8 + 2 * e], b1 = gl[i * 65 + dc * 8 + 2 * e + 1];
          oo[e] = pack2(bflo(rq[k][e]) * 0.125f * __expf(b0), bfhi(rq[k][e]) * 0.125f * __expf(b1));
        }
        *reinterpret_cast<u32x4*>(qe + i * 72 + dc * 8) = oo;
      }
#pragma unroll
      for (int k = 0; k < 2; ++k) {
        const int id = tid + 256 * k, dc = id >> 6, i = id & 63;
        u32x4 oo;
#pragma unroll
        for (int e = 0; e < 4; ++e) {
          const int d0 = dc * 8 + 2 * e;
          float b0 = gl[i * 65 + d0], b1 = gl[i * 65 + d0 + 1];
          float l0 = gl[63 * 65 + d0], l1 = gl[63 * 65 + d0 + 1];
          float k0 = bflo(rk[k][e]), k1 = bfhi(rk[k][e]);
          oo[e] = pack2(k0 * __expf(-b0), k1 * __expf(-b1));
          kdT[d0 * 72 + i] = f2bf(k0 * __expf(l0 - b0));
          kdT[(d0 + 1) * 72 + i] = f2bf(k1 * __expf(l1 - b1));
        }
        *reinterpret_cast<u32x4*>(ke + i * 72 + dc * 8) = oo;
      }
#pragma unroll
      for (int k = 0; k < 4; ++k) {
        const int id = tid + 256 * k, ec = id >> 6, i = id & 63;
#pragma unroll
        for (int e = 0; e < 4; ++e) {
          vT[(ec * 8 + 2 * e) * 72 + i] = (u16)(rv[k][e] & 0xffffu);
          vT[(ec * 8 + 2 * e + 1) * 72 + i] = (u16)(rv[k][e] >> 16);
        }
      }
      u32x4 tmpv[4];
      unsigned ggr[16];
#pragma unroll
      for (int e = 0; e < 4; ++e) tmpv[e] = u32x4{0u, 0u, 0u, 0u};
#pragma unroll
      for (int e = 0; e < 16; ++e) ggr[e] = 0u;
      if (mode == 2) {
        const int qs = (w * 4 + (3 - fq)) * 16 + fr;
        const u16* tp = Y + (size_t)(rowbase + c0 + (qs >> 2)) * MIXW + 1024 + h * 128 + (qs & 3) * 32;
#pragma unroll
        for (int e = 0; e < 4; ++e) tmpv[e] = *reinterpret_cast<const u32x4*>(tp + e * 8);
#pragma unroll
        for (int tt = 0; tt < 4; ++tt)
#pragma unroll
          for (int j = 0; j < 4; ++j) {
            const int t = tt * 16 + fq * 4 + j;
            const size_t row = (size_t)(rowbase + (sdir ? c0 + 63 - t : c0 + t));
            ggr[tt * 4 + j] = *reinterpret_cast<const unsigned*>(P + row * IND + C_GG + h * 128 + w * 32 + 2 * fr);
          }
      }
      if (ci + 1 < ci1) {
        const int cL = (sdir ? nch - 2 - ci : ci + 1) * 64;
#pragma unroll
        for (int k = 0; k < 2; ++k) {
          const int id = tid + 256 * k, i = id >> 3, dc = id & 7;
          const int tau = sdir ? cL + 63 - i : cL + i;
          rq[k] = *reinterpret_cast<const u32x4*>(P + (size_t)(rowbase + tau) * IND + C_Q + h * 64 + dc * 8);
        }
#pragma unroll
        for (int k = 0; k < 2; ++k) {
          const int id = tid + 256 * k, dc = id >> 6, i = id & 63;
          const int tau = sdir ? cL + 63 - i : cL + i;
          rk[k] = *reinterpret_cast<const u32x4*>(P + (size_t)(rowbase + tau) * IND + C_K + h * 64 + dc * 8);
        }
#pragma unroll
        for (int k = 0; k < 4; ++k) {
          const int id = tid + 256 * k, ec = id >> 6, i = id & 63;
          const int tau = sdir ? cL + 63 - i : cL + i;
          rv[k] = *reinterpret_cast<const u32x4*>(P + (size_t)(rowbase + tau) * IND + C_V + h * 128 + ec * 8);
        }
        {
          const int i = 32 * (tid >> 7) + (tid & 31), hf = (tid & 63) >> 5;
          const int tau = sdir ? cL + 63 - i : cL + i;
          rlr = *reinterpret_cast<const u32x4*>(P + (size_t)(rowbase + tau) * IND + C_LR + sdir * 16 + hf * 8);
        }
      }
      __syncthreads();
      {
        f32x4 aacc[4];
#pragma unroll
        for (int i = 0; i < 4; ++i) aacc[i] = f32x4{0.f, 0.f, 0.f, 0.f};
#pragma unroll
        for (int kk = 0; kk < 2; ++kk) {
          bf16x8 a = ld8(ke + (w * 16 + fr) * 72 + kk * 32 + fq * 8);
#pragma unroll
          for (int tb = 0; tb < 4; ++tb) {
            bf16x8 bb = ld8(qe + (tb * 16 + fr) * 72 + kk * 32 + fq * 8);
            aacc[tb] = mfma16(a, bb, aacc[tb]);
          }
        }
#pragma unroll
        for (int tb = 0; tb < 4; ++tb) {
          const int t = tb * 16 + fr;
          float mv[4];
#pragma unroll
          for (int j = 0; j < 4; ++j) { const int s = w * 16 + fq * 4 + j; mv[j] = (s <= t) ? aacc[tb][j] : 0.f; }
          uint2 o; o.x = pack2(mv[0], mv[1]); o.y = pack2(mv[2], mv[3]);
          *reinterpret_cast<uint2*>(at + t * 72 + w * 16 + fq * 4) = o;
        }
      }
      __syncthreads();
      f32x4 oacc[4][2];
#pragma unroll
      for (int i = 0; i < 4; ++i) { oacc[i][0] = f32x4{0.f, 0.f, 0.f, 0.f}; oacc[i][1] = f32x4{0.f, 0.f, 0.f, 0.f}; }
#pragma unroll
      for (int kk = 0; kk < 2; ++kk) {
        bf16x8 b0 = ld8(vT + (w * 32 + 2 * fr) * 72 + kk * 32 + fq * 8);
        bf16x8 b1 = ld8(vT + (w * 32 + 2 * fr + 1) * 72 + kk * 32 + fq * 8);
#pragma unroll
        for (int tt = 0; tt < 4; ++tt) {
          bf16x8 a = ld8(at + (tt * 16 + fr) * 72 + kk * 32 + fq * 8);
          oacc[tt][0] = mfma16(a, b0, oacc[tt][0]);
          oacc[tt][1] = mfma16(a, b1, oacc[tt][1]);
        }
      }
#pragma unroll
      for (int kk = 0; kk < 2; ++kk) {
        bf16x8 s0 = packacc(sacc[2 * kk][0], sacc[2 * kk + 1][0]);
        bf16x8 s1 = packacc(sacc[2 * kk][1], sacc[2 * kk + 1][1]);
#pragma unroll
        for (int tt = 0; tt < 4; ++tt) {
          const u16* qr = qe + (tt * 16 + fr) * 72 + fq * 4;
          bf16x8 a = ld44(qr + (2 * kk) * 16, qr + (2 * kk + 1) * 16);
          oacc[tt][0] = mfma16(a, s0, oacc[tt][0]);
          oacc[tt][1] = mfma16(a, s1, oacc[tt][1]);
        }
      }
#pragma unroll
      for (int db = 0; db < 4; ++db)
#pragma unroll
        for (int j = 0; j < 4; ++j) {
          const float sc = __expf(gl[63 * 65 + db * 16 + fq * 4 + j]);
          sacc[db][0][j] *= sc; sacc[db][1][j] *= sc;
        }
#pragma unroll
      for (int kk = 0; kk < 2; ++kk) {
        bf16x8 b0 = ld8(vT + (w * 32 + 2 * fr) * 72 + kk * 32 + fq * 8);
        bf16x8 b1 = ld8(vT + (w * 32 + 2 * fr + 1) * 72 + kk * 32 + fq * 8);
#pragma unroll
        for (int db = 0; db < 4; ++db) {
          bf16x8 a = ld8(kdT + (db * 16 + fr) * 72 + kk * 32 + fq * 8);
          sacc[db][0] = mfma16(a, b0, sacc[db][0]);
          sacc[db][1] = mfma16(a, b1, sacc[db][1]);
        }
      }
      pin4(tmpv[0]); pin4(tmpv[1]); pin4(tmpv[2]); pin4(tmpv[3]);
      if (mode != 0) {
        const int ycol = 1024 + h * 128 + w * 32 + 2 * fr;
        if (mode == 1) {
          const int qs = (w * 4 + fq) * 16 + fr;
          u16* tp = Y + (size_t)(rowbase + c0 + (qs >> 2)) * MIXW + 1024 + h * 128 + (qs & 3) * 32;
#pragma unroll
          for (int tt = 0; tt < 4; ++tt) {
            u32x4 o;
#pragma unroll
            for (int j = 0; j < 4; ++j) o[j] = pack2(oacc[tt][0][j], oacc[tt][1][j]);
            *reinterpret_cast<u32x4*>(tp + tt * 8) = o;
          }
        } else {
#pragma unroll
          for (int tt = 0; tt < 4; ++tt)
#pragma unroll
            for (int j = 0; j < 4; ++j) {
              const int t = tt * 16 + fq * 4 + j;
              const int e = 15 - (tt * 4 + j);
              const unsigned pw = tmpv[e >> 2][e & 3];
              float o0 = oacc[tt][0][j] + bflo(pw);
              float o1 = oacc[tt][1][j] + bfhi(pw);
              oacc[tt][0][j] = o0; oacc[tt][1][j] = o1;
              const float sq = row16_sum(o0 * o0 + o1 * o1);
              if (fr == 0) red[w * 64 + t] = sq;
            }
          __syncthreads();
          const float* nwv = p.in[opq(17)] + l * 128;
          const float nw0 = nwv[w * 32 + 2 * fr], nw1 = nwv[w * 32 + 2 * fr + 1];
#pragma unroll
          for (int tt = 0; tt < 4; ++tt)
#pragma unroll
            for (int j = 0; j < 4; ++j) {
              const int t = tt * 16 + fq * 4 + j;
              const size_t row = (size_t)(rowbase + (sdir ? c0 + 63 - t : c0 + t));
              const float tot = red[t] + red[64 + t] + red[128 + t] + red[192 + t];
              const float rs = rsqrtf(tot * (1.f / 128.f) + EPSF);
              const unsigned gw = pin(ggr[tt * 4 + j]);
              const float g0 = bflo(gw), g1 = bfhi(gw);
              *reinterpret_cast<unsigned*>(Y + row * MIXW + ycol) =
                  pack2(oacc[tt][0][j] * rs * nw0 * siluf(g0), oacc[tt][1][j] * rs * nw1 * siluf(g1));
            }
        }
      }
    }
  }
  if (part == 0) {
#pragma unroll
    for (int i = 0; i < 8; ++i) *reinterpret_cast<f32x4*>(stsave + (i * 256 + tid0) * 4) = sacc[i >> 1][i & 1];
  }
}

__device__ void s5_item(const Params& p, int l, int part, int blk, unsigned char* smem) {
  const int tid = opaque_tid(), lane = tid & 63, w = tid >> 6, fr = lane & 15, fq = lane >> 4;
  const int wi = blk * 4 + w;
  const int b = wi >> 6, g = (wi >> 1) & 31, dir = wi & 1;
  u16* hb = (u16*)smem + w * (32 * 136);
  u16* ust = (u16*)(smem + 4 * 32 * 136 * 2) + w * (32 * 16);
  u16* P = (u16*)(p.ws + WS_P);
  u16* Y = (u16*)(p.ws + WS_Y);
  u16* G5C = (u16*)(p.ws + WS_G5C);
  float* stsave = (float*)(p.ws + WS_S5ST) + (size_t)wi * 128;
  const float dsk = p.in[opq(25)][l * 512 + g * 16 + fr];
  float hre = 0.f, him = 0.f;
  if (part == 1) { hre = stsave[lane * 2]; him = stsave[lane * 2 + 1]; }
  const int nseg = part == 0 ? 3 : 1;
  for (int seg = 0; seg < nseg; ++seg) {
    bool isctx; int sdir, ti0, ti1, mode;
    if (part == 1) { isctx = false; sdir = dir; ti0 = 64; ti1 = 128; mode = 2; }
    else if (seg == 0) { if (!(dir == 0 && l == 0)) continue; isctx = true; sdir = 1; ti0 = 0; ti1 = 8; mode = 1; }
    else if (seg == 1) { isctx = true; sdir = dir; ti0 = 0; ti1 = 8; mode = (dir == 0 && l == 0) ? 2 : 0; }
    else { isctx = false; sdir = dir; ti0 = 0; ti1 = 64; mode = 1; }
    if (part == 0 && seg <= 1) { hre = 0.f; him = 0.f; }
    __threadfence();
    const unsigned char* cbase = p.ws + WS_S5C + (size_t)((l * 2 + sdir) * 32 + g) * 8704;
    const u16* BbarM = (const u16*)cbase;
    const u16* CmT = (const u16*)(cbase + 4096);
    const float* lamb = (const float*)(cbase + 8192);
    bf16x8 Bf[4], Cf[4];
#pragma unroll
    for (int cb = 0; cb < 4; ++cb) Bf[cb] = ld8(BbarM + (cb * 32 + (lane & 31)) * 16 + 8 * (lane >> 5));
#pragma unroll
    for (int kk = 0; kk < 4; ++kk) Cf[kk] = ld8(CmT + fr * 128 + kk * 32 + fq * 8);
    float lre = lamb[2 * lane], lim = lamb[2 * lane + 1];
#pragma unroll
    for (int i = 0; i < 4; ++i) asm volatile("" : "+v"(Bf[i]), "+v"(Cf[i]));
    asm volatile("" : "+v"(lre), "+v"(lim), "+v"(hre), "+v"(him));
    const int nt = isctx ? 8 : 128;
    const int rowbase = isctx ? NLAT + b * 256 : b * 4096;
    bf16x8 anext;
    {
      const int c0 = (sdir ? nt - 1 - ti0 : ti0) * 32, i = lane & 31;
      anext = ld8(P + (size_t)(rowbase + (sdir ? c0 + 31 - i : c0 + i)) * IND + C_U5 + g * 16 + 8 * (lane >> 5));
    }
    for (int ti = ti0; ti < ti1; ++ti) {
      const int c0 = (sdir ? nt - 1 - ti : ti) * 32;
      const bf16x8 a = anext;
      if (ti + 1 < ti1) {
        const int c1 = (sdir ? nt - 2 - ti : ti + 1) * 32, i = lane & 31;
        anext = ld8(P + (size_t)(rowbase + (sdir ? c1 + 31 - i : c1 + i)) * IND + C_U5 + g * 16 + 8 * (lane >> 5));
      }
      u32x4 tmpv = u32x4{0u, 0u, 0u, 0u};
      if (mode == 2) {
        const int qs = (3 - fq) * 16 + fr;
        tmpv = *reinterpret_cast<const u32x4*>(Y + (size_t)(rowbase + c0 + (qs >> 1)) * MIXW + 1536 + g * 16 + (qs & 1) * 8);
      }
      wave_lds_sync();
      if (mode == 2) *reinterpret_cast<bf16x8*>(ust + (lane & 31) * 16 + 8 * (lane >> 5)) = a;
#pragma unroll
      for (int cb = 0; cb < 4; ++cb) {
        f32x16 z;
#pragma unroll
        for (int r = 0; r < 16; ++r) z[r] = 0.f;
        f32x16 acc = mfma32(a, Bf[cb], z);
#pragma unroll
        for (int r = 0; r < 16; ++r) {
          const int ii = (r & 3) + 8 * (r >> 2) + 4 * (lane >> 5);
          hb[ii * 136 + cb * 32 + (lane & 31)] = f2bf(acc[r]);
        }
      }
      wave_lds_sync();
      {
        unsigned buv[32];
#pragma unroll
        for (int i = 0; i < 32; ++i) buv[i] = *reinterpret_cast<const unsigned*>(hb + i * 136 + 2 * lane);
#pragma unroll
        for (int i = 0; i < 32; ++i) {
          const float nre = lre * hre - lim * him + bflo(buv[i]);
          const float nim = lre * him + lim * hre + bfhi(buv[i]);
          hre = nre; him = nim;
          *reinterpret_cast<unsigned*>(hb + i * 136 + 2 * lane) = pack2(hre, him);
        }
      }
      wave_lds_sync();
      f32x4 ya[2];
      ya[0] = f32x4{0.f, 0.f, 0.f, 0.f}; ya[1] = f32x4{0.f, 0.f, 0.f, 0.f};
#pragma unroll
      for (int kk = 0; kk < 4; ++kk) {
        bf16x8 a0 = ld8(hb + fr * 136 + kk * 32 + fq * 8);
        bf16x8 a1 = ld8(hb + (16 + fr) * 136 + kk * 32 + fq * 8);
        ya[0] = mfma16(a0, Cf[kk], ya[0]);
        ya[1] = mfma16(a1, Cf[kk], ya[1]);
      }
      pin4(tmpv);
      if (mode == 1) {
        u32x4 o;
        o[0] = pack2(ya[0][0], ya[0][1]); o[1] = pack2(ya[0][2], ya[0][3]); o[2] = pack2(ya[1][0], ya[1][1]); o[3] = pack2(ya[1][2], ya[1][3]);
        const int qs = fq * 16 + fr;
        *reinterpret_cast<u32x4*>(Y + (size_t)(rowbase + c0 + (qs >> 1)) * MIXW + 1536 + g * 16 + (qs & 1) * 8) = o;
      } else if (mode == 2) {
#pragma unroll
        for (int rt = 0; rt < 2; ++rt)
#pragma unroll
          for (int j = 0; j < 4; ++j) {
            const int i = rt * 16 + fq * 4 + j;
            const int tau = sdir ? c0 + 31 - i : c0 + i;
            const size_t row = (size_t)(rowbase + tau);
            const int e = 7 - (rt * 4 + j);
            const unsigned pw = tmpv[e >> 1];
            const float yf = (e & 1) ? bfhi(pw) : bflo(pw);
            const float u = bf2f(ust[i * 16 + fr]);
            const float x = yf + ya[rt][j] + dsk * u;
            const float th = 1.f - 2.f * rcpf(1.f + __expf(2.f * 0.7978845608028654f * (x + 0.044715f * x * x * x)));
            const float ge = 0.5f * x * (1.f + th);
            if (isctx) G5C[(row - NLAT) * 512 + g * 16 + fr] = f2bf(ge);
            else P[row * IND + C_U5 + g * 16 + fr] = f2bf(ge);
          }
      }
    }
  }
  if (part == 0) { stsave[lane * 2] = hre; stsave[lane * 2 + 1] = him; }
}

__device__ void ssd_norm_rows(const Params& p, int nrows) {
  const int tid = opaque_tid();
  const float* ssq = (const float*)(p.ws + WS_SSQ);
  float* rsb = (float*)(p.ws + WS_RS);
  for (int i = blockIdx.x * 256 + tid; i < nrows * 2; i += gridDim.x * 256) {
    const float* sp = ssq + (size_t)i * 8;
    const float sum = sp[0] + sp[1] + sp[2] + sp[3] + sp[4] + sp[5] + sp[6] + sp[7];
    rsb[i] = rsqrtf(sum * (1.f / 512.f) + EPSF);
  }
}

__device__ void phase_final(const Params& p) {
  const int tid = opaque_tid(), lane = tid & 63, w = tid >> 6;
  const float* nw = p.in[opq(28)];
  for (int r = blockIdx.x * 4 + w; r < NLAT; r += gridDim.x * 4) {
    float* src = p.out + (size_t)r * 1024;
    float4 v[4]; float ss = 0.f;
#pragma unroll
    for (int q = 0; q < 4; ++q) {
      v[q] = *reinterpret_cast<const float4*>(src + lane * 4 + q * 256);
      ss += v[q].x * v[q].x + v[q].y * v[q].y + v[q].z * v[q].z + v[q].w * v[q].w;
    }
#pragma unroll
    for (int o = 32; o > 0; o >>= 1) ss += __shfl_xor(ss, o);
    const float rs = rsqrtf(ss * (1.f / 1024.f) + EPSF);
#pragma unroll
    for (int q = 0; q < 4; ++q) {
      const int col = lane * 4 + q * 256;
      float4 n4 = *reinterpret_cast<const float4*>(nw + col);
      float4 o = make_float4(v[q].x * rs * n4.x, v[q].y * rs * n4.y, v[q].z * rs * n4.z, v[q].w * rs * n4.w);
      *reinterpret_cast<float4*>(src + col) = o;
    }
  }
}


#define XB_TMO      128
#define XB_XCNT(j)  (256  + 64 * (j))
#define XB_XSUB(j)  (1280 + 64 * (j))
#define XB_XGEN(j)  (2304 + 64 * (j))
#define XB_TOP      3328
#define XB_TOPGEN   3392
#define XCD_BAR_WORDS 3456
#define XB_SPIN_CAP (1u << 20)
DI unsigned xb_ld(unsigned* p) { return __hip_atomic_load(p, __ATOMIC_RELAXED, __HIP_MEMORY_SCOPE_AGENT); }
DI unsigned xb_add(unsigned* p, unsigned v) { return __hip_atomic_fetch_add(p, v, __ATOMIC_RELAXED, __HIP_MEMORY_SCOPE_AGENT); }
DI unsigned xb_xcc_id() { return (unsigned)__builtin_amdgcn_s_getreg((3 << 11) | 20) & 0xFu; }
#define XB_SPIN(cond, bar) do { unsigned _sp = 0; while (cond) { __builtin_amdgcn_s_sleep(1); \
    if ((++_sp & 255u) == 0u) { if (xb_ld(&(bar)[XB_TMO])) break; if (_sp > XB_SPIN_CAP) { atomicAdd(&(bar)[XB_TMO], 1u); break; } } } } while (0)
struct XcdBarrier { unsigned* bar; unsigned x, nloc, nx; };
DI XcdBarrier xcd_barrier_post(unsigned* bar) {
  XcdBarrier b; b.bar = bar; b.x = xb_xcc_id(); b.nloc = 0u; b.nx = 0u;
  if (threadIdx.x == 0) (void)xb_add(&bar[XB_XCNT(b.x)], 1u);
  return b;
}
DI void xcd_barrier_complete(unsigned* bar, unsigned x, unsigned& nloc, unsigned& nx) {
  const unsigned G = gridDim.x;
  unsigned sum, cnt, mine, sp = 0u;
  for (;;) {
    sum = 0u; cnt = 0u; mine = 0u;
#pragma unroll
    for (unsigned j = 0; j < 16; ++j) { const unsigned c = xb_ld(&bar[XB_XCNT(j)]); sum += c; cnt += (c > 0u) ? 1u : 0u; mine = (j == x) ? c : mine; }
    if (sum == G) break;
    __builtin_amdgcn_s_sleep(1);
    if ((++sp & 255u) == 0u) { if (xb_ld(&bar[XB_TMO])) break; if (sp > XB_SPIN_CAP) { atomicAdd(&bar[XB_TMO], 1u); break; } }
  }
  nloc = mine > 0u ? mine : 1u; nx = cnt > 0u ? cnt : 1u;
}
DI void xcd_barrier(XcdBarrier& b) {
  asm volatile("s_waitcnt vmcnt(0)" ::: "memory");
  __syncthreads();
  if (threadIdx.x == 0) {
    unsigned* bar = b.bar;
    __builtin_amdgcn_s_waitcnt(0);
    if (b.nloc == 0u) xcd_barrier_complete(bar, b.x, b.nloc, b.nx);
    const unsigned nloc = b.nloc, nx = b.nx;
    const unsigned old = xb_add(&bar[XB_XSUB(b.x)], 1u);
    const unsigned gen = old / nloc;
    if (old + 1u == (gen + 1u) * nloc) {
      __builtin_amdgcn_fence(__ATOMIC_RELEASE, "agent");
      asm volatile("s_waitcnt vmcnt(0)" ::: "memory");
      const unsigned og = xb_add(&bar[XB_TOP], 1u);
      const unsigned tg = og / nx;
      if (og + 1u == (tg + 1u) * nx) xb_add(&bar[XB_TOPGEN], 1u);
      else XB_SPIN(xb_ld(&bar[XB_TOPGEN]) == tg, bar);
      __builtin_amdgcn_fence(__ATOMIC_ACQUIRE, "agent");
      xb_add(&bar[XB_XGEN(b.x)], 1u);
      asm volatile("s_waitcnt vmcnt(0)" ::: "memory");
    } else {
      XB_SPIN(xb_ld(&bar[XB_XGEN(b.x)]) == gen, bar);
      __builtin_amdgcn_fence(__ATOMIC_ACQUIRE, "agent");
      asm volatile("s_waitcnt vmcnt(0)" ::: "memory");
    }
  }
  __syncthreads();
}

__global__ void __launch_bounds__(256, 2) fwd_megakernel(Params p) {
  extern __shared__ __attribute__((aligned(16))) unsigned char smem[];
  cg::grid_group grid = cg::this_grid();
  XcdBarrier xb = xcd_barrier_post((unsigned*)(p.ws + WS_BAR));
  const int ph_lo = p.ph_lo, ph_hi = p.ph_hi;
  for (int ph = ph_lo; ph < ph_hi; ++ph) {
    if (ph == 0) {
      phase_prep(p, smem);
    } else if (ph == NPHASE - 1) {
      phase_final(p);
    } else {
      const int l = (ph - 1) / 7, sub = (ph - 1) % 7;
      const int mt = (l == 1) ? 256 : 272;
      if (sub == 0) {
        phase_pre(p, l, smem);
      } else if (sub == 1) {
        const u16* U = (const u16*)(p.ws + WS_Y);
        const u16* W = (const u16*)(p.ws + WS_WIN);
        const int xcd = blockIdx.x & 7, slot = blockIdx.x >> 3, nslots = gridDim.x >> 3;
        for (int u = slot; u < 918; u += nslots) {
          const int pnl = u / 306, v = u % 306;
          gemm_tile<192, 0>(p, l, U, 1024, W, 1024, 1024, (xcd * 34 + v / 9) * 128, (pnl * 9 + v % 9) * 192, smem);
        }
      } else if (sub == 2) {
        phase_conv(p, l);
      } else if (sub == 3 || sub == 4) {
        const int part = sub - 3;
        for (int k = 0;; ++k) {
          int it;
          if (gridDim.x == 512) {
            if (k > 0) break;
            const int blk = blockIdx.x;
            const int q = blk < 256 ? blk - 64 : 192 + (blk - 448);
            const int sit = q < 128 ? q * 2 : (q - 128) * 2 + 1;
            it = blk < 64 ? 256 + blk : blk < 256 ? sit : blk < 320 ? -1 : blk < 448 ? blk : sit;
          } else {
            it = blockIdx.x + k * gridDim.x;
            if (it >= 448) break;
          }
          if (it >= 0) {
            if (it < 256) ssd_item(p, l, part, it, smem);
            else if (it < 320) gla_item(p, l, part, it - 256, smem);
            else s5_item(p, l, part, it - 320, smem);
          }
          __syncthreads();
        }
      } else if (sub == 5) {
        const u16* W = (const u16*)(p.ws + WS_GLU);
        const int xcd = blockIdx.x & 7, slot = blockIdx.x >> 3, nslots = gridDim.x >> 3, mtx = mt >> 3;
        for (int u = slot; u < mtx * 8; u += nslots) {
          const int t = (xcd * mtx) * 8 + u;
          const int m0 = (t >> 3) * 128;
          if (m0 < NLAT) gemm_tile<128, 1>(p, l, (const u16*)(p.ws + WS_P) + C_U5, IND, W, 512, 512, m0, (t & 7) * 128, smem);
          else gemm_tile<128, 1>(p, l, (const u16*)(p.ws + WS_G5C) - (size_t)NLAT * 512, 512, W, 512, 512, m0, (t & 7) * 128, smem);
        }
        ssd_norm_rows(p, mt * 128);
      } else {
        const u16* A = (const u16*)(p.ws + WS_Y);
        const u16* W = (const u16*)(p.ws + WS_WOUT);
        const int xcd = blockIdx.x & 7, slot = blockIdx.x >> 3, nslots = gridDim.x >> 3, mtx = mt >> 3;
        for (int u = slot; u < mtx * 8; u += nslots) {
          const int t = (xcd * mtx) * 8 + u;
          gemm_tile<128, 2>(p, l, A, MIXW, W, MIXW, MIXW, (t >> 3) * 128, (t & 7) * 128, smem);
        }
      }
    }
    if (ph + 1 < ph_hi) {
      if (ph_hi < 0) grid.sync();
      xcd_barrier(xb);
    }
  }
}

extern "C" void kernel_launch(void* const* d_in, const int* in_sizes, int n_in, void* d_out, int out_size, void* d_ws,
                              size_t ws_size, hipStream_t stream) {
  static int grid_blocks = 0;
  if (grid_blocks == 0) {
    if (n_in != 29 || ws_size < WS_END) { fprintf(stderr, "kernel_launch: bad n_in %d / ws %zu (need %zu)\n", n_in, ws_size, (size_t)WS_END); grid_blocks = -1; return; }
    int dev = 0, cus = 0, per_cu = 0;
    hipGetDevice(&dev);
    hipDeviceGetAttribute(&cus, hipDeviceAttributeMultiprocessorCount, dev);
    hipFuncSetAttribute((const void*)fwd_megakernel, hipFuncAttributeMaxDynamicSharedMemorySize, SMEM_BYTES);
    hipOccupancyMaxActiveBlocksPerMultiprocessor(&per_cu, (const void*)fwd_megakernel, 256, SMEM_BYTES);
    if (per_cu < 1) per_cu = 1;
    if (per_cu > 2) per_cu = 2;
    grid_blocks = cus * per_cu;
    fprintf(stderr, "kernel_launch: cus %d per_cu %d grid %d\n", cus, per_cu, grid_blocks);
  }
  if (grid_blocks < 0) return;
  Params p{};
  for (int i = 0; i < 29; ++i) p.in[i] = (const float*)d_in[i];
  p.out = (float*)d_out; p.ws = (unsigned char*)d_ws; p.ph_lo = 0; p.ph_hi = NPHASE;
  if (hipMemsetAsync((char*)d_ws + WS_BAR, 0, 16384, stream) != hipSuccess) { fprintf(stderr, "kernel_launch: memset of the barrier words failed\n"); return; }
  void* args[] = {&p};
  hipError_t e = hipLaunchCooperativeKernel((const void*)fwd_megakernel, dim3(grid_blocks), dim3(256), args, SMEM_BYTES, stream);
  if (e != hipSuccess) fprintf(stderr, "cooperative launch failed: %s (grid %d)\n", hipGetErrorString(e), grid_blocks);
}
```

```cpp
#include <hip/hip_runtime.h>
#include <hip/hip_cooperative_groups.h>
#include <cstdio>
namespace cg = cooperative_groups;

typedef unsigned short u16;
using bf16x8 = __attribute__((ext_vector_type(8))) short;
using bf16x4 = __attribute__((ext_vector_type(4))) short;
using f32x4 = __attribute__((ext_vector_type(4))) float;
using f32x16 = __attribute__((ext_vector_type(16))) float;
using u32x4 = __attribute__((ext_vector_type(4))) unsigned;
#define DI __device__ __forceinline__

constexpr int DM = 1024, NLAT = 32768, NCTX = 2048, NTOK = 34816, IND = 5184, MIXW = 2048;
constexpr int C_XBC = 1024, C_BM = 2048, C_CM = 2304, C_DT = 2560, C_Q = 2592, C_K = 2848, C_V = 3104, C_GG = 3616,
              C_LR = 4128, C_U5 = 4160, C_SG = 4672;
constexpr float EPSF = 1e-6f;
constexpr int SMEM_BYTES = 81920;
constexpr int NPHASE = 16;

constexpr size_t WS_P = 0;
constexpr size_t WS_Y = WS_P + (size_t)NTOK * IND * 2;
constexpr size_t WS_WIN = WS_Y + (size_t)NTOK * MIXW * 2;
constexpr size_t WS_WOUT = WS_WIN + (size_t)IND * DM * 2;
constexpr size_t WS_GLU = WS_WOUT + (size_t)DM * MIXW * 2;
constexpr size_t WS_HCTX = WS_GLU + (size_t)1024 * 512 * 2;
constexpr size_t WS_MOD = WS_HCTX + (size_t)NCTX * DM * 4;
constexpr size_t WS_SSQ = WS_MOD + (size_t)2 * 9 * 3072 * 4;
constexpr size_t WS_S5C = WS_SSQ + (size_t)NTOK * 16 * 4;
constexpr size_t WS_G5C = WS_S5C + (size_t)128 * 8704;
constexpr size_t WS_S5ST = WS_G5C + (size_t)NCTX * 512 * 2;
constexpr size_t WS_BAR = WS_S5ST + (size_t)512 * 128 * 4;
constexpr size_t WS_RS = WS_BAR + 16384;
constexpr size_t WS_END = WS_RS + (size_t)NTOK * 2 * 4;

struct Params {
  const float* in[29];
  float* out;
  unsigned char* ws;
  int ph_lo, ph_hi;
};

DI int opq(int i) { asm volatile("" : "+s"(i)); return i; }
DI int opaque_tid() { int t = threadIdx.x; asm volatile("" : "+v"(t)); return t; }
typedef __bf16 hbf16x2 __attribute__((ext_vector_type(2)));
typedef float hf32x2 __attribute__((ext_vector_type(2)));
DI u16 f2bf(float x) { __bf16 h = (__bf16)x; return __builtin_bit_cast(u16, h); }
DI float bf2f(u16 h) { return __uint_as_float(((unsigned)h) << 16); }
DI unsigned pack2(float a, float b) { hf32x2 v = {a, b}; return __builtin_bit_cast(unsigned, __builtin_convertvector(v, hbf16x2)); }
DI float bflo(unsigned v) { return __uint_as_float(v << 16); }
DI float bfhi(unsigned v) { return __uint_as_float(v & 0xffff0000u); }
DI float rcpf(float x) { return __builtin_amdgcn_rcpf(x); }
DI float siluf(float x) { return x * rcpf(1.f + __expf(-x)); }
DI float logsigf(float x) { return fminf(x, 0.f) - __logf(1.f + __expf(-fabsf(x))); }
DI float softplusf(float v) { return fmaxf(v, 0.f) + log1pf(__expf(-fabsf(v))); }
DI f32x4 mfma16(bf16x8 a, bf16x8 b, f32x4 c) { return __builtin_amdgcn_mfma_f32_16x16x32_bf16(a, b, c, 0, 0, 0); }
DI f32x16 mfma32(bf16x8 a, bf16x8 b, f32x16 c) { return __builtin_amdgcn_mfma_f32_32x32x16_bf16(a, b, c, 0, 0, 0); }
DI void wave_lds_sync() { asm volatile("s_waitcnt lgkmcnt(0)" ::: "memory"); }
DI unsigned pin(unsigned v) { asm volatile("" : "+v"(v)); return v; }
DI void pin4(u32x4& v) { asm volatile("" : "+v"(v)); }
#define DPPF(v, old, ctrl, rmask) __builtin_bit_cast(float, __builtin_amdgcn_update_dpp(__builtin_bit_cast(int, (float)(old)), __builtin_bit_cast(int, (float)(v)), (ctrl), (rmask), 0xf, false))
DI float row16_sum(float v) {
  v += DPPF(v, 0.f, 0xB1, 0xf);
  v += DPPF(v, 0.f, 0x4E, 0xf);
  v += DPPF(v, 0.f, 0x141, 0xf);
  v += DPPF(v, 0.f, 0x140, 0xf);
  return v;
}
DI float wave_incl_scan(float v) {
  v += DPPF(v, 0.f, 0x111, 0xf);
  v += DPPF(v, 0.f, 0x112, 0xf);
  v += DPPF(v, 0.f, 0x114, 0xf);
  v += DPPF(v, 0.f, 0x118, 0xf);
  v += DPPF(v, 0.f, 0x142, 0xa);
  v += DPPF(v, 0.f, 0x143, 0xc);
  return v;
}
DI bf16x8 ld8(const u16* p) { return *reinterpret_cast<const bf16x8*>(p); }
DI bf16x8 ld44(const u16* p0, const u16* p1) {
  bf16x4 a = *reinterpret_cast<const bf16x4*>(p0), b = *reinterpret_cast<const bf16x4*>(p1);
  return __builtin_shufflevector(a, b, 0, 1, 2, 3, 4, 5, 6, 7);
}
DI bf16x8 packacc(const f32x4& a, const f32x4& b) {
  uint4 u; u.x = pack2(a[0], a[1]); u.y = pack2(a[2], a[3]); u.z = pack2(b[0], b[1]); u.w = pack2(b[2], b[3]);
  return __builtin_bit_cast(bf16x8, u);
}

__device__ void phase_prep(const Params& p, unsigned char* smem) {
  float* sc = (float*)smem;
  float* red = sc + 9 * 1024;
  const int tid = opaque_tid();
  float* modb = (float*)(p.ws + WS_MOD);
  bool filled = false;
  for (int it = blockIdx.x; it < 96 + 128; it += gridDim.x) {
    if (it < 96) {
      if (!filled) {
        for (int idx = tid; idx < 9216; idx += 256) {
          int r = idx >> 10, k = idx & 1023;
          float v = r < 8 ? p.in[opq(1)][r * 1024 + k] : p.in[opq(3)][k];
          sc[idx] = siluf(v);
        }
        filled = true;
        __syncthreads();
      }
      const int l = it / 48, j0 = (it % 48) * 64, kg = tid >> 6, jj = tid & 63;
      float a[9];
#pragma unroll
      for (int r = 0; r < 9; ++r) a[r] = 0.f;
      const float* W = p.in[opq(5)] + (size_t)l * 1024 * 3072 + j0 + jj;
      for (int k = kg * 256; k < kg * 256 + 256; ++k) {
        float wv = W[(size_t)k * 3072];
#pragma unroll
        for (int r = 0; r < 9; ++r) a[r] += sc[r * 1024 + k] * wv;
      }
#pragma unroll
      for (int r = 0; r < 9; ++r) red[(kg * 9 + r) * 64 + jj] = a[r];
      __syncthreads();
      for (int idx = tid; idx < 576; idx += 256) {
        int r = idx >> 6, j = idx & 63;
        float s = red[(0 * 9 + r) * 64 + j] + red[(1 * 9 + r) * 64 + j] + red[(2 * 9 + r) * 64 + j] + red[(3 * 9 + r) * 64 + j];
        modb[(l * 9 + r) * 3072 + j0 + j] = s + p.in[opq(6)][l * 3072 + j0 + j];
      }
      __syncthreads();
    } else {
      const int q = it - 96, l = q >> 6, d = (q >> 5) & 1, g = q & 31;
      unsigned char* base = p.ws + WS_S5C + (size_t)q * 8704;
      u16* BbarM = (u16*)base;
      u16* CmT = (u16*)(base + 4096);
      float* lamb = (float*)(base + 8192);
      const float st = expf(p.in[opq(20)][(l * 2 + d) * 32 + g]);
      for (int idx = tid; idx < 1024; idx += 256) {
        const int pp = idx >> 4, hh = idx & 15;
        const int li = ((l * 2 + d) * 32 + g) * 64 + pp;
        const float lre = p.in[opq(18)][li], lim = p.in[opq(19)][li];
        const float a = lre * st, bb = lim * st;
        const float ea = expf(a), sn = sinf(bb), cs = cosf(bb), s2 = sinf(0.5f * bb);
        const float lbre = ea * cs, lbim = ea * sn;
        const float nre = expm1f(a) * cs - 2.f * s2 * s2, nim = lbim;
        const float den = lre * lre + lim * lim;
        const float cre = (nre * lre + nim * lim) / den, cim = (nim * lre - nre * lim) / den;
        const int bi = ((l * 32 + g) * 64 + pp) * 16 + hh;
        const float bre = p.in[opq(21)][bi], bim = p.in[opq(22)][bi];
        BbarM[(2 * pp) * 16 + hh] = f2bf(cre * bre - cim * bim);
        BbarM[(2 * pp + 1) * 16 + hh] = f2bf(cre * bim + cim * bre);
        const int cidx = (((l * 2 + d) * 32 + g) * 16 + hh) * 64 + pp;
        CmT[hh * 128 + 2 * pp] = f2bf(p.in[opq(23)][cidx]);
        CmT[hh * 128 + 2 * pp + 1] = f2bf(-p.in[opq(24)][cidx]);
        if (hh == 0) { lamb[2 * pp] = lbre; lamb[2 * pp + 1] = lbim; }
      }
    }
  }
}

__device__ void phase_pre(const Params& p, int l, unsigned char* smem) {
  const int tid = opaque_tid(), lane = tid & 63, w = tid >> 6;
  const float* hl = l == 0 ? p.in[opq(0)] : p.out;
  const float* hc = l == 0 ? p.in[opq(2)] : (const float*)(p.ws + WS_HCTX);
  const float* nw = p.in[opq(4)] + l * 1024;
  const float* modb = (const float*)(p.ws + WS_MOD) + l * 9 * 3072;
  u16* U = (u16*)(p.ws + WS_Y);
  const bool cm = (l & 1);
  for (int r = blockIdx.x * 4 + w; r < NTOK; r += gridDim.x * 4) {
    const float* src; const float* mrow;
    if (r < NLAT) {
      int b = r >> 12, sp = r & 4095;
      int s = cm ? (((sp & 63) << 6) | (sp >> 6)) : sp;
      src = hl + ((size_t)(b * 4096 + s)) * 1024; mrow = modb + b * 3072;
    } else { src = hc + (size_t)(r - NLAT) * 1024; mrow = modb + 8 * 3072; }
    float4 v[4]; float ss = 0.f;
#pragma unroll
    for (int q = 0; q < 4; ++q) {
      v[q] = *reinterpret_cast<const float4*>(src + lane * 4 + q * 256);
      ss += v[q].x * v[q].x + v[q].y * v[q].y + v[q].z * v[q].z + v[q].w * v[q].w;
    }
#pragma unroll
    for (int o = 32; o > 0; o >>= 1) ss += __shfl_xor(ss, o);
    const float rs = rsqrtf(ss * (1.f / 1024.f) + EPSF);
#pragma unroll
    for (int q = 0; q < 4; ++q) {
      const int col = lane * 4 + q * 256;
      float4 n4 = *reinterpret_cast<const float4*>(nw + col);
      float4 sh = *reinterpret_cast<const float4*>(mrow + col);
      float4 s4 = *reinterpret_cast<const float4*>(mrow + 1024 + col);
      float u0 = v[q].x * rs * n4.x * (1.f + s4.x) + sh.x;
      float u1 = v[q].y * rs * n4.y * (1.f + s4.y) + sh.y;
      float u2 = v[q].z * rs * n4.z * (1.f + s4.z) + sh.z;
      float u3 = v[q].w * rs * n4.w * (1.f + s4.w) + sh.w;
      uint2 o; o.x = pack2(u0, u1); o.y = pack2(u2, u3);
      *reinterpret_cast<uint2*>(U + (size_t)r * 1024 + col) = o;
    }
  }
  float* tile = (float*)smem;
  for (int t = blockIdx.x; t < 1296 + 512 + 128; t += gridDim.x) {
    const float* src; int sld, k0, n0, kind; u16* dst; int dld;
    if (t < 1296) { kind = 0; k0 = (t / 81) * 64; n0 = (t % 81) * 64; src = p.in[opq(7)] + (size_t)l * 1024 * IND; sld = IND; dst = (u16*)(p.ws + WS_WIN); dld = 1024; }
    else if (t < 1808) { int q = t - 1296; kind = 1; k0 = (q / 16) * 64; n0 = (q % 16) * 64; src = p.in[opq(8)] + (size_t)l * 2048 * 1024; sld = 1024; dst = (u16*)(p.ws + WS_WOUT); dld = 2048; }
    else { int q = t - 1808; kind = 2; k0 = (q / 16) * 64; n0 = (q % 16) * 64; src = p.in[opq(26)] + (size_t)l * 512 * 1024; sld = 1024; dst = (u16*)(p.ws + WS_GLU); dld = 512; }
    __syncthreads();
#pragma unroll
    for (int rr = 0; rr < 4; ++rr) {
      int i = (tid >> 4) + 16 * rr, j = (tid & 15) * 4;
      float4 v = *reinterpret_cast<const float4*>(src + (size_t)(k0 + i) * sld + n0 + j);
      if (kind == 1 && k0 + i < 1024) { float s = p.in[opq(14)][l * 1024 + k0 + i]; v.x *= s; v.y *= s; v.z *= s; v.w *= s; }
      tile[i * 65 + j] = v.x; tile[i * 65 + j + 1] = v.y; tile[i * 65 + j + 2] = v.z; tile[i * 65 + j + 3] = v.w;
    }
    __syncthreads();
#pragma unroll
    for (int rr = 0; rr < 2; ++rr) {
      int n = (tid >> 3) + 32 * rr, i0 = (tid & 7) * 8;
      uint4 o;
      o.x = pack2(tile[(i0 + 0) * 65 + n], tile[(i0 + 1) * 65 + n]);
      o.y = pack2(tile[(i0 + 2) * 65 + n], tile[(i0 + 3) * 65 + n]);
      o.z = pack2(tile[(i0 + 4) * 65 + n], tile[(i0 + 5) * 65 + n]);
      o.w = pack2(tile[(i0 + 6) * 65 + n], tile[(i0 + 7) * 65 + n]);
      int drow = n0 + n;
      if (kind == 2) { int o_ = n0 + n, half = o_ >> 9, rem = o_ & 511; drow = (rem >> 6) * 128 + ((rem & 63) >> 4) * 32 + half * 16 + (rem & 15); }
      *reinterpret_cast<uint4*>(dst + (size_t)drow * dld + k0 + i0) = o;
    }
  }
}

template <int BN, int MODE>
__device__ void gemm_tile(const Params& p, int l, const u16* __restrict__ A, int lda, const u16* __restrict__ Bt, int ldb,
                          int K, int m0, int n0, unsigned char* smem) {
  constexpr int WN = BN / 2, NF = WN / 16, NBL = BN * 8 / 256;
  u16* As = (u16*)smem;
  u16* Bs = As + 128 * 64;
  const int tid = opaque_tid(), lane = tid & 63, w = tid >> 6, wr = w >> 1, wc = w & 1, fr = lane & 15, fq = lane >> 4;
  f32x4 acc[4][NF];
#pragma unroll
  for (int m = 0; m < 4; ++m)
#pragma unroll
    for (int n = 0; n < NF; ++n) acc[m][n] = f32x4{0.f, 0.f, 0.f, 0.f};
  constexpr int STAGE = (128 + BN) * 64;
  u32x4 ra[4], rb[NBL];
  const int nk = K / 64;
#define GLOAD(KT) do { const int k0_ = (KT) * 64; \
    _Pragma("unroll") for (int i = 0; i < 4; ++i) { int id = tid + 256 * i; ra[i] = *reinterpret_cast<const u32x4*>(A + (size_t)(m0 + (id >> 3)) * lda + k0_ + (id & 7) * 8); } \
    _Pragma("unroll") for (int i = 0; i < NBL; ++i) { int id = tid + 256 * i; rb[i] = *reinterpret_cast<const u32x4*>(Bt + (size_t)(n0 + (id >> 3)) * ldb + k0_ + (id & 7) * 8); } } while (0)
#define LSTORE(OFF) do { \
    _Pragma("unroll") for (int i = 0; i < 4; ++i) { int id = tid + 256 * i; *reinterpret_cast<u32x4*>(As + (OFF) + (id >> 3) * 64 + (((id & 7) ^ ((id >> 4) & 7)) * 8)) = ra[i]; } \
    _Pragma("unroll") for (int i = 0; i < NBL; ++i) { int id = tid + 256 * i; *reinterpret_cast<u32x4*>(Bs + (OFF) + (id >> 3) * 64 + (((id & 7) ^ ((id >> 4) & 7)) * 8)) = rb[i]; } } while (0)
#define COMPUTE(OFF) do { \
    _Pragma("unroll") for (int kk = 0; kk < 2; ++kk) { \
      bf16x8 af[4], bfr[NF]; \
      _Pragma("unroll") for (int m = 0; m < 4; ++m) af[m] = ld8(As + (OFF) + (wr * 64 + m * 16 + fr) * 64 + (((kk * 4 + fq) ^ (fr >> 1)) * 8)); \
      _Pragma("unroll") for (int n = 0; n < NF; ++n) bfr[n] = ld8(Bs + (OFF) + (wc * WN + n * 16 + fr) * 64 + (((kk * 4 + fq) ^ (fr >> 1)) * 8)); \
      __builtin_amdgcn_s_setprio(1); \
      _Pragma("unroll") for (int m = 0; m < 4; ++m) \
        _Pragma("unroll") for (int n = 0; n < NF; ++n) acc[m][n] = mfma16(bfr[n], af[m], acc[m][n]);     \
      __builtin_amdgcn_s_setprio(0); } } while (0)
  float f0[4], f1[4];
  if constexpr (MODE == 2) {
    const float* rsb = (const float*)(p.ws + WS_RS);
#pragma unroll
    for (int m = 0; m < 4; ++m) {
      const float2 r2 = *reinterpret_cast<const float2*>(rsb + (size_t)(m0 + wr * 64 + m * 16 + fr) * 2);
      f0[m] = r2.x * rcpf(r2.y); f1[m] = r2.y;
    }
  }
  GLOAD(0);
  __syncthreads();
  LSTORE(0);
  if (nk > 1) GLOAD(1);
  __syncthreads();
  for (int kt = 0; kt < nk; ++kt) {
    const int cur = (kt & 1) * STAGE, nxt = STAGE - cur;
    COMPUTE(cur);
    if constexpr (MODE == 2) {
      if (kt == 7 || kt == 15) {
#pragma unroll
        for (int m = 0; m < 4; ++m)
#pragma unroll
          for (int n = 0; n < NF; ++n)
#pragma unroll
            for (int j = 0; j < 4; ++j) acc[m][n][j] *= (kt == 7) ? f0[m] : f1[m];
      }
    }
    if (kt + 1 < nk) {
      LSTORE(nxt);
      if (kt + 2 < nk) GLOAD(kt + 2);
    }
    __syncthreads();
  }
#undef GLOAD
#undef LSTORE
#undef COMPUTE
  if constexpr (MODE == 0) {
    u16* P = (u16*)(p.ws + WS_P);
    constexpr int SLD = WN + 8;
    u16* stg = (u16*)smem + w * 16 * SLD;
    constexpr int CPR = WN / 8;
    __syncthreads();
#pragma unroll
    for (int m = 0; m < 4; ++m) {
      wave_lds_sync();
#pragma unroll
      for (int n = 0; n < NF; ++n) {
        const int cb = n0 + wc * WN + n * 16;
        if (cb < C_XBC || (cb >= C_GG && cb < C_LR) || cb >= C_SG) {
#pragma unroll
          for (int j = 0; j < 4; ++j) acc[m][n][j] = siluf(acc[m][n][j]);
        }
        uint2 o; o.x = pack2(acc[m][n][0], acc[m][n][1]); o.y = pack2(acc[m][n][2], acc[m][n][3]);
        *reinterpret_cast<uint2*>(stg + fr * SLD + n * 16 + fq * 4) = o;
      }
      wave_lds_sync();
      for (int id = lane; id < 16 * CPR; id += 64) {
        int row = id / CPR, ch = id % CPR;
        uint4 v = *reinterpret_cast<const uint4*>(stg + row * SLD + ch * 8);
        *reinterpret_cast<uint4*>(P + (size_t)(m0 + wr * 64 + m * 16 + row) * IND + n0 + wc * WN + ch * 8) = v;
      }
    }
  } else if constexpr (MODE == 1) {
    const u16* P = (const u16*)(p.ws + WS_P);
    u16* Y = (u16*)(p.ws + WS_Y);
    const float* gb = p.in[opq(27)] + l * 1024;
    const int tn = n0 >> 7;
#pragma unroll
    for (int q = 0; q < 2; ++q) {
      const int oc = tn * 64 + (wc * 2 + q) * 16 + fq * 4;
      const f32x4 b0 = *reinterpret_cast<const f32x4*>(gb + oc), b1 = *reinterpret_cast<const f32x4*>(gb + 512 + oc);
#pragma unroll
      for (int m = 0; m < 4; ++m) {
        const size_t row = (size_t)(m0 + wr * 64 + m * 16 + fr);
        const uint2 sgv = *reinterpret_cast<const uint2*>(P + row * IND + C_SG + oc);
        const float sg[4] = {bflo(sgv.x), bfhi(sgv.x), bflo(sgv.y), bfhi(sgv.y)};
        float y[4];
#pragma unroll
        for (int j = 0; j < 4; ++j) {
          const float val = acc[m][2 * q][j] + b0[j], gt = acc[m][2 * q + 1][j] + b1[j];
          y[j] = val * rcpf(1.f + __expf(-gt)) * sg[j];
        }
        uint2 o; o.x = pack2(y[0], y[1]); o.y = pack2(y[2], y[3]);
        *reinterpret_cast<uint2*>(Y + row * MIXW + 1536 + oc) = o;
      }
    }
  } else {
    const float* modb = (const float*)(p.ws + WS_MOD) + l * 9 * 3072;
    const bool cm = (l & 1);
    const float* hs = l == 0 ? p.in[opq(0)] : p.out;
    float* stg = (float*)smem + w * (16 * 68);
    __syncthreads();
#pragma unroll
    for (int m = 0; m < 4; ++m) {
#pragma unroll
      for (int n = 0; n < NF; ++n) *reinterpret_cast<f32x4*>(stg + fr * 68 + n * 16 + fq * 4) = acc[m][n];
      wave_lds_sync();
#pragma unroll
      for (int k = 0; k < 4; ++k) {
        const int id = lane + 64 * k, rowi = id >> 4, ch = id & 15;
        const f32x4 a = *reinterpret_cast<const f32x4*>(stg + rowi * 68 + ch * 4);
        const int r = m0 + wr * 64 + m * 16 + rowi, col = n0 + wc * WN + ch * 4;
        const float* src; float* dst; const float* gt;
        if (r < NLAT) {
          const int b = r >> 12, sp = r & 4095;
          const int sq = cm ? (((sp & 63) << 6) | (sp >> 6)) : sp;
          const size_t idx = ((size_t)(b * 4096 + sq)) * 1024 + col;
          src = hs + idx; dst = p.out + idx; gt = modb + b * 3072 + 2048 + col;
        } else {
          const size_t idx = (size_t)(r - NLAT) * 1024 + col;
          src = p.in[opq(2)] + idx; dst = (float*)(p.ws + WS_HCTX) + idx; gt = modb + 8 * 3072 + 2048 + col;
        }
        const f32x4 h = *reinterpret_cast<const f32x4*>(src), gv = *reinterpret_cast<const f32x4*>(gt);
        f32x4 o;
        o[0] = h[0] + gv[0] * a[0]; o[1] = h[1] + gv[1] * a[1]; o[2] = h[2] + gv[2] * a[2]; o[3] = h[3] + gv[3] * a[3];
        *reinterpret_cast<f32x4*>(dst) = o;
      }
      wave_lds_sync();
    }
  }
  __syncthreads();
}

__device__ void phase_conv(const Params& p, int l) {
  u16* P = (u16*)(p.ws + WS_P);
  const float* cw = p.in[opq(9)] + (size_t)l * 5 * 1536;
  const float* cb = p.in[opq(10)] + l * 1536;
  const int tid = opaque_tid(), cq = tid & 7, sgi = tid >> 3;
  for (int it = blockIdx.x; it < 768; it += gridDim.x) {
    const bool isctx = it >= 384;
    const int q = isctx ? it - 384 : it, b = q / 48, cgp = q % 48;
    const int L = isctx ? 256 : 4096, seg = L / 32, rowbase = isctx ? NLAT + b * 256 : b * 4096;
    const int ch = cgp * 32 + cq * 4;
    float4 wk[5];
#pragma unroll
    for (int k = 0; k < 5; ++k) wk[k] = *reinterpret_cast<const float4*>(cw + k * 1536 + ch);
    const float4 bias = *reinterpret_cast<const float4*>(cb + ch);
    u16* rp = P + (size_t)rowbase * IND + C_XBC + ch;
    const int a = sgi * seg;
    auto ld = [&](int sp) -> float4 {
      float4 r = make_float4(0.f, 0.f, 0.f, 0.f);
      if (sp >= 0 && sp < L) {
        uint2 v = *reinterpret_cast<const uint2*>(rp + (size_t)sp * IND);
        r.x = bflo(v.x); r.y = bfhi(v.x); r.z = bflo(v.y); r.w = bfhi(v.y);
      }
      return r;
    };
    float4 r0 = ld(a - 2), r1 = ld(a - 1), r2 = ld(a), r3 = ld(a + 1);
    const float4 e0 = ld(a + seg), e1 = ld(a + seg + 1);
    __syncthreads();
    auto ldraw = [&](int sp) -> uint2 {
      uint2 v = make_uint2(0u, 0u);
      if (sp < a + seg) v = *reinterpret_cast<const uint2*>(rp + (size_t)sp * IND);
      return v;
    };
    uint2 nraw[8];
#pragma unroll
    for (int j = 0; j < 8; ++j) nraw[j] = ldraw(a + 2 + j);
    for (int t0 = a; t0 < a + seg; t0 += 8) {
      uint2 cur[8];
#pragma unroll
      for (int j = 0; j < 8; ++j) cur[j] = nraw[j];
      if (t0 + 8 < a + seg) {
#pragma unroll
        for (int j = 0; j < 8; ++j) nraw[j] = ldraw(t0 + 10 + j);
      }
#pragma unroll
      for (int j = 0; j < 8; ++j) {
        const int sp = t0 + 2 + j;
        float4 r4;
        if (sp < a + seg) {
          const unsigned c0_ = pin(cur[j].x), c1_ = pin(cur[j].y);
          r4 = make_float4(bflo(c0_), bfhi(c0_), bflo(c1_), bfhi(c1_));
        } else r4 = (sp == a + seg) ? e0 : e1;
        float o0 = bias.x + wk[0].x * r0.x + wk[1].x * r1.x + wk[2].x * r2.x + wk[3].x * r3.x + wk[4].x * r4.x;
        float o1 = bias.y + wk[0].y * r0.y + wk[1].y * r1.y + wk[2].y * r2.y + wk[3].y * r3.y + wk[4].y * r4.y;
        float o2 = bias.z + wk[0].z * r0.z + wk[1].z * r1.z + wk[2].z * r2.z + wk[3].z * r3.z + wk[4].z * r4.z;
        float o3 = bias.w + wk[0].w * r0.w + wk[1].w * r1.w + wk[2].w * r2.w + wk[3].w * r3.w + wk[4].w * r4.w;
        uint2 o; o.x = pack2(siluf(o0), siluf(o1)); o.y = pack2(siluf(o2), siluf(o3));
        *reinterpret_cast<uint2*>(rp + (size_t)(t0 + j) * IND) = o;
        r0 = r1; r1 = r2; r2 = r3; r3 = r4;
      }
    }
    __syncthreads();
  }
}


__device__ void ssd_item(const Params& p, int l, int part, int item, unsigned char* smem) {
  u16* Bs = (u16*)smem;
  u16* Ms = Bs;
  u16* Cs = (u16*)(smem + 17408);
  u16* BT = (u16*)(smem + 34816);
  u16* xT = (u16*)(smem + 53248);
  u16* xwT = (u16*)(smem + 62464);
  float* dts = (float*)(smem + 71680);
  float* acs = dts + 64;
  float* wts = acs + 64;
  float* ssql = wts + 64;
  float* tots = ssql + 256;
  u16* ystg = (u16*)(smem + 73600);
  const int tid0 = opaque_tid();
  const int b = item >> 5, hd = (item >> 1) & 15, dir = item & 1, g = hd >> 3;
  u16* P = (u16*)(p.ws + WS_P);
  u16* Y = (u16*)(p.ws + WS_Y);
  float* ssq = (float*)(p.ws + WS_SSQ);
  float* stsave = (float*)(p.ws + WS_WIN) + (size_t)item * 8192;
  const float Dsk = p.in[opq(13)][l * 16 + hd];
  f32x4 hacc[8];
  if (part == 1) {
#pragma unroll
    for (int i = 0; i < 8; ++i) hacc[i] = *reinterpret_cast<const f32x4*>(stsave + (i * 256 + tid0) * 4);
  } else {
#pragma unroll
    for (int i = 0; i < 8; ++i) hacc[i] = f32x4{0.f, 0.f, 0.f, 0.f};
  }
  const int nseg = part == 0 ? 3 : 1;
  for (int seg = 0; seg < nseg; ++seg) {
    bool isctx; int sdir, ci0, ci1, mode;
    if (part == 1) { isctx = false; sdir = dir; ci0 = 32; ci1 = 64; mode = 2; }
    else if (seg == 0) { if (!(dir == 0 && l == 0)) continue; isctx = true; sdir = 1; ci0 = 0; ci1 = 4; mode = 1; }
    else if (seg == 1) { isctx = true; sdir = dir; ci0 = 0; ci1 = 4; mode = (dir == 0 && l == 0) ? 2 : 0; }
    else { isctx = false; sdir = dir; ci0 = 0; ci1 = 32; mode = 1; }
    if (part == 0 && seg <= 1) {
#pragma unroll
      for (int i = 0; i < 8; ++i) hacc[i] = f32x4{0.f, 0.f, 0.f, 0.f};
    }
    __threadfence();
    __syncthreads();
    const float aneg = -expf(p.in[opq(11)][(l * 2 + sdir) * 16 + hd]);
    const float dtb = p.in[opq(12)][(l * 2 + sdir) * 16 + hd];
    const int nch = isctx ? 4 : 64;
    const int rowbase = isctx ? NLAT + b * 256 : b * 4096;
#pragma unroll
    for (int i = 0; i < 8; ++i) asm volatile("" : "+v"(hacc[i]));
    u32x4 rx[2], rbm[4], rcm[4];
    unsigned rawdt = 0u;
    {
      const int tid = tid0, lane = tid & 63, w = tid >> 6;
      const int cL = (sdir ? nch - 1 - ci0 : ci0) * 64;
#pragma unroll
      for (int k = 0; k < 2; ++k) {
        const int id = tid + 256 * k, pch = id >> 6, i = id & 63;
        const int tau = sdir ? cL + 63 - i : cL + i;
        rx[k] = *reinterpret_cast<const u32x4*>(P + (size_t)(rowbase + tau) * IND + C_XBC + hd * 64 + pch * 8);
      }
#pragma unroll
      for (int k = 0; k < 4; ++k) {
        const int id = tid + 256 * k, nc = id >> 6, i = id & 63;
        const int tau = sdir ? cL + 63 - i : cL + i;
        rbm[k] = *reinterpret_cast<const u32x4*>(P + (size_t)(rowbase + tau) * IND + C_BM + g * 128 + nc * 8);
      }
#pragma unroll
      for (int k = 0; k < 4; ++k) {
        const int id = tid + 256 * k, i = id >> 4, nc = id & 15;
        const int tau = sdir ? cL + 63 - i : cL + i;
        rcm[k] = *reinterpret_cast<const u32x4*>(P + (size_t)(rowbase + tau) * IND + C_CM + g * 128 + nc * 8);
      }
      rawdt = P[(size_t)(rowbase + (sdir ? cL + 63 - lane : cL + lane)) * IND + C_DT + sdir * 16 + hd];
    }
    for (int ci = ci0; ci < ci1; ++ci) {
      const int c0 = (sdir ? nch - 1 - ci : ci) * 64;
      int tid = tid0;
      asm volatile("" : "+v"(tid));
      const int lane = tid & 63, w = tid >> 6, fr = lane & 15, fq = lane >> 4;
      __syncthreads();
      if (w == 0) {
        float dt = softplusf(bflo(pin(rawdt)) + dtb);
        const float cs = wave_incl_scan(dt * aneg);
        const float tot = __builtin_bit_cast(float, __builtin_amdgcn_readlane(__builtin_bit_cast(int, cs), 63));
        dts[lane] = dt; acs[lane] = cs; wts[lane] = __expf(tot - cs);
        if (lane == 0) tots[0] = tot;
      }
      pin4(rbm[0]); pin4(rbm[1]); pin4(rbm[2]); pin4(rbm[3]);
#pragma unroll
      for (int k = 0; k < 4; ++k) {
        const int id = tid + 256 * k, nc = id >> 6, i = id & 63;
        *reinterpret_cast<u32x4*>(Bs + i * 136 + nc * 8) = rbm[k];
#pragma unroll
        for (int e = 0; e < 4; ++e) {
          BT[(nc * 8 + 2 * e) * 72 + i] = (u16)(rbm[k][e] & 0xffffu);
          BT[(nc * 8 + 2 * e + 1) * 72 + i] = (u16)(rbm[k][e] >> 16);
        }
      }
#pragma unroll
      for (int k = 0; k < 4; ++k) {
        const int id = tid + 256 * k, i = id >> 4, nc = id & 15;
        *reinterpret_cast<u32x4*>(Cs + i * 136 + nc * 8) = rcm[k];
      }
      __syncthreads();
      pin4(rx[0]); pin4(rx[1]);
#pragma unroll
      for (int k = 0; k < 2; ++k) {
        const int id = tid + 256 * k, pch = id >> 6, i = id & 63;
        const float dt = dts[i], wt = wts[i];
#pragma unroll
        for (int e = 0; e < 4; ++e) {
          float x0 = bflo(rx[k][e]) * dt, x1 = bfhi(rx[k][e]) * dt;
          xT[(pch * 8 + 2 * e) * 72 + i] = f2bf(x0); xT[(pch * 8 + 2 * e + 1) * 72 + i] = f2bf(x1);
          xwT[(pch * 8 + 2 * e) * 72 + i] = f2bf(x0 * wt); xwT[(pch * 8 + 2 * e + 1) * 72 + i] = f2bf(x1 * wt);
        }
      }
      u32x4 tmpv[2] = {u32x4{0u, 0u, 0u, 0u}, u32x4{0u, 0u, 0u, 0u}};
      uint2 zr[4];
#pragma unroll
      for (int e = 0; e < 4; ++e) zr[e] = make_uint2(0u, 0u);
      if (mode == 2) {
        const int qs = (w * 4 + fq) * 16 + (15 - fr);
        const u16* tp = Y + (size_t)(rowbase + c0 + (qs >> 2)) * MIXW + hd * 64 + (qs & 3) * 16;
        tmpv[0] = *reinterpret_cast<const u32x4*>(tp); tmpv[1] = *reinterpret_cast<const u32x4*>(tp + 8);
#pragma unroll
        for (int tt = 0; tt < 4; ++tt) {
          const int t = tt * 16 + fr;
          const size_t row = (size_t)(rowbase + (sdir ? c0 + 63 - t : c0 + t));
          zr[tt] = *reinterpret_cast<const uint2*>(P + row * IND + hd * 64 + w * 16 + fq * 4);
        }
      }
      if (ci + 1 < ci1) {
        const int cL = (sdir ? nch - 2 - ci : ci + 1) * 64;
#pragma unroll
        for (int k = 0; k < 2; ++k) {
          const int id = tid + 256 * k, pch = id >> 6, i = id & 63;
          const int tau = sdir ? cL + 63 - i : cL + i;
          rx[k] = *reinterpret_cast<const u32x4*>(P + (size_t)(rowbase + tau) * IND + C_XBC + hd * 64 + pch * 8);
        }
#pragma unroll
        for (int k = 0; k < 4; ++k) {
          const int id = tid + 256 * k, nc = id >> 6, i = id & 63;
          const int tau = sdir ? cL + 63 - i : cL + i;
          rbm[k] = *reinterpret_cast<const u32x4*>(P + (size_t)(rowbase + tau) * IND + C_BM + g * 128 + nc * 8);
        }
#pragma unroll
        for (int k = 0; k < 4; ++k) {
          const int id = tid + 256 * k, i = id >> 4, nc = id & 15;
          const int tau = sdir ? cL + 63 - i : cL + i;
          rcm[k] = *reinterpret_cast<const u32x4*>(P + (size_t)(rowbase + tau) * IND + C_CM + g * 128 + nc * 8);
        }
        rawdt = P[(size_t)(rowbase + (sdir ? cL + 63 - lane : cL + lane)) * IND + C_DT + sdir * 16 + hd];
      }
      __syncthreads();
      f32x4 gacc[4];
#pragma unroll
      for (int i = 0; i < 4; ++i) gacc[i] = f32x4{0.f, 0.f, 0.f, 0.f};
#pragma unroll
      for (int kk = 0; kk < 4; ++kk) {
        bf16x8 a = ld8(Bs + (w * 16 + fr) * 136 + kk * 32 + fq * 8);
#pragma unroll
        for (int tb = 0; tb < 4; ++tb) {
          bf16x8 bb = ld8(Cs + (tb * 16 + fr) * 136 + kk * 32 + fq * 8);
          gacc[tb] = mfma16(a, bb, gacc[tb]);
        }
      }
      asm volatile("" : "+v"(tmpv[0]), "+v"(tmpv[1]));
      __syncthreads();
#pragma unroll
      for (int tb = 0; tb < 4; ++tb) {
        const int t = tb * 16 + fr;
        const float at = acs[t];
        float mv[4];
#pragma unroll
        for (int j = 0; j < 4; ++j) {
          const int s = w * 16 + fq * 4 + j;
          mv[j] = (s <= t) ? gacc[tb][j] * __expf(at - acs[s]) : 0.f;
        }
        uint2 o; o.x = pack2(mv[0], mv[1]); o.y = pack2(mv[2], mv[3]);
        *reinterpret_cast<uint2*>(Ms + t * 72 + w * 16 + fq * 4) = o;
      }
      __syncthreads();
      f32x4 yd[4], yo[4];
#pragma unroll
      for (int i = 0; i < 4; ++i) { yd[i] = f32x4{0.f, 0.f, 0.f, 0.f}; yo[i] = f32x4{0.f, 0.f, 0.f, 0.f}; }
#pragma unroll
      for (int kk = 0; kk < 2; ++kk) {
        bf16x8 bb = ld8(xT + (w * 16 + fr) * 72 + kk * 32 + fq * 8);
#pragma unroll
        for (int tt = 0; tt < 4; ++tt) {
          bf16x8 a = ld8(Ms + (tt * 16 + fr) * 72 + kk * 32 + fq * 8);
          yd[tt] = mfma16(bb, a, yd[tt]);
        }
      }
#pragma unroll
      for (int kk = 0; kk < 4; ++kk) {
        bf16x8 hb = packacc(hacc[2 * kk], hacc[2 * kk + 1]);
#pragma unroll
        for (int tt = 0; tt < 4; ++tt) {
          const u16* cr = Cs + (tt * 16 + fr) * 136 + fq * 4;
          bf16x8 a = ld44(cr + (2 * kk) * 16, cr + (2 * kk + 1) * 16);
          yo[tt] = mfma16(hb, a, yo[tt]);
        }
      }
      const float etot = __expf(tots[0]);
#pragma unroll
      for (int nb = 0; nb < 8; ++nb) { hacc[nb][0] *= etot; hacc[nb][1] *= etot; hacc[nb][2] *= etot; hacc[nb][3] *= etot; }
#pragma unroll
      for (int kk = 0; kk < 2; ++kk) {
        bf16x8 bb = ld8(xwT + (w * 16 + fr) * 72 + kk * 32 + fq * 8);
#pragma unroll
        for (int nb = 0; nb < 8; ++nb) {
          bf16x8 a = ld8(BT + (nb * 16 + fr) * 72 + kk * 32 + fq * 8);
          hacc[nb] = mfma16(a, bb, hacc[nb]);
        }
      }
      if (mode != 0) {
        float ea[4];
#pragma unroll
        for (int tt = 0; tt < 4; ++tt) ea[tt] = __expf(acs[tt * 16 + fr]);
        if (mode == 1) {
          u32x4 o0, o1;
#pragma unroll
          for (int tt = 0; tt < 4; ++tt) {
            float v[4];
#pragma unroll
            for (int j = 0; j < 4; ++j) v[j] = yd[tt][j] + ea[tt] * yo[tt][j];
            const unsigned a2 = pack2(v[0], v[1]), b2 = pack2(v[2], v[3]);
            if (tt == 0) { o0[0] = a2; o0[1] = b2; } else if (tt == 1) { o0[2] = a2; o0[3] = b2; }
            else if (tt == 2) { o1[0] = a2; o1[1] = b2; } else { o1[2] = a2; o1[3] = b2; }
          }
          const int qs = (w * 4 + fq) * 16 + fr;
          u16* tp = Y + (size_t)(rowbase + c0 + (qs >> 2)) * MIXW + hd * 64 + (qs & 3) * 16;
          *reinterpret_cast<u32x4*>(tp) = o0; *reinterpret_cast<u32x4*>(tp + 8) = o1;
        } else {
          float xsv[16], rdt[4], val[16];
#pragma unroll
          for (int tt = 0; tt < 4; ++tt) {
            rdt[tt] = rcpf(dts[tt * 16 + fr]);
#pragma unroll
            for (int j = 0; j < 4; ++j) xsv[tt * 4 + j] = bf2f(xT[(w * 16 + fq * 4 + j) * 72 + tt * 16 + fr]);
          }
          float sq[4];
#pragma unroll
          for (int tt = 0; tt < 4; ++tt) {
            const int t = tt * 16 + fr;
            const uint2 zw = zr[tt];
            const unsigned z01 = pin(zw.x), z23 = pin(zw.y);
            const float zz[4] = {bflo(z01), bfhi(z01), bflo(z23), bfhi(z23)};
            const int et = 3 - tt;
            const unsigned p01 = tmpv[et >> 1][(et & 1) * 2], p23 = tmpv[et >> 1][(et & 1) * 2 + 1];
            const float yf[4] = {bflo(p01), bfhi(p01), bflo(p23), bfhi(p23)};
            float s2 = 0.f;
#pragma unroll
            for (int j = 0; j < 4; ++j) {
              const float yv = yd[tt][j] + ea[tt] * yo[tt][j];
              const float vv = (yf[j] + yv + Dsk * xsv[tt * 4 + j] * rdt[tt]) * zz[j];
              val[tt * 4 + j] = vv; s2 += vv * vv;
            }
            sq[tt] = s2;
            uint2 o; o.x = pack2(val[tt * 4], val[tt * 4 + 1]); o.y = pack2(val[tt * 4 + 2], val[tt * 4 + 3]);
            const int c = w * 2 + (fq >> 1);
            *reinterpret_cast<uint2*>(ystg + t * 64 + ((c ^ ((t >> 2) & 7)) << 3) + (fq & 1) * 4) = o;
          }
#pragma unroll
          for (int tt = 0; tt < 4; ++tt) {
            sq[tt] += __shfl_xor(sq[tt], 16); sq[tt] += __shfl_xor(sq[tt], 32);
          }
          if (fq == 0) {
#pragma unroll
            for (int tt = 0; tt < 4; ++tt) ssql[w * 64 + tt * 16 + fr] = sq[tt];
          }
          __syncthreads();
#pragma unroll
          for (int k = 0; k < 2; ++k) {
            const int id = tid + 256 * k, t = id >> 3, c = id & 7;
            const u32x4 v = *reinterpret_cast<const u32x4*>(ystg + t * 64 + ((c ^ ((t >> 2) & 7)) << 3));
            const size_t row = (size_t)(rowbase + (sdir ? c0 + 63 - t : c0 + t));
            *reinterpret_cast<u32x4*>(Y + row * MIXW + hd * 64 + c * 8) = v;
          }
          if (tid < 64) {
            const size_t row = (size_t)(rowbase + (sdir ? c0 + 63 - tid : c0 + tid));
            ssq[row * 16 + hd] = ssql[tid] + ssql[64 + tid] + ssql[128 + tid] + ssql[192 + tid];
          }
        }
      }
    }
  }
  if (part == 0) {
#pragma unroll
    for (int i = 0; i < 8; ++i) *reinterpret_cast<f32x4*>(stsave + (i * 256 + tid0) * 4) = hacc[i];
  }
}

__device__ void gla_item(const Params& p, int l, int part, int item, unsigned char* smem) {
  u16* qe = (u16*)smem;
  u16* ke = (u16*)(smem + 9216);
  u16* kdT = (u16*)(smem + 18432);
  u16* vT = (u16*)(smem + 27648);
  u16* at = (u16*)(smem + 46080);
  float* gl = (float*)(smem + 55296);
  float* red = (float*)(smem + 71936);
  const int tid0 = opaque_tid();
  const int b = item >> 3, h = (item >> 1) & 3, dir = item & 1;
  u16* P = (u16*)(p.ws + WS_P);
  u16* Y = (u16*)(p.ws + WS_Y);
  float* stsave = (float*)(p.ws + WS_WIN) + (size_t)(256 + item) * 8192;
  f32x4 sacc[4][2];
  if (part == 1) {
#pragma unroll
    for (int i = 0; i < 8; ++i) sacc[i >> 1][i & 1] = *reinterpret_cast<const f32x4*>(stsave + (i * 256 + tid0) * 4);
  } else {
#pragma unroll
    for (int i = 0; i < 8; ++i) sacc[i >> 1][i & 1] = f32x4{0.f, 0.f, 0.f, 0.f};
  }
  const int nseg = part == 0 ? 3 : 1;
  for (int seg = 0; seg < nseg; ++seg) {
    bool isctx; int sdir, ci0, ci1, mode;
    if (part == 1) { isctx = false; sdir = dir; ci0 = 32; ci1 = 64; mode = 2; }
    else if (seg == 0) { if (!(dir == 0 && l == 0)) continue; isctx = true; sdir = 1; ci0 = 0; ci1 = 4; mode = 1; }
    else if (seg == 1) { isctx = true; sdir = dir; ci0 = 0; ci1 = 4; mode = (dir == 0 && l == 0) ? 2 : 0; }
    else { isctx = false; sdir = dir; ci0 = 0; ci1 = 32; mode = 1; }
    if (part == 0 && seg <= 1) {
#pragma unroll
      for (int i = 0; i < 8; ++i) sacc[i >> 1][i & 1] = f32x4{0.f, 0.f, 0.f, 0.f};
    }
    __threadfence();
    __syncthreads();
    const int nch = isctx ? 4 : 64;
    const int rowbase = isctx ? NLAT + b * 256 : b * 4096;
#pragma unroll
    for (int i = 0; i < 8; ++i) asm volatile("" : "+v"(sacc[i >> 1][i & 1]));
    u32x4 rq[2], rk[2], rv[4], rlr;
    bf16x8 Bw;
    float bl;
    {
      const int tid = tid0;
      const int dcol = h * 64 + 32 * ((tid >> 6) & 1) + (tid & 31), kb = 8 * ((tid & 63) >> 5);
      const float* wlp = p.in[opq(15)] + ((size_t)((l * 2 + sdir) * 16 + kb)) * 256 + dcol;
      u32x4 bw;
#pragma unroll
      for (int e = 0; e < 4; ++e) bw[e] = pack2(wlp[(2 * e) * 256], wlp[(2 * e + 1) * 256]);
      Bw = __builtin_bit_cast(bf16x8, bw);
      bl = p.in[opq(16)][(l * 2 + sdir) * 256 + dcol];
      asm volatile("" : "+v"(Bw), "+v"(bl));
      const int cL = (sdir ? nch - 1 - ci0 : ci0) * 64;
#pragma unroll
      for (int k = 0; k < 2; ++k) {
        const int id = tid + 256 * k, i = id >> 3, dc = id & 7;
        const int tau = sdir ? cL + 63 - i : cL + i;
        rq[k] = *reinterpret_cast<const u32x4*>(P + (size_t)(rowbase + tau) * IND + C_Q + h * 64 + dc * 8);
      }
#pragma unroll
      for (int k = 0; k < 2; ++k) {
        const int id = tid + 256 * k, dc = id >> 6, i = id & 63;
        const int tau = sdir ? cL + 63 - i : cL + i;
        rk[k] = *reinterpret_cast<const u32x4*>(P + (size_t)(rowbase + tau) * IND + C_K + h * 64 + dc * 8);
      }
#pragma unroll
      for (int k = 0; k < 4; ++k) {
        const int id = tid + 256 * k, ec = id >> 6, i = id & 63;
        const int tau = sdir ? cL + 63 - i : cL + i;
        rv[k] = *reinterpret_cast<const u32x4*>(P + (size_t)(rowbase + tau) * IND + C_V + h * 128 + ec * 8);
      }
      {
        const int i = 32 * (tid >> 7) + (tid & 31), hf = (tid & 63) >> 5;
        const int tau = sdir ? cL + 63 - i : cL + i;
        rlr = *reinterpret_cast<const u32x4*>(P + (size_t)(rowbase + tau) * IND + C_LR + sdir * 16 + hf * 8);
      }
    }
    for (int ci = ci0; ci < ci1; ++ci) {
      const int c0 = (sdir ? nch - 1 - ci : ci) * 64;
      int tid = tid0;
      asm volatile("" : "+v"(tid));
      const int lane = tid & 63, w = tid >> 6, fr = lane & 15, fq = lane >> 4, d = tid & 63, iq = tid >> 6;
      __syncthreads();
      pin4(rlr);
      {
        const int th = w >> 1, dh = w & 1;
        f32x16 z;
#pragma unroll
        for (int r = 0; r < 16; ++r) z[r] = 0.f;
        const f32x16 lg = mfma32(__builtin_bit_cast(bf16x8, rlr), Bw, z);
#pragma unroll
        for (int r = 0; r < 16; ++r) {
          const int t = 32 * th + (r & 3) + 8 * (r >> 2) + 4 * (lane >> 5);
          gl[t * 65 + 32 * dh + (lane & 31)] = logsigf(lg[r] + bl) * (1.f / 16.f);
        }
      }
      __syncthreads();
      {
        float vals[16];
#pragma unroll
        for (int ii = 0; ii < 16; ++ii) vals[ii] = gl[(iq * 16 + ii) * 65 + d];
        float run = 0.f;
#pragma unroll
        for (int ii = 0; ii < 16; ++ii) { run += vals[ii]; gl[(iq * 16 + ii) * 65 + d] = run; }
        red[iq * 64 + d] = run;
      }
      __syncthreads();
      {
        float off = 0.f;
        for (int q = 0; q < iq; ++q) off += red[q * 64 + d];
        if (iq > 0) {
#pragma unroll 4
          for (int ii = 0; ii < 16; ++ii) gl[(iq * 16 + ii) * 65 + d] += off;
        }
      }
      __syncthreads();
      pin4(rq[0]); pin4(rq[1]); pin4(rk[0]); pin4(rk[1]); pin4(rv[0]); pin4(rv[1]); pin4(rv[2]); pin4(rv[3]);
#pragma unroll
      for (int k = 0; k < 2; ++k) {
        const int id = tid + 256 * k, i = id >> 3, dc = id & 7;
        u32x4 oo;
#pragma unroll
        for (int e = 0; e < 4; ++e) {
          float b0 = gl[i * 65 + dc * 8 + 2 * e], b1 = gl[i * 65 + dc * 8 + 2 * e + 1];
          oo[e] = pack2(bflo(rq[k][e]) * 0.125f * __expf(b0), bfhi(rq[k][e]) * 0.125f * __expf(b1));
        }
        *reinterpret_cast<u32x4*>(qe + i * 72 + dc * 8) = oo;
      }
#pragma unroll
      for (int k = 0; k < 2; ++k) {
        const int id = tid + 256 * k, dc = id >> 6, i = id & 63;
        u32x4 oo;
#pragma unroll
        for (int e = 0; e < 4; ++e) {
          const int d0 = dc * 8 + 2 * e;
          float b0 = gl[i * 65 + d0], b1 = gl[i * 65 + d0 + 1];
          float l0 = gl[63 * 65 + d0], l1 = gl[63 * 65 + d0 + 1];
          float k0 = bflo(rk[k][e]), k1 = bfhi(rk[k][e]);
          oo[e] = pack2(k0 * __expf(-b0), k1 * __expf(-b1));
          kdT[d0 * 72 + i] = f2bf(k0 * __expf(l0 - b0));
          kdT[(d0 + 1) * 72 + i] = f2bf(k1 * __expf(l1 - b1));
        }
        *reinterpret_cast<u32x4*>(ke + i * 72 + dc * 8) = oo;
      }
#pragma unroll
      for (int k = 0; k < 4; ++k) {
        const int id = tid + 256 * k, ec = id >> 6, i = id & 63;
#pragma unroll
        for (int e = 0; e < 4; ++e) {
          vT[(ec * 8 + 2 * e) * 72 + i] = (u16)(rv[k][e] & 0xffffu);
          vT[(ec * 8 + 2 * e + 1) * 72 + i] = (u16)(rv[k][e] >> 16);
        }
      }
      u32x4 tmpv[4];
      unsigned ggr[16];
#pragma unroll
      for (int e = 0; e < 4; ++e) tmpv[e] = u32x4{0u, 0u, 0u, 0u};
#pragma unroll
      for (int e = 0; e < 16; ++e) ggr[e] = 0u;
      if (mode == 2) {
        const int qs = (w * 4 + (3 - fq)) * 16 + fr;
        const u16* tp = Y + (size_t)(rowbase + c0 + (qs >> 2)) * MIXW + 1024 + h * 128 + (qs & 3) * 32;
#pragma unroll
        for (int e = 0; e < 4; ++e) tmpv[e] = *reinterpret_cast<const u32x4*>(tp + e * 8);
#pragma unroll
        for (int tt = 0; tt < 4; ++tt)
#pragma unroll
          for (int j = 0; j < 4; ++j) {
            const int t = tt * 16 + fq * 4 + j;
            const size_t row = (size_t)(rowbase + (sdir ? c0 + 63 - t : c0 + t));
            ggr[tt * 4 + j] = *reinterpret_cast<const unsigned*>(P + row * IND + C_GG + h * 128 + w * 32 + 2 * fr);
          }
      }
      if (ci + 1 < ci1) {
        const int cL = (sdir ? nch - 2 - ci : ci + 1) * 64;
#pragma unroll
        for (int k = 0; k < 2; ++k) {
          const int id = tid + 256 * k, i = id >> 3, dc = id & 7;
          const int tau = sdir ? cL + 63 - i : cL + i;
          rq[k] = *reinterpret_cast<const u32x4*>(P + (size_t)(rowbase + tau) * IND + C_Q + h * 64 + dc * 8);
        }
#pragma unroll
        for (int k = 0; k < 2; ++k) {
          const int id = tid + 256 * k, dc = id >> 6, i = id & 63;
          const int tau = sdir ? cL + 63 - i : cL + i;
          rk[k] = *reinterpret_cast<const u32x4*>(P + (size_t)(rowbase + tau) * IND + C_K + h * 64 + dc * 8);
        }
#pragma unroll
        for (int k = 0; k < 4; ++k) {
          const int id = tid + 256 * k, ec = id >> 6, i = id & 63;
          const int tau = sdir ? cL + 63 - i : cL + i;
          rv[k] = *reinterpret_cast<const u32x4*>(P + (size_t)(rowbase + tau) * IND + C_V + h * 128 + ec * 8);
        }
        {
          const int i = 32 * (tid >> 7) + (tid & 31), hf = (tid & 63) >> 5;
          const int tau = sdir ? cL + 63 - i : cL + i;
          rlr = *reinterpret_cast<const u32x4*>(P + (size_t)(rowbase + tau) * IND + C_LR + sdir * 16 + hf * 8);
        }
      }
      __syncthreads();
      {
        f32x4 aacc[4];
#pragma unroll
        for (int i = 0; i < 4; ++i) aacc[i] = f32x4{0.f, 0.f, 0.f, 0.f};
#pragma unroll
        for (int kk = 0; kk < 2; ++kk) {
          bf16x8 a = ld8(ke + (w * 16 + fr) * 72 + kk * 32 + fq * 8);
#pragma unroll
          for (int tb = 0; tb < 4; ++tb) {
            bf16x8 bb = ld8(qe + (tb * 16 + fr) * 72 + kk * 32 + fq * 8);
            aacc[tb] = mfma16(a, bb, aacc[tb]);
          }
        }
#pragma unroll
        for (int tb = 0; tb < 4; ++tb) {
          const int t = tb * 16 + fr;
          float mv[4];
#pragma unroll
          for (int j = 0; j < 4; ++j) { const int s = w * 16 + fq * 4 + j; mv[j] = (s <= t) ? aacc[tb][j] : 0.f; }
          uint2 o; o.x = pack2(mv[0], mv[1]); o.y = pack2(mv[2], mv[3]);
          *reinterpret_cast<uint2*>(at + t * 72 + w * 16 + fq * 4) = o;
        }
      }
      __syncthreads();
      f32x4 oacc[4][2];
#pragma unroll
      for (int i = 0; i < 4; ++i) { oacc[i][0] = f32x4{0.f, 0.f, 0.f, 0.f}; oacc[i][1] = f32x4{0.f, 0.f, 0.f, 0.f}; }
#pragma unroll
      for (int kk = 0; kk < 2; ++kk) {
        bf16x8 b0 = ld8(vT + (w * 32 + 2 * fr) * 72 + kk * 32 + fq * 8);
        bf16x8 b1 = ld8(vT + (w * 32 + 2 * fr + 1) * 72 + kk * 32 + fq * 8);
#pragma unroll
        for (int tt = 0; tt < 4; ++tt) {
          bf16x8 a = ld8(at + (tt * 16 + fr) * 72 + kk * 32 + fq * 8);
          oacc[tt][0] = mfma16(a, b0, oacc[tt][0]);
          oacc[tt][1] = mfma16(a, b1, oacc[tt][1]);
        }
      }
#pragma unroll
      for (int kk = 0; kk < 2; ++kk) {
        bf16x8 s0 = packacc(sacc[2 * kk][0], sacc[2 * kk + 1][0]);
        bf16x8 s1 = packacc(sacc[2 * kk][1], sacc[2 * kk + 1][1]);
#pragma unroll
        for (int tt = 0; tt < 4; ++tt) {
          const u16* qr = qe + (tt * 16 + fr) * 72 + fq * 4;
          bf16x8 a = ld44(qr + (2 * kk) * 16, qr + (2 * kk + 1) * 16);
          oacc[tt][0] = mfma16(a, s0, oacc[tt][0]);
          oacc[tt][1] = mfma16(a, s1, oacc[tt][1]);
        }
      }
#pragma unroll
      for (int db = 0; db < 4; ++db)
#pragma unroll
        for (int j = 0; j < 4; ++j) {
          const float sc = __expf(gl[63 * 65 + db * 16 + fq * 4 + j]);
          sacc[db][0][j] *= sc; sacc[db][1][j] *= sc;
        }
#pragma unroll
      for (int kk = 0; kk < 2; ++kk) {
        bf16x8 b0 = ld8(vT + (w * 32 + 2 * fr) * 72 + kk * 32 + fq * 8);
        bf16x8 b1 = ld8(vT + (w * 32 + 2 * fr + 1) * 72 + kk * 32 + fq * 8);
#pragma unroll
        for (int db = 0; db < 4; ++db) {
          bf16x8 a = ld8(kdT + (db * 16 + fr) * 72 + kk * 32 + fq * 8);
          sacc[db][0] = mfma16(a, b0, sacc[db][0]);
          sacc[db][1] = mfma16(a, b1, sacc[db][1]);
        }
      }
      pin4(tmpv[0]); pin4(tmpv[1]); pin4(tmpv[2]); pin4(tmpv[3]);
      if (mode != 0) {
        const int ycol = 1024 + h * 128 + w * 32 + 2 * fr;
        if (mode == 1) {
          const int qs = (w * 4 + fq) * 16 + fr;
          u16* tp = Y + (size_t)(rowbase + c0 + (qs >> 2)) * MIXW + 1024 + h * 128 + (qs & 3) * 32;
#pragma unroll
          for (int tt = 0; tt < 4; ++tt) {
            u32x4 o;
#pragma unroll
            for (int j = 0; j < 4; ++j) o[j] = pack2(oacc[tt][0][j], oacc[tt][1][j]);
            *reinterpret_cast<u32x4*>(tp + tt * 8) = o;
          }
        } else {
#pragma unroll
          for (int tt = 0; tt < 4; ++tt)
#pragma unroll
            for (int j = 0; j < 4; ++j) {
              const int t = tt * 16 + fq * 4 + j;
              const int e = 15 - (tt * 4 + j);
              const unsigned pw = tmpv[e >> 2][e & 3];
              float o0 = oacc[tt][0][j] + bflo(pw);
              float o1 = oacc[tt][1][j] + bfhi(pw);
              oacc[tt][0][j] = o0; oacc[tt][1][j] = o1;
              const float sq = row16_sum(o0 * o0 + o1 * o1);
              if (fr == 0) red[w * 64 + t] = sq;
            }
          __syncthreads();
          const float* nwv = p.in[opq(17)] + l * 128;
          const float nw0 = nwv[w * 32 + 2 * fr], nw1 = nwv[w * 32 + 2 * fr + 1];
#pragma unroll
          for (int tt = 0; tt < 4; ++tt)
#pragma unroll
            for (int j = 0; j < 4; ++j) {
              const int t = tt * 16 + fq * 4 + j;
              const size_t row = (size_t)(rowbase + (sdir ? c0 + 63 - t : c0 + t));
              const float tot = red[t] + red[64 + t] + red[128 + t] + red[192 + t];
              const float rs = rsqrtf(tot * (1.f / 128.f) + EPSF);
              const unsigned gw = pin(ggr[tt * 4 + j]);
              const float g0 = bflo(gw), g1 = bfhi(gw);
              *reinterpret_cast<unsigned*>(Y + row * MIXW + ycol) =
                  pack2(oacc[tt][0][j] * rs * nw0 * g0, oacc[tt][1][j] * rs * nw1 * g1);
            }
        }
      }
    }
  }
  if (part == 0) {
#pragma unroll
    for (int i = 0; i < 8; ++i) *reinterpret_cast<f32x4*>(stsave + (i * 256 + tid0) * 4) = sacc[i >> 1][i & 1];
  }
}

__device__ void s5_item(const Params& p, int l, int part, int blk, unsigned char* smem) {
  const int tid = opaque_tid(), lane = tid & 63, w = tid >> 6, fr = lane & 15, fq = lane >> 4;
  const int wi = blk * 4 + w;
  const int b = wi >> 6, g = (wi >> 1) & 31, dir = wi & 1;
  u16* hb = (u16*)smem + w * (32 * 136);
  u16* ust = (u16*)(smem + 4 * 32 * 136 * 2) + w * (32 * 16);
  u16* P = (u16*)(p.ws + WS_P);
  u16* Y = (u16*)(p.ws + WS_Y);
  u16* G5C = (u16*)(p.ws + WS_G5C);
  float* stsave = (float*)(p.ws + WS_S5ST) + (size_t)wi * 128;
  const float dsk = p.in[opq(25)][l * 512 + g * 16 + fr];
  float hre = 0.f, him = 0.f;
  if (part == 1) { hre = stsave[lane * 2]; him = stsave[lane * 2 + 1]; }
  const int nseg = part == 0 ? 3 : 1;
  for (int seg = 0; seg < nseg; ++seg) {
    bool isctx; int sdir, ti0, ti1, mode;
    if (part == 1) { isctx = false; sdir = dir; ti0 = 64; ti1 = 128; mode = 2; }
    else if (seg == 0) { if (!(dir == 0 && l == 0)) continue; isctx = true; sdir = 1; ti0 = 0; ti1 = 8; mode = 1; }
    else if (seg == 1) { isctx = true; sdir = dir; ti0 = 0; ti1 = 8; mode = (dir == 0 && l == 0) ? 2 : 0; }
    else { isctx = false; sdir = dir; ti0 = 0; ti1 = 64; mode = 1; }
    if (part == 0 && seg <= 1) { hre = 0.f; him = 0.f; }
    __threadfence();
    const unsigned char* cbase = p.ws + WS_S5C + (size_t)((l * 2 + sdir) * 32 + g) * 8704;
    const u16* BbarM = (const u16*)cbase;
    const u16* CmT = (const u16*)(cbase + 4096);
    const float* lamb = (const float*)(cbase + 8192);
    bf16x8 Bf[4], Cf[4];
#pragma unroll
    for (int cb = 0; cb < 4; ++cb) Bf[cb] = ld8(BbarM + (cb * 32 + (lane & 31)) * 16 + 8 * (lane >> 5));
#pragma unroll
    for (int kk = 0; kk < 4; ++kk) Cf[kk] = ld8(CmT + fr * 128 + kk * 32 + fq * 8);
    float lre = lamb[2 * lane], lim = lamb[2 * lane + 1];
#pragma unroll
    for (int i = 0; i < 4; ++i) asm volatile("" : "+v"(Bf[i]), "+v"(Cf[i]));
    asm volatile("" : "+v"(lre), "+v"(lim), "+v"(hre), "+v"(him));
    const int nt = isctx ? 8 : 128;
    const int rowbase = isctx ? NLAT + b * 256 : b * 4096;
    bf16x8 anext;
    {
      const int c0 = (sdir ? nt - 1 - ti0 : ti0) * 32, i = lane & 31;
      anext = ld8(P + (size_t)(rowbase + (sdir ? c0 + 31 - i : c0 + i)) * IND + C_U5 + g * 16 + 8 * (lane >> 5));
    }
    for (int ti = ti0; ti < ti1; ++ti) {
      const int c0 = (sdir ? nt - 1 - ti : ti) * 32;
      const bf16x8 a = anext;
      if (ti + 1 < ti1) {
        const int c1 = (sdir ? nt - 2 - ti : ti + 1) * 32, i = lane & 31;
        anext = ld8(P + (size_t)(rowbase + (sdir ? c1 + 31 - i : c1 + i)) * IND + C_U5 + g * 16 + 8 * (lane >> 5));
      }
      u32x4 tmpv = u32x4{0u, 0u, 0u, 0u};
      if (mode == 2) {
        const int qs = (3 - fq) * 16 + fr;
        tmpv = *reinterpret_cast<const u32x4*>(Y + (size_t)(rowbase + c0 + (qs >> 1)) * MIXW + 1536 + g * 16 + (qs & 1) * 8);
      }
      wave_lds_sync();
      if (mode == 2) *reinterpret_cast<bf16x8*>(ust + (lane & 31) * 16 + 8 * (lane >> 5)) = a;
#pragma unroll
      for (int cb = 0; cb < 4; ++cb) {
        f32x16 z;
#pragma unroll
        for (int r = 0; r < 16; ++r) z[r] = 0.f;
        f32x16 acc = mfma32(a, Bf[cb], z);
#pragma unroll
        for (int r = 0; r < 16; ++r) {
          const int ii = (r & 3) + 8 * (r >> 2) + 4 * (lane >> 5);
          hb[ii * 136 + cb * 32 + (lane & 31)] = f2bf(acc[r]);
        }
      }
      wave_lds_sync();
      {
        unsigned buv[32];
#pragma unroll
        for (int i = 0; i < 32; ++i) buv[i] = *reinterpret_cast<const unsigned*>(hb + i * 136 + 2 * lane);
#pragma unroll
        for (int i = 0; i < 32; ++i) {
          const float nre = lre * hre - lim * him + bflo(buv[i]);
          const float nim = lre * him + lim * hre + bfhi(buv[i]);
          hre = nre; him = nim;
          *reinterpret_cast<unsigned*>(hb + i * 136 + 2 * lane) = pack2(hre, him);
        }
      }
      wave_lds_sync();
      f32x4 ya[2];
      ya[0] = f32x4{0.f, 0.f, 0.f, 0.f}; ya[1] = f32x4{0.f, 0.f, 0.f, 0.f};
#pragma unroll
      for (int kk = 0; kk < 4; ++kk) {
        bf16x8 a0 = ld8(hb + fr * 136 + kk * 32 + fq * 8);
        bf16x8 a1 = ld8(hb + (16 + fr) * 136 + kk * 32 + fq * 8);
        ya[0] = mfma16(a0, Cf[kk], ya[0]);
        ya[1] = mfma16(a1, Cf[kk], ya[1]);
      }
      pin4(tmpv);
      if (mode == 1) {
        u32x4 o;
        o[0] = pack2(ya[0][0], ya[0][1]); o[1] = pack2(ya[0][2], ya[0][3]); o[2] = pack2(ya[1][0], ya[1][1]); o[3] = pack2(ya[1][2], ya[1][3]);
        const int qs = fq * 16 + fr;
        *reinterpret_cast<u32x4*>(Y + (size_t)(rowbase + c0 + (qs >> 1)) * MIXW + 1536 + g * 16 + (qs & 1) * 8) = o;
      } else if (mode == 2) {
#pragma unroll
        for (int rt = 0; rt < 2; ++rt)
#pragma unroll
          for (int j = 0; j < 4; ++j) {
            const int i = rt * 16 + fq * 4 + j;
            const int tau = sdir ? c0 + 31 - i : c0 + i;
            const size_t row = (size_t)(rowbase + tau);
            const int e = 7 - (rt * 4 + j);
            const unsigned pw = tmpv[e >> 1];
            const float yf = (e & 1) ? bfhi(pw) : bflo(pw);
            const float u = bf2f(ust[i * 16 + fr]);
            const float x = yf + ya[rt][j] + dsk * u;
            const float th = 1.f - 2.f * rcpf(1.f + __expf(2.f * 0.7978845608028654f * (x + 0.044715f * x * x * x)));
            const float ge = 0.5f * x * (1.f + th);
            if (isctx) G5C[(row - NLAT) * 512 + g * 16 + fr] = f2bf(ge);
            else P[row * IND + C_U5 + g * 16 + fr] = f2bf(ge);
          }
      }
    }
  }
  if (part == 0) { stsave[lane * 2] = hre; stsave[lane * 2 + 1] = him; }
}

__device__ void ssd_norm_rows(const Params& p, int nrows) {
  const int tid = opaque_tid();
  const float* ssq = (const float*)(p.ws + WS_SSQ);
  float* rsb = (float*)(p.ws + WS_RS);
  for (int i = blockIdx.x * 256 + tid; i < nrows * 2; i += gridDim.x * 256) {
    const float* sp = ssq + (size_t)i * 8;
    const float sum = sp[0] + sp[1] + sp[2] + sp[3] + sp[4] + sp[5] + sp[6] + sp[7];
    rsb[i] = rsqrtf(sum * (1.f / 512.f) + EPSF);
  }
}

__device__ void phase_final(const Params& p) {
  const int tid = opaque_tid(), lane = tid & 63, w = tid >> 6;
  const float* nw = p.in[opq(28)];
  for (int r = blockIdx.x * 4 + w; r < NLAT; r += gridDim.x * 4) {
    float* src = p.out + (size_t)r * 1024;
    float4 v[4]; float ss = 0.f;
#pragma unroll
    for (int q = 0; q < 4; ++q) {
      v[q] = *reinterpret_cast<const float4*>(src + lane * 4 + q * 256);
      ss += v[q].x * v[q].x + v[q].y * v[q].y + v[q].z * v[q].z + v[q].w * v[q].w;
    }
#pragma unroll
    for (int o = 32; o > 0; o >>= 1) ss += __shfl_xor(ss, o);
    const float rs = rsqrtf(ss * (1.f / 1024.f) + EPSF);
#pragma unroll
    for (int q = 0; q < 4; ++q) {
      const int col = lane * 4 + q * 256;
      float4 n4 = *reinterpret_cast<const float4*>(nw + col);
      float4 o = make_float4(v[q].x * rs * n4.x, v[q].y * rs * n4.y, v[q].z * rs * n4.z, v[q].w * rs * n4.w);
      *reinterpret_cast<float4*>(src + col) = o;
    }
  }
}


#define XB_TMO      128
#define XB_XCNT(j)  (256  + 64 * (j))
#define XB_XSUB(j)  (1280 + 64 * (j))
#define XB_XGEN(j)  (2304 + 64 * (j))
#define XB_TOP      3328
#define XB_TOPGEN   3392
#define XCD_BAR_WORDS 3456
#define XB_SPIN_CAP (1u << 20)
DI unsigned xb_ld(unsigned* p) { return __hip_atomic_load(p, __ATOMIC_RELAXED, __HIP_MEMORY_SCOPE_AGENT); }
DI unsigned xb_add(unsigned* p, unsigned v) { return __hip_atomic_fetch_add(p, v, __ATOMIC_RELAXED, __HIP_MEMORY_SCOPE_AGENT); }
DI unsigned xb_xcc_id() { return (unsigned)__builtin_amdgcn_s_getreg((3 << 11) | 20) & 0xFu; }
#define XB_SPIN(cond, bar) do { unsigned _sp = 0; while (cond) { __builtin_amdgcn_s_sleep(1); \
    if ((++_sp & 255u) == 0u) { if (xb_ld(&(bar)[XB_TMO])) break; if (_sp > XB_SPIN_CAP) { atomicAdd(&(bar)[XB_TMO], 1u); break; } } } } while (0)
struct XcdBarrier { unsigned* bar; unsigned x, nloc, nx; };
DI XcdBarrier xcd_barrier_post(unsigned* bar) {
  XcdBarrier b; b.bar = bar; b.x = xb_xcc_id(); b.nloc = 0u; b.nx = 0u;
  if (threadIdx.x == 0) (void)xb_add(&bar[XB_XCNT(b.x)], 1u);
  return b;
}
DI void xcd_barrier_complete(unsigned* bar, unsigned x, unsigned& nloc, unsigned& nx) {
  const unsigned G = gridDim.x;
  unsigned sum, cnt, mine, sp = 0u;
  for (;;) {
    sum = 0u; cnt = 0u; mine = 0u;
#pragma unroll
    for (unsigned j = 0; j < 16; ++j) { const unsigned c = xb_ld(&bar[XB_XCNT(j)]); sum += c; cnt += (c > 0u) ? 1u : 0u; mine = (j == x) ? c : mine; }
    if (sum == G) break;
    __builtin_amdgcn_s_sleep(1);
    if ((++sp & 255u) == 0u) { if (xb_ld(&bar[XB_TMO])) break; if (sp > XB_SPIN_CAP) { atomicAdd(&bar[XB_TMO], 1u); break; } }
  }
  nloc = mine > 0u ? mine : 1u; nx = cnt > 0u ? cnt : 1u;
}
DI void xcd_barrier(XcdBarrier& b) {
  asm volatile("s_waitcnt vmcnt(0)" ::: "memory");
  __syncthreads();
  if (threadIdx.x == 0) {
    unsigned* bar = b.bar;
    __builtin_amdgcn_s_waitcnt(0);
    if (b.nloc == 0u) xcd_barrier_complete(bar, b.x, b.nloc, b.nx);
    const unsigned nloc = b.nloc, nx = b.nx;
    const unsigned old = xb_add(&bar[XB_XSUB(b.x)], 1u);
    const unsigned gen = old / nloc;
    if (old + 1u == (gen + 1u) * nloc) {
      __builtin_amdgcn_fence(__ATOMIC_RELEASE, "agent");
      asm volatile("s_waitcnt vmcnt(0)" ::: "memory");
      const unsigned og = xb_add(&bar[XB_TOP], 1u);
      const unsigned tg = og / nx;
      if (og + 1u == (tg + 1u) * nx) xb_add(&bar[XB_TOPGEN], 1u);
      else XB_SPIN(xb_ld(&bar[XB_TOPGEN]) == tg, bar);
      __builtin_amdgcn_fence(__ATOMIC_ACQUIRE, "agent");
      xb_add(&bar[XB_XGEN(b.x)], 1u);
      asm volatile("s_waitcnt vmcnt(0)" ::: "memory");
    } else {
      XB_SPIN(xb_ld(&bar[XB_XGEN(b.x)]) == gen, bar);
      __builtin_amdgcn_fence(__ATOMIC_ACQUIRE, "agent");
      asm volatile("s_waitcnt vmcnt(0)" ::: "memory");
    }
  }
  __syncthreads();
}

__global__ void __launch_bounds__(256, 2) fwd_megakernel(Params p) {
  extern __shared__ __attribute__((aligned(16))) unsigned char smem[];
  cg::grid_group grid = cg::this_grid();
  XcdBarrier xb = xcd_barrier_post((unsigned*)(p.ws + WS_BAR));
  const int ph_lo = p.ph_lo, ph_hi = p.ph_hi;
  for (int ph = ph_lo; ph < ph_hi; ++ph) {
    if (ph == 0) {
      phase_prep(p, smem);
    } else if (ph == NPHASE - 1) {
      phase_final(p);
    } else {
      const int l = (ph - 1) / 7, sub = (ph - 1) % 7;
      const int mt = (l == 1) ? 256 : 272;
      if (sub == 0) {
        phase_pre(p, l, smem);
      } else if (sub == 1) {
        const u16* U = (const u16*)(p.ws + WS_Y);
        const u16* W = (const u16*)(p.ws + WS_WIN);
        const int xcd = blockIdx.x & 7, slot = blockIdx.x >> 3, nslots = gridDim.x >> 3;
        for (int u = slot; u < 918; u += nslots) {
          const int pnl = u / 306, v = u % 306;
          gemm_tile<192, 0>(p, l, U, 1024, W, 1024, 1024, (xcd * 34 + v / 9) * 128, (pnl * 9 + v % 9) * 192, smem);
        }
      } else if (sub == 2) {
        phase_conv(p, l);
      } else if (sub == 3 || sub == 4) {
        const int part = sub - 3;
        for (int k = 0;; ++k) {
          int it;
          if (gridDim.x == 512) {
            if (k > 0) break;
            const int blk = blockIdx.x;
            const int q = blk < 256 ? blk - 64 : 192 + (blk - 448);
            const int sit = q < 128 ? q * 2 : (q - 128) * 2 + 1;
            it = blk < 64 ? 256 + blk : blk < 256 ? sit : blk < 320 ? -1 : blk < 448 ? blk : sit;
          } else {
            it = blockIdx.x + k * gridDim.x;
            if (it >= 448) break;
          }
          if (it >= 0) {
            if (it < 256) ssd_item(p, l, part, it, smem);
            else if (it < 320) gla_item(p, l, part, it - 256, smem);
            else s5_item(p, l, part, it - 320, smem);
          }
          __syncthreads();
        }
      } else if (sub == 5) {
        const u16* W = (const u16*)(p.ws + WS_GLU);
        const int xcd = blockIdx.x & 7, slot = blockIdx.x >> 3, nslots = gridDim.x >> 3, mtx = mt >> 3;
        for (int u = slot; u < mtx * 8; u += nslots) {
          const int t = (xcd * mtx) * 8 + u;
          const int m0 = (t >> 3) * 128;
          if (m0 < NLAT) gemm_tile<128, 1>(p, l, (const u16*)(p.ws + WS_P) + C_U5, IND, W, 512, 512, m0, (t & 7) * 128, smem);
          else gemm_tile<128, 1>(p, l, (const u16*)(p.ws + WS_G5C) - (size_t)NLAT * 512, 512, W, 512, 512, m0, (t & 7) * 128, smem);
        }
        ssd_norm_rows(p, mt * 128);
      } else {
        const u16* A = (const u16*)(p.ws + WS_Y);
        const u16* W = (const u16*)(p.ws + WS_WOUT);
        const int xcd = blockIdx.x & 7, slot = blockIdx.x >> 3, nslots = gridDim.x >> 3, mtx = mt >> 3;
        for (int u = slot; u < mtx * 8; u += nslots) {
          const int t = (xcd * mtx) * 8 + u;
          gemm_tile<128, 2>(p, l, A, MIXW, W, MIXW, MIXW, (t >> 3) * 128, (t & 7) * 128, smem);
        }
      }
    }
    if (ph + 1 < ph_hi) {
      if (ph_hi < 0) grid.sync();
      xcd_barrier(xb);
    }
  }
}

extern "C" void kernel_launch(void* const* d_in, const int* in_sizes, int n_in, void* d_out, int out_size, void* d_ws,
                              size_t ws_size, hipStream_t stream) {
  static int grid_blocks = 0;
  if (grid_blocks == 0) {
    if (n_in != 29 || ws_size < WS_END) { fprintf(stderr, "kernel_launch: bad n_in %d / ws %zu (need %zu)\n", n_in, ws_size, (size_t)WS_END); grid_blocks = -1; return; }
    int dev = 0, cus = 0, per_cu = 0;
    hipGetDevice(&dev);
    hipDeviceGetAttribute(&cus, hipDeviceAttributeMultiprocessorCount, dev);
    hipFuncSetAttribute((const void*)fwd_megakernel, hipFuncAttributeMaxDynamicSharedMemorySize, SMEM_BYTES);
    hipOccupancyMaxActiveBlocksPerMultiprocessor(&per_cu, (const void*)fwd_megakernel, 256, SMEM_BYTES);
    if (per_cu < 1) per_cu = 1;
    if (per_cu > 2) per_cu = 2;
    grid_blocks = cus * per_cu;
    fprintf(stderr, "kernel_launch: cus %d per_cu %d grid %d\n", cus, per_cu, grid_blocks);
  }
  if (grid_blocks < 0) return;
  Params p{};
  for (int i = 0; i < 29; ++i) p.in[i] = (const float*)d_in[i];
  p.out = (float*)d_out; p.ws = (unsigned char*)d_ws; p.ph_lo = 0; p.ph_hi = NPHASE;
  if (hipMemsetAsync((char*)d_ws + WS_BAR, 0, 16384, stream) != hipSuccess) { fprintf(stderr, "kernel_launch: memset of the barrier words failed\n"); return; }
  void* args[] = {&p};
  hipError_t e = hipLaunchCooperativeKernel((const void*)fwd_megakernel, dim3(grid_blocks), dim3(256), args, SMEM_BYTES, stream);
  if (e != hipSuccess) fprintf(stderr, "cooperative launch failed: %s (grid %d)\n", hipGetErrorString(e), grid_blocks);
}
```

```cpp
#include <hip/hip_runtime.h>
#include <hip/hip_cooperative_groups.h>
#include <cstdio>
namespace cg = cooperative_groups;

typedef unsigned short u16;
using bf16x8 = __attribute__((ext_vector_type(8))) short;
using bf16x4 = __attribute__((ext_vector_type(4))) short;
using f32x4 = __attribute__((ext_vector_type(4))) float;
using f32x16 = __attribute__((ext_vector_type(16))) float;
using u32x4 = __attribute__((ext_vector_type(4))) unsigned;
#define DI __device__ __forceinline__

constexpr int DM = 1024, NLAT = 32768, NCTX = 2048, NTOK = 34816, IND = 5184, MIXW = 2048;
constexpr int C_XBC = 1024, C_BM = 2048, C_CM = 2304, C_DT = 2560, C_Q = 2592, C_K = 2848, C_V = 3104, C_GG = 3616,
              C_LR = 4128, C_U5 = 4160, C_SG = 4672;
constexpr float EPSF = 1e-6f;
constexpr int SMEM_BYTES = 81920;
constexpr int NPHASE = 16;

constexpr size_t WS_P = 0;
constexpr size_t WS_Y = WS_P + (size_t)NTOK * IND * 2;
constexpr size_t WS_WIN = WS_Y + (size_t)NTOK * MIXW * 2;
constexpr size_t WS_WOUT = WS_WIN + (size_t)IND * DM * 2;
constexpr size_t WS_GLU = WS_WOUT + (size_t)DM * MIXW * 2;
constexpr size_t WS_HCTX = WS_GLU + (size_t)1024 * 512 * 2;
constexpr size_t WS_MOD = WS_HCTX + (size_t)NCTX * DM * 4;
constexpr size_t WS_SSQ = WS_MOD + (size_t)2 * 9 * 3072 * 4;
constexpr size_t WS_S5C = WS_SSQ + (size_t)NTOK * 16 * 4;
constexpr size_t WS_G5C = WS_S5C + (size_t)128 * 8704;
constexpr size_t WS_S5ST = WS_G5C + (size_t)NCTX * 512 * 2;
constexpr size_t WS_BAR = WS_S5ST + (size_t)512 * 128 * 4;
constexpr size_t WS_RS = WS_BAR + 16384;
constexpr size_t WS_END = WS_RS + (size_t)NTOK * 2 * 4;

struct Params {
  const float* in[29];
  float* out;
  unsigned char* ws;
  int ph_lo, ph_hi;
};

DI int opq(int i) { asm volatile("" : "+s"(i)); return i; }
DI int opaque_tid() { int t = threadIdx.x; asm volatile("" : "+v"(t)); return t; }
typedef __bf16 hbf16x2 __attribute__((ext_vector_type(2)));
typedef float hf32x2 __attribute__((ext_vector_type(2)));
DI u16 f2bf(float x) { __bf16 h = (__bf16)x; return __builtin_bit_cast(u16, h); }
DI float bf2f(u16 h) { return __uint_as_float(((unsigned)h) << 16); }
DI unsigned pack2(float a, float b) { hf32x2 v = {a, b}; return __builtin_bit_cast(unsigned, __builtin_convertvector(v, hbf16x2)); }
DI float bflo(unsigned v) { return __uint_as_float(v << 16); }
DI float bfhi(unsigned v) { return __uint_as_float(v & 0xffff0000u); }
DI float rcpf(float x) { return __builtin_amdgcn_rcpf(x); }
DI float siluf(float x) { return x * rcpf(1.f + __expf(-x)); }
DI float logsigf(float x) { return fminf(x, 0.f) - __logf(1.f + __expf(-fabsf(x))); }
DI float softplusf(float v) { return fmaxf(v, 0.f) + log1pf(__expf(-fabsf(v))); }
DI f32x4 mfma16(bf16x8 a, bf16x8 b, f32x4 c) { return __builtin_amdgcn_mfma_f32_16x16x32_bf16(a, b, c, 0, 0, 0); }
DI f32x16 mfma32(bf16x8 a, bf16x8 b, f32x16 c) { return __builtin_amdgcn_mfma_f32_32x32x16_bf16(a, b, c, 0, 0, 0); }
DI void wave_lds_sync() { asm volatile("s_waitcnt lgkmcnt(0)" ::: "memory"); }
DI unsigned pin(unsigned v) { asm volatile("" : "+v"(v)); return v; }
DI void pin4(u32x4& v) { asm volatile("" : "+v"(v)); }
#define DPPF(v, old, ctrl, rmask) __builtin_bit_cast(float, __builtin_amdgcn_update_dpp(__builtin_bit_cast(int, (float)(old)), __builtin_bit_cast(int, (float)(v)), (ctrl), (rmask), 0xf, false))
DI float row16_sum(float v) {
  v += DPPF(v, 0.f, 0xB1, 0xf);
  v += DPPF(v, 0.f, 0x4E, 0xf);
  v += DPPF(v, 0.f, 0x141, 0xf);
  v += DPPF(v, 0.f, 0x140, 0xf);
  return v;
}
DI float wave_incl_scan(float v) {
  v += DPPF(v, 0.f, 0x111, 0xf);
  v += DPPF(v, 0.f, 0x112, 0xf);
  v += DPPF(v, 0.f, 0x114, 0xf);
  v += DPPF(v, 0.f, 0x118, 0xf);
  v += DPPF(v, 0.f, 0x142, 0xa);
  v += DPPF(v, 0.f, 0x143, 0xc);
  return v;
}
DI bf16x8 ld8(const u16* p) { return *reinterpret_cast<const bf16x8*>(p); }
DI bf16x8 ld44(const u16* p0, const u16* p1) {
  bf16x4 a = *reinterpret_cast<const bf16x4*>(p0), b = *reinterpret_cast<const bf16x4*>(p1);
  return __builtin_shufflevector(a, b, 0, 1, 2, 3, 4, 5, 6, 7);
}
DI bf16x8 packacc(const f32x4& a, const f32x4& b) {
  uint4 u; u.x = pack2(a[0], a[1]); u.y = pack2(a[2], a[3]); u.z = pack2(b[0], b[1]); u.w = pack2(b[2], b[3]);
  return __builtin_bit_cast(bf16x8, u);
}

__device__ void phase_prep(const Params& p, unsigned char* smem) {
  float* sc = (float*)smem;
  float* red = sc + 9 * 1024;
  const int tid = opaque_tid();
  float* modb = (float*)(p.ws + WS_MOD);
  bool filled = false;
  for (int it = blockIdx.x; it < 96 + 128; it += gridDim.x) {
    if (it < 96) {
      if (!filled) {
        for (int idx = tid; idx < 9216; idx += 256) {
          int r = idx >> 10, k = idx & 1023;
          float v = r < 8 ? p.in[opq(1)][r * 1024 + k] : p.in[opq(3)][k];
          sc[idx] = siluf(v);
        }
        filled = true;
        __syncthreads();
      }
      const int l = it / 48, j0 = (it % 48) * 64, kg = tid >> 6, jj = tid & 63;
      float a[9];
#pragma unroll
      for (int r = 0; r < 9; ++r) a[r] = 0.f;
      const float* W = p.in[opq(5)] + (size_t)l * 1024 * 3072 + j0 + jj;
      for (int k = kg * 256; k < kg * 256 + 256; ++k) {
        float wv = W[(size_t)k * 3072];
#pragma unroll
        for (int r = 0; r < 9; ++r) a[r] += sc[r * 1024 + k] * wv;
      }
#pragma unroll
      for (int r = 0; r < 9; ++r) red[(kg * 9 + r) * 64 + jj] = a[r];
      __syncthreads();
      for (int idx = tid; idx < 576; idx += 256) {
        int r = idx >> 6, j = idx & 63;
        float s = red[(0 * 9 + r) * 64 + j] + red[(1 * 9 + r) * 64 + j] + red[(2 * 9 + r) * 64 + j] + red[(3 * 9 + r) * 64 + j];
        modb[(l * 9 + r) * 3072 + j0 + j] = s + p.in[opq(6)][l * 3072 + j0 + j];
      }
      __syncthreads();
    } else {
      const int q = it - 96, l = q >> 6, d = (q >> 5) & 1, g = q & 31;
      unsigned char* base = p.ws + WS_S5C + (size_t)q * 8704;
      u16* BbarM = (u16*)base;
      u16* CmT = (u16*)(base + 4096);
      float* lamb = (float*)(base + 8192);
      const float st = expf(p.in[opq(20)][(l * 2 + d) * 32 + g]);
      for (int idx = tid; idx < 1024; idx += 256) {
        const int pp = idx >> 4, hh = idx & 15;
        const int li = ((l * 2 + d) * 32 + g) * 64 + pp;
        const float lre = p.in[opq(18)][li], lim = p.in[opq(19)][li];
        const float a = lre * st, bb = lim * st;
        const float ea = expf(a), sn = sinf(bb), cs = cosf(bb), s2 = sinf(0.5f * bb);
        const float lbre = ea * cs, lbim = ea * sn;
        const float nre = expm1f(a) * cs - 2.f * s2 * s2, nim = lbim;
        const float den = lre * lre + lim * lim;
        const float cre = (nre * lre + nim * lim) / den, cim = (nim * lre - nre * lim) / den;
        const int bi = ((l * 32 + g) * 64 + pp) * 16 + hh;
        const float bre = p.in[opq(21)][bi], bim = p.in[opq(22)][bi];
        BbarM[(2 * pp) * 16 + hh] = f2bf(cre * bre - cim * bim);
        BbarM[(2 * pp + 1) * 16 + hh] = f2bf(cre * bim + cim * bre);
        const int cidx = (((l * 2 + d) * 32 + g) * 16 + hh) * 64 + pp;
        CmT[hh * 128 + 2 * pp] = f2bf(p.in[opq(23)][cidx]);
        CmT[hh * 128 + 2 * pp + 1] = f2bf(-p.in[opq(24)][cidx]);
        if (hh == 0) { lamb[2 * pp] = lbre; lamb[2 * pp + 1] = lbim; }
      }
    }
  }
}

__device__ void phase_pre(const Params& p, int l, unsigned char* smem) {
  const int tid = opaque_tid(), lane = tid & 63, w = tid >> 6;
  const float* hl = l == 0 ? p.in[opq(0)] : p.out;
  const float* hc = l == 0 ? p.in[opq(2)] : (const float*)(p.ws + WS_HCTX);
  const float* nw = p.in[opq(4)] + l * 1024;
  const float* modb = (const float*)(p.ws + WS_MOD) + l * 9 * 3072;
  u16* U = (u16*)(p.ws + WS_Y);
  const bool cm = (l & 1);
  for (int r = blockIdx.x * 4 + w; r < NTOK; r += gridDim.x * 4) {
    const float* src; const float* mrow;
    if (r < NLAT) {
      int b = r >> 12, sp = r & 4095;
      int s = cm ? (((sp & 63) << 6) | (sp >> 6)) : sp;
      src = hl + ((size_t)(b * 4096 + s)) * 1024; mrow = modb + b * 3072;
    } else { src = hc + (size_t)(r - NLAT) * 1024; mrow = modb + 8 * 3072; }
    float4 v[4]; float ss = 0.f;
#pragma unroll
    for (int q = 0; q < 4; ++q) {
      v[q] = *reinterpret_cast<const float4*>(src + lane * 4 + q * 256);
      ss += v[q].x * v[q].x + v[q].y * v[q].y + v[q].z * v[q].z + v[q].w * v[q].w;
    }
#pragma unroll
    for (int o = 32; o > 0; o >>= 1) ss += __shfl_xor(ss, o);
    const float rs = rsqrtf(ss * (1.f / 1024.f) + EPSF);
#pragma unroll
    for (int q = 0; q < 4; ++q) {
      const int col = lane * 4 + q * 256;
      float4 n4 = *reinterpret_cast<const float4*>(nw + col);
      float4 sh = *reinterpret_cast<const float4*>(mrow + col);
      float4 s4 = *reinterpret_cast<const float4*>(mrow + 1024 + col);
      float u0 = v[q].x * rs * n4.x * (1.f + s4.x) + sh.x;
      float u1 = v[q].y * rs * n4.y * (1.f + s4.y) + sh.y;
      float u2 = v[q].z * rs * n4.z * (1.f + s4.z) + sh.z;
      float u3 = v[q].w * rs * n4.w * (1.f + s4.w) + sh.w;
      uint2 o; o.x = pack2(u0, u1); o.y = pack2(u2, u3);
      *reinterpret_cast<uint2*>(U + (size_t)r * 1024 + col) = o;
    }
  }
  float* tile = (float*)smem;
  for (int t = blockIdx.x; t < 1296 + 512 + 128; t += gridDim.x) {
    const float* src; int sld, k0, n0, kind; u16* dst; int dld;
    if (t < 1296) { kind = 0; k0 = (t / 81) * 64; n0 = (t % 81) * 64; src = p.in[opq(7)] + (size_t)l * 1024 * IND; sld = IND; dst = (u16*)(p.ws + WS_WIN); dld = 1024; }
    else if (t < 1808) { int q = t - 1296; kind = 1; k0 = (q / 16) * 64; n0 = (q % 16) * 64; src = p.in[opq(8)] + (size_t)l * 2048 * 1024; sld = 1024; dst = (u16*)(p.ws + WS_WOUT); dld = 2048; }
    else { int q = t - 1808; kind = 2; k0 = (q / 16) * 64; n0 = (q % 16) * 64; src = p.in[opq(26)] + (size_t)l * 512 * 1024; sld = 1024; dst = (u16*)(p.ws + WS_GLU); dld = 512; }
    __syncthreads();
#pragma unroll
    for (int rr = 0; rr < 4; ++rr) {
      int i = (tid >> 4) + 16 * rr, j = (tid & 15) * 4;
      float4 v = *reinterpret_cast<const float4*>(src + (size_t)(k0 + i) * sld + n0 + j);
      if (kind == 1 && k0 + i < 1024) { float s = p.in[opq(14)][l * 1024 + k0 + i]; v.x *= s; v.y *= s; v.z *= s; v.w *= s; }
      tile[i * 65 + j] = v.x; tile[i * 65 + j + 1] = v.y; tile[i * 65 + j + 2] = v.z; tile[i * 65 + j + 3] = v.w;
    }
    __syncthreads();
#pragma unroll
    for (int rr = 0; rr < 2; ++rr) {
      int n = (tid >> 3) + 32 * rr, i0 = (tid & 7) * 8;
      uint4 o;
      o.x = pack2(tile[(i0 + 0) * 65 + n], tile[(i0 + 1) * 65 + n]);
      o.y = pack2(tile[(i0 + 2) * 65 + n], tile[(i0 + 3) * 65 + n]);
      o.z = pack2(tile[(i0 + 4) * 65 + n], tile[(i0 + 5) * 65 + n]);
      o.w = pack2(tile[(i0 + 6) * 65 + n], tile[(i0 + 7) * 65 + n]);
      int drow = n0 + n;
      if (kind == 2) { int o_ = n0 + n, half = o_ >> 9, rem = o_ & 511; drow = (rem >> 6) * 128 + ((rem & 63) >> 4) * 32 + half * 16 + (rem & 15); }
      *reinterpret_cast<uint4*>(dst + (size_t)drow * dld + k0 + i0) = o;
    }
  }
}

template <int BN, int MODE>
__device__ void gemm_tile(const Params& p, int l, const u16* __restrict__ A, int lda, const u16* __restrict__ Bt, int ldb,
                          int K, int m0, int n0, unsigned char* smem) {
  constexpr int WN = BN / 2, NF = WN / 16, NBL = BN * 8 / 256;
  u16* As = (u16*)smem;
  u16* Bs = As + 128 * 64;
  const int tid = opaque_tid(), lane = tid & 63, w = tid >> 6, wr = w >> 1, wc = w & 1, fr = lane & 15, fq = lane >> 4;
  f32x4 acc[4][NF];
#pragma unroll
  for (int m = 0; m < 4; ++m)
#pragma unroll
    for (int n = 0; n < NF; ++n) acc[m][n] = f32x4{0.f, 0.f, 0.f, 0.f};
  constexpr int STAGE = (128 + BN) * 64;
  const int nk = K / 64;
#define GLDS(OFF, KT) do { const int k0_ = (KT) * 64; \
    _Pragma("unroll") for (int i = 0; i < 4; ++i) { const int id = tid + 256 * i, row = id >> 3, c = (id & 7) ^ ((id >> 4) & 7); \
      __builtin_amdgcn_global_load_lds((const unsigned*)(A + (size_t)(m0 + row) * lda + k0_ + c * 8), (unsigned*)(As + (OFF) + id * 8), 16, 0, 0); } \
    _Pragma("unroll") for (int i = 0; i < NBL; ++i) { const int id = tid + 256 * i, row = id >> 3, c = (id & 7) ^ ((id >> 4) & 7); \
      __builtin_amdgcn_global_load_lds((const unsigned*)(Bt + (size_t)(n0 + row) * ldb + k0_ + c * 8), (unsigned*)(Bs + (OFF) + id * 8), 16, 0, 0); } } while (0)
#define COMPUTE(OFF) do { \
    _Pragma("unroll") for (int kk = 0; kk < 2; ++kk) { \
      bf16x8 af[4], bfr[NF]; \
      _Pragma("unroll") for (int m = 0; m < 4; ++m) af[m] = ld8(As + (OFF) + (wr * 64 + m * 16 + fr) * 64 + (((kk * 4 + fq) ^ (fr >> 1)) * 8)); \
      _Pragma("unroll") for (int n = 0; n < NF; ++n) bfr[n] = ld8(Bs + (OFF) + (wc * WN + n * 16 + fr) * 64 + (((kk * 4 + fq) ^ (fr >> 1)) * 8)); \
      __builtin_amdgcn_s_setprio(1); \
      _Pragma("unroll") for (int m = 0; m < 4; ++m) \
        _Pragma("unroll") for (int n = 0; n < NF; ++n) acc[m][n] = mfma16(bfr[n], af[m], acc[m][n]);     \
      __builtin_amdgcn_s_setprio(0); } } while (0)
  float f0[4], f1[4];
  if constexpr (MODE == 2) {
    const float* rsb = (const float*)(p.ws + WS_RS);
#pragma unroll
    for (int m = 0; m < 4; ++m) {
      const float2 r2 = *reinterpret_cast<const float2*>(rsb + (size_t)(m0 + wr * 64 + m * 16 + fr) * 2);
      f0[m] = r2.x * rcpf(r2.y); f1[m] = r2.y;
    }
  }
  __syncthreads();
  GLDS(0, 0);
  asm volatile("s_waitcnt vmcnt(0)" ::: "memory");
  __syncthreads();
  for (int kt = 0; kt < nk; ++kt) {
    const int cur = (kt & 1) * STAGE, nxt = STAGE - cur;
    if (kt + 1 < nk) GLDS(nxt, kt + 1);
    COMPUTE(cur);
    if constexpr (MODE == 2) {
      if (kt == 7 || kt == 15) {
#pragma unroll
        for (int m = 0; m < 4; ++m)
#pragma unroll
          for (int n = 0; n < NF; ++n)
#pragma unroll
            for (int j = 0; j < 4; ++j) acc[m][n][j] *= (kt == 7) ? f0[m] : f1[m];
      }
    }
    asm volatile("s_waitcnt vmcnt(0)" ::: "memory");
    __syncthreads();
  }
#define GLOAD(x)
#define LSTORE(x)
#undef GLOAD
#undef LSTORE
#undef COMPUTE
  if constexpr (MODE == 0) {
    u16* P = (u16*)(p.ws + WS_P);
    constexpr int SLD = WN + 8;
    u16* stg = (u16*)smem + w * 16 * SLD;
    constexpr int CPR = WN / 8;
    __syncthreads();
#pragma unroll
    for (int m = 0; m < 4; ++m) {
      wave_lds_sync();
#pragma unroll
      for (int n = 0; n < NF; ++n) {
        uint2 o; o.x = pack2(acc[m][n][0], acc[m][n][1]); o.y = pack2(acc[m][n][2], acc[m][n][3]);
        *reinterpret_cast<uint2*>(stg + fr * SLD + n * 16 + fq * 4) = o;
      }
      wave_lds_sync();
      for (int id = lane; id < 16 * CPR; id += 64) {
        int row = id / CPR, ch = id % CPR;
        uint4 v = *reinterpret_cast<const uint4*>(stg + row * SLD + ch * 8);
        *reinterpret_cast<uint4*>(P + (size_t)(m0 + wr * 64 + m * 16 + row) * IND + n0 + wc * WN + ch * 8) = v;
      }
    }
  } else if constexpr (MODE == 1) {
    const u16* P = (const u16*)(p.ws + WS_P);
    u16* Y = (u16*)(p.ws + WS_Y);
    const float* gb = p.in[opq(27)] + l * 1024;
    const int tn = n0 >> 7;
#pragma unroll
    for (int q = 0; q < 2; ++q) {
      const int oc = tn * 64 + (wc * 2 + q) * 16 + fq * 4;
      const f32x4 b0 = *reinterpret_cast<const f32x4*>(gb + oc), b1 = *reinterpret_cast<const f32x4*>(gb + 512 + oc);
#pragma unroll
      for (int m = 0; m < 4; ++m) {
        const size_t row = (size_t)(m0 + wr * 64 + m * 16 + fr);
        const uint2 sgv = *reinterpret_cast<const uint2*>(P + row * IND + C_SG + oc);
        const float sg[4] = {bflo(sgv.x), bfhi(sgv.x), bflo(sgv.y), bfhi(sgv.y)};
        float y[4];
#pragma unroll
        for (int j = 0; j < 4; ++j) {
          const float val = acc[m][2 * q][j] + b0[j], gt = acc[m][2 * q + 1][j] + b1[j];
          y[j] = val * rcpf(1.f + __expf(-gt)) * siluf(sg[j]);
        }
        uint2 o; o.x = pack2(y[0], y[1]); o.y = pack2(y[2], y[3]);
        *reinterpret_cast<uint2*>(Y + row * MIXW + 1536 + oc) = o;
      }
    }
  } else {
    const float* modb = (const float*)(p.ws + WS_MOD) + l * 9 * 3072;
    const bool cm = (l & 1);
    const float* hs = l == 0 ? p.in[opq(0)] : p.out;
    float* stg = (float*)smem + w * (16 * 68);
    __syncthreads();
#pragma unroll
    for (int m = 0; m < 4; ++m) {
#pragma unroll
      for (int n = 0; n < NF; ++n) *reinterpret_cast<f32x4*>(stg + fr * 68 + n * 16 + fq * 4) = acc[m][n];
      wave_lds_sync();
#pragma unroll
      for (int k = 0; k < 4; ++k) {
        const int id = lane + 64 * k, rowi = id >> 4, ch = id & 15;
        const f32x4 a = *reinterpret_cast<const f32x4*>(stg + rowi * 68 + ch * 4);
        const int r = m0 + wr * 64 + m * 16 + rowi, col = n0 + wc * WN + ch * 4;
        const float* src; float* dst; const float* gt;
        if (r < NLAT) {
          const int b = r >> 12, sp = r & 4095;
          const int sq = cm ? (((sp & 63) << 6) | (sp >> 6)) : sp;
          const size_t idx = ((size_t)(b * 4096 + sq)) * 1024 + col;
          src = hs + idx; dst = p.out + idx; gt = modb + b * 3072 + 2048 + col;
        } else {
          const size_t idx = (size_t)(r - NLAT) * 1024 + col;
          src = p.in[opq(2)] + idx; dst = (float*)(p.ws + WS_HCTX) + idx; gt = modb + 8 * 3072 + 2048 + col;
        }
        const f32x4 h = *reinterpret_cast<const f32x4*>(src), gv = *reinterpret_cast<const f32x4*>(gt);
        f32x4 o;
        o[0] = h[0] + gv[0] * a[0]; o[1] = h[1] + gv[1] * a[1]; o[2] = h[2] + gv[2] * a[2]; o[3] = h[3] + gv[3] * a[3];
        *reinterpret_cast<f32x4*>(dst) = o;
      }
      wave_lds_sync();
    }
  }
  __syncthreads();
}

__device__ void phase_conv(const Params& p, int l) {
  u16* P = (u16*)(p.ws + WS_P);
  const float* cw = p.in[opq(9)] + (size_t)l * 5 * 1536;
  const float* cb = p.in[opq(10)] + l * 1536;
  const int tid = opaque_tid(), cq = tid & 7, sgi = tid >> 3;
  for (int it = blockIdx.x; it < 768; it += gridDim.x) {
    const bool isctx = it >= 384;
    const int q = isctx ? it - 384 : it, b = q / 48, cgp = q % 48;
    const int L = isctx ? 256 : 4096, seg = L / 32, rowbase = isctx ? NLAT + b * 256 : b * 4096;
    const int ch = cgp * 32 + cq * 4;
    float4 wk[5];
#pragma unroll
    for (int k = 0; k < 5; ++k) wk[k] = *reinterpret_cast<const float4*>(cw + k * 1536 + ch);
    const float4 bias = *reinterpret_cast<const float4*>(cb + ch);
    u16* rp = P + (size_t)rowbase * IND + C_XBC + ch;
    const int a = sgi * seg;
    auto ld = [&](int sp) -> float4 {
      float4 r = make_float4(0.f, 0.f, 0.f, 0.f);
      if (sp >= 0 && sp < L) {
        uint2 v = *reinterpret_cast<const uint2*>(rp + (size_t)sp * IND);
        r.x = bflo(v.x); r.y = bfhi(v.x); r.z = bflo(v.y); r.w = bfhi(v.y);
      }
      return r;
    };
    float4 r0 = ld(a - 2), r1 = ld(a - 1), r2 = ld(a), r3 = ld(a + 1);
    const float4 e0 = ld(a + seg), e1 = ld(a + seg + 1);
    __syncthreads();
    auto ldraw = [&](int sp) -> uint2 {
      uint2 v = make_uint2(0u, 0u);
      if (sp < a + seg) v = *reinterpret_cast<const uint2*>(rp + (size_t)sp * IND);
      return v;
    };
    uint2 nraw[8];
#pragma unroll
    for (int j = 0; j < 8; ++j) nraw[j] = ldraw(a + 2 + j);
    for (int t0 = a; t0 < a + seg; t0 += 8) {
      uint2 cur[8];
#pragma unroll
      for (int j = 0; j < 8; ++j) cur[j] = nraw[j];
      if (t0 + 8 < a + seg) {
#pragma unroll
        for (int j = 0; j < 8; ++j) nraw[j] = ldraw(t0 + 10 + j);
      }
#pragma unroll
      for (int j = 0; j < 8; ++j) {
        const int sp = t0 + 2 + j;
        float4 r4;
        if (sp < a + seg) {
          const unsigned c0_ = pin(cur[j].x), c1_ = pin(cur[j].y);
          r4 = make_float4(bflo(c0_), bfhi(c0_), bflo(c1_), bfhi(c1_));
        } else r4 = (sp == a + seg) ? e0 : e1;
        float o0 = bias.x + wk[0].x * r0.x + wk[1].x * r1.x + wk[2].x * r2.x + wk[3].x * r3.x + wk[4].x * r4.x;
        float o1 = bias.y + wk[0].y * r0.y + wk[1].y * r1.y + wk[2].y * r2.y + wk[3].y * r3.y + wk[4].y * r4.y;
        float o2 = bias.z + wk[0].z * r0.z + wk[1].z * r1.z + wk[2].z * r2.z + wk[3].z * r3.z + wk[4].z * r4.z;
        float o3 = bias.w + wk[0].w * r0.w + wk[1].w * r1.w + wk[2].w * r2.w + wk[3].w * r3.w + wk[4].w * r4.w;
        uint2 o; o.x = pack2(siluf(o0), siluf(o1)); o.y = pack2(siluf(o2), siluf(o3));
        *reinterpret_cast<uint2*>(rp + (size_t)(t0 + j) * IND) = o;
        r0 = r1; r1 = r2; r2 = r3; r3 = r4;
      }
    }
    __syncthreads();
  }
}


__device__ void ssd_item(const Params& p, int l, int part, int item, unsigned char* smem) {
  u16* Bs = (u16*)smem;
  u16* Ms = Bs;
  u16* Cs = (u16*)(smem + 17408);
  u16* BT = (u16*)(smem + 34816);
  u16* xT = (u16*)(smem + 53248);
  u16* xwT = (u16*)(smem + 62464);
  float* dts = (float*)(smem + 71680);
  float* acs = dts + 64;
  float* wts = acs + 64;
  float* ssql = wts + 64;
  float* tots = ssql + 256;
  u16* ystg = (u16*)(smem + 73600);
  const int tid0 = opaque_tid();
  const int b = item >> 5, hd = (item >> 1) & 15, dir = item & 1, g = hd >> 3;
  u16* P = (u16*)(p.ws + WS_P);
  u16* Y = (u16*)(p.ws + WS_Y);
  float* ssq = (float*)(p.ws + WS_SSQ);
  float* stsave = (float*)(p.ws + WS_WIN) + (size_t)item * 8192;
  const float Dsk = p.in[opq(13)][l * 16 + hd];
  f32x4 hacc[8];
  if (part == 1) {
#pragma unroll
    for (int i = 0; i < 8; ++i) hacc[i] = *reinterpret_cast<const f32x4*>(stsave + (i * 256 + tid0) * 4);
  } else {
#pragma unroll
    for (int i = 0; i < 8; ++i) hacc[i] = f32x4{0.f, 0.f, 0.f, 0.f};
  }
  const int nseg = part == 0 ? 3 : 1;
  for (int seg = 0; seg < nseg; ++seg) {
    bool isctx; int sdir, ci0, ci1, mode;
    if (part == 1) { isctx = false; sdir = dir; ci0 = 32; ci1 = 64; mode = 2; }
    else if (seg == 0) { if (!(dir == 0 && l == 0)) continue; isctx = true; sdir = 1; ci0 = 0; ci1 = 4; mode = 1; }
    else if (seg == 1) { isctx = true; sdir = dir; ci0 = 0; ci1 = 4; mode = (dir == 0 && l == 0) ? 2 : 0; }
    else { isctx = false; sdir = dir; ci0 = 0; ci1 = 32; mode = 1; }
    if (part == 0 && seg <= 1) {
#pragma unroll
      for (int i = 0; i < 8; ++i) hacc[i] = f32x4{0.f, 0.f, 0.f, 0.f};
    }
    __threadfence();
    __syncthreads();
    const float aneg = -expf(p.in[opq(11)][(l * 2 + sdir) * 16 + hd]);
    const float dtb = p.in[opq(12)][(l * 2 + sdir) * 16 + hd];
    const int nch = isctx ? 4 : 64;
    const int rowbase = isctx ? NLAT + b * 256 : b * 4096;
#pragma unroll
    for (int i = 0; i < 8; ++i) asm volatile("" : "+v"(hacc[i]));
    u32x4 rx[2], rbm[4], rcm[4];
    unsigned rawdt = 0u;
    {
      const int tid = tid0, lane = tid & 63, w = tid >> 6;
      const int cL = (sdir ? nch - 1 - ci0 : ci0) * 64;
#pragma unroll
      for (int k = 0; k < 2; ++k) {
        const int id = tid + 256 * k, pch = id >> 6, i = id & 63;
        const int tau = sdir ? cL + 63 - i : cL + i;
        rx[k] = *reinterpret_cast<const u32x4*>(P + (size_t)(rowbase + tau) * IND + C_XBC + hd * 64 + pch * 8);
      }
#pragma unroll
      for (int k = 0; k < 4; ++k) {
        const int id = tid + 256 * k, nc = id >> 6, i = id & 63;
        const int tau = sdir ? cL + 63 - i : cL + i;
        rbm[k] = *reinterpret_cast<const u32x4*>(P + (size_t)(rowbase + tau) * IND + C_BM + g * 128 + nc * 8);
      }
#pragma unroll
      for (int k = 0; k < 4; ++k) {
        const int id = tid + 256 * k, i = id >> 4, nc = id & 15;
        const int tau = sdir ? cL + 63 - i : cL + i;
        rcm[k] = *reinterpret_cast<const u32x4*>(P + (size_t)(rowbase + tau) * IND + C_CM + g * 128 + nc * 8);
      }
      rawdt = P[(size_t)(rowbase + (sdir ? cL + 63 - lane : cL + lane)) * IND + C_DT + sdir * 16 + hd];
    }
    for (int ci = ci0; ci < ci1; ++ci) {
      const int c0 = (sdir ? nch - 1 - ci : ci) * 64;
      int tid = tid0;
      asm volatile("" : "+v"(tid));
      const int lane = tid & 63, w = tid >> 6, fr = lane & 15, fq = lane >> 4;
      __syncthreads();
      if (w == 0) {
        float dt = softplusf(bflo(pin(rawdt)) + dtb);
        const float cs = wave_incl_scan(dt * aneg);
        const float tot = __builtin_bit_cast(float, __builtin_amdgcn_readlane(__builtin_bit_cast(int, cs), 63));
        dts[lane] = dt; acs[lane] = cs; wts[lane] = __expf(tot - cs);
        if (lane == 0) tots[0] = tot;
      }
      pin4(rbm[0]); pin4(rbm[1]); pin4(rbm[2]); pin4(rbm[3]);
#pragma unroll
      for (int k = 0; k < 4; ++k) {
        const int id = tid + 256 * k, nc = id >> 6, i = id & 63;
        *reinterpret_cast<u32x4*>(Bs + i * 136 + nc * 8) = rbm[k];
#pragma unroll
        for (int e = 0; e < 4; ++e) {
          BT[(nc * 8 + 2 * e) * 72 + i] = (u16)(rbm[k][e] & 0xffffu);
          BT[(nc * 8 + 2 * e + 1) * 72 + i] = (u16)(rbm[k][e] >> 16);
        }
      }
#pragma unroll
      for (int k = 0; k < 4; ++k) {
        const int id = tid + 256 * k, i = id >> 4, nc = id & 15;
        *reinterpret_cast<u32x4*>(Cs + i * 136 + nc * 8) = rcm[k];
      }
      __syncthreads();
      pin4(rx[0]); pin4(rx[1]);
#pragma unroll
      for (int k = 0; k < 2; ++k) {
        const int id = tid + 256 * k, pch = id >> 6, i = id & 63;
        const float dt = dts[i], wt = wts[i];
#pragma unroll
        for (int e = 0; e < 4; ++e) {
          float x0 = bflo(rx[k][e]) * dt, x1 = bfhi(rx[k][e]) * dt;
          xT[(pch * 8 + 2 * e) * 72 + i] = f2bf(x0); xT[(pch * 8 + 2 * e + 1) * 72 + i] = f2bf(x1);
          xwT[(pch * 8 + 2 * e) * 72 + i] = f2bf(x0 * wt); xwT[(pch * 8 + 2 * e + 1) * 72 + i] = f2bf(x1 * wt);
        }
      }
      u32x4 tmpv[2] = {u32x4{0u, 0u, 0u, 0u}, u32x4{0u, 0u, 0u, 0u}};
      uint2 zr[4];
#pragma unroll
      for (int e = 0; e < 4; ++e) zr[e] = make_uint2(0u, 0u);
      if (mode == 2) {
        const int qs = (w * 4 + fq) * 16 + (15 - fr);
        const u16* tp = Y + (size_t)(rowbase + c0 + (qs >> 2)) * MIXW + hd * 64 + (qs & 3) * 16;
        tmpv[0] = *reinterpret_cast<const u32x4*>(tp); tmpv[1] = *reinterpret_cast<const u32x4*>(tp + 8);
#pragma unroll
        for (int tt = 0; tt < 4; ++tt) {
          const int t = tt * 16 + fr;
          const size_t row = (size_t)(rowbase + (sdir ? c0 + 63 - t : c0 + t));
          zr[tt] = *reinterpret_cast<const uint2*>(P + row * IND + hd * 64 + w * 16 + fq * 4);
        }
      }
      if (ci + 1 < ci1) {
        const int cL = (sdir ? nch - 2 - ci : ci + 1) * 64;
#pragma unroll
        for (int k = 0; k < 2; ++k) {
          const int id = tid + 256 * k, pch = id >> 6, i = id & 63;
          const int tau = sdir ? cL + 63 - i : cL + i;
          rx[k] = *reinterpret_cast<const u32x4*>(P + (size_t)(rowbase + tau) * IND + C_XBC + hd * 64 + pch * 8);
        }
#pragma unroll
        for (int k = 0; k < 4; ++k) {
          const int id = tid + 256 * k, nc = id >> 6, i = id & 63;
          const int tau = sdir ? cL + 63 - i : cL + i;
          rbm[k] = *reinterpret_cast<const u32x4*>(P + (size_t)(rowbase + tau) * IND + C_BM + g * 128 + nc * 8);
        }
#pragma unroll
        for (int k = 0; k < 4; ++k) {
          const int id = tid + 256 * k, i = id >> 4, nc = id & 15;
          const int tau = sdir ? cL + 63 - i : cL + i;
          rcm[k] = *reinterpret_cast<const u32x4*>(P + (size_t)(rowbase + tau) * IND + C_CM + g * 128 + nc * 8);
        }
        rawdt = P[(size_t)(rowbase + (sdir ? cL + 63 - lane : cL + lane)) * IND + C_DT + sdir * 16 + hd];
      }
      __syncthreads();
      f32x4 gacc[4];
#pragma unroll
      for (int i = 0; i < 4; ++i) gacc[i] = f32x4{0.f, 0.f, 0.f, 0.f};
#pragma unroll
      for (int kk = 0; kk < 4; ++kk) {
        bf16x8 a = ld8(Bs + (w * 16 + fr) * 136 + kk * 32 + fq * 8);
#pragma unroll
        for (int tb = 0; tb < 4; ++tb) {
          bf16x8 bb = ld8(Cs + (tb * 16 + fr) * 136 + kk * 32 + fq * 8);
          gacc[tb] = mfma16(a, bb, gacc[tb]);
        }
      }
      asm volatile("" : "+v"(tmpv[0]), "+v"(tmpv[1]));
      __syncthreads();
#pragma unroll
      for (int tb = 0; tb < 4; ++tb) {
        const int t = tb * 16 + fr;
        const float at = acs[t];
        float mv[4];
#pragma unroll
        for (int j = 0; j < 4; ++j) {
          const int s = w * 16 + fq * 4 + j;
          mv[j] = (s <= t) ? gacc[tb][j] * __expf(at - acs[s]) : 0.f;
        }
        uint2 o; o.x = pack2(mv[0], mv[1]); o.y = pack2(mv[2], mv[3]);
        *reinterpret_cast<uint2*>(Ms + t * 72 + w * 16 + fq * 4) = o;
      }
      __syncthreads();
      f32x4 yd[4], yo[4];
#pragma unroll
      for (int i = 0; i < 4; ++i) { yd[i] = f32x4{0.f, 0.f, 0.f, 0.f}; yo[i] = f32x4{0.f, 0.f, 0.f, 0.f}; }
#pragma unroll
      for (int kk = 0; kk < 2; ++kk) {
        bf16x8 bb = ld8(xT + (w * 16 + fr) * 72 + kk * 32 + fq * 8);
#pragma unroll
        for (int tt = 0; tt < 4; ++tt) {
          bf16x8 a = ld8(Ms + (tt * 16 + fr) * 72 + kk * 32 + fq * 8);
          yd[tt] = mfma16(bb, a, yd[tt]);
        }
      }
#pragma unroll
      for (int kk = 0; kk < 4; ++kk) {
        bf16x8 hb = packacc(hacc[2 * kk], hacc[2 * kk + 1]);
#pragma unroll
        for (int tt = 0; tt < 4; ++tt) {
          const u16* cr = Cs + (tt * 16 + fr) * 136 + fq * 4;
          bf16x8 a = ld44(cr + (2 * kk) * 16, cr + (2 * kk + 1) * 16);
          yo[tt] = mfma16(hb, a, yo[tt]);
        }
      }
      const float etot = __expf(tots[0]);
#pragma unroll
      for (int nb = 0; nb < 8; ++nb) { hacc[nb][0] *= etot; hacc[nb][1] *= etot; hacc[nb][2] *= etot; hacc[nb][3] *= etot; }
#pragma unroll
      for (int kk = 0; kk < 2; ++kk) {
        bf16x8 bb = ld8(xwT + (w * 16 + fr) * 72 + kk * 32 + fq * 8);
#pragma unroll
        for (int nb = 0; nb < 8; ++nb) {
          bf16x8 a = ld8(BT + (nb * 16 + fr) * 72 + kk * 32 + fq * 8);
          hacc[nb] = mfma16(a, bb, hacc[nb]);
        }
      }
      if (mode != 0) {
        float ea[4];
#pragma unroll
        for (int tt = 0; tt < 4; ++tt) ea[tt] = __expf(acs[tt * 16 + fr]);
        if (mode == 1) {
          u32x4 o0, o1;
#pragma unroll
          for (int tt = 0; tt < 4; ++tt) {
            float v[4];
#pragma unroll
            for (int j = 0; j < 4; ++j) v[j] = yd[tt][j] + ea[tt] * yo[tt][j];
            const unsigned a2 = pack2(v[0], v[1]), b2 = pack2(v[2], v[3]);
            if (tt == 0) { o0[0] = a2; o0[1] = b2; } else if (tt == 1) { o0[2] = a2; o0[3] = b2; }
            else if (tt == 2) { o1[0] = a2; o1[1] = b2; } else { o1[2] = a2; o1[3] = b2; }
          }
          const int qs = (w * 4 + fq) * 16 + fr;
          u16* tp = Y + (size_t)(rowbase + c0 + (qs >> 2)) * MIXW + hd * 64 + (qs & 3) * 16;
          *reinterpret_cast<u32x4*>(tp) = o0; *reinterpret_cast<u32x4*>(tp + 8) = o1;
        } else {
          float xsv[16], rdt[4], val[16];
#pragma unroll
          for (int tt = 0; tt < 4; ++tt) {
            rdt[tt] = rcpf(dts[tt * 16 + fr]);
#pragma unroll
            for (int j = 0; j < 4; ++j) xsv[tt * 4 + j] = bf2f(xT[(w * 16 + fq * 4 + j) * 72 + tt * 16 + fr]);
          }
          float sq[4];
#pragma unroll
          for (int tt = 0; tt < 4; ++tt) {
            const int t = tt * 16 + fr;
            const uint2 zw = zr[tt];
            const unsigned z01 = pin(zw.x), z23 = pin(zw.y);
            const float zz[4] = {bflo(z01), bfhi(z01), bflo(z23), bfhi(z23)};
            const int et = 3 - tt;
            const unsigned p01 = tmpv[et >> 1][(et & 1) * 2], p23 = tmpv[et >> 1][(et & 1) * 2 + 1];
            const float yf[4] = {bflo(p01), bfhi(p01), bflo(p23), bfhi(p23)};
            float s2 = 0.f;
#pragma unroll
            for (int j = 0; j < 4; ++j) {
              const float yv = yd[tt][j] + ea[tt] * yo[tt][j];
              const float vv = (yf[j] + yv + Dsk * xsv[tt * 4 + j] * rdt[tt]) * siluf(zz[j]);
              val[tt * 4 + j] = vv; s2 += vv * vv;
            }
            sq[tt] = s2;
            uint2 o; o.x = pack2(val[tt * 4], val[tt * 4 + 1]); o.y = pack2(val[tt * 4 + 2], val[tt * 4 + 3]);
            const int c = w * 2 + (fq >> 1);
            *reinterpret_cast<uint2*>(ystg + t * 64 + ((c ^ ((t >> 2) & 7)) << 3) + (fq & 1) * 4) = o;
          }
#pragma unroll
          for (int tt = 0; tt < 4; ++tt) {
            sq[tt] += __shfl_xor(sq[tt], 16); sq[tt] += __shfl_xor(sq[tt], 32);
          }
          if (fq == 0) {
#pragma unroll
            for (int tt = 0; tt < 4; ++tt) ssql[w * 64 + tt * 16 + fr] = sq[tt];
          }
          __syncthreads();
#pragma unroll
          for (int k = 0; k < 2; ++k) {
            const int id = tid + 256 * k, t = id >> 3, c = id & 7;
            const u32x4 v = *reinterpret_cast<const u32x4*>(ystg + t * 64 + ((c ^ ((t >> 2) & 7)) << 3));
            const size_t row = (size_t)(rowbase + (sdir ? c0 + 63 - t : c0 + t));
            *reinterpret_cast<u32x4*>(Y + row * MIXW + hd * 64 + c * 8) = v;
          }
          if (tid < 64) {
            const size_t row = (size_t)(rowbase + (sdir ? c0 + 63 - tid : c0 + tid));
            ssq[row * 16 + hd] = ssql[tid] + ssql[64 + tid] + ssql[128 + tid] + ssql[192 + tid];
          }
        }
      }
    }
  }
  if (part == 0) {
#pragma unroll
    for (int i = 0; i < 8; ++i) *reinterpret_cast<f32x4*>(stsave + (i * 256 + tid0) * 4) = hacc[i];
  }
}

__device__ void gla_item(const Params& p, int l, int part, int item, unsigned char* smem) {
  u16* qe = (u16*)smem;
  u16* ke = (u16*)(smem + 9216);
  u16* kdT = (u16*)(smem + 18432);
  u16* vT = (u16*)(smem + 27648);
  u16* at = (u16*)(smem + 46080);
  float* gl = (float*)(smem + 55296);
  float* red = (float*)(smem + 71936);
  const int tid0 = opaque_tid();
  const int b = item >> 3, h = (item >> 1) & 3, dir = item & 1;
  u16* P = (u16*)(p.ws + WS_P);
  u16* Y = (u16*)(p.ws + WS_Y);
  float* stsave = (float*)(p.ws + WS_WIN) + (size_t)(256 + item) * 8192;
  f32x4 sacc[4][2];
  if (part == 1) {
#pragma unroll
    for (int i = 0; i < 8; ++i) sacc[i >> 1][i & 1] = *reinterpret_cast<const f32x4*>(stsave + (i * 256 + tid0) * 4);
  } else {
#pragma unroll
    for (int i = 0; i < 8; ++i) sacc[i >> 1][i & 1] = f32x4{0.f, 0.f, 0.f, 0.f};
  }
  const int nseg = part == 0 ? 3 : 1;
  for (int seg = 0; seg < nseg; ++seg) {
    bool isctx; int sdir, ci0, ci1, mode;
    if (part == 1) { isctx = false; sdir = dir; ci0 = 32; ci1 = 64; mode = 2; }
    else if (seg == 0) { if (!(dir == 0 && l == 0)) continue; isctx = true; sdir = 1; ci0 = 0; ci1 = 4; mode = 1; }
    else if (seg == 1) { isctx = true; sdir = dir; ci0 = 0; ci1 = 4; mode = (dir == 0 && l == 0) ? 2 : 0; }
    else { isctx = false; sdir = dir; ci0 = 0; ci1 = 32; mode = 1; }
    if (part == 0 && seg <= 1) {
#pragma unroll
      for (int i = 0; i < 8; ++i) sacc[i >> 1][i & 1] = f32x4{0.f, 0.f, 0.f, 0.f};
    }
    __threadfence();
    __syncthreads();
    const int nch = isctx ? 4 : 64;
    const int rowbase = isctx ? NLAT + b * 256 : b * 4096;
#pragma unroll
    for (int i = 0; i < 8; ++i) asm volatile("" : "+v"(sacc[i >> 1][i & 1]));
    u32x4 rq[2], rk[2], rv[4], rlr;
    bf16x8 Bw;
    float bl;
    {
      const int tid = tid0;
      const int dcol = h * 64 + 32 * ((tid >> 6) & 1) + (tid & 31), kb = 8 * ((tid & 63) >> 5);
      const float* wlp = p.in[opq(15)] + ((size_t)((l * 2 + sdir) * 16 + kb)) * 256 + dcol;
      u32x4 bw;
#pragma unroll
      for (int e = 0; e < 4; ++e) bw[e] = pack2(wlp[(2 * e) * 256], wlp[(2 * e + 1) * 256]);
      Bw = __builtin_bit_cast(bf16x8, bw);
      bl = p.in[opq(16)][(l * 2 + sdir) * 256 + dcol];
      asm volatile("" : "+v"(Bw), "+v"(bl));
      const int cL = (sdir ? nch - 1 - ci0 : ci0) * 64;
#pragma unroll
      for (int k = 0; k < 2; ++k) {
        const int id = tid + 256 * k, i = id >> 3, dc = id & 7;
        const int tau = sdir ? cL + 63 - i : cL + i;
        rq[k] = *reinterpret_cast<const u32x4*>(P + (size_t)(rowbase + tau) * IND + C_Q + h * 64 + dc * 8);
      }
#pragma unroll
      for (int k = 0; k < 2; ++k) {
        const int id = tid + 256 * k, dc = id >> 6, i = id & 63;
        const int tau = sdir ? cL + 63 - i : cL + i;
        rk[k] = *reinterpret_cast<const u32x4*>(P + (size_t)(rowbase + tau) * IND + C_K + h * 64 + dc * 8);
      }
#pragma unroll
      for (int k = 0; k < 4; ++k) {
        const int id = tid + 256 * k, ec = id >> 6, i = id & 63;
        const int tau = sdir ? cL + 63 - i : cL + i;
        rv[k] = *reinterpret_cast<const u32x4*>(P + (size_t)(rowbase + tau) * IND + C_V + h * 128 + ec * 8);
      }
      {
        const int i = 32 * (tid >> 7) + (tid & 31), hf = (tid & 63) >> 5;
        const int tau = sdir ? cL + 63 - i : cL + i;
        rlr = *reinterpret_cast<const u32x4*>(P + (size_t)(rowbase + tau) * IND + C_LR + sdir * 16 + hf * 8);
      }
    }
    for (int ci = ci0; ci < ci1; ++ci) {
      const int c0 = (sdir ? nch - 1 - ci : ci) * 64;
      int tid = tid0;
      asm volatile("" : "+v"(tid));
      const int lane = tid & 63, w = tid >> 6, fr = lane & 15, fq = lane >> 4, d = tid & 63, iq = tid >> 6;
      __syncthreads();
      pin4(rlr);
      {
        const int th = w >> 1, dh = w & 1;
        f32x16 z;
#pragma unroll
        for (int r = 0; r < 16; ++r) z[r] = 0.f;
        const f32x16 lg = mfma32(__builtin_bit_cast(bf16x8, rlr), Bw, z);
#pragma unroll
        for (int r = 0; r < 16; ++r) {
          const int t = 32 * th + (r & 3) + 8 * (r >> 2) + 4 * (lane >> 5);
          gl[t * 65 + 32 * dh + (lane & 31)] = logsigf(lg[r] + bl) * (1.f / 16.f);
        }
      }
      __syncthreads();
      {
        float vals[16];
#pragma unroll
        for (int ii = 0; ii < 16; ++ii) vals[ii] = gl[(iq * 16 + ii) * 65 + d];
        float run = 0.f;
#pragma unroll
        for (int ii = 0; ii < 16; ++ii) { run += vals[ii]; gl[(iq * 16 + ii) * 65 + d] = run; }
        red[iq * 64 + d] = run;
      }
      __syncthreads();
      {
        float off = 0.f;
        for (int q = 0; q < iq; ++q) off += red[q * 64 + d];
        if (iq > 0) {
#pragma unroll 4
          for (int ii = 0; ii < 16; ++ii) gl[(iq * 16 + ii) * 65 + d] += off;
        }
      }
      __syncthreads();
      pin4(rq[0]); pin4(rq[1]); pin4(rk[0]); pin4(rk[1]); pin4(rv[0]); pin4(rv[1]); pin4(rv[2]); pin4(rv[3]);
#pragma unroll
      for (int k = 0; k < 2; ++k) {
        const int id = tid + 256 * k, i = id >> 3, dc = id & 7;
        u32x4 oo;
#pragma unroll
        for (int e = 0; e < 4; ++e) {
          float b0 = gl[i * 65 + dc * 8 + 2 * e], b1 = gl[i * 65 + dc * 8 + 2 * e + 1];
          oo[e] = pack2(bflo(rq[k][e]) * 0.125f * __expf(b0), bfhi(rq[k][e]) * 0.125f * __expf(b1));
        }
        *reinterpret_cast<u32x4*>(qe + i * 72 + dc * 8) = oo;
      }
#pragma unroll
      for (int k = 0; k < 2; ++k) {
        const int id = tid + 256 * k, dc = id >> 6, i = id & 63;
        u32x4 oo;
#pragma unroll
        for (int e = 0; e < 4; ++e) {
          const int d0 = dc * 8 + 2 * e;
          float b0 = gl[i * 65 + d0], b1 = gl[i * 65 + d0 + 1];
          float l0 = gl[63 * 65 + d0], l1 = gl[63 * 65 + d0 + 1];
          float k0 = bflo(rk[k][e]), k1 = bfhi(rk[k][e]);
          oo[e] = pack2(k0 * __expf(-b0), k1 * __expf(-b1));
          kdT[d0 * 72 + i] = f2bf(k0 * __expf(l0 - b0));
          kdT[(d0 + 1) * 72 + i] = f2bf(k1 * __expf(l1 - b1));
        }
        *reinterpret_cast<u32x4*>(ke + i * 72 + dc * 8) = oo;
      }
#pragma unroll
      for (int k = 0; k < 4; ++k) {
        const int id = tid + 256 * k, ec = id >> 6, i = id & 63;
#pragma unroll
        for (int e = 0; e < 4; ++e) {
          vT[(ec * 8 + 2 * e) * 72 + i] = (u16)(rv[k][e] & 0xffffu);
          vT[(ec * 8 + 2 * e + 1) * 72 + i] = (u16)(rv[k][e] >> 16);
        }
      }
      u32x4 tmpv[4];
      unsigned ggr[16];
#pragma unroll
      for (int e = 0; e < 4; ++e) tmpv[e] = u32x4{0u, 0u, 0u, 0u};
#pragma unroll
      for (int e = 0; e < 16; ++e) ggr[e] = 0u;
      if (mode == 2) {
        const int qs = (w * 4 + (3 - fq)) * 16 + fr;
        const u16* tp = Y + (size_t)(rowbase + c0 + (qs >> 2)) * MIXW + 1024 + h * 128 + (qs & 3) * 32;
#pragma unroll
        for (int e = 0; e < 4; ++e) tmpv[e] = *reinterpret_cast<const u32x4*>(tp + e * 8);
#pragma unroll
        for (int tt = 0; tt < 4; ++tt)
#pragma unroll
          for (int j = 0; j < 4; ++j) {
            const int t = tt * 16 + fq * 4 + j;
            const size_t row = (size_t)(rowbase + (sdir ? c0 + 63 - t : c0 + t));
            ggr[tt * 4 + j] = *reinterpret_cast<const unsigned*>(P + row * IND + C_GG + h * 128 + w * 32 + 2 * fr);
          }
      }
      if (ci + 1 < ci1) {
        const int cL = (sdir ? nch - 2 - ci : ci + 1) * 64;
#pragma unroll
        for (int k = 0; k < 2; ++k) {
          const int id = tid + 256 * k, i = id >> 3, dc = id & 7;
          const int tau = sdir ? cL + 63 - i : cL + i;
          rq[k] = *reinterpret_cast<const u32x4*>(P + (size_t)(rowbase + tau) * IND + C_Q + h * 64 + dc * 8);
        }
#pragma unroll
        for (int k = 0; k < 2; ++k) {
          const int id = tid + 256 * k, dc = id >> 6, i = id & 63;
          const int tau = sdir ? cL + 63 - i : cL + i;
          rk[k] = *reinterpret_cast<const u32x4*>(P + (size_t)(rowbase + tau) * IND + C_K + h * 64 + dc * 8);
        }
#pragma unroll
        for (int k = 0; k < 4; ++k) {
          const int id = tid + 256 * k, ec = id >> 6, i = id & 63;
          const int tau = sdir ? cL + 63 - i : cL + i;
          rv[k] = *reinterpret_cast<const u32x4*>(P + (size_t)(rowbase + tau) * IND + C_V + h * 128 + ec * 8);
        }
        {
          const int i = 32 * (tid >> 7) + (tid & 31), hf = (tid & 63) >> 5;
          const int tau = sdir ? cL + 63 - i : cL + i;
          rlr = *reinterpret_cast<const u32x4*>(P + (size_t)(rowbase + tau) * IND + C_LR + sdir * 16 + hf * 8);
        }
      }
      __syncthreads();
      {
        f32x4 aacc[4];
#pragma unroll
        for (int i = 0; i < 4; ++i) aacc[i] = f32x4{0.f, 0.f, 0.f, 0.f};
#pragma unroll
        for (int kk = 0; kk < 2; ++kk) {
          bf16x8 a = ld8(ke + (w * 16 + fr) * 72 + kk * 32 + fq * 8);
#pragma unroll
          for (int tb = 0; tb < 4; ++tb) {
            bf16x8 bb = ld8(qe + (tb * 16 + fr) * 72 + kk * 32 + fq * 8);
            aacc[tb] = mfma16(a, bb, aacc[tb]);
          }
        }
#pragma unroll
        for (int tb = 0; tb < 4; ++tb) {
          const int t = tb * 16 + fr;
          float mv[4];
#pragma unroll
          for (int j = 0; j < 4; ++j) { const int s = w * 16 + fq * 4 + j; mv[j] = (s <= t) ? aacc[tb][j] : 0.f; }
          uint2 o; o.x = pack2(mv[0], mv[1]); o.y = pack2(mv[2], mv[3]);
          *reinterpret_cast<uint2*>(at + t * 72 + w * 16 + fq * 4) = o;
        }
      }
      __syncthreads();
      f32x4 oacc[4][2];
#pragma unroll
      for (int i = 0; i < 4; ++i) { oacc[i][0] = f32x4{0.f, 0.f, 0.f, 0.f}; oacc[i][1] = f32x4{0.f, 0.f, 0.f, 0.f}; }
#pragma unroll
      for (int kk = 0; kk < 2; ++kk) {
        bf16x8 b0 = ld8(vT + (w * 32 + 2 * fr) * 72 + kk * 32 + fq * 8);
        bf16x8 b1 = ld8(vT + (w * 32 + 2 * fr + 1) * 72 + kk * 32 + fq * 8);
#pragma unroll
        for (int tt = 0; tt < 4; ++tt) {
          bf16x8 a = ld8(at + (tt * 16 + fr) * 72 + kk * 32 + fq * 8);
          oacc[tt][0] = mfma16(a, b0, oacc[tt][0]);
          oacc[tt][1] = mfma16(a, b1, oacc[tt][1]);
        }
      }
#pragma unroll
      for (int kk = 0; kk < 2; ++kk) {
        bf16x8 s0 = packacc(sacc[2 * kk][0], sacc[2 * kk + 1][0]);
        bf16x8 s1 = packacc(sacc[2 * kk][1], sacc[2 * kk + 1][1]);
#pragma unroll
        for (int tt = 0; tt < 4; ++tt) {
          const u16* qr = qe + (tt * 16 + fr) * 72 + fq * 4;
          bf16x8 a = ld44(qr + (2 * kk) * 16, qr + (2 * kk + 1) * 16);
          oacc[tt][0] = mfma16(a, s0, oacc[tt][0]);
          oacc[tt][1] = mfma16(a, s1, oacc[tt][1]);
        }
      }
#pragma unroll
      for (int db = 0; db < 4; ++db)
#pragma unroll
        for (int j = 0; j < 4; ++j) {
          const float sc = __expf(gl[63 * 65 + db * 16 + fq * 4 + j]);
          sacc[db][0][j] *= sc; sacc[db][1][j] *= sc;
        }
#pragma unroll
      for (int kk = 0; kk < 2; ++kk) {
        bf16x8 b0 = ld8(vT + (w * 32 + 2 * fr) * 72 + kk * 32 + fq * 8);
        bf16x8 b1 = ld8(vT + (w * 32 + 2 * fr + 1) * 72 + kk * 32 + fq * 8);
#pragma unroll
        for (int db = 0; db < 4; ++db) {
          bf16x8 a = ld8(kdT + (db * 16 + fr) * 72 + kk * 32 + fq * 8);
          sacc[db][0] = mfma16(a, b0, sacc[db][0]);
          sacc[db][1] = mfma16(a, b1, sacc[db][1]);
        }
      }
      pin4(tmpv[0]); pin4(tmpv[1]); pin4(tmpv[2]); pin4(tmpv[3]);
      if (mode != 0) {
        const int ycol = 1024 + h * 128 + w * 32 + 2 * fr;
        if (mode == 1) {
          const int qs = (w * 4 + fq) * 16 + fr;
          u16* tp = Y + (size_t)(rowbase + c0 + (qs >> 2)) * MIXW + 1024 + h * 128 + (qs & 3) * 32;
#pragma unroll
          for (int tt = 0; tt < 4; ++tt) {
            u32x4 o;
#pragma unroll
            for (int j = 0; j < 4; ++j) o[j] = pack2(oacc[tt][0][j], oacc[tt][1][j]);
            *reinterpret_cast<u32x4*>(tp + tt * 8) = o;
          }
        } else {
#pragma unroll
          for (int tt = 0; tt < 4; ++tt)
#pragma unroll
            for (int j = 0; j < 4; ++j) {
              const int t = tt * 16 + fq * 4 + j;
              const int e = 15 - (tt * 4 + j);
              const unsigned pw = tmpv[e >> 2][e & 3];
              float o0 = oacc[tt][0][j] + bflo(pw);
              float o1 = oacc[tt][1][j] + bfhi(pw);
              oacc[tt][0][j] = o0; oacc[tt][1][j] = o1;
              const float sq = row16_sum(o0 * o0 + o1 * o1);
              if (fr == 0) red[w * 64 + t] = sq;
            }
          __syncthreads();
          const float* nwv = p.in[opq(17)] + l * 128;
          const float nw0 = nwv[w * 32 + 2 * fr], nw1 = nwv[w * 32 + 2 * fr + 1];
#pragma unroll
          for (int tt = 0; tt < 4; ++tt)
#pragma unroll
            for (int j = 0; j < 4; ++j) {
              const int t = tt * 16 + fq * 4 + j;
              const size_t row = (size_t)(rowbase + (sdir ? c0 + 63 - t : c0 + t));
              const float tot = red[t] + red[64 + t] + red[128 + t] + red[192 + t];
              const float rs = rsqrtf(tot * (1.f / 128.f) + EPSF);
              const unsigned gw = pin(ggr[tt * 4 + j]);
              const float g0 = bflo(gw), g1 = bfhi(gw);
              *reinterpret_cast<unsigned*>(Y + row * MIXW + ycol) =
                  pack2(oacc[tt][0][j] * rs * nw0 * siluf(g0), oacc[tt][1][j] * rs * nw1 * siluf(g1));
            }
        }
      }
    }
  }
  if (part == 0) {
#pragma unroll
    for (int i = 0; i < 8; ++i) *reinterpret_cast<f32x4*>(stsave + (i * 256 + tid0) * 4) = sacc[i >> 1][i & 1];
  }
}

__device__ void s5_item(const Params& p, int l, int part, int blk, unsigned char* smem) {
  const int tid = opaque_tid(), lane = tid & 63, w = tid >> 6, fr = lane & 15, fq = lane >> 4;
  const int wi = blk * 4 + w;
  const int b = wi >> 6, g = (wi >> 1) & 31, dir = wi & 1;
  u16* hb = (u16*)smem + w * (32 * 136);
  u16* ust = (u16*)(smem + 4 * 32 * 136 * 2) + w * (32 * 16);
  u16* P = (u16*)(p.ws + WS_P);
  u16* Y = (u16*)(p.ws + WS_Y);
  u16* G5C = (u16*)(p.ws + WS_G5C);
  float* stsave = (float*)(p.ws + WS_S5ST) + (size_t)wi * 128;
  const float dsk = p.in[opq(25)][l * 512 + g * 16 + fr];
  float hre = 0.f, him = 0.f;
  if (part == 1) { hre = stsave[lane * 2]; him = stsave[lane * 2 + 1]; }
  const int nseg = part == 0 ? 3 : 1;
  for (int seg = 0; seg < nseg; ++seg) {
    bool isctx; int sdir, ti0, ti1, mode;
    if (part == 1) { isctx = false; sdir = dir; ti0 = 64; ti1 = 128; mode = 2; }
    else if (seg == 0) { if (!(dir == 0 && l == 0)) continue; isctx = true; sdir = 1; ti0 = 0; ti1 = 8; mode = 1; }
    else if (seg == 1) { isctx = true; sdir = dir; ti0 = 0; ti1 = 8; mode = (dir == 0 && l == 0) ? 2 : 0; }
    else { isctx = false; sdir = dir; ti0 = 0; ti1 = 64; mode = 1; }
    if (part == 0 && seg <= 1) { hre = 0.f; him = 0.f; }
    __threadfence();
    const unsigned char* cbase = p.ws + WS_S5C + (size_t)((l * 2 + sdir) * 32 + g) * 8704;
    const u16* BbarM = (const u16*)cbase;
    const u16* CmT = (const u16*)(cbase + 4096);
    const float* lamb = (const float*)(cbase + 8192);
    bf16x8 Bf[4], Cf[4];
#pragma unroll
    for (int cb = 0; cb < 4; ++cb) Bf[cb] = ld8(BbarM + (cb * 32 + (lane & 31)) * 16 + 8 * (lane >> 5));
#pragma unroll
    for (int kk = 0; kk < 4; ++kk) Cf[kk] = ld8(CmT + fr * 128 + kk * 32 + fq * 8);
    float lre = lamb[2 * lane], lim = lamb[2 * lane + 1];
#pragma unroll
    for (int i = 0; i < 4; ++i) asm volatile("" : "+v"(Bf[i]), "+v"(Cf[i]));
    asm volatile("" : "+v"(lre), "+v"(lim), "+v"(hre), "+v"(him));
    const int nt = isctx ? 8 : 128;
    const int rowbase = isctx ? NLAT + b * 256 : b * 4096;
    bf16x8 anext;
    {
      const int c0 = (sdir ? nt - 1 - ti0 : ti0) * 32, i = lane & 31;
      anext = ld8(P + (size_t)(rowbase + (sdir ? c0 + 31 - i : c0 + i)) * IND + C_U5 + g * 16 + 8 * (lane >> 5));
    }
    for (int ti = ti0; ti < ti1; ++ti) {
      const int c0 = (sdir ? nt - 1 - ti : ti) * 32;
      const bf16x8 a = anext;
      if (ti + 1 < ti1) {
        const int c1 = (sdir ? nt - 2 - ti : ti + 1) * 32, i = lane & 31;
        anext = ld8(P + (size_t)(rowbase + (sdir ? c1 + 31 - i : c1 + i)) * IND + C_U5 + g * 16 + 8 * (lane >> 5));
      }
      u32x4 tmpv = u32x4{0u, 0u, 0u, 0u};
      if (mode == 2) {
        const int qs = (3 - fq) * 16 + fr;
        tmpv = *reinterpret_cast<const u32x4*>(Y + (size_t)(rowbase + c0 + (qs >> 1)) * MIXW + 1536 + g * 16 + (qs & 1) * 8);
      }
      wave_lds_sync();
      if (mode == 2) *reinterpret_cast<bf16x8*>(ust + (lane & 31) * 16 + 8 * (lane >> 5)) = a;
#pragma unroll
      for (int cb = 0; cb < 4; ++cb) {
        f32x16 z;
#pragma unroll
        for (int r = 0; r < 16; ++r) z[r] = 0.f;
        f32x16 acc = mfma32(a, Bf[cb], z);
#pragma unroll
        for (int r = 0; r < 16; ++r) {
          const int ii = (r & 3) + 8 * (r >> 2) + 4 * (lane >> 5);
          hb[ii * 136 + cb * 32 + (lane & 31)] = f2bf(acc[r]);
        }
      }
      wave_lds_sync();
      {
        unsigned buv[32];
#pragma unroll
        for (int i = 0; i < 32; ++i) buv[i] = *reinterpret_cast<const unsigned*>(hb + i * 136 + 2 * lane);
#pragma unroll
        for (int i = 0; i < 32; ++i) {
          const float nre = lre * hre - lim * him + bflo(buv[i]);
          const float nim = lre * him + lim * hre + bfhi(buv[i]);
          hre = nre; him = nim;
          *reinterpret_cast<unsigned*>(hb + i * 136 + 2 * lane) = pack2(hre, him);
        }
      }
      wave_lds_sync();
      f32x4 ya[2];
      ya[0] = f32x4{0.f, 0.f, 0.f, 0.f}; ya[1] = f32x4{0.f, 0.f, 0.f, 0.f};
#pragma unroll
      for (int kk = 0; kk < 4; ++kk) {
        bf16x8 a0 = ld8(hb + fr * 136 + kk * 32 + fq * 8);
        bf16x8 a1 = ld8(hb + (16 + fr) * 136 + kk * 32 + fq * 8);
        ya[0] = mfma16(a0, Cf[kk], ya[0]);
        ya[1] = mfma16(a1, Cf[kk], ya[1]);
      }
      pin4(tmpv);
      if (mode == 1) {
        u32x4 o;
        o[0] = pack2(ya[0][0], ya[0][1]); o[1] = pack2(ya[0][2], ya[0][3]); o[2] = pack2(ya[1][0], ya[1][1]); o[3] = pack2(ya[1][2], ya[1][3]);
        const int qs = fq * 16 + fr;
        *reinterpret_cast<u32x4*>(Y + (size_t)(rowbase + c0 + (qs >> 1)) * MIXW + 1536 + g * 16 + (qs & 1) * 8) = o;
      } else if (mode == 2) {
#pragma unroll
        for (int rt = 0; rt < 2; ++rt)
#pragma unroll
          for (int j = 0; j < 4; ++j) {
            const int i = rt * 16 + fq * 4 + j;
            const int tau = sdir ? c0 + 31 - i : c0 + i;
            const size_t row = (size_t)(rowbase + tau);
            const int e = 7 - (rt * 4 + j);
            const unsigned pw = tmpv[e >> 1];
            const float yf = (e & 1) ? bfhi(pw) : bflo(pw);
            const float u = bf2f(ust[i * 16 + fr]);
            const float x = yf + ya[rt][j] + dsk * u;
            const float th = 1.f - 2.f * rcpf(1.f + __expf(2.f * 0.7978845608028654f * (x + 0.044715f * x * x * x)));
            const float ge = 0.5f * x * (1.f + th);
            if (isctx) G5C[(row - NLAT) * 512 + g * 16 + fr] = f2bf(ge);
            else P[row * IND + C_U5 + g * 16 + fr] = f2bf(ge);
          }
      }
    }
  }
  if (part == 0) { stsave[lane * 2] = hre; stsave[lane * 2 + 1] = him; }
}

__device__ void ssd_norm_rows(const Params& p, int nrows) {
  const int tid = opaque_tid();
  const float* ssq = (const float*)(p.ws + WS_SSQ);
  float* rsb = (float*)(p.ws + WS_RS);
  for (int i = blockIdx.x * 256 + tid; i < nrows * 2; i += gridDim.x * 256) {
    const float* sp = ssq + (size_t)i * 8;
    const float sum = sp[0] + sp[1] + sp[2] + sp[3] + sp[4] + sp[5] + sp[6] + sp[7];
    rsb[i] = rsqrtf(sum * (1.f / 512.f) + EPSF);
  }
}

__device__ void phase_final(const Params& p) {
  const int tid = opaque_tid(), lane = tid & 63, w = tid >> 6;
  const float* nw = p.in[opq(28)];
  for (int r = blockIdx.x * 4 + w; r < NLAT; r += gridDim.x * 4) {
    float* src = p.out + (size_t)r * 1024;
    float4 v[4]; float ss = 0.f;
#pragma unroll
    for (int q = 0; q < 4; ++q) {
      v[q] = *reinterpret_cast<const float4*>(src + lane * 4 + q * 256);
      ss += v[q].x * v[q].x + v[q].y * v[q].y + v[q].z * v[q].z + v[q].w * v[q].w;
    }
#pragma unroll
    for (int o = 32; o > 0; o >>= 1) ss += __shfl_xor(ss, o);
    const float rs = rsqrtf(ss * (1.f / 1024.f) + EPSF);
#pragma unroll
    for (int q = 0; q < 4; ++q) {
      const int col = lane * 4 + q * 256;
      float4 n4 = *reinterpret_cast<const float4*>(nw + col);
      float4 o = make_float4(v[q].x * rs * n4.x, v[q].y * rs * n4.y, v[q].z * rs * n4.z, v[q].w * rs * n4.w);
      *reinterpret_cast<float4*>(src + col) = o;
    }
  }
}


#define XB_TMO      128
#define XB_XCNT(j)  (256  + 64 * (j))
#define XB_XSUB(j)  (1280 + 64 * (j))
#define XB_XGEN(j)  (2304 + 64 * (j))
#define XB_TOP      3328
#define XB_TOPGEN   3392
#define XCD_BAR_WORDS 3456
#define XB_SPIN_CAP (1u << 20)
DI unsigned xb_ld(unsigned* p) { return __hip_atomic_load(p, __ATOMIC_RELAXED, __HIP_MEMORY_SCOPE_AGENT); }
DI unsigned xb_add(unsigned* p, unsigned v) { return __hip_atomic_fetch_add(p, v, __ATOMIC_RELAXED, __HIP_MEMORY_SCOPE_AGENT); }
DI unsigned xb_xcc_id() { return (unsigned)__builtin_amdgcn_s_getreg((3 << 11) | 20) & 0xFu; }
#define XB_SPIN(cond, bar) do { unsigned _sp = 0; while (cond) { __builtin_amdgcn_s_sleep(1); \
    if ((++_sp & 255u) == 0u) { if (xb_ld(&(bar)[XB_TMO])) break; if (_sp > XB_SPIN_CAP) { atomicAdd(&(bar)[XB_TMO], 1u); break; } } } } while (0)
struct XcdBarrier { unsigned* bar; unsigned x, nloc, nx; };
DI XcdBarrier xcd_barrier_post(unsigned* bar) {
  XcdBarrier b; b.bar = bar; b.x = xb_xcc_id(); b.nloc = 0u; b.nx = 0u;
  if (threadIdx.x == 0) (void)xb_add(&bar[XB_XCNT(b.x)], 1u);
  return b;
}
DI void xcd_barrier_complete(unsigned* bar, unsigned x, unsigned& nloc, unsigned& nx) {
  const unsigned G = gridDim.x;
  unsigned sum, cnt, mine, sp = 0u;
  for (;;) {
    sum = 0u; cnt = 0u; mine = 0u;
#pragma unroll
    for (unsigned j = 0; j < 16; ++j) { const unsigned c = xb_ld(&bar[XB_XCNT(j)]); sum += c; cnt += (c > 0u) ? 1u : 0u; mine = (j == x) ? c : mine; }
    if (sum == G) break;
    __builtin_amdgcn_s_sleep(1);
    if ((++sp & 255u) == 0u) { if (xb_ld(&bar[XB_TMO])) break; if (sp > XB_SPIN_CAP) { atomicAdd(&bar[XB_TMO], 1u); break; } }
  }
  nloc = mine > 0u ? mine : 1u; nx = cnt > 0u ? cnt : 1u;
}
DI void xcd_barrier(XcdBarrier& b) {
  asm volatile("s_waitcnt vmcnt(0)" ::: "memory");
  __syncthreads();
  if (threadIdx.x == 0) {
    unsigned* bar = b.bar;
    __builtin_amdgcn_s_waitcnt(0);
    if (b.nloc == 0u) xcd_barrier_complete(bar, b.x, b.nloc, b.nx);
    const unsigned nloc = b.nloc, nx = b.nx;
    const unsigned old = xb_add(&bar[XB_XSUB(b.x)], 1u);
    const unsigned gen = old / nloc;
    if (old + 1u == (gen + 1u) * nloc) {
      __builtin_amdgcn_fence(__ATOMIC_RELEASE, "agent");
      asm volatile("s_waitcnt vmcnt(0)" ::: "memory");
      const unsigned og = xb_add(&bar[XB_TOP], 1u);
      const unsigned tg = og / nx;
      if (og + 1u == (tg + 1u) * nx) xb_add(&bar[XB_TOPGEN], 1u);
      else XB_SPIN(xb_ld(&bar[XB_TOPGEN]) == tg, bar);
      __builtin_amdgcn_fence(__ATOMIC_ACQUIRE, "agent");
      xb_add(&bar[XB_XGEN(b.x)], 1u);
      asm volatile("s_waitcnt vmcnt(0)" ::: "memory");
    } else {
      XB_SPIN(xb_ld(&bar[XB_XGEN(b.x)]) == gen, bar);
      __builtin_amdgcn_fence(__ATOMIC_ACQUIRE, "agent");
      asm volatile("s_waitcnt vmcnt(0)" ::: "memory");
    }
  }
  __syncthreads();
}

__global__ void __launch_bounds__(256, 2) fwd_megakernel(Params p) {
  extern __shared__ __attribute__((aligned(16))) unsigned char smem[];
  cg::grid_group grid = cg::this_grid();
  XcdBarrier xb = xcd_barrier_post((unsigned*)(p.ws + WS_BAR));
  const int ph_lo = p.ph_lo, ph_hi = p.ph_hi;
  for (int ph = ph_lo; ph < ph_hi; ++ph) {
    if (ph == 0) {
      phase_prep(p, smem);
    } else if (ph == NPHASE - 1) {
      phase_final(p);
    } else {
      const int l = (ph - 1) / 7, sub = (ph - 1) % 7;
      const int mt = (l == 1) ? 256 : 272;
      if (sub == 0) {
        phase_pre(p, l, smem);
      } else if (sub == 1) {
        const u16* U = (const u16*)(p.ws + WS_Y);
        const u16* W = (const u16*)(p.ws + WS_WIN);
        const int xcd = blockIdx.x & 7, slot = blockIdx.x >> 3, nslots = gridDim.x >> 3;
        for (int u = slot; u < 918; u += nslots) {
          const int pnl = u / 306, v = u % 306;
          gemm_tile<192, 0>(p, l, U, 1024, W, 1024, 1024, (xcd * 34 + v / 9) * 128, (pnl * 9 + v % 9) * 192, smem);
        }
      } else if (sub == 2) {
        phase_conv(p, l);
      } else if (sub == 3 || sub == 4) {
        const int part = sub - 3;
        for (int k = 0;; ++k) {
          int it;
          if (gridDim.x == 512) {
            if (k > 0) break;
            const int blk = blockIdx.x;
            const int q = blk < 256 ? blk - 64 : 192 + (blk - 448);
            const int sit = q < 128 ? q * 2 : (q - 128) * 2 + 1;
            it = blk < 64 ? 256 + blk : blk < 256 ? sit : blk < 320 ? -1 : blk < 448 ? blk : sit;
          } else {
            it = blockIdx.x + k * gridDim.x;
            if (it >= 448) break;
          }
          if (it >= 0) {
            if (it < 256) ssd_item(p, l, part, it, smem);
            else if (it < 320) gla_item(p, l, part, it - 256, smem);
            else s5_item(p, l, part, it - 320, smem);
          }
          __syncthreads();
        }
      } else if (sub == 5) {
        const u16* W = (const u16*)(p.ws + WS_GLU);
        const int xcd = blockIdx.x & 7, slot = blockIdx.x >> 3, nslots = gridDim.x >> 3, mtx = mt >> 3;
        for (int u = slot; u < mtx * 8; u += nslots) {
          const int t = (xcd * mtx) * 8 + u;
          const int m0 = (t >> 3) * 128;
          if (m0 < NLAT) gemm_tile<128, 1>(p, l, (const u16*)(p.ws + WS_P) + C_U5, IND, W, 512, 512, m0, (t & 7) * 128, smem);
          else gemm_tile<128, 1>(p, l, (const u16*)(p.ws + WS_G5C) - (size_t)NLAT * 512, 512, W, 512, 512, m0, (t & 7) * 128, smem);
        }
        ssd_norm_rows(p, mt * 128);
      } else {
        const u16* A = (const u16*)(p.ws + WS_Y);
        const u16* W = (const u16*)(p.ws + WS_WOUT);
        const int xcd = blockIdx.x & 7, slot = blockIdx.x >> 3, nslots = gridDim.x >> 3, mtx = mt >> 3;
        for (int u = slot; u < mtx * 8; u += nslots) {
          const int t = (xcd * mtx) * 8 + u;
          gemm_tile<128, 2>(p, l, A, MIXW, W, MIXW, MIXW, (t >> 3) * 128, (t & 7) * 128, smem);
        }
      }
    }
    if (ph + 1 < ph_hi) {
      if (ph_hi < 0) grid.sync();
      xcd_barrier(xb);
    }
  }
}

extern "C" void kernel_launch(void* const* d_in, const int* in_sizes, int n_in, void* d_out, int out_size, void* d_ws,
                              size_t ws_size, hipStream_t stream) {
  static int grid_blocks = 0;
  if (grid_blocks == 0) {
    if (n_in != 29 || ws_size < WS_END) { fprintf(stderr, "kernel_launch: bad n_in %d / ws %zu (need %zu)\n", n_in, ws_size, (size_t)WS_END); grid_blocks = -1; return; }
    int dev = 0, cus = 0, per_cu = 0;
    hipGetDevice(&dev);
    hipDeviceGetAttribute(&cus, hipDeviceAttributeMultiprocessorCount, dev);
    hipFuncSetAttribute((const void*)fwd_megakernel, hipFuncAttributeMaxDynamicSharedMemorySize, SMEM_BYTES);
    hipOccupancyMaxActiveBlocksPerMultiprocessor(&per_cu, (const void*)fwd_megakernel, 256, SMEM_BYTES);
    if (per_cu < 1) per_cu = 1;
    if (per_cu > 2) per_cu = 2;
    grid_blocks = cus * per_cu;
    fprintf(stderr, "kernel_launch: cus %d per_cu %d grid %d\n", cus, per_cu, grid_blocks);
  }
  if (grid_blocks < 0) return;
  Params p{};
  for (int i = 0; i < 29; ++i) p.in[i] = (const float*)d_in[i];
  p.out = (float*)d_out; p.ws = (unsigned char*)d_ws; p.ph_lo = 0; p.ph_hi = NPHASE;
  if (hipMemsetAsync((char*)d_ws + WS_BAR, 0, 16384, stream) != hipSuccess) { fprintf(stderr, "kernel_launch: memset of the barrier words failed\n"); return; }
  void* args[] = {&p};
  hipError_t e = hipLaunchCooperativeKernel((const void*)fwd_megakernel, dim3(grid_blocks), dim3(256), args, SMEM_BYTES, stream);
  if (e != hipSuccess) fprintf(stderr, "cooperative launch failed: %s (grid %d)\n", hipGetErrorString(e), grid_blocks);
}
```

```cpp
#include <hip/hip_runtime.h>
#include <hip/hip_cooperative_groups.h>
#include <cstdio>
namespace cg = cooperative_groups;

typedef unsigned short u16;
using bf16x8 = __attribute__((ext_vector_type(8))) short;
using bf16x4 = __attribute__((ext_vector_type(4))) short;
using f32x4 = __attribute__((ext_vector_type(4))) float;
using f32x16 = __attribute__((ext_vector_type(16))) float;
using u32x4 = __attribute__((ext_vector_type(4))) unsigned;
#define DI __device__ __forceinline__

constexpr int DM = 1024, NLAT = 32768, NCTX = 2048, NTOK = 34816, IND = 5184, MIXW = 2048;
constexpr int C_XBC = 1024, C_BM = 2048, C_CM = 2304, C_DT = 2560, C_Q = 2592, C_K = 2848, C_V = 3104, C_GG = 3616,
              C_LR = 4128, C_U5 = 4160, C_SG = 4672;
constexpr float EPSF = 1e-6f;
constexpr int SMEM_BYTES = 81920;
constexpr int NPHASE = 16;

constexpr size_t WS_P = 0;
constexpr size_t WS_Y = WS_P + (size_t)NTOK * IND * 2;
constexpr size_t WS_WIN = WS_Y + (size_t)NTOK * MIXW * 2;
constexpr size_t WS_WOUT = WS_WIN + (size_t)IND * DM * 2;
constexpr size_t WS_GLU = WS_WOUT + (size_t)DM * MIXW * 2;
constexpr size_t WS_HCTX = WS_GLU + (size_t)1024 * 512 * 2;
constexpr size_t WS_MOD = WS_HCTX + (size_t)NCTX * DM * 4;
constexpr size_t WS_SSQ = WS_MOD + (size_t)2 * 9 * 3072 * 4;
constexpr size_t WS_S5C = WS_SSQ + (size_t)NTOK * 16 * 4;
constexpr size_t WS_G5C = WS_S5C + (size_t)128 * 8704;
constexpr size_t WS_S5ST = WS_G5C + (size_t)NCTX * 512 * 2;
constexpr size_t WS_BAR = WS_S5ST + (size_t)512 * 128 * 4;
constexpr size_t WS_RS = WS_BAR + 16384;
constexpr size_t WS_END = WS_RS + (size_t)NTOK * 2 * 4;

struct Params {
  const float* in[29];
  float* out;
  unsigned char* ws;
  int ph_lo, ph_hi;
};

DI int opq(int i) { asm volatile("" : "+s"(i)); return i; }
DI int opaque_tid() { int t = threadIdx.x; asm volatile("" : "+v"(t)); return t; }
typedef __bf16 hbf16x2 __attribute__((ext_vector_type(2)));
typedef float hf32x2 __attribute__((ext_vector_type(2)));
DI u16 f2bf(float x) { __bf16 h = (__bf16)x; return __builtin_bit_cast(u16, h); }
DI float bf2f(u16 h) { return __uint_as_float(((unsigned)h) << 16); }
DI unsigned pack2(float a, float b) { hf32x2 v = {a, b}; return __builtin_bit_cast(unsigned, __builtin_convertvector(v, hbf16x2)); }
DI float bflo(unsigned v) { return __uint_as_float(v << 16); }
DI float bfhi(unsigned v) { return __uint_as_float(v & 0xffff0000u); }
DI float rcpf(float x) { return __builtin_amdgcn_rcpf(x); }
DI float siluf(float x) { return x * rcpf(1.f + __expf(-x)); }
DI float logsigf(float x) { return fminf(x, 0.f) - __logf(1.f + __expf(-fabsf(x))); }
DI float softplusf(float v) { return fmaxf(v, 0.f) + log1pf(__expf(-fabsf(v))); }
DI f32x4 mfma16(bf16x8 a, bf16x8 b, f32x4 c) { return __builtin_amdgcn_mfma_f32_16x16x32_bf16(a, b, c, 0, 0, 0); }
DI f32x16 mfma32(bf16x8 a, bf16x8 b, f32x16 c) { return __builtin_amdgcn_mfma_f32_32x32x16_bf16(a, b, c, 0, 0, 0); }
DI void wave_lds_sync() { asm volatile("s_waitcnt lgkmcnt(0)" ::: "memory"); }
DI unsigned pin(unsigned v) { asm volatile("" : "+v"(v)); return v; }
DI void pin4(u32x4& v) { asm volatile("" : "+v"(v)); }
#define DPPF(v, old, ctrl, rmask) __builtin_bit_cast(float, __builtin_amdgcn_update_dpp(__builtin_bit_cast(int, (float)(old)), __builtin_bit_cast(int, (float)(v)), (ctrl), (rmask), 0xf, false))
DI float row16_sum(float v) {
  v += DPPF(v, 0.f, 0xB1, 0xf);
  v += DPPF(v, 0.f, 0x4E, 0xf);
  v += DPPF(v, 0.f, 0x141, 0xf);
  v += DPPF(v, 0.f, 0x140, 0xf);
  return v;
}
DI float wave_incl_scan(float v) {
  v += DPPF(v, 0.f, 0x111, 0xf);
  v += DPPF(v, 0.f, 0x112, 0xf);
  v += DPPF(v, 0.f, 0x114, 0xf);
  v += DPPF(v, 0.f, 0x118, 0xf);
  v += DPPF(v, 0.f, 0x142, 0xa);
  v += DPPF(v, 0.f, 0x143, 0xc);
  return v;
}
DI bf16x8 ld8(const u16* p) { return *reinterpret_cast<const bf16x8*>(p); }
DI bf16x8 ld44(const u16* p0, const u16* p1) {
  bf16x4 a = *reinterpret_cast<const bf16x4*>(p0), b = *reinterpret_cast<const bf16x4*>(p1);
  return __builtin_shufflevector(a, b, 0, 1, 2, 3, 4, 5, 6, 7);
}
DI bf16x8 packacc(const f32x4& a, const f32x4& b) {
  uint4 u; u.x = pack2(a[0], a[1]); u.y = pack2(a[2], a[3]); u.z = pack2(b[0], b[1]); u.w = pack2(b[2], b[3]);
  return __builtin_bit_cast(bf16x8, u);
}

__device__ void phase_prep(const Params& p, unsigned char* smem) {
  float* sc = (float*)smem;
  float* red = sc + 9 * 1024;
  const int tid = opaque_tid();
  float* modb = (float*)(p.ws + WS_MOD);
  bool filled = false;
  for (int it = blockIdx.x; it < 96 + 128; it += gridDim.x) {
    if (it < 96) {
      if (!filled) {
        for (int idx = tid; idx < 9216; idx += 256) {
          int r = idx >> 10, k = idx & 1023;
          float v = r < 8 ? p.in[opq(1)][r * 1024 + k] : p.in[opq(3)][k];
          sc[idx] = siluf(v);
        }
        filled = true;
        __syncthreads();
      }
      const int l = it / 48, j0 = (it % 48) * 64, kg = tid >> 6, jj = tid & 63;
      float a[9];
#pragma unroll
      for (int r = 0; r < 9; ++r) a[r] = 0.f;
      const float* W = p.in[opq(5)] + (size_t)l * 1024 * 3072 + j0 + jj;
      for (int k = kg * 256; k < kg * 256 + 256; ++k) {
        float wv = W[(size_t)k * 3072];
#pragma unroll
        for (int r = 0; r < 9; ++r) a[r] += sc[r * 1024 + k] * wv;
      }
#pragma unroll
      for (int r = 0; r < 9; ++r) red[(kg * 9 + r) * 64 + jj] = a[r];
      __syncthreads();
      for (int idx = tid; idx < 576; idx += 256) {
        int r = idx >> 6, j = idx & 63;
        float s = red[(0 * 9 + r) * 64 + j] + red[(1 * 9 + r) * 64 + j] + red[(2 * 9 + r) * 64 + j] + red[(3 * 9 + r) * 64 + j];
        modb[(l * 9 + r) * 3072 + j0 + j] = s + p.in[opq(6)][l * 3072 + j0 + j];
      }
      __syncthreads();
    } else {
      const int q = it - 96, l = q >> 6, d = (q >> 5) & 1, g = q & 31;
      unsigned char* base = p.ws + WS_S5C + (size_t)q * 8704;
      u16* BbarM = (u16*)base;
      u16* CmT = (u16*)(base + 4096);
      float* lamb = (float*)(base + 8192);
      const float st = expf(p.in[opq(20)][(l * 2 + d) * 32 + g]);
      for (int idx = tid; idx < 1024; idx += 256) {
        const int pp = idx >> 4, hh = idx & 15;
        const int li = ((l * 2 + d) * 32 + g) * 64 + pp;
        const float lre = p.in[opq(18)][li], lim = p.in[opq(19)][li];
        const float a = lre * st, bb = lim * st;
        const float ea = expf(a), sn = sinf(bb), cs = cosf(bb), s2 = sinf(0.5f * bb);
        const float lbre = ea * cs, lbim = ea * sn;
        const float nre = expm1f(a) * cs - 2.f * s2 * s2, nim = lbim;
        const float den = lre * lre + lim * lim;
        const float cre = (nre * lre + nim * lim) / den, cim = (nim * lre - nre * lim) / den;
        const int bi = ((l * 32 + g) * 64 + pp) * 16 + hh;
        const float bre = p.in[opq(21)][bi], bim = p.in[opq(22)][bi];
        BbarM[(2 * pp) * 16 + hh] = f2bf(cre * bre - cim * bim);
        BbarM[(2 * pp + 1) * 16 + hh] = f2bf(cre * bim + cim * bre);
        const int cidx = (((l * 2 + d) * 32 + g) * 16 + hh) * 64 + pp;
        CmT[hh * 128 + 2 * pp] = f2bf(p.in[opq(23)][cidx]);
        CmT[hh * 128 + 2 * pp + 1] = f2bf(-p.in[opq(24)][cidx]);
        if (hh == 0) { lamb[2 * pp] = lbre; lamb[2 * pp + 1] = lbim; }
      }
    }
  }
}

__device__ void phase_pre(const Params& p, int l, unsigned char* smem) {
  const int tid = opaque_tid(), lane = tid & 63, w = tid >> 6;
  const float* hl = l == 0 ? p.in[opq(0)] : p.out;
  const float* hc = l == 0 ? p.in[opq(2)] : (const float*)(p.ws + WS_HCTX);
  const float* nw = p.in[opq(4)] + l * 1024;
  const float* modb = (const float*)(p.ws + WS_MOD) + l * 9 * 3072;
  u16* U = (u16*)(p.ws + WS_Y);
  const bool cm = (l & 1);
  for (int r = blockIdx.x * 4 + w; r < NTOK; r += gridDim.x * 4) {
    const float* src; const float* mrow;
    if (r < NLAT) {
      int b = r >> 12, sp = r & 4095;
      int s = cm ? (((sp & 63) << 6) | (sp >> 6)) : sp;
      src = hl + ((size_t)(b * 4096 + s)) * 1024; mrow = modb + b * 3072;
    } else { src = hc + (size_t)(r - NLAT) * 1024; mrow = modb + 8 * 3072; }
    float4 v[4]; float ss = 0.f;
#pragma unroll
    for (int q = 0; q < 4; ++q) {
      v[q] = *reinterpret_cast<const float4*>(src + lane * 4 + q * 256);
      ss += v[q].x * v[q].x + v[q].y * v[q].y + v[q].z * v[q].z + v[q].w * v[q].w;
    }
#pragma unroll
    for (int o = 32; o > 0; o >>= 1) ss += __shfl_xor(ss, o);
    const float rs = rsqrtf(ss * (1.f / 1024.f) + EPSF);
#pragma unroll
    for (int q = 0; q < 4; ++q) {
      const int col = lane * 4 + q * 256;
      float4 n4 = *reinterpret_cast<const float4*>(nw + col);
      float4 sh = *reinterpret_cast<const float4*>(mrow + col);
      float4 s4 = *reinterpret_cast<const float4*>(mrow + 1024 + col);
      float u0 = v[q].x * rs * n4.x * (1.f + s4.x) + sh.x;
      float u1 = v[q].y * rs * n4.y * (1.f + s4.y) + sh.y;
      float u2 = v[q].z * rs * n4.z * (1.f + s4.z) + sh.z;
      float u3 = v[q].w * rs * n4.w * (1.f + s4.w) + sh.w;
      uint2 o; o.x = pack2(u0, u1); o.y = pack2(u2, u3);
      *reinterpret_cast<uint2*>(U + (size_t)r * 1024 + col) = o;
    }
  }
  float* tile = (float*)smem;
  for (int t = blockIdx.x; t < 1296 + 512 + 128; t += gridDim.x) {
    const float* src; int sld, k0, n0, kind; u16* dst; int dld;
    if (t < 1296) { kind = 0; k0 = (t / 81) * 64; n0 = (t % 81) * 64; src = p.in[opq(7)] + (size_t)l * 1024 * IND; sld = IND; dst = (u16*)(p.ws + WS_WIN); dld = 1024; }
    else if (t < 1808) { int q = t - 1296; kind = 1; k0 = (q / 16) * 64; n0 = (q % 16) * 64; src = p.in[opq(8)] + (size_t)l * 2048 * 1024; sld = 1024; dst = (u16*)(p.ws + WS_WOUT); dld = 2048; }
    else { int q = t - 1808; kind = 2; k0 = (q / 16) * 64; n0 = (q % 16) * 64; src = p.in[opq(26)] + (size_t)l * 512 * 1024; sld = 1024; dst = (u16*)(p.ws + WS_GLU); dld = 512; }
    __syncthreads();
#pragma unroll
    for (int rr = 0; rr < 4; ++rr) {
      int i = (tid >> 4) + 16 * rr, j = (tid & 15) * 4;
      float4 v = *reinterpret_cast<const float4*>(src + (size_t)(k0 + i) * sld + n0 + j);
      if (kind == 1 && k0 + i < 1024) { float s = p.in[opq(14)][l * 1024 + k0 + i]; v.x *= s; v.y *= s; v.z *= s; v.w *= s; }
      tile[i * 65 + j] = v.x; tile[i * 65 + j + 1] = v.y; tile[i * 65 + j + 2] = v.z; tile[i * 65 + j + 3] = v.w;
    }
    __syncthreads();
#pragma unroll
    for (int rr = 0; rr < 2; ++rr) {
      int n = (tid >> 3) + 32 * rr, i0 = (tid & 7) * 8;
      uint4 o;
      o.x = pack2(tile[(i0 + 0) * 65 + n], tile[(i0 + 1) * 65 + n]);
      o.y = pack2(tile[(i0 + 2) * 65 + n], tile[(i0 + 3) * 65 + n]);
      o.z = pack2(tile[(i0 + 4) * 65 + n], tile[(i0 + 5) * 65 + n]);
      o.w = pack2(tile[(i0 + 6) * 65 + n], tile[(i0 + 7) * 65 + n]);
      int drow = n0 + n;
      if (kind == 2) { int o_ = n0 + n, half = o_ >> 9, rem = o_ & 511; drow = (rem >> 6) * 128 + ((rem & 63) >> 4) * 32 + half * 16 + (rem & 15); }
      *reinterpret_cast<uint4*>(dst + (size_t)drow * dld + k0 + i0) = o;
    }
  }
}

template <int BN, int MODE>
__device__ void gemm_tile(const Params& p, int l, const u16* __restrict__ A, int lda, const u16* __restrict__ Bt, int ldb,
                          int K, int m0, int n0, unsigned char* smem,
                          bool pre, bool has_next, const u16* __restrict__ An, int ldan, int m0n, int n0n) {
  constexpr int WN = BN / 2, NF = WN / 16, NBL = BN * 8 / 256;
  u16* As = (u16*)smem;
  u16* Bs = As + 128 * 64;
  const int tid = opaque_tid(), lane = tid & 63, w = tid >> 6, wr = w >> 1, wc = w & 1, fr = lane & 15, fq = lane >> 4;
  f32x4 acc[4][NF];
#pragma unroll
  for (int m = 0; m < 4; ++m)
#pragma unroll
    for (int n = 0; n < NF; ++n) acc[m][n] = f32x4{0.f, 0.f, 0.f, 0.f};
  constexpr int STAGE = (128 + BN) * 64;
  const int nk = K / 64;
#define GLDS(OFF, KT) do { const int k0_ = (KT) * 64; \
    _Pragma("unroll") for (int i = 0; i < 4; ++i) { const int id = tid + 256 * i, row = id >> 3, c = (id & 7) ^ ((id >> 4) & 7); \
      __builtin_amdgcn_global_load_lds((const unsigned*)(A + (size_t)(m0 + row) * lda + k0_ + c * 8), (unsigned*)(As + (OFF) + id * 8), 16, 0, 0); } \
    _Pragma("unroll") for (int i = 0; i < NBL; ++i) { const int id = tid + 256 * i, row = id >> 3, c = (id & 7) ^ ((id >> 4) & 7); \
      __builtin_amdgcn_global_load_lds((const unsigned*)(Bt + (size_t)(n0 + row) * ldb + k0_ + c * 8), (unsigned*)(Bs + (OFF) + id * 8), 16, 0, 0); } } while (0)
#define COMPUTE(OFF) do { \
    _Pragma("unroll") for (int kk = 0; kk < 2; ++kk) { \
      bf16x8 af[4], bfr[NF]; \
      _Pragma("unroll") for (int m = 0; m < 4; ++m) af[m] = ld8(As + (OFF) + (wr * 64 + m * 16 + fr) * 64 + (((kk * 4 + fq) ^ (fr >> 1)) * 8)); \
      _Pragma("unroll") for (int n = 0; n < NF; ++n) bfr[n] = ld8(Bs + (OFF) + (wc * WN + n * 16 + fr) * 64 + (((kk * 4 + fq) ^ (fr >> 1)) * 8)); \
      __builtin_amdgcn_s_setprio(1); \
      _Pragma("unroll") for (int m = 0; m < 4; ++m) \
        _Pragma("unroll") for (int n = 0; n < NF; ++n) acc[m][n] = mfma16(bfr[n], af[m], acc[m][n]);     \
      __builtin_amdgcn_s_setprio(0); } } while (0)
  float f0[4], f1[4];
  if constexpr (MODE == 2) {
    const float* rsb = (const float*)(p.ws + WS_RS);
#pragma unroll
    for (int m = 0; m < 4; ++m) {
      const float2 r2 = *reinterpret_cast<const float2*>(rsb + (size_t)(m0 + wr * 64 + m * 16 + fr) * 2);
      f0[m] = r2.x * rcpf(r2.y); f1[m] = r2.y;
    }
  }
  __syncthreads();
  if (!pre) GLDS(0, 0);
  asm volatile("s_waitcnt vmcnt(0)" ::: "memory");
  __syncthreads();
  for (int kt = 0; kt < nk; ++kt) {
    const int cur = (kt & 1) * STAGE, nxt = STAGE - cur;
    if (kt + 1 < nk) GLDS(nxt, kt + 1);
    else if (has_next) {
#pragma unroll
      for (int i = 0; i < 4; ++i) { const int id = tid + 256 * i, row = id >> 3, c = (id & 7) ^ ((id >> 4) & 7);
        __builtin_amdgcn_global_load_lds((const unsigned*)(An + (size_t)(m0n + row) * ldan + c * 8), (unsigned*)(As + id * 8), 16, 0, 0); }
#pragma unroll
      for (int i = 0; i < NBL; ++i) { const int id = tid + 256 * i, row = id >> 3, c = (id & 7) ^ ((id >> 4) & 7);
        __builtin_amdgcn_global_load_lds((const unsigned*)(Bt + (size_t)(n0n + row) * ldb + c * 8), (unsigned*)(Bs + id * 8), 16, 0, 0); }
    }
    COMPUTE(cur);
    if constexpr (MODE == 2) {
      if (kt == 7 || kt == 15) {
#pragma unroll
        for (int m = 0; m < 4; ++m)
#pragma unroll
          for (int n = 0; n < NF; ++n)
#pragma unroll
            for (int j = 0; j < 4; ++j) acc[m][n][j] *= (kt == 7) ? f0[m] : f1[m];
      }
    }
    if (kt + 1 < nk) asm volatile("s_waitcnt vmcnt(0)" ::: "memory");
    __syncthreads();
  }
#define GLOAD(x)
#define LSTORE(x)
#undef GLOAD
#undef LSTORE
#undef COMPUTE
  if constexpr (MODE == 0) {
    u16* P = (u16*)(p.ws + WS_P);
    constexpr int SLD = WN + 8;
    u16* stg = (u16*)smem + STAGE + w * 16 * SLD;
    constexpr int CPR = WN / 8;
    __syncthreads();
#pragma unroll
    for (int m = 0; m < 4; ++m) {
      wave_lds_sync();
#pragma unroll
      for (int n = 0; n < NF; ++n) {
        uint2 o; o.x = pack2(acc[m][n][0], acc[m][n][1]); o.y = pack2(acc[m][n][2], acc[m][n][3]);
        *reinterpret_cast<uint2*>(stg + fr * SLD + n * 16 + fq * 4) = o;
      }
      wave_lds_sync();
      for (int id = lane; id < 16 * CPR; id += 64) {
        int row = id / CPR, ch = id % CPR;
        uint4 v = *reinterpret_cast<const uint4*>(stg + row * SLD + ch * 8);
        *reinterpret_cast<uint4*>(P + (size_t)(m0 + wr * 64 + m * 16 + row) * IND + n0 + wc * WN + ch * 8) = v;
      }
    }
  } else if constexpr (MODE == 1) {
    const u16* P = (const u16*)(p.ws + WS_P);
    u16* Y = (u16*)(p.ws + WS_Y);
    const float* gb = p.in[opq(27)] + l * 1024;
    const int tn = n0 >> 7;
#pragma unroll
    for (int q = 0; q < 2; ++q) {
      const int oc = tn * 64 + (wc * 2 + q) * 16 + fq * 4;
      const f32x4 b0 = *reinterpret_cast<const f32x4*>(gb + oc), b1 = *reinterpret_cast<const f32x4*>(gb + 512 + oc);
#pragma unroll
      for (int m = 0; m < 4; ++m) {
        const size_t row = (size_t)(m0 + wr * 64 + m * 16 + fr);
        const uint2 sgv = *reinterpret_cast<const uint2*>(P + row * IND + C_SG + oc);
        const float sg[4] = {bflo(sgv.x), bfhi(sgv.x), bflo(sgv.y), bfhi(sgv.y)};
        float y[4];
#pragma unroll
        for (int j = 0; j < 4; ++j) {
          const float val = acc[m][2 * q][j] + b0[j], gt = acc[m][2 * q + 1][j] + b1[j];
          y[j] = val * rcpf(1.f + __expf(-gt)) * siluf(sg[j]);
        }
        uint2 o; o.x = pack2(y[0], y[1]); o.y = pack2(y[2], y[3]);
        *reinterpret_cast<uint2*>(Y + row * MIXW + 1536 + oc) = o;
      }
    }
  } else {
    const float* modb = (const float*)(p.ws + WS_MOD) + l * 9 * 3072;
    const bool cm = (l & 1);
    const float* hs = l == 0 ? p.in[opq(0)] : p.out;
    float* stg = (float*)((u16*)smem + STAGE) + w * (16 * 68);
    __syncthreads();
#pragma unroll
    for (int m = 0; m < 4; ++m) {
#pragma unroll
      for (int n = 0; n < NF; ++n) *reinterpret_cast<f32x4*>(stg + fr * 68 + n * 16 + fq * 4) = acc[m][n];
      wave_lds_sync();
#pragma unroll
      for (int k = 0; k < 4; ++k) {
        const int id = lane + 64 * k, rowi = id >> 4, ch = id & 15;
        const f32x4 a = *reinterpret_cast<const f32x4*>(stg + rowi * 68 + ch * 4);
        const int r = m0 + wr * 64 + m * 16 + rowi, col = n0 + wc * WN + ch * 4;
        const float* src; float* dst; const float* gt;
        if (r < NLAT) {
          const int b = r >> 12, sp = r & 4095;
          const int sq = cm ? (((sp & 63) << 6) | (sp >> 6)) : sp;
          const size_t idx = ((size_t)(b * 4096 + sq)) * 1024 + col;
          src = hs + idx; dst = p.out + idx; gt = modb + b * 3072 + 2048 + col;
        } else {
          const size_t idx = (size_t)(r - NLAT) * 1024 + col;
          src = p.in[opq(2)] + idx; dst = (float*)(p.ws + WS_HCTX) + idx; gt = modb + 8 * 3072 + 2048 + col;
        }
        const f32x4 h = *reinterpret_cast<const f32x4*>(src), gv = *reinterpret_cast<const f32x4*>(gt);
        f32x4 o;
        o[0] = h[0] + gv[0] * a[0]; o[1] = h[1] + gv[1] * a[1]; o[2] = h[2] + gv[2] * a[2]; o[3] = h[3] + gv[3] * a[3];
        *reinterpret_cast<f32x4*>(dst) = o;
      }
      wave_lds_sync();
    }
  }
  __syncthreads();
}

__device__ void phase_conv(const Params& p, int l) {
  u16* P = (u16*)(p.ws + WS_P);
  const float* cw = p.in[opq(9)] + (size_t)l * 5 * 1536;
  const float* cb = p.in[opq(10)] + l * 1536;
  const int tid = opaque_tid(), cq = tid & 7, sgi = tid >> 3;
  for (int it = blockIdx.x; it < 768; it += gridDim.x) {
    const bool isctx = it >= 384;
    const int q = isctx ? it - 384 : it, b = q / 48, cgp = q % 48;
    const int L = isctx ? 256 : 4096, seg = L / 32, rowbase = isctx ? NLAT + b * 256 : b * 4096;
    const int ch = cgp * 32 + cq * 4;
    float4 wk[5];
#pragma unroll
    for (int k = 0; k < 5; ++k) wk[k] = *reinterpret_cast<const float4*>(cw + k * 1536 + ch);
    const float4 bias = *reinterpret_cast<const float4*>(cb + ch);
    u16* rp = P + (size_t)rowbase * IND + C_XBC + ch;
    const int a = sgi * seg;
    auto ld = [&](int sp) -> float4 {
      float4 r = make_float4(0.f, 0.f, 0.f, 0.f);
      if (sp >= 0 && sp < L) {
        uint2 v = *reinterpret_cast<const uint2*>(rp + (size_t)sp * IND);
        r.x = bflo(v.x); r.y = bfhi(v.x); r.z = bflo(v.y); r.w = bfhi(v.y);
      }
      return r;
    };
    float4 r0 = ld(a - 2), r1 = ld(a - 1), r2 = ld(a), r3 = ld(a + 1);
    const float4 e0 = ld(a + seg), e1 = ld(a + seg + 1);
    __syncthreads();
    auto ldraw = [&](int sp) -> uint2 {
      uint2 v = make_uint2(0u, 0u);
      if (sp < a + seg) v = *reinterpret_cast<const uint2*>(rp + (size_t)sp * IND);
      return v;
    };
    uint2 nraw[8];
#pragma unroll
    for (int j = 0; j < 8; ++j) nraw[j] = ldraw(a + 2 + j);
    for (int t0 = a; t0 < a + seg; t0 += 8) {
      uint2 cur[8];
#pragma unroll
      for (int j = 0; j < 8; ++j) cur[j] = nraw[j];
      if (t0 + 8 < a + seg) {
#pragma unroll
        for (int j = 0; j < 8; ++j) nraw[j] = ldraw(t0 + 10 + j);
      }
#pragma unroll
      for (int j = 0; j < 8; ++j) {
        const int sp = t0 + 2 + j;
        float4 r4;
        if (sp < a + seg) {
          const unsigned c0_ = pin(cur[j].x), c1_ = pin(cur[j].y);
          r4 = make_float4(bflo(c0_), bfhi(c0_), bflo(c1_), bfhi(c1_));
        } else r4 = (sp == a + seg) ? e0 : e1;
        float o0 = bias.x + wk[0].x * r0.x + wk[1].x * r1.x + wk[2].x * r2.x + wk[3].x * r3.x + wk[4].x * r4.x;
        float o1 = bias.y + wk[0].y * r0.y + wk[1].y * r1.y + wk[2].y * r2.y + wk[3].y * r3.y + wk[4].y * r4.y;
        float o2 = bias.z + wk[0].z * r0.z + wk[1].z * r1.z + wk[2].z * r2.z + wk[3].z * r3.z + wk[4].z * r4.z;
        float o3 = bias.w + wk[0].w * r0.w + wk[1].w * r1.w + wk[2].w * r2.w + wk[3].w * r3.w + wk[4].w * r4.w;
        uint2 o; o.x = pack2(siluf(o0), siluf(o1)); o.y = pack2(siluf(o2), siluf(o3));
        *reinterpret_cast<uint2*>(rp + (size_t)(t0 + j) * IND) = o;
        r0 = r1; r1 = r2; r2 = r3; r3 = r4;
      }
    }
    __syncthreads();
  }
}


__device__ void ssd_item(const Params& p, int l, int part, int item, unsigned char* smem) {
  u16* Bs = (u16*)smem;
  u16* Ms = Bs;
  u16* Cs = (u16*)(smem + 17408);
  u16* BT = (u16*)(smem + 34816);
  u16* xT = (u16*)(smem + 53248);
  u16* xwT = (u16*)(smem + 62464);
  float* dts = (float*)(smem + 71680);
  float* acs = dts + 64;
  float* wts = acs + 64;
  float* ssql = wts + 64;
  float* tots = ssql + 256;
  u16* ystg = (u16*)(smem + 73600);
  const int tid0 = opaque_tid();
  const int b = item >> 5, hd = (item >> 1) & 15, dir = item & 1, g = hd >> 3;
  u16* P = (u16*)(p.ws + WS_P);
  u16* Y = (u16*)(p.ws + WS_Y);
  float* ssq = (float*)(p.ws + WS_SSQ);
  float* stsave = (float*)(p.ws + WS_WIN) + (size_t)item * 8192;
  const float Dsk = p.in[opq(13)][l * 16 + hd];
  f32x4 hacc[8];
  if (part == 1) {
#pragma unroll
    for (int i = 0; i < 8; ++i) hacc[i] = *reinterpret_cast<const f32x4*>(stsave + (i * 256 + tid0) * 4);
  } else {
#pragma unroll
    for (int i = 0; i < 8; ++i) hacc[i] = f32x4{0.f, 0.f, 0.f, 0.f};
  }
  const int nseg = part == 0 ? 3 : 1;
  for (int seg = 0; seg < nseg; ++seg) {
    bool isctx; int sdir, ci0, ci1, mode;
    if (part == 1) { isctx = false; sdir = dir; ci0 = 32; ci1 = 64; mode = 2; }
    else if (seg == 0) { if (!(dir == 0 && l == 0)) continue; isctx = true; sdir = 1; ci0 = 0; ci1 = 4; mode = 1; }
    else if (seg == 1) { isctx = true; sdir = dir; ci0 = 0; ci1 = 4; mode = (dir == 0 && l == 0) ? 2 : 0; }
    else { isctx = false; sdir = dir; ci0 = 0; ci1 = 32; mode = 1; }
    if (part == 0 && seg <= 1) {
#pragma unroll
      for (int i = 0; i < 8; ++i) hacc[i] = f32x4{0.f, 0.f, 0.f, 0.f};
    }
    __threadfence();
    __syncthreads();
    const float aneg = -expf(p.in[opq(11)][(l * 2 + sdir) * 16 + hd]);
    const float dtb = p.in[opq(12)][(l * 2 + sdir) * 16 + hd];
    const int nch = isctx ? 4 : 64;
    const int rowbase = isctx ? NLAT + b * 256 : b * 4096;
#pragma unroll
    for (int i = 0; i < 8; ++i) asm volatile("" : "+v"(hacc[i]));
    u32x4 rx[2], rbm[4], rcm[4];
    unsigned rawdt = 0u;
    {
      const int tid = tid0, lane = tid & 63, w = tid >> 6;
      const int cL = (sdir ? nch - 1 - ci0 : ci0) * 64;
#pragma unroll
      for (int k = 0; k < 2; ++k) {
        const int id = tid + 256 * k, pch = id >> 6, i = id & 63;
        const int tau = sdir ? cL + 63 - i : cL + i;
        rx[k] = *reinterpret_cast<const u32x4*>(P + (size_t)(rowbase + tau) * IND + C_XBC + hd * 64 + pch * 8);
      }
#pragma unroll
      for (int k = 0; k < 4; ++k) {
        const int id = tid + 256 * k, nc = id >> 6, i = id & 63;
        const int tau = sdir ? cL + 63 - i : cL + i;
        rbm[k] = *reinterpret_cast<const u32x4*>(P + (size_t)(rowbase + tau) * IND + C_BM + g * 128 + nc * 8);
      }
#pragma unroll
      for (int k = 0; k < 4; ++k) {
        const int id = tid + 256 * k, i = id >> 4, nc = id & 15;
        const int tau = sdir ? cL + 63 - i : cL + i;
        rcm[k] = *reinterpret_cast<const u32x4*>(P + (size_t)(rowbase + tau) * IND + C_CM + g * 128 + nc * 8);
      }
      rawdt = P[(size_t)(rowbase + (sdir ? cL + 63 - lane : cL + lane)) * IND + C_DT + sdir * 16 + hd];
    }
    for (int ci = ci0; ci < ci1; ++ci) {
      const int c0 = (sdir ? nch - 1 - ci : ci) * 64;
      int tid = tid0;
      asm volatile("" : "+v"(tid));
      const int lane = tid & 63, w = tid >> 6, fr = lane & 15, fq = lane >> 4;
      __syncthreads();
      if (w == 0) {
        float dt = softplusf(bflo(pin(rawdt)) + dtb);
        const float cs = wave_incl_scan(dt * aneg);
        const float tot = __builtin_bit_cast(float, __builtin_amdgcn_readlane(__builtin_bit_cast(int, cs), 63));
        dts[lane] = dt; acs[lane] = cs; wts[lane] = __expf(tot - cs);
        if (lane == 0) tots[0] = tot;
      }
      pin4(rbm[0]); pin4(rbm[1]); pin4(rbm[2]); pin4(rbm[3]);
#pragma unroll
      for (int k = 0; k < 4; ++k) {
        const int id = tid + 256 * k, nc = id >> 6, i = id & 63;
        *reinterpret_cast<u32x4*>(Bs + i * 136 + nc * 8) = rbm[k];
#pragma unroll
        for (int e = 0; e < 4; ++e) {
          BT[(nc * 8 + 2 * e) * 72 + i] = (u16)(rbm[k][e] & 0xffffu);
          BT[(nc * 8 + 2 * e + 1) * 72 + i] = (u16)(rbm[k][e] >> 16);
        }
      }
#pragma unroll
      for (int k = 0; k < 4; ++k) {
        const int id = tid + 256 * k, i = id >> 4, nc = id & 15;
        *reinterpret_cast<u32x4*>(Cs + i * 136 + nc * 8) = rcm[k];
      }
      __syncthreads();
      pin4(rx[0]); pin4(rx[1]);
#pragma unroll
      for (int k = 0; k < 2; ++k) {
        const int id = tid + 256 * k, pch = id >> 6, i = id & 63;
        const float dt = dts[i], wt = wts[i];
#pragma unroll
        for (int e = 0; e < 4; ++e) {
          float x0 = bflo(rx[k][e]) * dt, x1 = bfhi(rx[k][e]) * dt;
          xT[(pch * 8 + 2 * e) * 72 + i] = f2bf(x0); xT[(pch * 8 + 2 * e + 1) * 72 + i] = f2bf(x1);
          xwT[(pch * 8 + 2 * e) * 72 + i] = f2bf(x0 * wt); xwT[(pch * 8 + 2 * e + 1) * 72 + i] = f2bf(x1 * wt);
        }
      }
      u32x4 tmpv[2] = {u32x4{0u, 0u, 0u, 0u}, u32x4{0u, 0u, 0u, 0u}};
      uint2 zr[4];
#pragma unroll
      for (int e = 0; e < 4; ++e) zr[e] = make_uint2(0u, 0u);
      if (mode == 2) {
        const int qs = (w * 4 + fq) * 16 + (15 - fr);
        const u16* tp = Y + (size_t)(rowbase + c0 + (qs >> 2)) * MIXW + hd * 64 + (qs & 3) * 16;
        tmpv[0] = *reinterpret_cast<const u32x4*>(tp); tmpv[1] = *reinterpret_cast<const u32x4*>(tp + 8);
#pragma unroll
        for (int tt = 0; tt < 4; ++tt) {
          const int t = tt * 16 + fr;
          const size_t row = (size_t)(rowbase + (sdir ? c0 + 63 - t : c0 + t));
          zr[tt] = *reinterpret_cast<const uint2*>(P + row * IND + hd * 64 + w * 16 + fq * 4);
        }
      }
      if (ci + 1 < ci1) {
        const int cL = (sdir ? nch - 2 - ci : ci + 1) * 64;
#pragma unroll
        for (int k = 0; k < 2; ++k) {
          const int id = tid + 256 * k, pch = id >> 6, i = id & 63;
          const int tau = sdir ? cL + 63 - i : cL + i;
          rx[k] = *reinterpret_cast<const u32x4*>(P + (size_t)(rowbase + tau) * IND + C_XBC + hd * 64 + pch * 8);
        }
#pragma unroll
        for (int k = 0; k < 4; ++k) {
          const int id = tid + 256 * k, nc = id >> 6, i = id & 63;
          const int tau = sdir ? cL + 63 - i : cL + i;
          rbm[k] = *reinterpret_cast<const u32x4*>(P + (size_t)(rowbase + tau) * IND + C_BM + g * 128 + nc * 8);
        }
#pragma unroll
        for (int k = 0; k < 4; ++k) {
          const int id = tid + 256 * k, i = id >> 4, nc = id & 15;
          const int tau = sdir ? cL + 63 - i : cL + i;
          rcm[k] = *reinterpret_cast<const u32x4*>(P + (size_t)(rowbase + tau) * IND + C_CM + g * 128 + nc * 8);
        }
        rawdt = P[(size_t)(rowbase + (sdir ? cL + 63 - lane : cL + lane)) * IND + C_DT + sdir * 16 + hd];
      }
      __syncthreads();
      f32x4 gacc[4];
#pragma unroll
      for (int i = 0; i < 4; ++i) gacc[i] = f32x4{0.f, 0.f, 0.f, 0.f};
#pragma unroll
      for (int kk = 0; kk < 4; ++kk) {
        bf16x8 a = ld8(Bs + (w * 16 + fr) * 136 + kk * 32 + fq * 8);
#pragma unroll
        for (int tb = 0; tb < 4; ++tb) {
          bf16x8 bb = ld8(Cs + (tb * 16 + fr) * 136 + kk * 32 + fq * 8);
          gacc[tb] = mfma16(a, bb, gacc[tb]);
        }
      }
      asm volatile("" : "+v"(tmpv[0]), "+v"(tmpv[1]));
      __syncthreads();
#pragma unroll
      for (int tb = 0; tb < 4; ++tb) {
        const int t = tb * 16 + fr;
        const float at = acs[t];
        float mv[4];
#pragma unroll
        for (int j = 0; j < 4; ++j) {
          const int s = w * 16 + fq * 4 + j;
          mv[j] = (s <= t) ? gacc[tb][j] * __expf(at - acs[s]) : 0.f;
        }
        uint2 o; o.x = pack2(mv[0], mv[1]); o.y = pack2(mv[2], mv[3]);
        *reinterpret_cast<uint2*>(Ms + t * 72 + w * 16 + fq * 4) = o;
      }
      __syncthreads();
      f32x4 yd[4], yo[4];
#pragma unroll
      for (int i = 0; i < 4; ++i) { yd[i] = f32x4{0.f, 0.f, 0.f, 0.f}; yo[i] = f32x4{0.f, 0.f, 0.f, 0.f}; }
#pragma unroll
      for (int kk = 0; kk < 2; ++kk) {
        bf16x8 bb = ld8(xT + (w * 16 + fr) * 72 + kk * 32 + fq * 8);
#pragma unroll
        for (int tt = 0; tt < 4; ++tt) {
          bf16x8 a = ld8(Ms + (tt * 16 + fr) * 72 + kk * 32 + fq * 8);
          yd[tt] = mfma16(bb, a, yd[tt]);
        }
      }
#pragma unroll
      for (int kk = 0; kk < 4; ++kk) {
        bf16x8 hb = packacc(hacc[2 * kk], hacc[2 * kk + 1]);
#pragma unroll
        for (int tt = 0; tt < 4; ++tt) {
          const u16* cr = Cs + (tt * 16 + fr) * 136 + fq * 4;
          bf16x8 a = ld44(cr + (2 * kk) * 16, cr + (2 * kk + 1) * 16);
          yo[tt] = mfma16(hb, a, yo[tt]);
        }
      }
      const float etot = __expf(tots[0]);
#pragma unroll
      for (int nb = 0; nb < 8; ++nb) { hacc[nb][0] *= etot; hacc[nb][1] *= etot; hacc[nb][2] *= etot; hacc[nb][3] *= etot; }
#pragma unroll
      for (int kk = 0; kk < 2; ++kk) {
        bf16x8 bb = ld8(xwT + (w * 16 + fr) * 72 + kk * 32 + fq * 8);
#pragma unroll
        for (int nb = 0; nb < 8; ++nb) {
          bf16x8 a = ld8(BT + (nb * 16 + fr) * 72 + kk * 32 + fq * 8);
          hacc[nb] = mfma16(a, bb, hacc[nb]);
        }
      }
      if (mode != 0) {
        float ea[4];
#pragma unroll
        for (int tt = 0; tt < 4; ++tt) ea[tt] = __expf(acs[tt * 16 + fr]);
        if (mode == 1) {
          u32x4 o0, o1;
#pragma unroll
          for (int tt = 0; tt < 4; ++tt) {
            float v[4];
#pragma unroll
            for (int j = 0; j < 4; ++j) v[j] = yd[tt][j] + ea[tt] * yo[tt][j];
            const unsigned a2 = pack2(v[0], v[1]), b2 = pack2(v[2], v[3]);
            if (tt == 0) { o0[0] = a2; o0[1] = b2; } else if (tt == 1) { o0[2] = a2; o0[3] = b2; }
            else if (tt == 2) { o1[0] = a2; o1[1] = b2; } else { o1[2] = a2; o1[3] = b2; }
          }
          const int qs = (w * 4 + fq) * 16 + fr;
          u16* tp = Y + (size_t)(rowbase + c0 + (qs >> 2)) * MIXW + hd * 64 + (qs & 3) * 16;
          *reinterpret_cast<u32x4*>(tp) = o0; *reinterpret_cast<u32x4*>(tp + 8) = o1;
        } else {
          float xsv[16], rdt[4], val[16];
#pragma unroll
          for (int tt = 0; tt < 4; ++tt) {
            rdt[tt] = rcpf(dts[tt * 16 + fr]);
#pragma unroll
            for (int j = 0; j < 4; ++j) xsv[tt * 4 + j] = bf2f(xT[(w * 16 + fq * 4 + j) * 72 + tt * 16 + fr]);
          }
          float sq[4];
#pragma unroll
          for (int tt = 0; tt < 4; ++tt) {
            const int t = tt * 16 + fr;
            const uint2 zw = zr[tt];
            const unsigned z01 = pin(zw.x), z23 = pin(zw.y);
            const float zz[4] = {bflo(z01), bfhi(z01), bflo(z23), bfhi(z23)};
            const int et = 3 - tt;
            const unsigned p01 = tmpv[et >> 1][(et & 1) * 2], p23 = tmpv[et >> 1][(et & 1) * 2 + 1];
            const float yf[4] = {bflo(p01), bfhi(p01), bflo(p23), bfhi(p23)};
            float s2 = 0.f;
#pragma unroll
            for (int j = 0; j < 4; ++j) {
              const float yv = yd[tt][j] + ea[tt] * yo[tt][j];
              const float vv = (yf[j] + yv + Dsk * xsv[tt * 4 + j] * rdt[tt]) * siluf(zz[j]);
              val[tt * 4 + j] = vv; s2 += vv * vv;
            }
            sq[tt] = s2;
            uint2 o; o.x = pack2(val[tt * 4], val[tt * 4 + 1]); o.y = pack2(val[tt * 4 + 2], val[tt * 4 + 3]);
            const int c = w * 2 + (fq >> 1);
            *reinterpret_cast<uint2*>(ystg + t * 64 + ((c ^ ((t >> 2) & 7)) << 3) + (fq & 1) * 4) = o;
          }
#pragma unroll
          for (int tt = 0; tt < 4; ++tt) {
            sq[tt] += __shfl_xor(sq[tt], 16); sq[tt] += __shfl_xor(sq[tt], 32);
          }
          if (fq == 0) {
#pragma unroll
            for (int tt = 0; tt < 4; ++tt) ssql[w * 64 + tt * 16 + fr] = sq[tt];
          }
          __syncthreads();
#pragma unroll
          for (int k = 0; k < 2; ++k) {
            const int id = tid + 256 * k, t = id >> 3, c = id & 7;
            const u32x4 v = *reinterpret_cast<const u32x4*>(ystg + t * 64 + ((c ^ ((t >> 2) & 7)) << 3));
            const size_t row = (size_t)(rowbase + (sdir ? c0 + 63 - t : c0 + t));
            *reinterpret_cast<u32x4*>(Y + row * MIXW + hd * 64 + c * 8) = v;
          }
          if (tid < 64) {
            const size_t row = (size_t)(rowbase + (sdir ? c0 + 63 - tid : c0 + tid));
            ssq[row * 16 + hd] = ssql[tid] + ssql[64 + tid] + ssql[128 + tid] + ssql[192 + tid];
          }
        }
      }
    }
  }
  if (part == 0) {
#pragma unroll
    for (int i = 0; i < 8; ++i) *reinterpret_cast<f32x4*>(stsave + (i * 256 + tid0) * 4) = hacc[i];
  }
}

__device__ void gla_item(const Params& p, int l, int part, int item, unsigned char* smem) {
  u16* qe = (u16*)smem;
  u16* ke = (u16*)(smem + 9216);
  u16* kdT = (u16*)(smem + 18432);
  u16* vT = (u16*)(smem + 27648);
  u16* at = (u16*)(smem + 46080);
  float* gl = (float*)(smem + 55296);
  float* red = (float*)(smem + 71936);
  const int tid0 = opaque_tid();
  const int b = item >> 3, h = (item >> 1) & 3, dir = item & 1;
  u16* P = (u16*)(p.ws + WS_P);
  u16* Y = (u16*)(p.ws + WS_Y);
  float* stsave = (float*)(p.ws + WS_WIN) + (size_t)(256 + item) * 8192;
  f32x4 sacc[4][2];
  if (part == 1) {
#pragma unroll
    for (int i = 0; i < 8; ++i) sacc[i >> 1][i & 1] = *reinterpret_cast<const f32x4*>(stsave + (i * 256 + tid0) * 4);
  } else {
#pragma unroll
    for (int i = 0; i < 8; ++i) sacc[i >> 1][i & 1] = f32x4{0.f, 0.f, 0.f, 0.f};
  }
  const int nseg = part == 0 ? 3 : 1;
  for (int seg = 0; seg < nseg; ++seg) {
    bool isctx; int sdir, ci0, ci1, mode;
    if (part == 1) { isctx = false; sdir = dir; ci0 = 32; ci1 = 64; mode = 2; }
    else if (seg == 0) { if (!(dir == 0 && l == 0)) continue; isctx = true; sdir = 1; ci0 = 0; ci1 = 4; mode = 1; }
    else if (seg == 1) { isctx = true; sdir = dir; ci0 = 0; ci1 = 4; mode = (dir == 0 && l == 0) ? 2 : 0; }
    else { isctx = false; sdir = dir; ci0 = 0; ci1 = 32; mode = 1; }
    if (part == 0 && seg <= 1) {
#pragma unroll
      for (int i = 0; i < 8; ++i) sacc[i >> 1][i & 1] = f32x4{0.f, 0.f, 0.f, 0.f};
    }
    __threadfence();
    __syncthreads();
    const int nch = isctx ? 4 : 64;
    const int rowbase = isctx ? NLAT + b * 256 : b * 4096;
#pragma unroll
    for (int i = 0; i < 8; ++i) asm volatile("" : "+v"(sacc[i >> 1][i & 1]));
    u32x4 rq[2], rk[2], rv[4], rlr;
    bf16x8 Bw;
    float bl;
    {
      const int tid = tid0;
      const int dcol = h * 64 + 32 * ((tid >> 6) & 1) + (tid & 31), kb = 8 * ((tid & 63) >> 5);
      const float* wlp = p.in[opq(15)] + ((size_t)((l * 2 + sdir) * 16 + kb)) * 256 + dcol;
      u32x4 bw;
#pragma unroll
      for (int e = 0; e < 4; ++e) bw[e] = pack2(wlp[(2 * e) * 256], wlp[(2 * e + 1) * 256]);
      Bw = __builtin_bit_cast(bf16x8, bw);
      bl = p.in[opq(16)][(l * 2 + sdir) * 256 + dcol];
      asm volatile("" : "+v"(Bw), "+v"(bl));
      const int cL = (sdir ? nch - 1 - ci0 : ci0) * 64;
#pragma unroll
      for (int k = 0; k < 2; ++k) {
        const int id = tid + 256 * k, i = id >> 3, dc = id & 7;
        const int tau = sdir ? cL + 63 - i : cL + i;
        rq[k] = *reinterpret_cast<const u32x4*>(P + (size_t)(rowbase + tau) * IND + C_Q + h * 64 + dc * 8);
      }
#pragma unroll
      for (int k = 0; k < 2; ++k) {
        const int id = tid + 256 * k, dc = id >> 6, i = id & 63;
        const int tau = sdir ? cL + 63 - i : cL + i;
        rk[k] = *reinterpret_cast<const u32x4*>(P + (size_t)(rowbase + tau) * IND + C_K + h * 64 + dc * 8);
      }
#pragma unroll
      for (int k = 0; k < 4; ++k) {
        const int id = tid + 256 * k, ec = id >> 6, i = id & 63;
        const int tau = sdir ? cL + 63 - i : cL + i;
        rv[k] = *reinterpret_cast<const u32x4*>(P + (size_t)(rowbase + tau) * IND + C_V + h * 128 + ec * 8);
      }
      {
        const int i = 32 * (tid >> 7) + (tid & 31), hf = (tid & 63) >> 5;
        const int tau = sdir ? cL + 63 - i : cL + i;
        rlr = *reinterpret_cast<const u32x4*>(P + (size_t)(rowbase + tau) * IND + C_LR + sdir * 16 + hf * 8);
      }
    }
    for (int ci = ci0; ci < ci1; ++ci) {
      const int c0 = (sdir ? nch - 1 - ci : ci) * 64;
      int tid = tid0;
      asm volatile("" : "+v"(tid));
      const int lane = tid & 63, w = tid >> 6, fr = lane & 15, fq = lane >> 4, d = tid & 63, iq = tid >> 6;
      __syncthreads();
      pin4(rlr);
      {
        const int th = w >> 1, dh = w & 1;
        f32x16 z;
#pragma unroll
        for (int r = 0; r < 16; ++r) z[r] = 0.f;
        const f32x16 lg = mfma32(__builtin_bit_cast(bf16x8, rlr), Bw, z);
#pragma unroll
        for (int r = 0; r < 16; ++r) {
          const int t = 32 * th + (r & 3) + 8 * (r >> 2) + 4 * (lane >> 5);
          gl[t * 65 + 32 * dh + (lane & 31)] = logsigf(lg[r] + bl) * (1.f / 16.f);
        }
      }
      __syncthreads();
      {
        float vals[16];
#pragma unroll
        for (int ii = 0; ii < 16; ++ii) vals[ii] = gl[(iq * 16 + ii) * 65 + d];
        float run = 0.f;
#pragma unroll
        for (int ii = 0; ii < 16; ++ii) { run += vals[ii]; gl[(iq * 16 + ii) * 65 + d] = run; }
        red[iq * 64 + d] = run;
      }
      __syncthreads();
      {
        float off = 0.f;
        for (int q = 0; q < iq; ++q) off += red[q * 64 + d];
        if (iq > 0) {
#pragma unroll 4
          for (int ii = 0; ii < 16; ++ii) gl[(iq * 16 + ii) * 65 + d] += off;
        }
      }
      __syncthreads();
      pin4(rq[0]); pin4(rq[1]); pin4(rk[0]); pin4(rk[1]); pin4(rv[0]); pin4(rv[1]); pin4(rv[2]); pin4(rv[3]);
#pragma unroll
      for (int k = 0; k < 2; ++k) {
        const int id = tid + 256 * k, i = id >> 3, dc = id & 7;
        u32x4 oo;
#pragma unroll
        for (int e = 0; e < 4; ++e) {
          float b0 = gl[i * 65 + dc * 8 + 2 * e], b1 = gl[i * 65 + dc * 8 + 2 * e + 1];
          oo[e] = pack2(bflo(rq[k][e]) * 0.125f * __expf(b0), bfhi(rq[k][e]) * 0.125f * __expf(b1));
        }
        *reinterpret_cast<u32x4*>(qe + i * 72 + dc * 8) = oo;
      }
#pragma unroll
      for (int k = 0; k < 2; ++k) {
        const int id = tid + 256 * k, dc = id >> 6, i = id & 63;
        u32x4 oo;
#pragma unroll
        for (int e = 0; e < 4; ++e) {
          const int d0 = dc * 8 + 2 * e;
          float b0 = gl[i * 65 + d0], b1 = gl[i * 65 + d0 + 1];
          float l0 = gl[63 * 65 + d0], l1 = gl[63 * 65 + d0 + 1];
          float k0 = bflo(rk[k][e]), k1 = bfhi(rk[k][e]);
          oo[e] = pack2(k0 * __expf(-b0), k1 * __expf(-b1));
          kdT[d0 * 72 + i] = f2bf(k0 * __expf(l0 - b0));
          kdT[(d0 + 1) * 72 + i] = f2bf(k1 * __expf(l1 - b1));
        }
        *reinterpret_cast<u32x4*>(ke + i * 72 + dc * 8) = oo;
      }
#pragma unroll
      for (int k = 0; k < 4; ++k) {
        const int id = tid + 256 * k, ec = id >> 6, i = id & 63;
#pragma unroll
        for (int e = 0; e < 4; ++e) {
          vT[(ec * 8 + 2 * e) * 72 + i] = (u16)(rv[k][e] & 0xffffu);
          vT[(ec * 8 + 2 * e + 1) * 72 + i] = (u16)(rv[k][e] >> 16);
        }
      }
      u32x4 tmpv[4];
      unsigned ggr[16];
#pragma unroll
      for (int e = 0; e < 4; ++e) tmpv[e] = u32x4{0u, 0u, 0u, 0u};
#pragma unroll
      for (int e = 0; e < 16; ++e) ggr[e] = 0u;
      if (mode == 2) {
        const int qs = (w * 4 + (3 - fq)) * 16 + fr;
        const u16* tp = Y + (size_t)(rowbase + c0 + (qs >> 2)) * MIXW + 1024 + h * 128 + (qs & 3) * 32;
#pragma unroll
        for (int e = 0; e < 4; ++e) tmpv[e] = *reinterpret_cast<const u32x4*>(tp + e * 8);
#pragma unroll
        for (int tt = 0; tt < 4; ++tt)
#pragma unroll
          for (int j = 0; j < 4; ++j) {
            const int t = tt * 16 + fq * 4 + j;
            const size_t row = (size_t)(rowbase + (sdir ? c0 + 63 - t : c0 + t));
            ggr[tt * 4 + j] = *reinterpret_cast<const unsigned*>(P + row * IND + C_GG + h * 128 + w * 32 + 2 * fr);
          }
      }
      if (ci + 1 < ci1) {
        const int cL = (sdir ? nch - 2 - ci : ci + 1) * 64;
#pragma unroll
        for (int k = 0; k < 2; ++k) {
          const int id = tid + 256 * k, i = id >> 3, dc = id & 7;
          const int tau = sdir ? cL + 63 - i : cL + i;
          rq[k] = *reinterpret_cast<const u32x4*>(P + (size_t)(rowbase + tau) * IND + C_Q + h * 64 + dc * 8);
        }
#pragma unroll
        for (int k = 0; k < 2; ++k) {
          const int id = tid + 256 * k, dc = id >> 6, i = id & 63;
          const int tau = sdir ? cL + 63 - i : cL + i;
          rk[k] = *reinterpret_cast<const u32x4*>(P + (size_t)(rowbase + tau) * IND + C_K + h * 64 + dc * 8);
        }
#pragma unroll
        for (int k = 0; k < 4; ++k) {
          const int id = tid + 256 * k, ec = id >> 6, i = id & 63;
          const int tau = sdir ? cL + 63 - i : cL + i;
          rv[k] = *reinterpret_cast<const u32x4*>(P + (size_t)(rowbase + tau) * IND + C_V + h * 128 + ec * 8);
        }
        {
          const int i = 32 * (tid >> 7) + (tid & 31), hf = (tid & 63) >> 5;
          const int tau = sdir ? cL + 63 - i : cL + i;
          rlr = *reinterpret_cast<const u32x4*>(P + (size_t)(rowbase + tau) * IND + C_LR + sdir * 16 + hf * 8);
        }
      }
      __syncthreads();
      {
        f32x4 aacc[4];
#pragma unroll
        for (int i = 0; i < 4; ++i) aacc[i] = f32x4{0.f, 0.f, 0.f, 0.f};
#pragma unroll
        for (int kk = 0; kk < 2; ++kk) {
          bf16x8 a = ld8(ke + (w * 16 + fr) * 72 + kk * 32 + fq * 8);
#pragma unroll
          for (int tb = 0; tb < 4; ++tb) {
            bf16x8 bb = ld8(qe + (tb * 16 + fr) * 72 + kk * 32 + fq * 8);
            aacc[tb] = mfma16(a, bb, aacc[tb]);
          }
        }
#pragma unroll
        for (int tb = 0; tb < 4; ++tb) {
          const int t = tb * 16 + fr;
          float mv[4];
#pragma unroll
          for (int j = 0; j < 4; ++j) { const int s = w * 16 + fq * 4 + j; mv[j] = (s <= t) ? aacc[tb][j] : 0.f; }
          uint2 o; o.x = pack2(mv[0], mv[1]); o.y = pack2(mv[2], mv[3]);
          *reinterpret_cast<uint2*>(at + t * 72 + w * 16 + fq * 4) = o;
        }
      }
      __syncthreads();
      f32x4 oacc[4][2];
#pragma unroll
      for (int i = 0; i < 4; ++i) { oacc[i][0] = f32x4{0.f, 0.f, 0.f, 0.f}; oacc[i][1] = f32x4{0.f, 0.f, 0.f, 0.f}; }
#pragma unroll
      for (int kk = 0; kk < 2; ++kk) {
        bf16x8 b0 = ld8(vT + (w * 32 + 2 * fr) * 72 + kk * 32 + fq * 8);
        bf16x8 b1 = ld8(vT + (w * 32 + 2 * fr + 1) * 72 + kk * 32 + fq * 8);
#pragma unroll
        for (int tt = 0; tt < 4; ++tt) {
          bf16x8 a = ld8(at + (tt * 16 + fr) * 72 + kk * 32 + fq * 8);
          oacc[tt][0] = mfma16(a, b0, oacc[tt][0]);
          oacc[tt][1] = mfma16(a, b1, oacc[tt][1]);
        }
      }
#pragma unroll
      for (int kk = 0; kk < 2; ++kk) {
        bf16x8 s0 = packacc(sacc[2 * kk][0], sacc[2 * kk + 1][0]);
        bf16x8 s1 = packacc(sacc[2 * kk][1], sacc[2 * kk + 1][1]);
#pragma unroll
        for (int tt = 0; tt < 4; ++tt) {
          const u16* qr = qe + (tt * 16 + fr) * 72 + fq * 4;
          bf16x8 a = ld44(qr + (2 * kk) * 16, qr + (2 * kk + 1) * 16);
          oacc[tt][0] = mfma16(a, s0, oacc[tt][0]);
          oacc[tt][1] = mfma16(a, s1, oacc[tt][1]);
        }
      }
#pragma unroll
      for (int db = 0; db < 4; ++db)
#pragma unroll
        for (int j = 0; j < 4; ++j) {
          const float sc = __expf(gl[63 * 65 + db * 16 + fq * 4 + j]);
          sacc[db][0][j] *= sc; sacc[db][1][j] *= sc;
        }
#pragma unroll
      for (int kk = 0; kk < 2; ++kk) {
        bf16x8 b0 = ld8(vT + (w * 32 + 2 * fr) * 72 + kk * 32 + fq * 8);
        bf16x8 b1 = ld8(vT + (w * 32 + 2 * fr + 1) * 72 + kk * 32 + fq * 8);
#pragma unroll
        for (int db = 0; db < 4; ++db) {
          bf16x8 a = ld8(kdT + (db * 16 + fr) * 72 + kk * 32 + fq * 8);
          sacc[db][0] = mfma16(a, b0, sacc[db][0]);
          sacc[db][1] = mfma16(a, b1, sacc[db][1]);
        }
      }
      pin4(tmpv[0]); pin4(tmpv[1]); pin4(tmpv[2]); pin4(tmpv[3]);
      if (mode != 0) {
        const int ycol = 1024 + h * 128 + w * 32 + 2 * fr;
        if (mode == 1) {
          const int qs = (w * 4 + fq) * 16 + fr;
          u16* tp = Y + (size_t)(rowbase + c0 + (qs >> 2)) * MIXW + 1024 + h * 128 + (qs & 3) * 32;
#pragma unroll
          for (int tt = 0; tt < 4; ++tt) {
            u32x4 o;
#pragma unroll
            for (int j = 0; j < 4; ++j) o[j] = pack2(oacc[tt][0][j], oacc[tt][1][j]);
            *reinterpret_cast<u32x4*>(tp + tt * 8) = o;
          }
        } else {
#pragma unroll
          for (int tt = 0; tt < 4; ++tt)
#pragma unroll
            for (int j = 0; j < 4; ++j) {
              const int t = tt * 16 + fq * 4 + j;
              const int e = 15 - (tt * 4 + j);
              const unsigned pw = tmpv[e >> 2][e & 3];
              float o0 = oacc[tt][0][j] + bflo(pw);
              float o1 = oacc[tt][1][j] + bfhi(pw);
              oacc[tt][0][j] = o0; oacc[tt][1][j] = o1;
              const float sq = row16_sum(o0 * o0 + o1 * o1);
              if (fr == 0) red[w * 64 + t] = sq;
            }
          __syncthreads();
          const float* nwv = p.in[opq(17)] + l * 128;
          const float nw0 = nwv[w * 32 + 2 * fr], nw1 = nwv[w * 32 + 2 * fr + 1];
#pragma unroll
          for (int tt = 0; tt < 4; ++tt)
#pragma unroll
            for (int j = 0; j < 4; ++j) {
              const int t = tt * 16 + fq * 4 + j;
              const size_t row = (size_t)(rowbase + (sdir ? c0 + 63 - t : c0 + t));
              const float tot = red[t] + red[64 + t] + red[128 + t] + red[192 + t];
              const float rs = rsqrtf(tot * (1.f / 128.f) + EPSF);
              const unsigned gw = pin(ggr[tt * 4 + j]);
              const float g0 = bflo(gw), g1 = bfhi(gw);
              *reinterpret_cast<unsigned*>(Y + row * MIXW + ycol) =
                  pack2(oacc[tt][0][j] * rs * nw0 * siluf(g0), oacc[tt][1][j] * rs * nw1 * siluf(g1));
            }
        }
      }
    }
  }
  if (part == 0) {
#pragma unroll
    for (int i = 0; i < 8; ++i) *reinterpret_cast<f32x4*>(stsave + (i * 256 + tid0) * 4) = sacc[i >> 1][i & 1];
  }
}

__device__ void s5_item(const Params& p, int l, int part, int blk, unsigned char* smem) {
  const int tid = opaque_tid(), lane = tid & 63, w = tid >> 6, fr = lane & 15, fq = lane >> 4;
  const int wi = blk * 4 + w;
  const int b = wi >> 6, g = (wi >> 1) & 31, dir = wi & 1;
  u16* hb = (u16*)smem + w * (32 * 136);
  u16* ust = (u16*)(smem + 4 * 32 * 136 * 2) + w * (32 * 16);
  u16* P = (u16*)(p.ws + WS_P);
  u16* Y = (u16*)(p.ws + WS_Y);
  u16* G5C = (u16*)(p.ws + WS_G5C);
  float* stsave = (float*)(p.ws + WS_S5ST) + (size_t)wi * 128;
  const float dsk = p.in[opq(25)][l * 512 + g * 16 + fr];
  float hre = 0.f, him = 0.f;
  if (part == 1) { hre = stsave[lane * 2]; him = stsave[lane * 2 + 1]; }
  const int nseg = part == 0 ? 3 : 1;
  for (int seg = 0; seg < nseg; ++seg) {
    bool isctx; int sdir, ti0, ti1, mode;
    if (part == 1) { isctx = false; sdir = dir; ti0 = 64; ti1 = 128; mode = 2; }
    else if (seg == 0) { if (!(dir == 0 && l == 0)) continue; isctx = true; sdir = 1; ti0 = 0; ti1 = 8; mode = 1; }
    else if (seg == 1) { isctx = true; sdir = dir; ti0 = 0; ti1 = 8; mode = (dir == 0 && l == 0) ? 2 : 0; }
    else { isctx = false; sdir = dir; ti0 = 0; ti1 = 64; mode = 1; }
    if (part == 0 && seg <= 1) { hre = 0.f; him = 0.f; }
    __threadfence();
    const unsigned char* cbase = p.ws + WS_S5C + (size_t)((l * 2 + sdir) * 32 + g) * 8704;
    const u16* BbarM = (const u16*)cbase;
    const u16* CmT = (const u16*)(cbase + 4096);
    const float* lamb = (const float*)(cbase + 8192);
    bf16x8 Bf[4], Cf[4];
#pragma unroll
    for (int cb = 0; cb < 4; ++cb) Bf[cb] = ld8(BbarM + (cb * 32 + (lane & 31)) * 16 + 8 * (lane >> 5));
#pragma unroll
    for (int kk = 0; kk < 4; ++kk) Cf[kk] = ld8(CmT + fr * 128 + kk * 32 + fq * 8);
    float lre = lamb[2 * lane], lim = lamb[2 * lane + 1];
#pragma unroll
    for (int i = 0; i < 4; ++i) asm volatile("" : "+v"(Bf[i]), "+v"(Cf[i]));
    asm volatile("" : "+v"(lre), "+v"(lim), "+v"(hre), "+v"(him));
    const int nt = isctx ? 8 : 128;
    const int rowbase = isctx ? NLAT + b * 256 : b * 4096;
    bf16x8 anext;
    {
      const int c0 = (sdir ? nt - 1 - ti0 : ti0) * 32, i = lane & 31;
      anext = ld8(P + (size_t)(rowbase + (sdir ? c0 + 31 - i : c0 + i)) * IND + C_U5 + g * 16 + 8 * (lane >> 5));
    }
    for (int ti = ti0; ti < ti1; ++ti) {
      const int c0 = (sdir ? nt - 1 - ti : ti) * 32;
      const bf16x8 a = anext;
      if (ti + 1 < ti1) {
        const int c1 = (sdir ? nt - 2 - ti : ti + 1) * 32, i = lane & 31;
        anext = ld8(P + (size_t)(rowbase + (sdir ? c1 + 31 - i : c1 + i)) * IND + C_U5 + g * 16 + 8 * (lane >> 5));
      }
      u32x4 tmpv = u32x4{0u, 0u, 0u, 0u};
      if (mode == 2) {
        const int qs = (3 - fq) * 16 + fr;
        tmpv = *reinterpret_cast<const u32x4*>(Y + (size_t)(rowbase + c0 + (qs >> 1)) * MIXW + 1536 + g * 16 + (qs & 1) * 8);
      }
      wave_lds_sync();
      if (mode == 2) *reinterpret_cast<bf16x8*>(ust + (lane & 31) * 16 + 8 * (lane >> 5)) = a;
#pragma unroll
      for (int cb = 0; cb < 4; ++cb) {
        f32x16 z;
#pragma unroll
        for (int r = 0; r < 16; ++r) z[r] = 0.f;
        f32x16 acc = mfma32(a, Bf[cb], z);
#pragma unroll
        for (int r = 0; r < 16; ++r) {
          const int ii = (r & 3) + 8 * (r >> 2) + 4 * (lane >> 5);
          hb[ii * 136 + cb * 32 + (lane & 31)] = f2bf(acc[r]);
        }
      }
      wave_lds_sync();
      {
        unsigned buv[32];
#pragma unroll
        for (int i = 0; i < 32; ++i) buv[i] = *reinterpret_cast<const unsigned*>(hb + i * 136 + 2 * lane);
#pragma unroll
        for (int i = 0; i < 32; ++i) {
          const float nre = lre * hre - lim * him + bflo(buv[i]);
          const float nim = lre * him + lim * hre + bfhi(buv[i]);
          hre = nre; him = nim;
          *reinterpret_cast<unsigned*>(hb + i * 136 + 2 * lane) = pack2(hre, him);
        }
      }
      wave_lds_sync();
      f32x4 ya[2];
      ya[0] = f32x4{0.f, 0.f, 0.f, 0.f}; ya[1] = f32x4{0.f, 0.f, 0.f, 0.f};
#pragma unroll
      for (int kk = 0; kk < 4; ++kk) {
        bf16x8 a0 = ld8(hb + fr * 136 + kk * 32 + fq * 8);
        bf16x8 a1 = ld8(hb + (16 + fr) * 136 + kk * 32 + fq * 8);
        ya[0] = mfma16(a0, Cf[kk], ya[0]);
        ya[1] = mfma16(a1, Cf[kk], ya[1]);
      }
      pin4(tmpv);
      if (mode == 1) {
        u32x4 o;
        o[0] = pack2(ya[0][0], ya[0][1]); o[1] = pack2(ya[0][2], ya[0][3]); o[2] = pack2(ya[1][0], ya[1][1]); o[3] = pack2(ya[1][2], ya[1][3]);
        const int qs = fq * 16 + fr;
        *reinterpret_cast<u32x4*>(Y + (size_t)(rowbase + c0 + (qs >> 1)) * MIXW + 1536 + g * 16 + (qs & 1) * 8) = o;
      } else if (mode == 2) {
#pragma unroll
        for (int rt = 0; rt < 2; ++rt)
#pragma unroll
          for (int j = 0; j < 4; ++j) {
            const int i = rt * 16 + fq * 4 + j;
            const int tau = sdir ? c0 + 31 - i : c0 + i;
            const size_t row = (size_t)(rowbase + tau);
            const int e = 7 - (rt * 4 + j);
            const unsigned pw = tmpv[e >> 1];
            const float yf = (e & 1) ? bfhi(pw) : bflo(pw);
            const float u = bf2f(ust[i * 16 + fr]);
            const float x = yf + ya[rt][j] + dsk * u;
            const float th = 1.f - 2.f * rcpf(1.f + __expf(2.f * 0.7978845608028654f * (x + 0.044715f * x * x * x)));
            const float ge = 0.5f * x * (1.f + th);
            if (isctx) G5C[(row - NLAT) * 512 + g * 16 + fr] = f2bf(ge);
            else P[row * IND + C_U5 + g * 16 + fr] = f2bf(ge);
          }
      }
    }
  }
  if (part == 0) { stsave[lane * 2] = hre; stsave[lane * 2 + 1] = him; }
}

__device__ void ssd_norm_rows(const Params& p, int nrows) {
  const int tid = opaque_tid();
  const float* ssq = (const float*)(p.ws + WS_SSQ);
  float* rsb = (float*)(p.ws + WS_RS);
  for (int i = blockIdx.x * 256 + tid; i < nrows * 2; i += gridDim.x * 256) {
    const float* sp = ssq + (size_t)i * 8;
    const float sum = sp[0] + sp[1] + sp[2] + sp[3] + sp[4] + sp[5] + sp[6] + sp[7];
    rsb[i] = rsqrtf(sum * (1.f / 512.f) + EPSF);
  }
}

__device__ void phase_final(const Params& p) {
  const int tid = opaque_tid(), lane = tid & 63, w = tid >> 6;
  const float* nw = p.in[opq(28)];
  for (int r = blockIdx.x * 4 + w; r < NLAT; r += gridDim.x * 4) {
    float* src = p.out + (size_t)r * 1024;
    float4 v[4]; float ss = 0.f;
#pragma unroll
    for (int q = 0; q < 4; ++q) {
      v[q] = *reinterpret_cast<const float4*>(src + lane * 4 + q * 256);
      ss += v[q].x * v[q].x + v[q].y * v[q].y + v[q].z * v[q].z + v[q].w * v[q].w;
    }
#pragma unroll
    for (int o = 32; o > 0; o >>= 1) ss += __shfl_xor(ss, o);
    const float rs = rsqrtf(ss * (1.f / 1024.f) + EPSF);
#pragma unroll
    for (int q = 0; q < 4; ++q) {
      const int col = lane * 4 + q * 256;
      float4 n4 = *reinterpret_cast<const float4*>(nw + col);
      float4 o = make_float4(v[q].x * rs * n4.x, v[q].y * rs * n4.y, v[q].z * rs * n4.z, v[q].w * rs * n4.w);
      *reinterpret_cast<float4*>(src + col) = o;
    }
  }
}


#define XB_TMO      128
#define XB_XCNT(j)  (256  + 64 * (j))
#define XB_XSUB(j)  (1280 + 64 * (j))
#define XB_XGEN(j)  (2304 + 64 * (j))
#define XB_TOP      3328
#define XB_TOPGEN   3392
#define XCD_BAR_WORDS 3456
#define XB_SPIN_CAP (1u << 20)
DI unsigned xb_ld(unsigned* p) { return __hip_atomic_load(p, __ATOMIC_RELAXED, __HIP_MEMORY_SCOPE_AGENT); }
DI unsigned xb_add(unsigned* p, unsigned v) { return __hip_atomic_fetch_add(p, v, __ATOMIC_RELAXED, __HIP_MEMORY_SCOPE_AGENT); }
DI unsigned xb_xcc_id() { return (unsigned)__builtin_amdgcn_s_getreg((3 << 11) | 20) & 0xFu; }
#define XB_SPIN(cond, bar) do { unsigned _sp = 0; while (cond) { __builtin_amdgcn_s_sleep(1); \
    if ((++_sp & 255u) == 0u) { if (xb_ld(&(bar)[XB_TMO])) break; if (_sp > XB_SPIN_CAP) { atomicAdd(&(bar)[XB_TMO], 1u); break; } } } } while (0)
struct XcdBarrier { unsigned* bar; unsigned x, nloc, nx; };
DI XcdBarrier xcd_barrier_post(unsigned* bar) {
  XcdBarrier b; b.bar = bar; b.x = xb_xcc_id(); b.nloc = 0u; b.nx = 0u;
  if (threadIdx.x == 0) (void)xb_add(&bar[XB_XCNT(b.x)], 1u);
  return b;
}
DI void xcd_barrier_complete(unsigned* bar, unsigned x, unsigned& nloc, unsigned& nx) {
  const unsigned G = gridDim.x;
  unsigned sum, cnt, mine, sp = 0u;
  for (;;) {
    sum = 0u; cnt = 0u; mine = 0u;
#pragma unroll
    for (unsigned j = 0; j < 16; ++j) { const unsigned c = xb_ld(&bar[XB_XCNT(j)]); sum += c; cnt += (c > 0u) ? 1u : 0u; mine = (j == x) ? c : mine; }
    if (sum == G) break;
    __builtin_amdgcn_s_sleep(1);
    if ((++sp & 255u) == 0u) { if (xb_ld(&bar[XB_TMO])) break; if (sp > XB_SPIN_CAP) { atomicAdd(&bar[XB_TMO], 1u); break; } }
  }
  nloc = mine > 0u ? mine : 1u; nx = cnt > 0u ? cnt : 1u;
}
DI void xcd_barrier(XcdBarrier& b) {
  asm volatile("s_waitcnt vmcnt(0)" ::: "memory");
  __syncthreads();
  if (threadIdx.x == 0) {
    unsigned* bar = b.bar;
    __builtin_amdgcn_s_waitcnt(0);
    if (b.nloc == 0u) xcd_barrier_complete(bar, b.x, b.nloc, b.nx);
    const unsigned nloc = b.nloc, nx = b.nx;
    const unsigned old = xb_add(&bar[XB_XSUB(b.x)], 1u);
    const unsigned gen = old / nloc;
    if (old + 1u == (gen + 1u) * nloc) {
      __builtin_amdgcn_fence(__ATOMIC_RELEASE, "agent");
      asm volatile("s_waitcnt vmcnt(0)" ::: "memory");
      const unsigned og = xb_add(&bar[XB_TOP], 1u);
      const unsigned tg = og / nx;
      if (og + 1u == (tg + 1u) * nx) xb_add(&bar[XB_TOPGEN], 1u);
      else XB_SPIN(xb_ld(&bar[XB_TOPGEN]) == tg, bar);
      __builtin_amdgcn_fence(__ATOMIC_ACQUIRE, "agent");
      xb_add(&bar[XB_XGEN(b.x)], 1u);
      asm volatile("s_waitcnt vmcnt(0)" ::: "memory");
    } else {
      XB_SPIN(xb_ld(&bar[XB_XGEN(b.x)]) == gen, bar);
      __builtin_amdgcn_fence(__ATOMIC_ACQUIRE, "agent");
      asm volatile("s_waitcnt vmcnt(0)" ::: "memory");
    }
  }
  __syncthreads();
}

__global__ void __launch_bounds__(256, 2) fwd_megakernel(Params p) {
  extern __shared__ __attribute__((aligned(16))) unsigned char smem[];
  cg::grid_group grid = cg::this_grid();
  XcdBarrier xb = xcd_barrier_post((unsigned*)(p.ws + WS_BAR));
  const int ph_lo = p.ph_lo, ph_hi = p.ph_hi;
  for (int ph = ph_lo; ph < ph_hi; ++ph) {
    if (ph == 0) {
      phase_prep(p, smem);
    } else if (ph == NPHASE - 1) {
      phase_final(p);
    } else {
      const int l = (ph - 1) / 7, sub = (ph - 1) % 7;
      const int mt = (l == 1) ? 256 : 272;
      if (sub == 0) {
        phase_pre(p, l, smem);
      } else if (sub == 1) {
        const u16* U = (const u16*)(p.ws + WS_Y);
        const u16* W = (const u16*)(p.ws + WS_WIN);
        const int xcd = blockIdx.x & 7, slot = blockIdx.x >> 3, nslots = gridDim.x >> 3;
        bool pre = false;
        for (int u = slot; u < 918; u += nslots) {
          const int pnl = u / 306, v = u % 306;
          const int u2 = u + nslots, pnl2 = u2 / 306, v2 = u2 % 306;
          const bool hn = u2 < 918;
          gemm_tile<192, 0>(p, l, U, 1024, W, 1024, 1024, (xcd * 34 + v / 9) * 128, (pnl * 9 + v % 9) * 192, smem,
                            pre, hn, U, 1024, (xcd * 34 + v2 / 9) * 128, (pnl2 * 9 + v2 % 9) * 192);
          pre = hn;
        }
      } else if (sub == 2) {
        phase_conv(p, l);
      } else if (sub == 3 || sub == 4) {
        const int part = sub - 3;
        for (int k = 0;; ++k) {
          int it;
          if (gridDim.x == 512) {
            if (k > 0) break;
            const int blk = blockIdx.x;
            const int q = blk < 256 ? blk - 64 : 192 + (blk - 448);
            const int sit = q < 128 ? q * 2 : (q - 128) * 2 + 1;
            it = blk < 64 ? 256 + blk : blk < 256 ? sit : blk < 320 ? -1 : blk < 448 ? blk : sit;
          } else {
            it = blockIdx.x + k * gridDim.x;
            if (it >= 448) break;
          }
          if (it >= 0) {
            if (it < 256) ssd_item(p, l, part, it, smem);
            else if (it < 320) gla_item(p, l, part, it - 256, smem);
            else s5_item(p, l, part, it - 320, smem);
          }
          __syncthreads();
        }
      } else if (sub == 5) {
        const u16* W = (const u16*)(p.ws + WS_GLU);
        const int xcd = blockIdx.x & 7, slot = blockIdx.x >> 3, nslots = gridDim.x >> 3, mtx = mt >> 3;
        const u16* Alat = (const u16*)(p.ws + WS_P) + C_U5;
        const u16* Actx = (const u16*)(p.ws + WS_G5C) - (size_t)NLAT * 512;
        bool pre = false;
        for (int u = slot; u < mtx * 8; u += nslots) {
          const int t = (xcd * mtx) * 8 + u, t2 = t + nslots;
          const int m0 = (t >> 3) * 128, m0n = (t2 >> 3) * 128;
          const bool hn = u + nslots < mtx * 8;
          const u16* Ac = m0 < NLAT ? Alat : Actx; const int ldc = m0 < NLAT ? IND : 512;
          const u16* An = m0n < NLAT ? Alat : Actx; const int ldn = m0n < NLAT ? IND : 512;
          gemm_tile<128, 1>(p, l, Ac, ldc, W, 512, 512, m0, (t & 7) * 128, smem, pre, hn, An, ldn, m0n, (t2 & 7) * 128);
          pre = hn;
        }
        ssd_norm_rows(p, mt * 128);
      } else {
        const u16* A = (const u16*)(p.ws + WS_Y);
        const u16* W = (const u16*)(p.ws + WS_WOUT);
        const int xcd = blockIdx.x & 7, slot = blockIdx.x >> 3, nslots = gridDim.x >> 3, mtx = mt >> 3;
        bool pre = false;
        for (int u = slot; u < mtx * 8; u += nslots) {
          const int t = (xcd * mtx) * 8 + u, t2 = t + nslots;
          const bool hn = u + nslots < mtx * 8;
          gemm_tile<128, 2>(p, l, A, MIXW, W, MIXW, MIXW, (t >> 3) * 128, (t & 7) * 128, smem, pre, hn, A, MIXW, (t2 >> 3) * 128, (t2 & 7) * 128);
          pre = hn;
        }
      }
    }
    if (ph + 1 < ph_hi) {
      if (ph_hi < 0) grid.sync();
      xcd_barrier(xb);
    }
  }
}

extern "C" void kernel_launch(void* const* d_in, const int* in_sizes, int n_in, void* d_out, int out_size, void* d_ws,
                              size_t ws_size, hipStream_t stream) {
  static int grid_blocks = 0;
  if (grid_blocks == 0) {
    if (n_in != 29 || ws_size < WS_END) { fprintf(stderr, "kernel_launch: bad n_in %d / ws %zu (need %zu)\n", n_in, ws_size, (size_t)WS_END); grid_blocks = -1; return; }
    int dev = 0, cus = 0, per_cu = 0;
    hipGetDevice(&dev);
    hipDeviceGetAttribute(&cus, hipDeviceAttributeMultiprocessorCount, dev);
    hipFuncSetAttribute((const void*)fwd_megakernel, hipFuncAttributeMaxDynamicSharedMemorySize, SMEM_BYTES);
    hipOccupancyMaxActiveBlocksPerMultiprocessor(&per_cu, (const void*)fwd_megakernel, 256, SMEM_BYTES);
    if (per_cu < 1) per_cu = 1;
    if (per_cu > 2) per_cu = 2;
    grid_blocks = cus * per_cu;
    fprintf(stderr, "kernel_launch: cus %d per_cu %d grid %d\n", cus, per_cu, grid_blocks);
  }
  if (grid_blocks < 0) return;
  Params p{};
  for (int i = 0; i < 29; ++i) p.in[i] = (const float*)d_in[i];
  p.out = (float*)d_out; p.ws = (unsigned char*)d_ws; p.ph_lo = 0; p.ph_hi = NPHASE;
  if (hipMemsetAsync((char*)d_ws + WS_BAR, 0, 16384, stream) != hipSuccess) { fprintf(stderr, "kernel_launch: memset of the barrier words failed\n"); return; }
  void* args[] = {&p};
  hipError_t e = hipLaunchCooperativeKernel((const void*)fwd_megakernel, dim3(grid_blocks), dim3(256), args, SMEM_BYTES, stream);
  if (e != hipSuccess) fprintf(stderr, "cooperative launch failed: %s (grid %d)\n", hipGetErrorString(e), grid_blocks);
}
```

```cpp
#include <hip/hip_runtime.h>
#include <hip/hip_cooperative_groups.h>
#include <cstdio>
namespace cg = cooperative_groups;

typedef unsigned short u16;
using bf16x8 = __attribute__((ext_vector_type(8))) short;
using bf16x4 = __attribute__((ext_vector_type(4))) short;
using f32x4 = __attribute__((ext_vector_type(4))) float;
using f32x16 = __attribute__((ext_vector_type(16))) float;
using u32x4 = __attribute__((ext_vector_type(4))) unsigned;
#define DI __device__ __forceinline__

constexpr int DM = 1024, NLAT = 32768, NCTX = 2048, NTOK = 34816, IND = 5184, MIXW = 2048;
constexpr int C_XBC = 1024, C_BM = 2048, C_CM = 2304, C_DT = 2560, C_Q = 2592, C_K = 2848, C_V = 3104, C_GG = 3616,
              C_LR = 4128, C_U5 = 4160, C_SG = 4672;
constexpr float EPSF = 1e-6f;
constexpr int SMEM_BYTES = 81920;
constexpr int NPHASE = 16;

constexpr size_t WS_P = 0;
constexpr size_t WS_Y = WS_P + (size_t)NTOK * IND * 2;
constexpr size_t WS_WIN = WS_Y + (size_t)NTOK * MIXW * 2;
constexpr size_t WS_WOUT = WS_WIN + (size_t)IND * DM * 2;
constexpr size_t WS_GLU = WS_WOUT + (size_t)DM * MIXW * 2;
constexpr size_t WS_HCTX = WS_GLU + (size_t)1024 * 512 * 2;
constexpr size_t WS_MOD = WS_HCTX + (size_t)NCTX * DM * 4;
constexpr size_t WS_SSQ = WS_MOD + (size_t)2 * 9 * 3072 * 4;
constexpr size_t WS_S5C = WS_SSQ + (size_t)NTOK * 16 * 4;
constexpr size_t WS_G5C = WS_S5C + (size_t)128 * 8704;
constexpr size_t WS_S5ST = WS_G5C + (size_t)NCTX * 512 * 2;
constexpr size_t WS_BAR = WS_S5ST + (size_t)512 * 128 * 4;
constexpr size_t WS_RS = WS_BAR + 16384;
constexpr size_t WS_END = WS_RS + (size_t)NTOK * 2 * 4;

struct Params {
  const float* in[29];
  float* out;
  unsigned char* ws;
  int ph_lo, ph_hi;
};

DI int opq(int i) { asm volatile("" : "+s"(i)); return i; }
DI int opaque_tid() { int t = threadIdx.x; asm volatile("" : "+v"(t)); return t; }
typedef __bf16 hbf16x2 __attribute__((ext_vector_type(2)));
typedef float hf32x2 __attribute__((ext_vector_type(2)));
DI u16 f2bf(float x) { __bf16 h = (__bf16)x; return __builtin_bit_cast(u16, h); }
DI float bf2f(u16 h) { return __uint_as_float(((unsigned)h) << 16); }
DI unsigned pack2(float a, float b) { hf32x2 v = {a, b}; return __builtin_bit_cast(unsigned, __builtin_convertvector(v, hbf16x2)); }
DI float bflo(unsigned v) { return __uint_as_float(v << 16); }
DI float bfhi(unsigned v) { return __uint_as_float(v & 0xffff0000u); }
DI float rcpf(float x) { return __builtin_amdgcn_rcpf(x); }
DI float siluf(float x) { return x * rcpf(1.f + __expf(-x)); }
DI float logsigf(float x) { return fminf(x, 0.f) - __logf(1.f + __expf(-fabsf(x))); }
DI float softplusf(float v) { return fmaxf(v, 0.f) + log1pf(__expf(-fabsf(v))); }
DI f32x4 mfma16(bf16x8 a, bf16x8 b, f32x4 c) { return __builtin_amdgcn_mfma_f32_16x16x32_bf16(a, b, c, 0, 0, 0); }
DI f32x16 mfma32(bf16x8 a, bf16x8 b, f32x16 c) { return __builtin_amdgcn_mfma_f32_32x32x16_bf16(a, b, c, 0, 0, 0); }
DI void wave_lds_sync() { asm volatile("s_waitcnt lgkmcnt(0)" ::: "memory"); }
DI unsigned pin(unsigned v) { asm volatile("" : "+v"(v)); return v; }
DI void pin4(u32x4& v) { asm volatile("" : "+v"(v)); }
#define DPPF(v, old, ctrl, rmask) __builtin_bit_cast(float, __builtin_amdgcn_update_dpp(__builtin_bit_cast(int, (float)(old)), __builtin_bit_cast(int, (float)(v)), (ctrl), (rmask), 0xf, false))
DI float row16_sum(float v) {
  v += DPPF(v, 0.f, 0xB1, 0xf);
  v += DPPF(v, 0.f, 0x4E, 0xf);
  v += DPPF(v, 0.f, 0x141, 0xf);
  v += DPPF(v, 0.f, 0x140, 0xf);
  return v;
}
DI float wave_incl_scan(float v) {
  v += DPPF(v, 0.f, 0x111, 0xf);
  v += DPPF(v, 0.f, 0x112, 0xf);
  v += DPPF(v, 0.f, 0x114, 0xf);
  v += DPPF(v, 0.f, 0x118, 0xf);
  v += DPPF(v, 0.f, 0x142, 0xa);
  v += DPPF(v, 0.f, 0x143, 0xc);
  return v;
}
DI bf16x8 ld8(const u16* p) { return *reinterpret_cast<const bf16x8*>(p); }
DI bf16x8 ld44(const u16* p0, const u16* p1) {
  bf16x4 a = *reinterpret_cast<const bf16x4*>(p0), b = *reinterpret_cast<const bf16x4*>(p1);
  return __builtin_shufflevector(a, b, 0, 1, 2, 3, 4, 5, 6, 7);
}
DI bf16x8 packacc(const f32x4& a, const f32x4& b) {
  uint4 u; u.x = pack2(a[0], a[1]); u.y = pack2(a[2], a[3]); u.z = pack2(b[0], b[1]); u.w = pack2(b[2], b[3]);
  return __builtin_bit_cast(bf16x8, u);
}

__device__ void phase_prep(const Params& p, unsigned char* smem) {
  float* sc = (float*)smem;
  float* red = sc + 9 * 1024;
  const int tid = opaque_tid();
  float* modb = (float*)(p.ws + WS_MOD);
  bool filled = false;
  for (int it = blockIdx.x; it < 96 + 128; it += gridDim.x) {
    if (it < 96) {
      if (!filled) {
        for (int idx = tid; idx < 9216; idx += 256) {
          int r = idx >> 10, k = idx & 1023;
          float v = r < 8 ? p.in[opq(1)][r * 1024 + k] : p.in[opq(3)][k];
          sc[idx] = siluf(v);
        }
        filled = true;
        __syncthreads();
      }
      const int l = it / 48, j0 = (it % 48) * 64, kg = tid >> 6, jj = tid & 63;
      float a[9];
#pragma unroll
      for (int r = 0; r < 9; ++r) a[r] = 0.f;
      const float* W = p.in[opq(5)] + (size_t)l * 1024 * 3072 + j0 + jj;
      for (int k = kg * 256; k < kg * 256 + 256; ++k) {
        float wv = W[(size_t)k * 3072];
#pragma unroll
        for (int r = 0; r < 9; ++r) a[r] += sc[r * 1024 + k] * wv;
      }
#pragma unroll
      for (int r = 0; r < 9; ++r) red[(kg * 9 + r) * 64 + jj] = a[r];
      __syncthreads();
      for (int idx = tid; idx < 576; idx += 256) {
        int r = idx >> 6, j = idx & 63;
        float s = red[(0 * 9 + r) * 64 + j] + red[(1 * 9 + r) * 64 + j] + red[(2 * 9 + r) * 64 + j] + red[(3 * 9 + r) * 64 + j];
        modb[(l * 9 + r) * 3072 + j0 + j] = s + p.in[opq(6)][l * 3072 + j0 + j];
      }
      __syncthreads();
    } else {
      const int q = it - 96, l = q >> 6, d = (q >> 5) & 1, g = q & 31;
      unsigned char* base = p.ws + WS_S5C + (size_t)q * 8704;
      u16* BbarM = (u16*)base;
      u16* CmT = (u16*)(base + 4096);
      float* lamb = (float*)(base + 8192);
      const float st = expf(p.in[opq(20)][(l * 2 + d) * 32 + g]);
      for (int idx = tid; idx < 1024; idx += 256) {
        const int pp = idx >> 4, hh = idx & 15;
        const int li = ((l * 2 + d) * 32 + g) * 64 + pp;
        const float lre = p.in[opq(18)][li], lim = p.in[opq(19)][li];
        const float a = lre * st, bb = lim * st;
        const float ea = expf(a), sn = sinf(bb), cs = cosf(bb), s2 = sinf(0.5f * bb);
        const float lbre = ea * cs, lbim = ea * sn;
        const float nre = expm1f(a) * cs - 2.f * s2 * s2, nim = lbim;
        const float den = lre * lre + lim * lim;
        const float cre = (nre * lre + nim * lim) / den, cim = (nim * lre - nre * lim) / den;
        const int bi = ((l * 32 + g) * 64 + pp) * 16 + hh;
        const float bre = p.in[opq(21)][bi], bim = p.in[opq(22)][bi];
        BbarM[(2 * pp) * 16 + hh] = f2bf(cre * bre - cim * bim);
        BbarM[(2 * pp + 1) * 16 + hh] = f2bf(cre * bim + cim * bre);
        const int cidx = (((l * 2 + d) * 32 + g) * 16 + hh) * 64 + pp;
        CmT[hh * 128 + 2 * pp] = f2bf(p.in[opq(23)][cidx]);
        CmT[hh * 128 + 2 * pp + 1] = f2bf(-p.in[opq(24)][cidx]);
        if (hh == 0) { lamb[2 * pp] = lbre; lamb[2 * pp + 1] = lbim; }
      }
    }
  }
}

__device__ void phase_pre(const Params& p, int l, unsigned char* smem) {
  const int tid = opaque_tid(), lane = tid & 63, w = tid >> 6;
  const float* hl = l == 0 ? p.in[opq(0)] : p.out;
  const float* hc = l == 0 ? p.in[opq(2)] : (const float*)(p.ws + WS_HCTX);
  const float* nw = p.in[opq(4)] + l * 1024;
  const float* modb = (const float*)(p.ws + WS_MOD) + l * 9 * 3072;
  u16* U = (u16*)(p.ws + WS_Y);
  const bool cm = (l & 1);
  for (int r = blockIdx.x * 4 + w; r < NTOK; r += gridDim.x * 4) {
    const float* src; const float* mrow;
    if (r < NLAT) {
      int b = r >> 12, sp = r & 4095;
      int s = cm ? (((sp & 63) << 6) | (sp >> 6)) : sp;
      src = hl + ((size_t)(b * 4096 + s)) * 1024; mrow = modb + b * 3072;
    } else { src = hc + (size_t)(r - NLAT) * 1024; mrow = modb + 8 * 3072; }
    float4 v[4]; float ss = 0.f;
#pragma unroll
    for (int q = 0; q < 4; ++q) {
      v[q] = *reinterpret_cast<const float4*>(src + lane * 4 + q * 256);
      ss += v[q].x * v[q].x + v[q].y * v[q].y + v[q].z * v[q].z + v[q].w * v[q].w;
    }
#pragma unroll
    for (int o = 32; o > 0; o >>= 1) ss += __shfl_xor(ss, o);
    const float rs = rsqrtf(ss * (1.f / 1024.f) + EPSF);
#pragma unroll
    for (int q = 0; q < 4; ++q) {
      const int col = lane * 4 + q * 256;
      float4 n4 = *reinterpret_cast<const float4*>(nw + col);
      float4 sh = *reinterpret_cast<const float4*>(mrow + col);
      float4 s4 = *reinterpret_cast<const float4*>(mrow + 1024 + col);
      float u0 = v[q].x * rs * n4.x * (1.f + s4.x) + sh.x;
      float u1 = v[q].y * rs * n4.y * (1.f + s4.y) + sh.y;
      float u2 = v[q].z * rs * n4.z * (1.f + s4.z) + sh.z;
      float u3 = v[q].w * rs * n4.w * (1.f + s4.w) + sh.w;
      uint2 o; o.x = pack2(u0, u1); o.y = pack2(u2, u3);
      *reinterpret_cast<uint2*>(U + (size_t)r * 1024 + col) = o;
    }
  }
  float* tile = (float*)smem;
  for (int t = blockIdx.x; t < 1296 + 512 + 128; t += gridDim.x) {
    const float* src; int sld, k0, n0, kind; u16* dst; int dld;
    if (t < 1296) { kind = 0; k0 = (t / 81) * 64; n0 = (t % 81) * 64; src = p.in[opq(7)] + (size_t)l * 1024 * IND; sld = IND; dst = (u16*)(p.ws + WS_WIN); dld = 1024; }
    else if (t < 1808) { int q = t - 1296; kind = 1; k0 = (q / 16) * 64; n0 = (q % 16) * 64; src = p.in[opq(8)] + (size_t)l * 2048 * 1024; sld = 1024; dst = (u16*)(p.ws + WS_WOUT); dld = 2048; }
    else { int q = t - 1808; kind = 2; k0 = (q / 16) * 64; n0 = (q % 16) * 64; src = p.in[opq(26)] + (size_t)l * 512 * 1024; sld = 1024; dst = (u16*)(p.ws + WS_GLU); dld = 512; }
    __syncthreads();
#pragma unroll
    for (int rr = 0; rr < 4; ++rr) {
      int i = (tid >> 4) + 16 * rr, j = (tid & 15) * 4;
      float4 v = *reinterpret_cast<const float4*>(src + (size_t)(k0 + i) * sld + n0 + j);
      if (kind == 1 && k0 + i < 1024) { float s = p.in[opq(14)][l * 1024 + k0 + i]; v.x *= s; v.y *= s; v.z *= s; v.w *= s; }
      tile[i * 65 + j] = v.x; tile[i * 65 + j + 1] = v.y; tile[i * 65 + j + 2] = v.z; tile[i * 65 + j + 3] = v.w;
    }
    __syncthreads();
#pragma unroll
    for (int rr = 0; rr < 2; ++rr) {
      int n = (tid >> 3) + 32 * rr, i0 = (tid & 7) * 8;
      uint4 o;
      o.x = pack2(tile[(i0 + 0) * 65 + n], tile[(i0 + 1) * 65 + n]);
      o.y = pack2(tile[(i0 + 2) * 65 + n], tile[(i0 + 3) * 65 + n]);
      o.z = pack2(tile[(i0 + 4) * 65 + n], tile[(i0 + 5) * 65 + n]);
      o.w = pack2(tile[(i0 + 6) * 65 + n], tile[(i0 + 7) * 65 + n]);
      int drow = n0 + n;
      if (kind == 2) { int o_ = n0 + n, half = o_ >> 9, rem = o_ & 511; drow = (rem >> 6) * 128 + ((rem & 63) >> 4) * 32 + half * 16 + (rem & 15); }
      *reinterpret_cast<uint4*>(dst + (size_t)drow * dld + k0 + i0) = o;
    }
  }
}

template <int BN, int MODE>
__device__ void gemm_tile(const Params& p, int l, const u16* __restrict__ A, int lda, const u16* __restrict__ Bt, int ldb,
                          int K, int m0, int n0, unsigned char* smem,
                          bool pre, bool has_next, const u16* __restrict__ An, int ldan, int m0n, int n0n) {
  constexpr int WN = BN / 2, NF = WN / 16, NBL = BN * 8 / 256;
  u16* As = (u16*)smem;
  u16* Bs = As + 128 * 64;
  const int tid = opaque_tid(), lane = tid & 63, w = tid >> 6, wr = w >> 1, wc = w & 1, fr = lane & 15, fq = lane >> 4;
  f32x4 acc[4][NF];
#pragma unroll
  for (int m = 0; m < 4; ++m)
#pragma unroll
    for (int n = 0; n < NF; ++n) acc[m][n] = f32x4{0.f, 0.f, 0.f, 0.f};
  constexpr int STAGE = (128 + BN) * 64;
  const int nk = K / 64;
#define GLDS(OFF, KT) do { const int k0_ = (KT) * 64; \
    _Pragma("unroll") for (int i = 0; i < 4; ++i) { const int id = tid + 256 * i, row = id >> 3, c = (id & 7) ^ ((id >> 4) & 7); \
      __builtin_amdgcn_global_load_lds((const unsigned*)(A + (size_t)(m0 + row) * lda + k0_ + c * 8), (unsigned*)(As + (OFF) + id * 8), 16, 0, 0); } \
    _Pragma("unroll") for (int i = 0; i < NBL; ++i) { const int id = tid + 256 * i, row = id >> 3, c = (id & 7) ^ ((id >> 4) & 7); \
      __builtin_amdgcn_global_load_lds((const unsigned*)(Bt + (size_t)(n0 + row) * ldb + k0_ + c * 8), (unsigned*)(Bs + (OFF) + id * 8), 16, 0, 0); } } while (0)
#define COMPUTE(OFF) do { \
    _Pragma("unroll") for (int kk = 0; kk < 2; ++kk) { \
      bf16x8 af[4], bfr[NF]; \
      _Pragma("unroll") for (int m = 0; m < 4; ++m) af[m] = ld8(As + (OFF) + (wr * 64 + m * 16 + fr) * 64 + (((kk * 4 + fq) ^ (fr >> 1)) * 8)); \
      _Pragma("unroll") for (int n = 0; n < NF; ++n) bfr[n] = ld8(Bs + (OFF) + (wc * WN + n * 16 + fr) * 64 + (((kk * 4 + fq) ^ (fr >> 1)) * 8)); \
      __builtin_amdgcn_s_setprio(1); \
      _Pragma("unroll") for (int m = 0; m < 4; ++m) \
        _Pragma("unroll") for (int n = 0; n < NF; ++n) acc[m][n] = mfma16(bfr[n], af[m], acc[m][n]);     \
      __builtin_amdgcn_s_setprio(0); } } while (0)
  float f0[4], f1[4];
  if constexpr (MODE == 2) {
    const float* rsb = (const float*)(p.ws + WS_RS);
#pragma unroll
    for (int m = 0; m < 4; ++m) {
      const float2 r2 = *reinterpret_cast<const float2*>(rsb + (size_t)(m0 + wr * 64 + m * 16 + fr) * 2);
      f0[m] = r2.x * rcpf(r2.y); f1[m] = r2.y;
    }
  }
  __syncthreads();
  if (!pre) GLDS(0, 0);
  asm volatile("s_waitcnt vmcnt(0)" ::: "memory");
  __syncthreads();
  for (int kt = 0; kt < nk; ++kt) {
    const int cur = (kt & 1) * STAGE, nxt = STAGE - cur;
    if (kt + 1 < nk) GLDS(nxt, kt + 1);
    else if (has_next) {
#pragma unroll
      for (int i = 0; i < 4; ++i) { const int id = tid + 256 * i, row = id >> 3, c = (id & 7) ^ ((id >> 4) & 7);
        __builtin_amdgcn_global_load_lds((const unsigned*)(An + (size_t)(m0n + row) * ldan + c * 8), (unsigned*)(As + id * 8), 16, 0, 0); }
#pragma unroll
      for (int i = 0; i < NBL; ++i) { const int id = tid + 256 * i, row = id >> 3, c = (id & 7) ^ ((id >> 4) & 7);
        __builtin_amdgcn_global_load_lds((const unsigned*)(Bt + (size_t)(n0n + row) * ldb + c * 8), (unsigned*)(Bs + id * 8), 16, 0, 0); }
    }
    COMPUTE(cur);
    if constexpr (MODE == 2) {
      if (kt == 7 || kt == 15) {
#pragma unroll
        for (int m = 0; m < 4; ++m)
#pragma unroll
          for (int n = 0; n < NF; ++n)
#pragma unroll
            for (int j = 0; j < 4; ++j) acc[m][n][j] *= (kt == 7) ? f0[m] : f1[m];
      }
    }
    if (kt + 1 < nk) asm volatile("s_waitcnt vmcnt(0)" ::: "memory");
    __syncthreads();
  }
#define GLOAD(x)
#define LSTORE(x)
#undef GLOAD
#undef LSTORE
#undef COMPUTE
  if constexpr (MODE == 0) {
    u16* P = (u16*)(p.ws + WS_P);
    constexpr int SLD = WN + 8;
    u16* stg = (u16*)smem + STAGE + w * 16 * SLD;
    constexpr int CPR = WN / 8;
    __syncthreads();
#pragma unroll
    for (int m = 0; m < 4; ++m) {
      wave_lds_sync();
#pragma unroll
      for (int n = 0; n < NF; ++n) {
        uint2 o; o.x = pack2(acc[m][n][0], acc[m][n][1]); o.y = pack2(acc[m][n][2], acc[m][n][3]);
        *reinterpret_cast<uint2*>(stg + fr * SLD + n * 16 + fq * 4) = o;
      }
      wave_lds_sync();
      for (int id = lane; id < 16 * CPR; id += 64) {
        int row = id / CPR, ch = id % CPR;
        uint4 v = *reinterpret_cast<const uint4*>(stg + row * SLD + ch * 8);
        *reinterpret_cast<uint4*>(P + (size_t)(m0 + wr * 64 + m * 16 + row) * IND + n0 + wc * WN + ch * 8) = v;
      }
    }
  } else if constexpr (MODE == 1) {
    const u16* P = (const u16*)(p.ws + WS_P);
    u16* Y = (u16*)(p.ws + WS_Y);
    const float* gb = p.in[opq(27)] + l * 1024;
    const int tn = n0 >> 7;
#pragma unroll
    for (int q = 0; q < 2; ++q) {
      const int oc = tn * 64 + (wc * 2 + q) * 16 + fq * 4;
      const f32x4 b0 = *reinterpret_cast<const f32x4*>(gb + oc), b1 = *reinterpret_cast<const f32x4*>(gb + 512 + oc);
#pragma unroll
      for (int m = 0; m < 4; ++m) {
        const size_t row = (size_t)(m0 + wr * 64 + m * 16 + fr);
        const uint2 sgv = *reinterpret_cast<const uint2*>(P + row * IND + C_SG + oc);
        const float sg[4] = {bflo(sgv.x), bfhi(sgv.x), bflo(sgv.y), bfhi(sgv.y)};
        float y[4];
#pragma unroll
        for (int j = 0; j < 4; ++j) {
          const float val = acc[m][2 * q][j] + b0[j], gt = acc[m][2 * q + 1][j] + b1[j];
          y[j] = val * rcpf(1.f + __expf(-gt)) * siluf(sg[j]);
        }
        uint2 o; o.x = pack2(y[0], y[1]); o.y = pack2(y[2], y[3]);
        *reinterpret_cast<uint2*>(Y + row * MIXW + 1536 + oc) = o;
      }
    }
  } else {
    const float* modb = (const float*)(p.ws + WS_MOD) + l * 9 * 3072;
    const bool cm = (l & 1);
    const float* hs = l == 0 ? p.in[opq(0)] : p.out;
    float* stg = (float*)((u16*)smem + STAGE) + w * (16 * 68);
    __syncthreads();
#pragma unroll
    for (int m = 0; m < 4; ++m) {
#pragma unroll
      for (int n = 0; n < NF; ++n) *reinterpret_cast<f32x4*>(stg + fr * 68 + n * 16 + fq * 4) = acc[m][n];
      wave_lds_sync();
#pragma unroll
      for (int k = 0; k < 4; ++k) {
        const int id = lane + 64 * k, rowi = id >> 4, ch = id & 15;
        const f32x4 a = *reinterpret_cast<const f32x4*>(stg + rowi * 68 + ch * 4);
        const int r = m0 + wr * 64 + m * 16 + rowi, col = n0 + wc * WN + ch * 4;
        const float* src; float* dst; const float* gt;
        if (r < NLAT) {
          const int b = r >> 12, sp = r & 4095;
          const int sq = cm ? (((sp & 63) << 6) | (sp >> 6)) : sp;
          const size_t idx = ((size_t)(b * 4096 + sq)) * 1024 + col;
          src = hs + idx; dst = p.out + idx; gt = modb + b * 3072 + 2048 + col;
        } else {
          const size_t idx = (size_t)(r - NLAT) * 1024 + col;
          src = p.in[opq(2)] + idx; dst = (float*)(p.ws + WS_HCTX) + idx; gt = modb + 8 * 3072 + 2048 + col;
        }
        const f32x4 h = *reinterpret_cast<const f32x4*>(src), gv = *reinterpret_cast<const f32x4*>(gt);
        f32x4 o;
        o[0] = h[0] + gv[0] * a[0]; o[1] = h[1] + gv[1] * a[1]; o[2] = h[2] + gv[2] * a[2]; o[3] = h[3] + gv[3] * a[3];
        *reinterpret_cast<f32x4*>(dst) = o;
      }
      wave_lds_sync();
    }
  }
  __syncthreads();
}

__device__ void phase_conv(const Params& p, int l) {
  u16* P = (u16*)(p.ws + WS_P);
  const float* cw = p.in[opq(9)] + (size_t)l * 5 * 1536;
  const float* cb = p.in[opq(10)] + l * 1536;
  const int tid = opaque_tid(), cq = tid & 7, sgi = tid >> 3;
  for (int it = blockIdx.x; it < 768; it += gridDim.x) {
    const bool isctx = it >= 384;
    const int q = isctx ? it - 384 : it, b = q / 48, cgp = q % 48;
    const int L = isctx ? 256 : 4096, seg = L / 32, rowbase = isctx ? NLAT + b * 256 : b * 4096;
    const int ch = cgp * 32 + cq * 4;
    float4 wk[5];
#pragma unroll
    for (int k = 0; k < 5; ++k) wk[k] = *reinterpret_cast<const float4*>(cw + k * 1536 + ch);
    const float4 bias = *reinterpret_cast<const float4*>(cb + ch);
    u16* rp = P + (size_t)rowbase * IND + C_XBC + ch;
    const int a = sgi * seg;
    auto ld = [&](int sp) -> float4 {
      float4 r = make_float4(0.f, 0.f, 0.f, 0.f);
      if (sp >= 0 && sp < L) {
        uint2 v = *reinterpret_cast<const uint2*>(rp + (size_t)sp * IND);
        r.x = bflo(v.x); r.y = bfhi(v.x); r.z = bflo(v.y); r.w = bfhi(v.y);
      }
      return r;
    };
    float4 r0 = ld(a - 2), r1 = ld(a - 1), r2 = ld(a), r3 = ld(a + 1);
    const float4 e0 = ld(a + seg), e1 = ld(a + seg + 1);
    __syncthreads();
    auto ldraw = [&](int sp) -> uint2 {
      uint2 v = make_uint2(0u, 0u);
      if (sp < a + seg) v = *reinterpret_cast<const uint2*>(rp + (size_t)sp * IND);
      return v;
    };
    uint2 nraw[8];
#pragma unroll
    for (int j = 0; j < 8; ++j) nraw[j] = ldraw(a + 2 + j);
    for (int t0 = a; t0 < a + seg; t0 += 8) {
      uint2 cur[8];
#pragma unroll
      for (int j = 0; j < 8; ++j) cur[j] = nraw[j];
      if (t0 + 8 < a + seg) {
#pragma unroll
        for (int j = 0; j < 8; ++j) nraw[j] = ldraw(t0 + 10 + j);
      }
#pragma unroll
      for (int j = 0; j < 8; ++j) {
        const int sp = t0 + 2 + j;
        float4 r4;
        if (sp < a + seg) {
          const unsigned c0_ = pin(cur[j].x), c1_ = pin(cur[j].y);
          r4 = make_float4(bflo(c0_), bfhi(c0_), bflo(c1_), bfhi(c1_));
        } else r4 = (sp == a + seg) ? e0 : e1;
        float o0 = bias.x + wk[0].x * r0.x + wk[1].x * r1.x + wk[2].x * r2.x + wk[3].x * r3.x + wk[4].x * r4.x;
        float o1 = bias.y + wk[0].y * r0.y + wk[1].y * r1.y + wk[2].y * r2.y + wk[3].y * r3.y + wk[4].y * r4.y;
        float o2 = bias.z + wk[0].z * r0.z + wk[1].z * r1.z + wk[2].z * r2.z + wk[3].z * r3.z + wk[4].z * r4.z;
        float o3 = bias.w + wk[0].w * r0.w + wk[1].w * r1.w + wk[2].w * r2.w + wk[3].w * r3.w + wk[4].w * r4.w;
        uint2 o; o.x = pack2(siluf(o0), siluf(o1)); o.y = pack2(siluf(o2), siluf(o3));
        *reinterpret_cast<uint2*>(rp + (size_t)(t0 + j) * IND) = o;
        r0 = r1; r1 = r2; r2 = r3; r3 = r4;
      }
    }
    __syncthreads();
  }
}


__device__ void ssd_item(const Params& p, int l, int part, int item, unsigned char* smem) {
  u16* Bs = (u16*)smem;
  u16* Ms = Bs;
  u16* Cs = (u16*)(smem + 17408);
  u16* BT = (u16*)(smem + 34816);
  u16* xT = (u16*)(smem + 53248);
  u16* xwT = (u16*)(smem + 62464);
  float* dts = (float*)(smem + 71680);
  float* acs = dts + 64;
  float* wts = acs + 64;
  float* ssql = wts + 64;
  float* tots = ssql + 256;
  u16* ystg = (u16*)(smem + 73600);
  const int tid0 = opaque_tid();
  const int b = item >> 5, hd = (item >> 1) & 15, dir = item & 1, g = hd >> 3;
  u16* P = (u16*)(p.ws + WS_P);
  u16* Y = (u16*)(p.ws + WS_Y);
  float* ssq = (float*)(p.ws + WS_SSQ);
  float* stsave = (float*)(p.ws + WS_WIN) + (size_t)item * 8192;
  const float Dsk = p.in[opq(13)][l * 16 + hd];
  f32x4 hacc[8];
  if (part == 1) {
#pragma unroll
    for (int i = 0; i < 8; ++i) hacc[i] = *reinterpret_cast<const f32x4*>(stsave + (i * 256 + tid0) * 4);
  } else {
#pragma unroll
    for (int i = 0; i < 8; ++i) hacc[i] = f32x4{0.f, 0.f, 0.f, 0.f};
  }
  const int nseg = part == 0 ? 3 : 1;
  for (int seg = 0; seg < nseg; ++seg) {
    bool isctx; int sdir, ci0, ci1, mode;
    if (part == 1) { isctx = false; sdir = dir; ci0 = 32; ci1 = 64; mode = 2; }
    else if (seg == 0) { if (!(dir == 0 && l == 0)) continue; isctx = true; sdir = 1; ci0 = 0; ci1 = 4; mode = 1; }
    else if (seg == 1) { isctx = true; sdir = dir; ci0 = 0; ci1 = 4; mode = (dir == 0 && l == 0) ? 2 : 0; }
    else { isctx = false; sdir = dir; ci0 = 0; ci1 = 32; mode = 1; }
    if (part == 0 && seg <= 1) {
#pragma unroll
      for (int i = 0; i < 8; ++i) hacc[i] = f32x4{0.f, 0.f, 0.f, 0.f};
    }
    __threadfence();
    __syncthreads();
    const float aneg = -expf(p.in[opq(11)][(l * 2 + sdir) * 16 + hd]);
    const float dtb = p.in[opq(12)][(l * 2 + sdir) * 16 + hd];
    const int nch = isctx ? 4 : 64;
    const int rowbase = isctx ? NLAT + b * 256 : b * 4096;
#pragma unroll
    for (int i = 0; i < 8; ++i) asm volatile("" : "+v"(hacc[i]));
    u32x4 rx[2], rbm[4], rcm[4];
    unsigned rawdt = 0u;
    {
      const int tid = tid0, lane = tid & 63, w = tid >> 6;
      const int cL = (sdir ? nch - 1 - ci0 : ci0) * 64;
#pragma unroll
      for (int k = 0; k < 2; ++k) {
        const int id = tid + 256 * k, pch = id >> 6, i = id & 63;
        const int tau = sdir ? cL + 63 - i : cL + i;
        rx[k] = *reinterpret_cast<const u32x4*>(P + (size_t)(rowbase + tau) * IND + C_XBC + hd * 64 + pch * 8);
      }
#pragma unroll
      for (int k = 0; k < 4; ++k) {
        const int id = tid + 256 * k, nc = id >> 6, i = id & 63;
        const int tau = sdir ? cL + 63 - i : cL + i;
        rbm[k] = *reinterpret_cast<const u32x4*>(P + (size_t)(rowbase + tau) * IND + C_BM + g * 128 + nc * 8);
      }
#pragma unroll
      for (int k = 0; k < 4; ++k) {
        const int id = tid + 256 * k, i = id >> 4, nc = id & 15;
        const int tau = sdir ? cL + 63 - i : cL + i;
        rcm[k] = *reinterpret_cast<const u32x4*>(P + (size_t)(rowbase + tau) * IND + C_CM + g * 128 + nc * 8);
      }
      rawdt = P[(size_t)(rowbase + (sdir ? cL + 63 - lane : cL + lane)) * IND + C_DT + sdir * 16 + hd];
    }
    for (int ci = ci0; ci < ci1; ++ci) {
      const int c0 = (sdir ? nch - 1 - ci : ci) * 64;
      int tid = tid0;
      asm volatile("" : "+v"(tid));
      const int lane = tid & 63, w = tid >> 6, fr = lane & 15, fq = lane >> 4;
      __syncthreads();
      if (w == 0) {
        float dt = softplusf(bflo(pin(rawdt)) + dtb);
        const float cs = wave_incl_scan(dt * aneg);
        const float tot = __builtin_bit_cast(float, __builtin_amdgcn_readlane(__builtin_bit_cast(int, cs), 63));
        dts[lane] = dt; acs[lane] = cs; wts[lane] = __expf(tot - cs);
        if (lane == 0) tots[0] = tot;
      }
      pin4(rbm[0]); pin4(rbm[1]); pin4(rbm[2]); pin4(rbm[3]);
#pragma unroll
      for (int k = 0; k < 4; ++k) {
        const int id = tid + 256 * k, nc = id >> 6, i = id & 63;
        *reinterpret_cast<u32x4*>(Bs + i * 136 + nc * 8) = rbm[k];
#pragma unroll
        for (int e = 0; e < 4; ++e) {
          BT[(nc * 8 + 2 * e) * 72 + i] = (u16)(rbm[k][e] & 0xffffu);
          BT[(nc * 8 + 2 * e + 1) * 72 + i] = (u16)(rbm[k][e] >> 16);
        }
      }
#pragma unroll
      for (int k = 0; k < 4; ++k) {
        const int id = tid + 256 * k, i = id >> 4, nc = id & 15;
        *reinterpret_cast<u32x4*>(Cs + i * 136 + nc * 8) = rcm[k];
      }
      __syncthreads();
      pin4(rx[0]); pin4(rx[1]);
#pragma unroll
      for (int k = 0; k < 2; ++k) {
        const int id = tid + 256 * k, pch = id >> 6, i = id & 63;
        const float dt = dts[i], wt = wts[i];
#pragma unroll
        for (int e = 0; e < 4; ++e) {
          float x0 = bflo(rx[k][e]) * dt, x1 = bfhi(rx[k][e]) * dt;
          xT[(pch * 8 + 2 * e) * 72 + i] = f2bf(x0); xT[(pch * 8 + 2 * e + 1) * 72 + i] = f2bf(x1);
          xwT[(pch * 8 + 2 * e) * 72 + i] = f2bf(x0 * wt); xwT[(pch * 8 + 2 * e + 1) * 72 + i] = f2bf(x1 * wt);
        }
      }
      u32x4 tmpv[2] = {u32x4{0u, 0u, 0u, 0u}, u32x4{0u, 0u, 0u, 0u}};
      uint2 zr[4];
#pragma unroll
      for (int e = 0; e < 4; ++e) zr[e] = make_uint2(0u, 0u);
      if (mode == 2) {
        const int qs = (w * 4 + fq) * 16 + (15 - fr);
        const u16* tp = Y + (size_t)(rowbase + c0 + (qs >> 2)) * MIXW + hd * 64 + (qs & 3) * 16;
        tmpv[0] = *reinterpret_cast<const u32x4*>(tp); tmpv[1] = *reinterpret_cast<const u32x4*>(tp + 8);
#pragma unroll
        for (int tt = 0; tt < 4; ++tt) {
          const int t = tt * 16 + fr;
          const size_t row = (size_t)(rowbase + (sdir ? c0 + 63 - t : c0 + t));
          zr[tt] = *reinterpret_cast<const uint2*>(P + row * IND + hd * 64 + w * 16 + fq * 4);
        }
      }
      if (ci + 1 < ci1) {
        const int cL = (sdir ? nch - 2 - ci : ci + 1) * 64;
#pragma unroll
        for (int k = 0; k < 2; ++k) {
          const int id = tid + 256 * k, pch = id >> 6, i = id & 63;
          const int tau = sdir ? cL + 63 - i : cL + i;
          rx[k] = *reinterpret_cast<const u32x4*>(P + (size_t)(rowbase + tau) * IND + C_XBC + hd * 64 + pch * 8);
        }
#pragma unroll
        for (int k = 0; k < 4; ++k) {
          const int id = tid + 256 * k, nc = id >> 6, i = id & 63;
          const int tau = sdir ? cL + 63 - i : cL + i;
          rbm[k] = *reinterpret_cast<const u32x4*>(P + (size_t)(rowbase + tau) * IND + C_BM + g * 128 + nc * 8);
        }
#pragma unroll
        for (int k = 0; k < 4; ++k) {
          const int id = tid + 256 * k, i = id >> 4, nc = id & 15;
          const int tau = sdir ? cL + 63 - i : cL + i;
          rcm[k] = *reinterpret_cast<const u32x4*>(P + (size_t)(rowbase + tau) * IND + C_CM + g * 128 + nc * 8);
        }
        rawdt = P[(size_t)(rowbase + (sdir ? cL + 63 - lane : cL + lane)) * IND + C_DT + sdir * 16 + hd];
      }
      __syncthreads();
      f32x4 gacc[4];
#pragma unroll
      for (int i = 0; i < 4; ++i) gacc[i] = f32x4{0.f, 0.f, 0.f, 0.f};
#pragma unroll
      for (int kk = 0; kk < 4; ++kk) {
        bf16x8 a = ld8(Bs + (w * 16 + fr) * 136 + kk * 32 + fq * 8);
#pragma unroll
        for (int tb = 0; tb < 4; ++tb) {
          bf16x8 bb = ld8(Cs + (tb * 16 + fr) * 136 + kk * 32 + fq * 8);
          gacc[tb] = mfma16(a, bb, gacc[tb]);
        }
      }
      asm volatile("" : "+v"(tmpv[0]), "+v"(tmpv[1]));
      __syncthreads();
#pragma unroll
      for (int tb = 0; tb < 4; ++tb) {
        const int t = tb * 16 + fr;
        const float at = acs[t];
        float mv[4];
#pragma unroll
        for (int j = 0; j < 4; ++j) {
          const int s = w * 16 + fq * 4 + j;
          mv[j] = (s <= t) ? gacc[tb][j] * __expf(at - acs[s]) : 0.f;
        }
        uint2 o; o.x = pack2(mv[0], mv[1]); o.y = pack2(mv[2], mv[3]);
        *reinterpret_cast<uint2*>(Ms + t * 72 + w * 16 + fq * 4) = o;
      }
      __syncthreads();
      f32x4 yd[4], yo[4];
#pragma unroll
      for (int i = 0; i < 4; ++i) { yd[i] = f32x4{0.f, 0.f, 0.f, 0.f}; yo[i] = f32x4{0.f, 0.f, 0.f, 0.f}; }
#pragma unroll
      for (int kk = 0; kk < 2; ++kk) {
        bf16x8 bb = ld8(xT + (w * 16 + fr) * 72 + kk * 32 + fq * 8);
#pragma unroll
        for (int tt = 0; tt < 4; ++tt) {
          bf16x8 a = ld8(Ms + (tt * 16 + fr) * 72 + kk * 32 + fq * 8);
          yd[tt] = mfma16(bb, a, yd[tt]);
        }
      }
#pragma unroll
      for (int kk = 0; kk < 4; ++kk) {
        bf16x8 hb = packacc(hacc[2 * kk], hacc[2 * kk + 1]);
#pragma unroll
        for (int tt = 0; tt < 4; ++tt) {
          const u16* cr = Cs + (tt * 16 + fr) * 136 + fq * 4;
          bf16x8 a = ld44(cr + (2 * kk) * 16, cr + (2 * kk + 1) * 16);
          yo[tt] = mfma16(hb, a, yo[tt]);
        }
      }
      const float etot = __expf(tots[0]);
#pragma unroll
      for (int nb = 0; nb < 8; ++nb) { hacc[nb][0] *= etot; hacc[nb][1] *= etot; hacc[nb][2] *= etot; hacc[nb][3] *= etot; }
#pragma unroll
      for (int kk = 0; kk < 2; ++kk) {
        bf16x8 bb = ld8(xwT + (w * 16 + fr) * 72 + kk * 32 + fq * 8);
#pragma unroll
        for (int nb = 0; nb < 8; ++nb) {
          bf16x8 a = ld8(BT + (nb * 16 + fr) * 72 + kk * 32 + fq * 8);
          hacc[nb] = mfma16(a, bb, hacc[nb]);
        }
      }
      if (mode != 0) {
        float ea[4];
#pragma unroll
        for (int tt = 0; tt < 4; ++tt) ea[tt] = __expf(acs[tt * 16 + fr]);
        if (mode == 1) {
          u32x4 o0, o1;
#pragma unroll
          for (int tt = 0; tt < 4; ++tt) {
            float v[4];
#pragma unroll
            for (int j = 0; j < 4; ++j) v[j] = yd[tt][j] + ea[tt] * yo[tt][j];
            const unsigned a2 = pack2(v[0], v[1]), b2 = pack2(v[2], v[3]);
            if (tt == 0) { o0[0] = a2; o0[1] = b2; } else if (tt == 1) { o0[2] = a2; o0[3] = b2; }
            else if (tt == 2) { o1[0] = a2; o1[1] = b2; } else { o1[2] = a2; o1[3] = b2; }
          }
          const int qs = (w * 4 + fq) * 16 + fr;
          u16* tp = Y + (size_t)(rowbase + c0 + (qs >> 2)) * MIXW + hd * 64 + (qs & 3) * 16;
          *reinterpret_cast<u32x4*>(tp) = o0; *reinterpret_cast<u32x4*>(tp + 8) = o1;
        } else {
          float xsv[16], rdt[4], val[16];
#pragma unroll
          for (int tt = 0; tt < 4; ++tt) {
            rdt[tt] = rcpf(dts[tt * 16 + fr]);
#pragma unroll
            for (int j = 0; j < 4; ++j) xsv[tt * 4 + j] = bf2f(xT[(w * 16 + fq * 4 + j) * 72 + tt * 16 + fr]);
          }
          float sq[4];
#pragma unroll
          for (int tt = 0; tt < 4; ++tt) {
            const int t = tt * 16 + fr;
            const uint2 zw = zr[tt];
            const unsigned z01 = pin(zw.x), z23 = pin(zw.y);
            const float zz[4] = {bflo(z01), bfhi(z01), bflo(z23), bfhi(z23)};
            const int et = 3 - tt;
            const unsigned p01 = tmpv[et >> 1][(et & 1) * 2], p23 = tmpv[et >> 1][(et & 1) * 2 + 1];
            const float yf[4] = {bflo(p01), bfhi(p01), bflo(p23), bfhi(p23)};
            float s2 = 0.f;
#pragma unroll
            for (int j = 0; j < 4; ++j) {
              const float yv = yd[tt][j] + ea[tt] * yo[tt][j];
              const float vv = (yf[j] + yv + Dsk * xsv[tt * 4 + j] * rdt[tt]) * siluf(zz[j]);
              val[tt * 4 + j] = vv; s2 += vv * vv;
            }
            sq[tt] = s2;
            uint2 o; o.x = pack2(val[tt * 4], val[tt * 4 + 1]); o.y = pack2(val[tt * 4 + 2], val[tt * 4 + 3]);
            const int c = w * 2 + (fq >> 1);
            *reinterpret_cast<uint2*>(ystg + t * 64 + ((c ^ ((t >> 2) & 7)) << 3) + (fq & 1) * 4) = o;
          }
#pragma unroll
          for (int tt = 0; tt < 4; ++tt) {
            sq[tt] += __shfl_xor(sq[tt], 16); sq[tt] += __shfl_xor(sq[tt], 32);
          }
          if (fq == 0) {
#pragma unroll
            for (int tt = 0; tt < 4; ++tt) ssql[w * 64 + tt * 16 + fr] = sq[tt];
          }
          __syncthreads();
#pragma unroll
          for (int k = 0; k < 2; ++k) {
            const int id = tid + 256 * k, t = id >> 3, c = id & 7;
            const u32x4 v = *reinterpret_cast<const u32x4*>(ystg + t * 64 + ((c ^ ((t >> 2) & 7)) << 3));
            const size_t row = (size_t)(rowbase + (sdir ? c0 + 63 - t : c0 + t));
            *reinterpret_cast<u32x4*>(Y + row * MIXW + hd * 64 + c * 8) = v;
          }
          if (tid < 64) {
            const size_t row = (size_t)(rowbase + (sdir ? c0 + 63 - tid : c0 + tid));
            ssq[row * 16 + hd] = ssql[tid] + ssql[64 + tid] + ssql[128 + tid] + ssql[192 + tid];
          }
        }
      }
    }
  }
  if (part == 0) {
#pragma unroll
    for (int i = 0; i < 8; ++i) *reinterpret_cast<f32x4*>(stsave + (i * 256 + tid0) * 4) = hacc[i];
  }
}

__device__ void gla_item(const Params& p, int l, int part, int item, unsigned char* smem) {
  u16* qe = (u16*)smem;
  u16* ke = (u16*)(smem + 9216);
  u16* kdT = (u16*)(smem + 18432);
  u16* vT = (u16*)(smem + 27648);
  u16* at = (u16*)(smem + 46080);
  float* gl = (float*)(smem + 55296);
  float* red = (float*)(smem + 71936);
  const int tid0 = opaque_tid();
  const int b = item >> 3, h = (item >> 1) & 3, dir = item & 1;
  u16* P = (u16*)(p.ws + WS_P);
  u16* Y = (u16*)(p.ws + WS_Y);
  float* stsave = (float*)(p.ws + WS_WIN) + (size_t)(256 + item) * 8192;
  f32x4 sacc[4][2];
  if (part == 1) {
#pragma unroll
    for (int i = 0; i < 8; ++i) sacc[i >> 1][i & 1] = *reinterpret_cast<const f32x4*>(stsave + (i * 256 + tid0) * 4);
  } else {
#pragma unroll
    for (int i = 0; i < 8; ++i) sacc[i >> 1][i & 1] = f32x4{0.f, 0.f, 0.f, 0.f};
  }
  const int nseg = part == 0 ? 3 : 1;
  for (int seg = 0; seg < nseg; ++seg) {
    bool isctx; int sdir, ci0, ci1, mode;
    if (part == 1) { isctx = false; sdir = dir; ci0 = 32; ci1 = 64; mode = 2; }
    else if (seg == 0) { if (!(dir == 0 && l == 0)) continue; isctx = true; sdir = 1; ci0 = 0; ci1 = 4; mode = 1; }
    else if (seg == 1) { isctx = true; sdir = dir; ci0 = 0; ci1 = 4; mode = (dir == 0 && l == 0) ? 2 : 0; }
    else { isctx = false; sdir = dir; ci0 = 0; ci1 = 32; mode = 1; }
    if (part == 0 && seg <= 1) {
#pragma unroll
      for (int i = 0; i < 8; ++i) sacc[i >> 1][i & 1] = f32x4{0.f, 0.f, 0.f, 0.f};
    }
    __threadfence();
    __syncthreads();
    const int nch = isctx ? 4 : 64;
    const int rowbase = isctx ? NLAT + b * 256 : b * 4096;
#pragma unroll
    for (int i = 0; i < 8; ++i) asm volatile("" : "+v"(sacc[i >> 1][i & 1]));
    u32x4 rq[2], rk[2], rv[4], rlr;
    bf16x8 Bw;
    float bl;
    {
      const int tid = tid0;
      const int dcol = h * 64 + 32 * ((tid >> 6) & 1) + (tid & 31), kb = 8 * ((tid & 63) >> 5);
      const float* wlp = p.in[opq(15)] + ((size_t)((l * 2 + sdir) * 16 + kb)) * 256 + dcol;
      u32x4 bw;
#pragma unroll
      for (int e = 0; e < 4; ++e) bw[e] = pack2(wlp[(2 * e) * 256], wlp[(2 * e + 1) * 256]);
      Bw = __builtin_bit_cast(bf16x8, bw);
      bl = p.in[opq(16)][(l * 2 + sdir) * 256 + dcol];
      asm volatile("" : "+v"(Bw), "+v"(bl));
      const int cL = (sdir ? nch - 1 - ci0 : ci0) * 64;
#pragma unroll
      for (int k = 0; k < 2; ++k) {
        const int id = tid + 256 * k, i = id >> 3, dc = id & 7;
        const int tau = sdir ? cL + 63 - i : cL + i;
        rq[k] = *reinterpret_cast<const u32x4*>(P + (size_t)(rowbase + tau) * IND + C_Q + h * 64 + dc * 8);
      }
#pragma unroll
      for (int k = 0; k < 2; ++k) {
        const int id = tid + 256 * k, dc = id >> 6, i = id & 63;
        const int tau = sdir ? cL + 63 - i : cL + i;
        rk[k] = *reinterpret_cast<const u32x4*>(P + (size_t)(rowbase + tau) * IND + C_K + h * 64 + dc * 8);
      }
#pragma unroll
      for (int k = 0; k < 4; ++k) {
        const int id = tid + 256 * k, ec = id >> 6, i = id & 63;
        const int tau = sdir ? cL + 63 - i : cL + i;
        rv[k] = *reinterpret_cast<const u32x4*>(P + (size_t)(rowbase + tau) * IND + C_V + h * 128 + ec * 8);
      }
      {
        const int i = 32 * (tid >> 7) + (tid & 31), hf = (tid & 63) >> 5;
        const int tau = sdir ? cL + 63 - i : cL + i;
        rlr = *reinterpret_cast<const u32x4*>(P + (size_t)(rowbase + tau) * IND + C_LR + sdir * 16 + hf * 8);
      }
    }
    for (int ci = ci0; ci < ci1; ++ci) {
      const int c0 = (sdir ? nch - 1 - ci : ci) * 64;
      int tid = tid0;
      asm volatile("" : "+v"(tid));
      const int lane = tid & 63, w = tid >> 6, fr = lane & 15, fq = lane >> 4, d = tid & 63, iq = tid >> 6;
      __syncthreads();
      pin4(rlr);
      {
        const int th = w >> 1, dh = w & 1;
        f32x16 z;
#pragma unroll
        for (int r = 0; r < 16; ++r) z[r] = 0.f;
        const f32x16 lg = mfma32(__builtin_bit_cast(bf16x8, rlr), Bw, z);
#pragma unroll
        for (int r = 0; r < 16; ++r) {
          const int t = 32 * th + (r & 3) + 8 * (r >> 2) + 4 * (lane >> 5);
          gl[t * 65 + 32 * dh + (lane & 31)] = logsigf(lg[r] + bl) * (1.f / 16.f);
        }
      }
      __syncthreads();
      {
        float vals[16];
#pragma unroll
        for (int ii = 0; ii < 16; ++ii) vals[ii] = gl[(iq * 16 + ii) * 65 + d];
        float run = 0.f;
#pragma unroll
        for (int ii = 0; ii < 16; ++ii) { run += vals[ii]; gl[(iq * 16 + ii) * 65 + d] = run; }
        red[iq * 64 + d] = run;
      }
      __syncthreads();
      {
        float off = 0.f;
        for (int q = 0; q < iq; ++q) off += red[q * 64 + d];
        if (iq > 0) {
#pragma unroll 4
          for (int ii = 0; ii < 16; ++ii) gl[(iq * 16 + ii) * 65 + d] += off;
        }
      }
      __syncthreads();
      pin4(rq[0]); pin4(rq[1]); pin4(rk[0]); pin4(rk[1]); pin4(rv[0]); pin4(rv[1]); pin4(rv[2]); pin4(rv[3]);
#pragma unroll
      for (int k = 0; k < 2; ++k) {
        const int id = tid + 256 * k, i = id >> 3, dc = id & 7;
        u32x4 oo;
#pragma unroll
        for (int e = 0; e < 4; ++e) {
          float b0 = gl[i * 65 + dc * 8 + 2 * e], b1 = gl[i * 65 + dc * 8 + 2 * e + 1];
          oo[e] = pack2(bflo(rq[k][e]) * 0.125f * __expf(b0), bfhi(rq[k][e]) * 0.125f * __expf(b1));
        }
        *reinterpret_cast<u32x4*>(qe + i * 72 + dc * 8) = oo;
      }
#pragma unroll
      for (int k = 0; k < 2; ++k) {
        const int id = tid + 256 * k, dc = id >> 6, i = id & 63;
        u32x4 oo;
#pragma unroll
        for (int e = 0; e < 4; ++e) {
          const int d0 = dc * 8 + 2 * e;
          float b0 = gl[i * 65 + d0], b1 = gl[i * 65 + d0 + 1];
          float l0 = gl[63 * 65 + d0], l1 = gl[63 * 65 + d0 + 1];
          float k0 = bflo(rk[k][e]), k1 = bfhi(rk[k][e]);
          oo[e] = pack2(k0 * __expf(-b0), k1 * __expf(-b1));
          kdT[d0 * 72 + i] = f2bf(k0 * __expf(l0 - b0));
          kdT[(d0 + 1) * 72 + i] = f2bf(k1 * __expf(l1 - b1));
        }
        *reinterpret_cast<u32x4*>(ke + i * 72 + dc * 8) = oo;
      }
#pragma unroll
      for (int k = 0; k < 4; ++k) {
        const int id = tid + 256 * k, ec = id >> 6, i = id & 63;
#pragma unroll
        for (int e = 0; e < 4; ++e) {
          vT[(ec * 8 + 2 * e) * 72 + i] = (u16)(rv[k][e] & 0xffffu);
          vT[(ec * 8 + 2 * e + 1) * 72 + i] = (u16)(rv[k][e] >> 16);
        }
      }
      u32x4 tmpv[4];
      unsigned ggr[16];
#pragma unroll
      for (int e = 0; e < 4; ++e) tmpv[e] = u32x4{0u, 0u, 0u, 0u};
#pragma unroll
      for (int e = 0; e < 16; ++e) ggr[e] = 0u;
      if (mode == 2) {
        const int qs = (w * 4 + (3 - fq)) * 16 + fr;
        const u16* tp = Y + (size_t)(rowbase + c0 + (qs >> 2)) * MIXW + 1024 + h * 128 + (qs & 3) * 32;
#pragma unroll
        for (int e = 0; e < 4; ++e) tmpv[e] = *reinterpret_cast<const u32x4*>(tp + e * 8);
#pragma unroll
        for (int tt = 0; tt < 4; ++tt)
#pragma unroll
          for (int j = 0; j < 4; ++j) {
            const int t = tt * 16 + fq * 4 + j;
            const size_t row = (size_t)(rowbase + (sdir ? c0 + 63 - t : c0 + t));
            ggr[tt * 4 + j] = *reinterpret_cast<const unsigned*>(P + row * IND + C_GG + h * 128 + w * 32 + 2 * fr);
          }
      }
      if (ci + 1 < ci1) {
        const int cL = (sdir ? nch - 2 - ci : ci + 1) * 64;
#pragma unroll
        for (int k = 0; k < 2; ++k) {
          const int id = tid + 256 * k, i = id >> 3, dc = id & 7;
          const int tau = sdir ? cL + 63 - i : cL + i;
          rq[k] = *reinterpret_cast<const u32x4*>(P + (size_t)(rowbase + tau) * IND + C_Q + h * 64 + dc * 8);
        }
#pragma unroll
        for (int k = 0; k < 2; ++k) {
          const int id = tid + 256 * k, dc = id >> 6, i = id & 63;
          const int tau = sdir ? cL + 63 - i : cL + i;
          rk[k] = *reinterpret_cast<const u32x4*>(P + (size_t)(rowbase + tau) * IND + C_K + h * 64 + dc * 8);
        }
#pragma unroll
        for (int k = 0; k < 4; ++k) {
          const int id = tid + 256 * k, ec = id >> 6, i = id & 63;
          const int tau = sdir ? cL + 63 - i : cL + i;
          rv[k] = *reinterpret_cast<const u32x4*>(P + (size_t)(rowbase + tau) * IND + C_V + h * 128 + ec * 8);
        }
        {
          const int i = 32 * (tid >> 7) + (tid & 31), hf = (tid & 63) >> 5;
          const int tau = sdir ? cL + 63 - i : cL + i;
          rlr = *reinterpret_cast<const u32x4*>(P + (size_t)(rowbase + tau) * IND + C_LR + sdir * 16 + hf * 8);
        }
      }
      __syncthreads();
      {
        f32x4 aacc[4];
#pragma unroll
        for (int i = 0; i < 4; ++i) aacc[i] = f32x4{0.f, 0.f, 0.f, 0.f};
#pragma unroll
        for (int kk = 0; kk < 2; ++kk) {
          bf16x8 a = ld8(ke + (w * 16 + fr) * 72 + kk * 32 + fq * 8);
#pragma unroll
          for (int tb = 0; tb < 4; ++tb) {
            bf16x8 bb = ld8(qe + (tb * 16 + fr) * 72 + kk * 32 + fq * 8);
            aacc[tb] = mfma16(a, bb, aacc[tb]);
          }
        }
#pragma unroll
        for (int tb = 0; tb < 4; ++tb) {
          const int t = tb * 16 + fr;
          float mv[4];
#pragma unroll
          for (int j = 0; j < 4; ++j) { const int s = w * 16 + fq * 4 + j; mv[j] = (s <= t) ? aacc[tb][j] : 0.f; }
          uint2 o; o.x = pack2(mv[0], mv[1]); o.y = pack2(mv[2], mv[3]);
          *reinterpret_cast<uint2*>(at + t * 72 + w * 16 + fq * 4) = o;
        }
      }
      __syncthreads();
      f32x4 oacc[4][2];
#pragma unroll
      for (int i = 0; i < 4; ++i) { oacc[i][0] = f32x4{0.f, 0.f, 0.f, 0.f}; oacc[i][1] = f32x4{0.f, 0.f, 0.f, 0.f}; }
#pragma unroll
      for (int kk = 0; kk < 2; ++kk) {
        bf16x8 b0 = ld8(vT + (w * 32 + 2 * fr) * 72 + kk * 32 + fq * 8);
        bf16x8 b1 = ld8(vT + (w * 32 + 2 * fr + 1) * 72 + kk * 32 + fq * 8);
#pragma unroll
        for (int tt = 0; tt < 4; ++tt) {
          bf16x8 a = ld8(at + (tt * 16 + fr) * 72 + kk * 32 + fq * 8);
          oacc[tt][0] = mfma16(a, b0, oacc[tt][0]);
          oacc[tt][1] = mfma16(a, b1, oacc[tt][1]);
        }
      }
#pragma unroll
      for (int kk = 0; kk < 2; ++kk) {
        bf16x8 s0 = packacc(sacc[2 * kk][0], sacc[2 * kk + 1][0]);
        bf16x8 s1 = packacc(sacc[2 * kk][1], sacc[2 * kk + 1][1]);
#pragma unroll
        for (int tt = 0; tt < 4; ++tt) {
          const u16* qr = qe + (tt * 16 + fr) * 72 + fq * 4;
          bf16x8 a = ld44(qr + (2 * kk) * 16, qr + (2 * kk + 1) * 16);
          oacc[tt][0] = mfma16(a, s0, oacc[tt][0]);
          oacc[tt][1] = mfma16(a, s1, oacc[tt][1]);
        }
      }
#pragma unroll
      for (int db = 0; db < 4; ++db)
#pragma unroll
        for (int j = 0; j < 4; ++j) {
          const float sc = __expf(gl[63 * 65 + db * 16 + fq * 4 + j]);
          sacc[db][0][j] *= sc; sacc[db][1][j] *= sc;
        }
#pragma unroll
      for (int kk = 0; kk < 2; ++kk) {
        bf16x8 b0 = ld8(vT + (w * 32 + 2 * fr) * 72 + kk * 32 + fq * 8);
        bf16x8 b1 = ld8(vT + (w * 32 + 2 * fr + 1) * 72 + kk * 32 + fq * 8);
#pragma unroll
        for (int db = 0; db < 4; ++db) {
          bf16x8 a = ld8(kdT + (db * 16 + fr) * 72 + kk * 32 + fq * 8);
          sacc[db][0] = mfma16(a, b0, sacc[db][0]);
          sacc[db][1] = mfma16(a, b1, sacc[db][1]);
        }
      }
      pin4(tmpv[0]); pin4(tmpv[1]); pin4(tmpv[2]); pin4(tmpv[3]);
      if (mode != 0) {
        const int ycol = 1024 + h * 128 + w * 32 + 2 * fr;
        if (mode == 1) {
          const int qs = (w * 4 + fq) * 16 + fr;
          u16* tp = Y + (size_t)(rowbase + c0 + (qs >> 2)) * MIXW + 1024 + h * 128 + (qs & 3) * 32;
#pragma unroll
          for (int tt = 0; tt < 4; ++tt) {
            u32x4 o;
#pragma unroll
            for (int j = 0; j < 4; ++j) o[j] = pack2(oacc[tt][0][j], oacc[tt][1][j]);
            *reinterpret_cast<u32x4*>(tp + tt * 8) = o;
          }
        } else {
#pragma unroll
          for (int tt = 0; tt < 4; ++tt)
#pragma unroll
            for (int j = 0; j < 4; ++j) {
              const int t = tt * 16 + fq * 4 + j;
              const int e = 15 - (tt * 4 + j);
              const unsigned pw = tmpv[e >> 2][e & 3];
              float o0 = oacc[tt][0][j] + bflo(pw);
              float o1 = oacc[tt][1][j] + bfhi(pw);
              oacc[tt][0][j] = o0; oacc[tt][1][j] = o1;
              const float sq = row16_sum(o0 * o0 + o1 * o1);
              if (fr == 0) red[w * 64 + t] = sq;
            }
          __syncthreads();
          const float* nwv = p.in[opq(17)] + l * 128;
          const float nw0 = nwv[w * 32 + 2 * fr], nw1 = nwv[w * 32 + 2 * fr + 1];
#pragma unroll
          for (int tt = 0; tt < 4; ++tt)
#pragma unroll
            for (int j = 0; j < 4; ++j) {
              const int t = tt * 16 + fq * 4 + j;
              const size_t row = (size_t)(rowbase + (sdir ? c0 + 63 - t : c0 + t));
              const float tot = red[t] + red[64 + t] + red[128 + t] + red[192 + t];
              const float rs = rsqrtf(tot * (1.f / 128.f) + EPSF);
              const unsigned gw = pin(ggr[tt * 4 + j]);
              const float g0 = bflo(gw), g1 = bfhi(gw);
              *reinterpret_cast<unsigned*>(Y + row * MIXW + ycol) =
                  pack2(oacc[tt][0][j] * rs * nw0 * siluf(g0), oacc[tt][1][j] * rs * nw1 * siluf(g1));
            }
        }
      }
    }
  }
  if (part == 0) {
#pragma unroll
    for (int i = 0; i < 8; ++i) *reinterpret_cast<f32x4*>(stsave + (i * 256 + tid0) * 4) = sacc[i >> 1][i & 1];
  }
}

__device__ void s5_item(const Params& p, int l, int part, int blk, unsigned char* smem) {
  const int tid = opaque_tid(), lane = tid & 63, w = tid >> 6, fr = lane & 15, fq = lane >> 4;
  const int wi = blk * 4 + w;
  const int b = wi >> 6, g = (wi >> 1) & 31, dir = wi & 1;
  u16* hb = (u16*)smem + w * (32 * 136);
  u16* ust = (u16*)(smem + 4 * 32 * 136 * 2) + w * (32 * 16);
  u16* P = (u16*)(p.ws + WS_P);
  u16* Y = (u16*)(p.ws + WS_Y);
  u16* G5C = (u16*)(p.ws + WS_G5C);
  float* stsave = (float*)(p.ws + WS_S5ST) + (size_t)wi * 128;
  const float dsk = p.in[opq(25)][l * 512 + g * 16 + fr];
  float hre = 0.f, him = 0.f;
  if (part == 1) { hre = stsave[lane * 2]; him = stsave[lane * 2 + 1]; }
  const int nseg = part == 0 ? 3 : 1;
  for (int seg = 0; seg < nseg; ++seg) {
    bool isctx; int sdir, ti0, ti1, mode;
    if (part == 1) { isctx = false; sdir = dir; ti0 = 64; ti1 = 128; mode = 2; }
    else if (seg == 0) { if (!(dir == 0 && l == 0)) continue; isctx = true; sdir = 1; ti0 = 0; ti1 = 8; mode = 1; }
    else if (seg == 1) { isctx = true; sdir = dir; ti0 = 0; ti1 = 8; mode = (dir == 0 && l == 0) ? 2 : 0; }
    else { isctx = false; sdir = dir; ti0 = 0; ti1 = 64; mode = 1; }
    if (part == 0 && seg <= 1) { hre = 0.f; him = 0.f; }
    __threadfence();
    const unsigned char* cbase = p.ws + WS_S5C + (size_t)((l * 2 + sdir) * 32 + g) * 8704;
    const u16* BbarM = (const u16*)cbase;
    const u16* CmT = (const u16*)(cbase + 4096);
    const float* lamb = (const float*)(cbase + 8192);
    bf16x8 Bf[4], Cf[4];
#pragma unroll
    for (int cb = 0; cb < 4; ++cb) Bf[cb] = ld8(BbarM + (cb * 32 + (lane & 31)) * 16 + 8 * (lane >> 5));
#pragma unroll
    for (int kk = 0; kk < 4; ++kk) Cf[kk] = ld8(CmT + fr * 128 + kk * 32 + fq * 8);
    float lre = lamb[2 * lane], lim = lamb[2 * lane + 1];
#pragma unroll
    for (int i = 0; i < 4; ++i) asm volatile("" : "+v"(Bf[i]), "+v"(Cf[i]));
    asm volatile("" : "+v"(lre), "+v"(lim), "+v"(hre), "+v"(him));
    const int nt = isctx ? 8 : 128;
    const int rowbase = isctx ? NLAT + b * 256 : b * 4096;
    bf16x8 anext;
    {
      const int c0 = (sdir ? nt - 1 - ti0 : ti0) * 32, i = lane & 31;
      anext = ld8(P + (size_t)(rowbase + (sdir ? c0 + 31 - i : c0 + i)) * IND + C_U5 + g * 16 + 8 * (lane >> 5));
    }
    for (int ti = ti0; ti < ti1; ++ti) {
      const int c0 = (sdir ? nt - 1 - ti : ti) * 32;
      const bf16x8 a = anext;
      if (ti + 1 < ti1) {
        const int c1 = (sdir ? nt - 2 - ti : ti + 1) * 32, i = lane & 31;
        anext = ld8(P + (size_t)(rowbase + (sdir ? c1 + 31 - i : c1 + i)) * IND + C_U5 + g * 16 + 8 * (lane >> 5));
      }
      u32x4 tmpv = u32x4{0u, 0u, 0u, 0u};
      if (mode == 2) {
        const int qs = (3 - fq) * 16 + fr;
        tmpv = *reinterpret_cast<const u32x4*>(Y + (size_t)(rowbase + c0 + (qs >> 1)) * MIXW + 1536 + g * 16 + (qs & 1) * 8);
      }
      wave_lds_sync();
      if (mode == 2) *reinterpret_cast<bf16x8*>(ust + (lane & 31) * 16 + 8 * (lane >> 5)) = a;
#pragma unroll
      for (int cb = 0; cb < 4; ++cb) {
        f32x16 z;
#pragma unroll
        for (int r = 0; r < 16; ++r) z[r] = 0.f;
        f32x16 acc = mfma32(a, Bf[cb], z);
#pragma unroll
        for (int r = 0; r < 16; ++r) {
          const int ii = (r & 3) + 8 * (r >> 2) + 4 * (lane >> 5);
          hb[ii * 136 + cb * 32 + (lane & 31)] = f2bf(acc[r]);
        }
      }
      wave_lds_sync();
      {
        unsigned buv[32];
#pragma unroll
        for (int i = 0; i < 32; ++i) buv[i] = *reinterpret_cast<const unsigned*>(hb + i * 136 + 2 * lane);
#pragma unroll
        for (int i = 0; i < 32; ++i) {
          const float nre = lre * hre - lim * him + bflo(buv[i]);
          const float nim = lre * him + lim * hre + bfhi(buv[i]);
          hre = nre; him = nim;
          *reinterpret_cast<unsigned*>(hb + i * 136 + 2 * lane) = pack2(hre, him);
        }
      }
      wave_lds_sync();
      f32x4 ya[2];
      ya[0] = f32x4{0.f, 0.f, 0.f, 0.f}; ya[1] = f32x4{0.f, 0.f, 0.f, 0.f};
#pragma unroll
      for (int kk = 0; kk < 4; ++kk) {
        bf16x8 a0 = ld8(hb + fr * 136 + kk * 32 + fq * 8);
        bf16x8 a1 = ld8(hb + (16 + fr) * 136 + kk * 32 + fq * 8);
        ya[0] = mfma16(a0, Cf[kk], ya[0]);
        ya[1] = mfma16(a1, Cf[kk], ya[1]);
      }
      pin4(tmpv);
      if (mode == 1) {
        u32x4 o;
        o[0] = pack2(ya[0][0], ya[0][1]); o[1] = pack2(ya[0][2], ya[0][3]); o[2] = pack2(ya[1][0], ya[1][1]); o[3] = pack2(ya[1][2], ya[1][3]);
        const int qs = fq * 16 + fr;
        *reinterpret_cast<u32x4*>(Y + (size_t)(rowbase + c0 + (qs >> 1)) * MIXW + 1536 + g * 16 + (qs & 1) * 8) = o;
      } else if (mode == 2) {
#pragma unroll
        for (int rt = 0; rt < 2; ++rt)
#pragma unroll
          for (int j = 0; j < 4; ++j) {
            const int i = rt * 16 + fq * 4 + j;
            const int tau = sdir ? c0 + 31 - i : c0 + i;
            const size_t row = (size_t)(rowbase + tau);
            const int e = 7 - (rt * 4 + j);
            const unsigned pw = tmpv[e >> 1];
            const float yf = (e & 1) ? bfhi(pw) : bflo(pw);
            const float u = bf2f(ust[i * 16 + fr]);
            const float x = yf + ya[rt][j] + dsk * u;
            const float th = 1.f - 2.f * rcpf(1.f + __expf(2.f * 0.7978845608028654f * (x + 0.044715f * x * x * x)));
            const float ge = 0.5f * x * (1.f + th);
            if (isctx) G5C[(row - NLAT) * 512 + g * 16 + fr] = f2bf(ge);
            else P[row * IND + C_U5 + g * 16 + fr] = f2bf(ge);
          }
      }
    }
  }
  if (part == 0) { stsave[lane * 2] = hre; stsave[lane * 2 + 1] = him; }
}

__device__ void ssd_norm_rows(const Params& p, int nrows) {
  const int tid = opaque_tid();
  const float* ssq = (const float*)(p.ws + WS_SSQ);
  float* rsb = (float*)(p.ws + WS_RS);
  for (int i = blockIdx.x * 256 + tid; i < nrows * 2; i += gridDim.x * 256) {
    const float* sp = ssq + (size_t)i * 8;
    const float sum = sp[0] + sp[1] + sp[2] + sp[3] + sp[4] + sp[5] + sp[6] + sp[7];
    rsb[i] = rsqrtf(sum * (1.f / 512.f) + EPSF);
  }
}

__device__ void phase_final(const Params& p) {
  const int tid = opaque_tid(), lane = tid & 63, w = tid >> 6;
  const float* nw = p.in[opq(28)];
  for (int r = blockIdx.x * 4 + w; r < NLAT; r += gridDim.x * 4) {
    float* src = p.out + (size_t)r * 1024;
    float4 v[4]; float ss = 0.f;
#pragma unroll
    for (int q = 0; q < 4; ++q) {
      v[q] = *reinterpret_cast<const float4*>(src + lane * 4 + q * 256);
      ss += v[q].x * v[q].x + v[q].y * v[q].y + v[q].z * v[q].z + v[q].w * v[q].w;
    }
#pragma unroll
    for (int o = 32; o > 0; o >>= 1) ss += __shfl_xor(ss, o);
    const float rs = rsqrtf(ss * (1.f / 1024.f) + EPSF);
#pragma unroll
    for (int q = 0; q < 4; ++q) {
      const int col = lane * 4 + q * 256;
      float4 n4 = *reinterpret_cast<const float4*>(nw + col);
      float4 o = make_float4(v[q].x * rs * n4.x, v[q].y * rs * n4.y, v[q].z * rs * n4.z, v[q].w * rs * n4.w);
      *reinterpret_cast<float4*>(src + col) = o;
    }
  }
}


#define XB_TMO      128
#define XB_XCNT(j)  (256  + 64 * (j))
#define XB_XSUB(j)  (1280 + 64 * (j))
#define XB_XGEN(j)  (2304 + 64 * (j))
#define XB_TOP      3328
#define XB_TOPGEN   3392
#define XCD_BAR_WORDS 3456
#define XB_SPIN_CAP (1u << 20)
DI unsigned xb_ld(unsigned* p) { return __hip_atomic_load(p, __ATOMIC_RELAXED, __HIP_MEMORY_SCOPE_AGENT); }
DI unsigned xb_add(unsigned* p, unsigned v) { return __hip_atomic_fetch_add(p, v, __ATOMIC_RELAXED, __HIP_MEMORY_SCOPE_AGENT); }
DI unsigned xb_xcc_id() { return (unsigned)__builtin_amdgcn_s_getreg((3 << 11) | 20) & 0xFu; }
#define XB_SPIN(cond, bar) do { unsigned _sp = 0; while (cond) { __builtin_amdgcn_s_sleep(1); \
    if ((++_sp & 255u) == 0u) { if (xb_ld(&(bar)[XB_TMO])) break; if (_sp > XB_SPIN_CAP) { atomicAdd(&(bar)[XB_TMO], 1u); break; } } } } while (0)
struct XcdBarrier { unsigned* bar; unsigned x, nloc, nx; };
DI XcdBarrier xcd_barrier_post(unsigned* bar) {
  XcdBarrier b; b.bar = bar; b.x = xb_xcc_id(); b.nloc = 0u; b.nx = 0u;
  if (threadIdx.x == 0) (void)xb_add(&bar[XB_XCNT(b.x)], 1u);
  return b;
}
DI void xcd_barrier_complete(unsigned* bar, unsigned x, unsigned& nloc, unsigned& nx) {
  const unsigned G = gridDim.x;
  unsigned sum, cnt, mine, sp = 0u;
  for (;;) {
    sum = 0u; cnt = 0u; mine = 0u;
#pragma unroll
    for (unsigned j = 0; j < 16; ++j) { const unsigned c = xb_ld(&bar[XB_XCNT(j)]); sum += c; cnt += (c > 0u) ? 1u : 0u; mine = (j == x) ? c : mine; }
    if (sum == G) break;
    __builtin_amdgcn_s_sleep(1);
    if ((++sp & 255u) == 0u) { if (xb_ld(&bar[XB_TMO])) break; if (sp > XB_SPIN_CAP) { atomicAdd(&bar[XB_TMO], 1u); break; } }
  }
  nloc = mine > 0u ? mine : 1u; nx = cnt > 0u ? cnt : 1u;
}
DI void xcd_barrier(XcdBarrier& b) {
  asm volatile("s_waitcnt vmcnt(0)" ::: "memory");
  __syncthreads();
  if (threadIdx.x == 0) {
    unsigned* bar = b.bar;
    __builtin_amdgcn_s_waitcnt(0);
    if (b.nloc == 0u) xcd_barrier_complete(bar, b.x, b.nloc, b.nx);
    const unsigned nloc = b.nloc, nx = b.nx;
    const unsigned old = xb_add(&bar[XB_XSUB(b.x)], 1u);
    const unsigned gen = old / nloc;
    if (old + 1u == (gen + 1u) * nloc) {
      __builtin_amdgcn_fence(__ATOMIC_RELEASE, "agent");
      asm volatile("s_waitcnt vmcnt(0)" ::: "memory");
      const unsigned og = xb_add(&bar[XB_TOP], 1u);
      const unsigned tg = og / nx;
      if (og + 1u == (tg + 1u) * nx) xb_add(&bar[XB_TOPGEN], 1u);
      else XB_SPIN(xb_ld(&bar[XB_TOPGEN]) == tg, bar);
      __builtin_amdgcn_fence(__ATOMIC_ACQUIRE, "agent");
      xb_add(&bar[XB_XGEN(b.x)], 1u);
      asm volatile("s_waitcnt vmcnt(0)" ::: "memory");
    } else {
      XB_SPIN(xb_ld(&bar[XB_XGEN(b.x)]) == gen, bar);
      __builtin_amdgcn_fence(__ATOMIC_ACQUIRE, "agent");
      asm volatile("s_waitcnt vmcnt(0)" ::: "memory");
    }
  }
  __syncthreads();
}

__global__ void __launch_bounds__(256, 2) fwd_megakernel(Params p) {
  extern __shared__ __attribute__((aligned(16))) unsigned char smem[];
  cg::grid_group grid = cg::this_grid();
  XcdBarrier xb = xcd_barrier_post((unsigned*)(p.ws + WS_BAR));
  const int ph_lo = p.ph_lo, ph_hi = p.ph_hi;
  for (int ph = ph_lo; ph < ph_hi; ++ph) {
    if (ph == 0) {
      phase_prep(p, smem);
    } else if (ph == NPHASE - 1) {
      phase_final(p);
    } else {
      const int l = (ph - 1) / 7, sub = (ph - 1) % 7;
      const int mt = (l == 1) ? 256 : 272;
      if (sub == 0) {
        phase_pre(p, l, smem);
      } else if (sub == 1) {
        const u16* U = (const u16*)(p.ws + WS_Y);
        const u16* W = (const u16*)(p.ws + WS_WIN);
        const int xcd = blockIdx.x & 7, slot = blockIdx.x >> 3, nslots = gridDim.x >> 3;
        bool pre = false;
        for (int u = slot; u < 918; u += nslots) {
          const int pnl = u / 306, v = u % 306;
          const int u2 = u + nslots, pnl2 = u2 / 306, v2 = u2 % 306;
          const bool hn = u2 < 918;
          gemm_tile<192, 0>(p, l, U, 1024, W, 1024, 1024, (xcd * 34 + v / 9) * 128, (pnl * 9 + v % 9) * 192, smem,
                            pre, hn, U, 1024, (xcd * 34 + v2 / 9) * 128, (pnl2 * 9 + v2 % 9) * 192);
          pre = hn;
        }
      } else if (sub == 2) {
        phase_conv(p, l);
      } else if (sub == 3 || sub == 4) {
        const int part = sub - 3;
        for (int k = 0;; ++k) {
          int it;
          if (gridDim.x == 512) {
            if (k > 0) break;
            const int blk = blockIdx.x;
            const int q = blk < 256 ? blk - 64 : 192 + (blk - 448);
            const int sit = q < 128 ? q * 2 : (q < 192 ? 2 * (q - 128) : 2 * (q - 192) + 1) * 2 + 1;
            it = blk < 64 ? 256 + blk : blk < 256 ? sit : blk < 320 ? -1 : blk < 448 ? blk : sit;
          } else {
            it = blockIdx.x + k * gridDim.x;
            if (it >= 448) break;
          }
          if (it >= 0) {
            if (it < 256) ssd_item(p, l, part, it, smem);
            else if (it < 320) gla_item(p, l, part, it - 256, smem);
            else s5_item(p, l, part, it - 320, smem);
          }
          __syncthreads();
        }
      } else if (sub == 5) {
        const u16* W = (const u16*)(p.ws + WS_GLU);
        const int xcd = blockIdx.x & 7, slot = blockIdx.x >> 3, nslots = gridDim.x >> 3, mtx = mt >> 3;
        const u16* Alat = (const u16*)(p.ws + WS_P) + C_U5;
        const u16* Actx = (const u16*)(p.ws + WS_G5C) - (size_t)NLAT * 512;
        bool pre = false;
        for (int u = slot; u < mtx * 8; u += nslots) {
          const int t = (xcd * mtx) * 8 + u, t2 = t + nslots;
          const int m0 = (t >> 3) * 128, m0n = (t2 >> 3) * 128;
          const bool hn = u + nslots < mtx * 8;
          const u16* Ac = m0 < NLAT ? Alat : Actx; const int ldc = m0 < NLAT ? IND : 512;
          const u16* An = m0n < NLAT ? Alat : Actx; const int ldn = m0n < NLAT ? IND : 512;
          gemm_tile<128, 1>(p, l, Ac, ldc, W, 512, 512, m0, (t & 7) * 128, smem, pre, hn, An, ldn, m0n, (t2 & 7) * 128);
          pre = hn;
        }
        ssd_norm_rows(p, mt * 128);
      } else {
        const u16* A = (const u16*)(p.ws + WS_Y);
        const u16* W = (const u16*)(p.ws + WS_WOUT);
        const int xcd = blockIdx.x & 7, slot = blockIdx.x >> 3, nslots = gridDim.x >> 3, mtx = mt >> 3;
        bool pre = false;
        for (int u = slot; u < mtx * 8; u += nslots) {
          const int t = (xcd * mtx) * 8 + u, t2 = t + nslots;
          const bool hn = u + nslots < mtx * 8;
          gemm_tile<128, 2>(p, l, A, MIXW, W, MIXW, MIXW, (t >> 3) * 128, (t & 7) * 128, smem, pre, hn, A, MIXW, (t2 >> 3) * 128, (t2 & 7) * 128);
          pre = hn;
        }
      }
    }
    if (ph + 1 < ph_hi) {
      if (ph_hi < 0) grid.sync();
      xcd_barrier(xb);
    }
  }
}

extern "C" void kernel_launch(void* const* d_in, const int* in_sizes, int n_in, void* d_out, int out_size, void* d_ws,
                              size_t ws_size, hipStream_t stream) {
  static int grid_blocks = 0;
  if (grid_blocks == 0) {
    if (n_in != 29 || ws_size < WS_END) { fprintf(stderr, "kernel_launch: bad n_in %d / ws %zu (need %zu)\n", n_in, ws_size, (size_t)WS_END); grid_blocks = -1; return; }
    int dev = 0, cus = 0, per_cu = 0;
    hipGetDevice(&dev);
    hipDeviceGetAttribute(&cus, hipDeviceAttributeMultiprocessorCount, dev);
    hipFuncSetAttribute((const void*)fwd_megakernel, hipFuncAttributeMaxDynamicSharedMemorySize, SMEM_BYTES);
    hipOccupancyMaxActiveBlocksPerMultiprocessor(&per_cu, (const void*)fwd_megakernel, 256, SMEM_BYTES);
    if (per_cu < 1) per_cu = 1;
    if (per_cu > 2) per_cu = 2;
    grid_blocks = cus * per_cu;
    fprintf(stderr, "kernel_launch: cus %d per_cu %d grid %d\n", cus, per_cu, grid_blocks);
  }
  if (grid_blocks < 0) return;
  Params p{};
  for (int i = 0; i < 29; ++i) p.in[i] = (const float*)d_in[i];
  p.out = (float*)d_out; p.ws = (unsigned char*)d_ws; p.ph_lo = 0; p.ph_hi = NPHASE;
  if (hipMemsetAsync((char*)d_ws + WS_BAR, 0, 16384, stream) != hipSuccess) { fprintf(stderr, "kernel_launch: memset of the barrier words failed\n"); return; }
  void* args[] = {&p};
  hipError_t e = hipLaunchCooperativeKernel((const void*)fwd_megakernel, dim3(grid_blocks), dim3(256), args, SMEM_BYTES, stream);
  if (e != hipSuccess) fprintf(stderr, "cooperative launch failed: %s (grid %d)\n", hipGetErrorString(e), grid_blocks);
}
```

```cpp
#include <hip/hip_runtime.h>
#include <hip/hip_cooperative_groups.h>
#include <cstdio>
namespace cg = cooperative_groups;

typedef unsigned short u16;
using bf16x8 = __attribute__((ext_vector_type(8))) short;
using bf16x4 = __attribute__((ext_vector_type(4))) short;
using f32x4 = __attribute__((ext_vector_type(4))) float;
using f32x16 = __attribute__((ext_vector_type(16))) float;
using u32x4 = __attribute__((ext_vector_type(4))) unsigned;
#define DI __device__ __forceinline__

constexpr int DM = 1024, NLAT = 32768, NCTX = 2048, NTOK = 34816, IND = 5184, MIXW = 2048;
constexpr int C_XBC = 1024, C_BM = 2048, C_CM = 2304, C_DT = 2560, C_Q = 2592, C_K = 2848, C_V = 3104, C_GG = 3616,
              C_LR = 4128, C_U5 = 4160, C_SG = 4672;
constexpr float EPSF = 1e-6f;
constexpr int SMEM_BYTES = 81920;
constexpr int NPHASE = 16;

constexpr size_t WS_P = 0;
constexpr size_t WS_Y = WS_P + (size_t)NTOK * IND * 2;
constexpr size_t WS_WIN = WS_Y + (size_t)NTOK * MIXW * 2;
constexpr size_t WS_WOUT = WS_WIN + (size_t)IND * DM * 2;
constexpr size_t WS_GLU = WS_WOUT + (size_t)DM * MIXW * 2;
constexpr size_t WS_HCTX = WS_GLU + (size_t)1024 * 512 * 2;
constexpr size_t WS_MOD = WS_HCTX + (size_t)NCTX * DM * 4;
constexpr size_t WS_SSQ = WS_MOD + (size_t)2 * 9 * 3072 * 4;
constexpr size_t WS_S5C = WS_SSQ + (size_t)NTOK * 16 * 4;
constexpr size_t WS_G5C = WS_S5C + (size_t)128 * 8704;
constexpr size_t WS_S5ST = WS_G5C + (size_t)NCTX * 512 * 2;
constexpr size_t WS_BAR = WS_S5ST + (size_t)512 * 128 * 4;
constexpr size_t WS_RS = WS_BAR + 16384;
constexpr size_t WS_END = WS_RS + (size_t)NTOK * 2 * 4;

struct Params {
  const float* in[29];
  float* out;
  unsigned char* ws;
  int ph_lo, ph_hi;
};

DI int opq(int i) { asm volatile("" : "+s"(i)); return i; }
DI int opaque_tid() { int t = threadIdx.x; asm volatile("" : "+v"(t)); return t; }
typedef __bf16 hbf16x2 __attribute__((ext_vector_type(2)));
typedef float hf32x2 __attribute__((ext_vector_type(2)));
DI u16 f2bf(float x) { __bf16 h = (__bf16)x; return __builtin_bit_cast(u16, h); }
DI float bf2f(u16 h) { return __uint_as_float(((unsigned)h) << 16); }
DI unsigned pack2(float a, float b) { hf32x2 v = {a, b}; return __builtin_bit_cast(unsigned, __builtin_convertvector(v, hbf16x2)); }
DI float bflo(unsigned v) { return __uint_as_float(v << 16); }
DI float bfhi(unsigned v) { return __uint_as_float(v & 0xffff0000u); }
DI float rcpf(float x) { return __builtin_amdgcn_rcpf(x); }
DI float siluf(float x) { return x * rcpf(1.f + __expf(-x)); }
DI float logsigf(float x) { return fminf(x, 0.f) - __logf(1.f + __expf(-fabsf(x))); }
DI float softplusf(float v) { return fmaxf(v, 0.f) + log1pf(__expf(-fabsf(v))); }
DI f32x4 mfma16(bf16x8 a, bf16x8 b, f32x4 c) { return __builtin_amdgcn_mfma_f32_16x16x32_bf16(a, b, c, 0, 0, 0); }
DI f32x16 mfma32(bf16x8 a, bf16x8 b, f32x16 c) { return __builtin_amdgcn_mfma_f32_32x32x16_bf16(a, b, c, 0, 0, 0); }
DI void wave_lds_sync() { asm volatile("s_waitcnt lgkmcnt(0)" ::: "memory"); }
DI unsigned pin(unsigned v) { asm volatile("" : "+v"(v)); return v; }
DI void pin4(u32x4& v) { asm volatile("" : "+v"(v)); }
#define DPPF(v, old, ctrl, rmask) __builtin_bit_cast(float, __builtin_amdgcn_update_dpp(__builtin_bit_cast(int, (float)(old)), __builtin_bit_cast(int, (float)(v)), (ctrl), (rmask), 0xf, false))
DI float row16_sum(float v) {
  v += DPPF(v, 0.f, 0xB1, 0xf);
  v += DPPF(v, 0.f, 0x4E, 0xf);
  v += DPPF(v, 0.f, 0x141, 0xf);
  v += DPPF(v, 0.f, 0x140, 0xf);
  return v;
}
DI float wave_incl_scan(float v) {
  v += DPPF(v, 0.f, 0x111, 0xf);
  v += DPPF(v, 0.f, 0x112, 0xf);
  v += DPPF(v, 0.f, 0x114, 0xf);
  v += DPPF(v, 0.f, 0x118, 0xf);
  v += DPPF(v, 0.f, 0x142, 0xa);
  v += DPPF(v, 0.f, 0x143, 0xc);
  return v;
}
DI bf16x8 ld8(const u16* p) { return *reinterpret_cast<const bf16x8*>(p); }
DI bf16x8 ld44(const u16* p0, const u16* p1) {
  bf16x4 a = *reinterpret_cast<const bf16x4*>(p0), b = *reinterpret_cast<const bf16x4*>(p1);
  return __builtin_shufflevector(a, b, 0, 1, 2, 3, 4, 5, 6, 7);
}
DI bf16x8 packacc(const f32x4& a, const f32x4& b) {
  uint4 u; u.x = pack2(a[0], a[1]); u.y = pack2(a[2], a[3]); u.z = pack2(b[0], b[1]); u.w = pack2(b[2], b[3]);
  return __builtin_bit_cast(bf16x8, u);
}

__device__ void phase_prep(const Params& p, unsigned char* smem) {
  float* sc = (float*)smem;
  float* red = sc + 9 * 1024;
  const int tid = opaque_tid();
  float* modb = (float*)(p.ws + WS_MOD);
  bool filled = false;
  for (int it = blockIdx.x; it < 96 + 128; it += gridDim.x) {
    if (it < 96) {
      if (!filled) {
        for (int idx = tid; idx < 9216; idx += 256) {
          int r = idx >> 10, k = idx & 1023;
          float v = r < 8 ? p.in[opq(1)][r * 1024 + k] : p.in[opq(3)][k];
          sc[idx] = siluf(v);
        }
        filled = true;
        __syncthreads();
      }
      const int l = it / 48, j0 = (it % 48) * 64, kg = tid >> 6, jj = tid & 63;
      float a[9];
#pragma unroll
      for (int r = 0; r < 9; ++r) a[r] = 0.f;
      const float* W = p.in[opq(5)] + (size_t)l * 1024 * 3072 + j0 + jj;
      for (int k = kg * 256; k < kg * 256 + 256; ++k) {
        float wv = W[(size_t)k * 3072];
#pragma unroll
        for (int r = 0; r < 9; ++r) a[r] += sc[r * 1024 + k] * wv;
      }
#pragma unroll
      for (int r = 0; r < 9; ++r) red[(kg * 9 + r) * 64 + jj] = a[r];
      __syncthreads();
      for (int idx = tid; idx < 576; idx += 256) {
        int r = idx >> 6, j = idx & 63;
        float s = red[(0 * 9 + r) * 64 + j] + red[(1 * 9 + r) * 64 + j] + red[(2 * 9 + r) * 64 + j] + red[(3 * 9 + r) * 64 + j];
        modb[(l * 9 + r) * 3072 + j0 + j] = s + p.in[opq(6)][l * 3072 + j0 + j];
      }
      __syncthreads();
    } else {
      const int q = it - 96, l = q >> 6, d = (q >> 5) & 1, g = q & 31;
      unsigned char* base = p.ws + WS_S5C + (size_t)q * 8704;
      u16* BbarM = (u16*)base;
      u16* CmT = (u16*)(base + 4096);
      float* lamb = (float*)(base + 8192);
      const float st = expf(p.in[opq(20)][(l * 2 + d) * 32 + g]);
      for (int idx = tid; idx < 1024; idx += 256) {
        const int pp = idx >> 4, hh = idx & 15;
        const int li = ((l * 2 + d) * 32 + g) * 64 + pp;
        const float lre = p.in[opq(18)][li], lim = p.in[opq(19)][li];
        const float a = lre * st, bb = lim * st;
        const float ea = expf(a), sn = sinf(bb), cs = cosf(bb), s2 = sinf(0.5f * bb);
        const float lbre = ea * cs, lbim = ea * sn;
        const float nre = expm1f(a) * cs - 2.f * s2 * s2, nim = lbim;
        const float den = lre * lre + lim * lim;
        const float cre = (nre * lre + nim * lim) / den, cim = (nim * lre - nre * lim) / den;
        const int bi = ((l * 32 + g) * 64 + pp) * 16 + hh;
        const float bre = p.in[opq(21)][bi], bim = p.in[opq(22)][bi];
        BbarM[(2 * pp) * 16 + hh] = f2bf(cre * bre - cim * bim);
        BbarM[(2 * pp + 1) * 16 + hh] = f2bf(cre * bim + cim * bre);
        const int cidx = (((l * 2 + d) * 32 + g) * 16 + hh) * 64 + pp;
        CmT[hh * 128 + 2 * pp] = f2bf(p.in[opq(23)][cidx]);
        CmT[hh * 128 + 2 * pp + 1] = f2bf(-p.in[opq(24)][cidx]);
        if (hh == 0) { lamb[2 * pp] = lbre; lamb[2 * pp + 1] = lbim; }
      }
    }
  }
}

__device__ void phase_pre(const Params& p, int l, unsigned char* smem) {
  const int tid = opaque_tid(), lane = tid & 63, w = tid >> 6;
  const float* hl = l == 0 ? p.in[opq(0)] : p.out;
  const float* hc = l == 0 ? p.in[opq(2)] : (const float*)(p.ws + WS_HCTX);
  const float* nw = p.in[opq(4)] + l * 1024;
  const float* modb = (const float*)(p.ws + WS_MOD) + l * 9 * 3072;
  u16* U = (u16*)(p.ws + WS_Y);
  const bool cm = (l & 1);
  for (int r = blockIdx.x * 4 + w; r < NTOK; r += gridDim.x * 4) {
    const float* src; const float* mrow;
    if (r < NLAT) {
      int b = r >> 12, sp = r & 4095;
      int s = cm ? (((sp & 63) << 6) | (sp >> 6)) : sp;
      src = hl + ((size_t)(b * 4096 + s)) * 1024; mrow = modb + b * 3072;
    } else { src = hc + (size_t)(r - NLAT) * 1024; mrow = modb + 8 * 3072; }
    float4 v[4]; float ss = 0.f;
#pragma unroll
    for (int q = 0; q < 4; ++q) {
      v[q] = *reinterpret_cast<const float4*>(src + lane * 4 + q * 256);
      ss += v[q].x * v[q].x + v[q].y * v[q].y + v[q].z * v[q].z + v[q].w * v[q].w;
    }
#pragma unroll
    for (int o = 32; o > 0; o >>= 1) ss += __shfl_xor(ss, o);
    const float rs = rsqrtf(ss * (1.f / 1024.f) + EPSF);
#pragma unroll
    for (int q = 0; q < 4; ++q) {
      const int col = lane * 4 + q * 256;
      float4 n4 = *reinterpret_cast<const float4*>(nw + col);
      float4 sh = *reinterpret_cast<const float4*>(mrow + col);
      float4 s4 = *reinterpret_cast<const float4*>(mrow + 1024 + col);
      float u0 = v[q].x * rs * n4.x * (1.f + s4.x) + sh.x;
      float u1 = v[q].y * rs * n4.y * (1.f + s4.y) + sh.y;
      float u2 = v[q].z * rs * n4.z * (1.f + s4.z) + sh.z;
      float u3 = v[q].w * rs * n4.w * (1.f + s4.w) + sh.w;
      uint2 o; o.x = pack2(u0, u1); o.y = pack2(u2, u3);
      *reinterpret_cast<uint2*>(U + (size_t)r * 1024 + col) = o;
    }
  }
  float* tile = (float*)smem;
  for (int t = blockIdx.x; t < 1296 + 512 + 128; t += gridDim.x) {
    const float* src; int sld, k0, n0, kind; u16* dst; int dld;
    if (t < 1296) { kind = 0; k0 = (t / 81) * 64; n0 = (t % 81) * 64; src = p.in[opq(7)] + (size_t)l * 1024 * IND; sld = IND; dst = (u16*)(p.ws + WS_WIN); dld = 1024; }
    else if (t < 1808) { int q = t - 1296; kind = 1; k0 = (q / 16) * 64; n0 = (q % 16) * 64; src = p.in[opq(8)] + (size_t)l * 2048 * 1024; sld = 1024; dst = (u16*)(p.ws + WS_WOUT); dld = 2048; }
    else { int q = t - 1808; kind = 2; k0 = (q / 16) * 64; n0 = (q % 16) * 64; src = p.in[opq(26)] + (size_t)l * 512 * 1024; sld = 1024; dst = (u16*)(p.ws + WS_GLU); dld = 512; }
    __syncthreads();
#pragma unroll
    for (int rr = 0; rr < 4; ++rr) {
      int i = (tid >> 4) + 16 * rr, j = (tid & 15) * 4;
      float4 v = *reinterpret_cast<const float4*>(src + (size_t)(k0 + i) * sld + n0 + j);
      if (kind == 1 && k0 + i < 1024) { float s = p.in[opq(14)][l * 1024 + k0 + i]; v.x *= s; v.y *= s; v.z *= s; v.w *= s; }
      tile[i * 65 + j] = v.x; tile[i * 65 + j + 1] = v.y; tile[i * 65 + j + 2] = v.z; tile[i * 65 + j + 3] = v.w;
    }
    __syncthreads();
#pragma unroll
    for (int rr = 0; rr < 2; ++rr) {
      int n = (tid >> 3) + 32 * rr, i0 = (tid & 7) * 8;
      uint4 o;
      o.x = pack2(tile[(i0 + 0) * 65 + n], tile[(i0 + 1) * 65 + n]);
      o.y = pack2(tile[(i0 + 2) * 65 + n], tile[(i0 + 3) * 65 + n]);
      o.z = pack2(tile[(i0 + 4) * 65 + n], tile[(i0 + 5) * 65 + n]);
      o.w = pack2(tile[(i0 + 6) * 65 + n], tile[(i0 + 7) * 65 + n]);
      int drow = n0 + n;
      if (kind == 2) { int o_ = n0 + n, half = o_ >> 9, rem = o_ & 511; drow = (rem >> 6) * 128 + ((rem & 63) >> 4) * 32 + half * 16 + (rem & 15); }
      *reinterpret_cast<uint4*>(dst + (size_t)drow * dld + k0 + i0) = o;
    }
  }
}

template <int BN, int MODE>
__device__ void gemm_tile(const Params& p, int l, const u16* __restrict__ A, int lda, const u16* __restrict__ Bt, int ldb,
                          int K, int m0, int n0, unsigned char* smem,
                          bool pre, bool has_next, const u16* __restrict__ An, int ldan, int m0n, int n0n) {
  constexpr int WN = BN / 2, NF = WN / 16, NBL = BN * 8 / 256;
  u16* As = (u16*)smem;
  u16* Bs = As + 128 * 64;
  const int tid = opaque_tid(), lane = tid & 63, w = tid >> 6, wr = w >> 1, wc = w & 1, fr = lane & 15, fq = lane >> 4;
  f32x4 acc[4][NF];
#pragma unroll
  for (int m = 0; m < 4; ++m)
#pragma unroll
    for (int n = 0; n < NF; ++n) acc[m][n] = f32x4{0.f, 0.f, 0.f, 0.f};
  constexpr int STAGE = (128 + BN) * 64;
  const int nk = K / 64;
#define GLDS(OFF, KT) do { const int k0_ = (KT) * 64; \
    _Pragma("unroll") for (int i = 0; i < 4; ++i) { const int id = tid + 256 * i, row = id >> 3, c = (id & 7) ^ ((id >> 4) & 7); \
      __builtin_amdgcn_global_load_lds((const unsigned*)(A + (size_t)(m0 + row) * lda + k0_ + c * 8), (unsigned*)(As + (OFF) + id * 8), 16, 0, 0); } \
    _Pragma("unroll") for (int i = 0; i < NBL; ++i) { const int id = tid + 256 * i, row = id >> 3, c = (id & 7) ^ ((id >> 4) & 7); \
      __builtin_amdgcn_global_load_lds((const unsigned*)(Bt + (size_t)(n0 + row) * ldb + k0_ + c * 8), (unsigned*)(Bs + (OFF) + id * 8), 16, 0, 0); } } while (0)
#define COMPUTE(OFF) do { \
    bf16x8 af[2][4], bfr[2][NF];        \
    _Pragma("unroll") for (int kk = 0; kk < 2; ++kk) { \
      _Pragma("unroll") for (int m = 0; m < 4; ++m) af[kk][m] = ld8(As + (OFF) + (wr * 64 + m * 16 + fr) * 64 + (((kk * 4 + fq) ^ (fr >> 1)) * 8)); \
      _Pragma("unroll") for (int n = 0; n < NF; ++n) bfr[kk][n] = ld8(Bs + (OFF) + (wc * WN + n * 16 + fr) * 64 + (((kk * 4 + fq) ^ (fr >> 1)) * 8)); } \
    __builtin_amdgcn_s_setprio(1); \
    _Pragma("unroll") for (int kk = 0; kk < 2; ++kk) \
      _Pragma("unroll") for (int m = 0; m < 4; ++m) \
        _Pragma("unroll") for (int n = 0; n < NF; ++n) acc[m][n] = mfma16(bfr[kk][n], af[kk][m], acc[m][n]); \
    __builtin_amdgcn_s_setprio(0); } while (0)
  float f0[4], f1[4];
  if constexpr (MODE == 2) {
    const float* rsb = (const float*)(p.ws + WS_RS);
#pragma unroll
    for (int m = 0; m < 4; ++m) {
      const float2 r2 = *reinterpret_cast<const float2*>(rsb + (size_t)(m0 + wr * 64 + m * 16 + fr) * 2);
      f0[m] = r2.x * rcpf(r2.y); f1[m] = r2.y;
    }
  }
  __syncthreads();
  if (!pre) GLDS(0, 0);
  asm volatile("s_waitcnt vmcnt(0)" ::: "memory");
  __syncthreads();
  for (int kt = 0; kt < nk; ++kt) {
    const int cur = (kt & 1) * STAGE, nxt = STAGE - cur;
    if (kt + 1 < nk) GLDS(nxt, kt + 1);
    else if (has_next) {
#pragma unroll
      for (int i = 0; i < 4; ++i) { const int id = tid + 256 * i, row = id >> 3, c = (id & 7) ^ ((id >> 4) & 7);
        __builtin_amdgcn_global_load_lds((const unsigned*)(An + (size_t)(m0n + row) * ldan + c * 8), (unsigned*)(As + id * 8), 16, 0, 0); }
#pragma unroll
      for (int i = 0; i < NBL; ++i) { const int id = tid + 256 * i, row = id >> 3, c = (id & 7) ^ ((id >> 4) & 7);
        __builtin_amdgcn_global_load_lds((const unsigned*)(Bt + (size_t)(n0n + row) * ldb + c * 8), (unsigned*)(Bs + id * 8), 16, 0, 0); }
    }
    COMPUTE(cur);
    if constexpr (MODE == 2) {
      if (kt == 7 || kt == 15) {
#pragma unroll
        for (int m = 0; m < 4; ++m)
#pragma unroll
          for (int n = 0; n < NF; ++n)
#pragma unroll
            for (int j = 0; j < 4; ++j) acc[m][n][j] *= (kt == 7) ? f0[m] : f1[m];
      }
    }
    if (kt + 1 < nk) asm volatile("s_waitcnt vmcnt(0)" ::: "memory");
    __syncthreads();
  }
#define GLOAD(x)
#define LSTORE(x)
#undef GLOAD
#undef LSTORE
#undef COMPUTE
  if constexpr (MODE == 0) {
    u16* P = (u16*)(p.ws + WS_P);
    constexpr int SLD = WN + 8;
    u16* stg = (u16*)smem + STAGE + w * 16 * SLD;
    constexpr int CPR = WN / 8;
    __syncthreads();
#pragma unroll
    for (int m = 0; m < 4; ++m) {
      wave_lds_sync();
#pragma unroll
      for (int n = 0; n < NF; ++n) {
        uint2 o; o.x = pack2(acc[m][n][0], acc[m][n][1]); o.y = pack2(acc[m][n][2], acc[m][n][3]);
        *reinterpret_cast<uint2*>(stg + fr * SLD + n * 16 + fq * 4) = o;
      }
      wave_lds_sync();
      for (int id = lane; id < 16 * CPR; id += 64) {
        int row = id / CPR, ch = id % CPR;
        uint4 v = *reinterpret_cast<const uint4*>(stg + row * SLD + ch * 8);
        *reinterpret_cast<uint4*>(P + (size_t)(m0 + wr * 64 + m * 16 + row) * IND + n0 + wc * WN + ch * 8) = v;
      }
    }
  } else if constexpr (MODE == 1) {
    const u16* P = (const u16*)(p.ws + WS_P);
    u16* Y = (u16*)(p.ws + WS_Y);
    const float* gb = p.in[opq(27)] + l * 1024;
    const int tn = n0 >> 7;
#pragma unroll
    for (int q = 0; q < 2; ++q) {
      const int oc = tn * 64 + (wc * 2 + q) * 16 + fq * 4;
      const f32x4 b0 = *reinterpret_cast<const f32x4*>(gb + oc), b1 = *reinterpret_cast<const f32x4*>(gb + 512 + oc);
#pragma unroll
      for (int m = 0; m < 4; ++m) {
        const size_t row = (size_t)(m0 + wr * 64 + m * 16 + fr);
        const uint2 sgv = *reinterpret_cast<const uint2*>(P + row * IND + C_SG + oc);
        const float sg[4] = {bflo(sgv.x), bfhi(sgv.x), bflo(sgv.y), bfhi(sgv.y)};
        float y[4];
#pragma unroll
        for (int j = 0; j < 4; ++j) {
          const float val = acc[m][2 * q][j] + b0[j], gt = acc[m][2 * q + 1][j] + b1[j];
          y[j] = val * rcpf(1.f + __expf(-gt)) * siluf(sg[j]);
        }
        uint2 o; o.x = pack2(y[0], y[1]); o.y = pack2(y[2], y[3]);
        *reinterpret_cast<uint2*>(Y + row * MIXW + 1536 + oc) = o;
      }
    }
  } else {
    const float* modb = (const float*)(p.ws + WS_MOD) + l * 9 * 3072;
    const bool cm = (l & 1);
    const float* hs = l == 0 ? p.in[opq(0)] : p.out;
    float* stg = (float*)((u16*)smem + STAGE) + w * (16 * 68);
    __syncthreads();
#pragma unroll
    for (int m = 0; m < 4; ++m) {
#pragma unroll
      for (int n = 0; n < NF; ++n) *reinterpret_cast<f32x4*>(stg + fr * 68 + n * 16 + fq * 4) = acc[m][n];
      wave_lds_sync();
#pragma unroll
      for (int k = 0; k < 4; ++k) {
        const int id = lane + 64 * k, rowi = id >> 4, ch = id & 15;
        const f32x4 a = *reinterpret_cast<const f32x4*>(stg + rowi * 68 + ch * 4);
        const int r = m0 + wr * 64 + m * 16 + rowi, col = n0 + wc * WN + ch * 4;
        const float* src; float* dst; const float* gt;
        if (r < NLAT) {
          const int b = r >> 12, sp = r & 4095;
          const int sq = cm ? (((sp & 63) << 6) | (sp >> 6)) : sp;
          const size_t idx = ((size_t)(b * 4096 + sq)) * 1024 + col;
          src = hs + idx; dst = p.out + idx; gt = modb + b * 3072 + 2048 + col;
        } else {
          const size_t idx = (size_t)(r - NLAT) * 1024 + col;
          src = p.in[opq(2)] + idx; dst = (float*)(p.ws + WS_HCTX) + idx; gt = modb + 8 * 3072 + 2048 + col;
        }
        const f32x4 h = *reinterpret_cast<const f32x4*>(src), gv = *reinterpret_cast<const f32x4*>(gt);
        f32x4 o;
        o[0] = h[0] + gv[0] * a[0]; o[1] = h[1] + gv[1] * a[1]; o[2] = h[2] + gv[2] * a[2]; o[3] = h[3] + gv[3] * a[3];
        *reinterpret_cast<f32x4*>(dst) = o;
      }
      wave_lds_sync();
    }
  }
  __syncthreads();
}

__device__ void phase_conv(const Params& p, int l) {
  u16* P = (u16*)(p.ws + WS_P);
  const float* cw = p.in[opq(9)] + (size_t)l * 5 * 1536;
  const float* cb = p.in[opq(10)] + l * 1536;
  const int tid = opaque_tid(), cq = tid & 7, sgi = tid >> 3;
  for (int it = blockIdx.x; it < 768; it += gridDim.x) {
    const bool isctx = it >= 384;
    const int q = isctx ? it - 384 : it, b = q / 48, cgp = q % 48;
    const int L = isctx ? 256 : 4096, seg = L / 32, rowbase = isctx ? NLAT + b * 256 : b * 4096;
    const int ch = cgp * 32 + cq * 4;
    float4 wk[5];
#pragma unroll
    for (int k = 0; k < 5; ++k) wk[k] = *reinterpret_cast<const float4*>(cw + k * 1536 + ch);
    const float4 bias = *reinterpret_cast<const float4*>(cb + ch);
    u16* rp = P + (size_t)rowbase * IND + C_XBC + ch;
    const int a = sgi * seg;
    auto ld = [&](int sp) -> float4 {
      float4 r = make_float4(0.f, 0.f, 0.f, 0.f);
      if (sp >= 0 && sp < L) {
        uint2 v = *reinterpret_cast<const uint2*>(rp + (size_t)sp * IND);
        r.x = bflo(v.x); r.y = bfhi(v.x); r.z = bflo(v.y); r.w = bfhi(v.y);
      }
      return r;
    };
    float4 r0 = ld(a - 2), r1 = ld(a - 1), r2 = ld(a), r3 = ld(a + 1);
    const float4 e0 = ld(a + seg), e1 = ld(a + seg + 1);
    __syncthreads();
    auto ldraw = [&](int sp) -> uint2 {
      uint2 v = make_uint2(0u, 0u);
      if (sp < a + seg) v = *reinterpret_cast<const uint2*>(rp + (size_t)sp * IND);
      return v;
    };
    uint2 nraw[8];
#pragma unroll
    for (int j = 0; j < 8; ++j) nraw[j] = ldraw(a + 2 + j);
    for (int t0 = a; t0 < a + seg; t0 += 8) {
      uint2 cur[8];
#pragma unroll
      for (int j = 0; j < 8; ++j) cur[j] = nraw[j];
      if (t0 + 8 < a + seg) {
#pragma unroll
        for (int j = 0; j < 8; ++j) nraw[j] = ldraw(t0 + 10 + j);
      }
#pragma unroll
      for (int j = 0; j < 8; ++j) {
        const int sp = t0 + 2 + j;
        float4 r4;
        if (sp < a + seg) {
          const unsigned c0_ = pin(cur[j].x), c1_ = pin(cur[j].y);
          r4 = make_float4(bflo(c0_), bfhi(c0_), bflo(c1_), bfhi(c1_));
        } else r4 = (sp == a + seg) ? e0 : e1;
        float o0 = bias.x + wk[0].x * r0.x + wk[1].x * r1.x + wk[2].x * r2.x + wk[3].x * r3.x + wk[4].x * r4.x;
        float o1 = bias.y + wk[0].y * r0.y + wk[1].y * r1.y + wk[2].y * r2.y + wk[3].y * r3.y + wk[4].y * r4.y;
        float o2 = bias.z + wk[0].z * r0.z + wk[1].z * r1.z + wk[2].z * r2.z + wk[3].z * r3.z + wk[4].z * r4.z;
        float o3 = bias.w + wk[0].w * r0.w + wk[1].w * r1.w + wk[2].w * r2.w + wk[3].w * r3.w + wk[4].w * r4.w;
        uint2 o; o.x = pack2(siluf(o0), siluf(o1)); o.y = pack2(siluf(o2), siluf(o3));
        *reinterpret_cast<uint2*>(rp + (size_t)(t0 + j) * IND) = o;
        r0 = r1; r1 = r2; r2 = r3; r3 = r4;
      }
    }
    __syncthreads();
  }
}


__device__ void ssd_item(const Params& p, int l, int part, int item, unsigned char* smem) {
  u16* Bs = (u16*)smem;
  u16* Ms = Bs;
  u16* Cs = (u16*)(smem + 17408);
  u16* BT = (u16*)(smem + 34816);
  u16* xT = (u16*)(smem + 53248);
  u16* xwT = (u16*)(smem + 62464);
  float* dts = (float*)(smem + 71680);
  float* acs = dts + 64;
  float* wts = acs + 64;
  float* ssql = wts + 64;
  float* tots = ssql + 256;
  u16* ystg = (u16*)(smem + 73600);
  const int tid0 = opaque_tid();
  const int b = item >> 5, hd = (item >> 1) & 15, dir = item & 1, g = hd >> 3;
  u16* P = (u16*)(p.ws + WS_P);
  u16* Y = (u16*)(p.ws + WS_Y);
  float* ssq = (float*)(p.ws + WS_SSQ);
  float* stsave = (float*)(p.ws + WS_WIN) + (size_t)item * 8192;
  const float Dsk = p.in[opq(13)][l * 16 + hd];
  f32x4 hacc[8];
  if (part == 1) {
#pragma unroll
    for (int i = 0; i < 8; ++i) hacc[i] = *reinterpret_cast<const f32x4*>(stsave + (i * 256 + tid0) * 4);
  } else {
#pragma unroll
    for (int i = 0; i < 8; ++i) hacc[i] = f32x4{0.f, 0.f, 0.f, 0.f};
  }
  const int nseg = part == 0 ? 3 : 1;
  for (int seg = 0; seg < nseg; ++seg) {
    bool isctx; int sdir, ci0, ci1, mode;
    if (part == 1) { isctx = false; sdir = dir; ci0 = 32; ci1 = 64; mode = 2; }
    else if (seg == 0) { if (!(dir == 0 && l == 0)) continue; isctx = true; sdir = 1; ci0 = 0; ci1 = 4; mode = 1; }
    else if (seg == 1) { isctx = true; sdir = dir; ci0 = 0; ci1 = 4; mode = (dir == 0 && l == 0) ? 2 : 0; }
    else { isctx = false; sdir = dir; ci0 = 0; ci1 = 32; mode = 1; }
    if (part == 0 && seg <= 1) {
#pragma unroll
      for (int i = 0; i < 8; ++i) hacc[i] = f32x4{0.f, 0.f, 0.f, 0.f};
    }
    __threadfence();
    __syncthreads();
    const float aneg = -expf(p.in[opq(11)][(l * 2 + sdir) * 16 + hd]);
    const float dtb = p.in[opq(12)][(l * 2 + sdir) * 16 + hd];
    const int nch = isctx ? 4 : 64;
    const int rowbase = isctx ? NLAT + b * 256 : b * 4096;
#pragma unroll
    for (int i = 0; i < 8; ++i) asm volatile("" : "+v"(hacc[i]));
    u32x4 rx[2], rbm[4], rcm[4];
    unsigned rawdt = 0u;
    {
      const int tid = tid0, lane = tid & 63, w = tid >> 6;
      const int cL = (sdir ? nch - 1 - ci0 : ci0) * 64;
#pragma unroll
      for (int k = 0; k < 2; ++k) {
        const int id = tid + 256 * k, pch = id >> 6, i = id & 63;
        const int tau = sdir ? cL + 63 - i : cL + i;
        rx[k] = *reinterpret_cast<const u32x4*>(P + (size_t)(rowbase + tau) * IND + C_XBC + hd * 64 + pch * 8);
      }
#pragma unroll
      for (int k = 0; k < 4; ++k) {
        const int id = tid + 256 * k, nc = id >> 6, i = id & 63;
        const int tau = sdir ? cL + 63 - i : cL + i;
        rbm[k] = *reinterpret_cast<const u32x4*>(P + (size_t)(rowbase + tau) * IND + C_BM + g * 128 + nc * 8);
      }
#pragma unroll
      for (int k = 0; k < 4; ++k) {
        const int id = tid + 256 * k, i = id >> 4, nc = id & 15;
        const int tau = sdir ? cL + 63 - i : cL + i;
        rcm[k] = *reinterpret_cast<const u32x4*>(P + (size_t)(rowbase + tau) * IND + C_CM + g * 128 + nc * 8);
      }
      rawdt = P[(size_t)(rowbase + (sdir ? cL + 63 - lane : cL + lane)) * IND + C_DT + sdir * 16 + hd];
    }
    for (int ci = ci0; ci < ci1; ++ci) {
      const int c0 = (sdir ? nch - 1 - ci : ci) * 64;
      int tid = tid0;
      asm volatile("" : "+v"(tid));
      const int lane = tid & 63, w = tid >> 6, fr = lane & 15, fq = lane >> 4;
      __syncthreads();
      if (w == 0) {
        float dt = softplusf(bflo(pin(rawdt)) + dtb);
        const float cs = wave_incl_scan(dt * aneg);
        const float tot = __builtin_bit_cast(float, __builtin_amdgcn_readlane(__builtin_bit_cast(int, cs), 63));
        dts[lane] = dt; acs[lane] = cs; wts[lane] = __expf(tot - cs);
        if (lane == 0) tots[0] = tot;
      }
      pin4(rbm[0]); pin4(rbm[1]); pin4(rbm[2]); pin4(rbm[3]);
#pragma unroll
      for (int k = 0; k < 4; ++k) {
        const int id = tid + 256 * k, nc = id >> 6, i = id & 63;
        *reinterpret_cast<u32x4*>(Bs + i * 136 + nc * 8) = rbm[k];
#pragma unroll
        for (int e = 0; e < 4; ++e) {
          BT[(nc * 8 + 2 * e) * 72 + i] = (u16)(rbm[k][e] & 0xffffu);
          BT[(nc * 8 + 2 * e + 1) * 72 + i] = (u16)(rbm[k][e] >> 16);
        }
      }
#pragma unroll
      for (int k = 0; k < 4; ++k) {
        const int id = tid + 256 * k, i = id >> 4, nc = id & 15;
        *reinterpret_cast<u32x4*>(Cs + i * 136 + nc * 8) = rcm[k];
      }
      __syncthreads();
      pin4(rx[0]); pin4(rx[1]);
#pragma unroll
      for (int k = 0; k < 2; ++k) {
        const int id = tid + 256 * k, pch = id >> 6, i = id & 63;
        const float dt = dts[i], wt = wts[i];
#pragma unroll
        for (int e = 0; e < 4; ++e) {
          float x0 = bflo(rx[k][e]) * dt, x1 = bfhi(rx[k][e]) * dt;
          xT[(pch * 8 + 2 * e) * 72 + i] = f2bf(x0); xT[(pch * 8 + 2 * e + 1) * 72 + i] = f2bf(x1);
          xwT[(pch * 8 + 2 * e) * 72 + i] = f2bf(x0 * wt); xwT[(pch * 8 + 2 * e + 1) * 72 + i] = f2bf(x1 * wt);
        }
      }
      u32x4 tmpv[2] = {u32x4{0u, 0u, 0u, 0u}, u32x4{0u, 0u, 0u, 0u}};
      uint2 zr[4];
#pragma unroll
      for (int e = 0; e < 4; ++e) zr[e] = make_uint2(0u, 0u);
      if (mode == 2) {
        const int qs = (w * 4 + fq) * 16 + (15 - fr);
        const u16* tp = Y + (size_t)(rowbase + c0 + (qs >> 2)) * MIXW + hd * 64 + (qs & 3) * 16;
        tmpv[0] = *reinterpret_cast<const u32x4*>(tp); tmpv[1] = *reinterpret_cast<const u32x4*>(tp + 8);
#pragma unroll
        for (int tt = 0; tt < 4; ++tt) {
          const int t = tt * 16 + fr;
          const size_t row = (size_t)(rowbase + (sdir ? c0 + 63 - t : c0 + t));
          zr[tt] = *reinterpret_cast<const uint2*>(P + row * IND + hd * 64 + w * 16 + fq * 4);
        }
      }
      if (ci + 1 < ci1) {
        const int cL = (sdir ? nch - 2 - ci : ci + 1) * 64;
#pragma unroll
        for (int k = 0; k < 2; ++k) {
          const int id = tid + 256 * k, pch = id >> 6, i = id & 63;
          const int tau = sdir ? cL + 63 - i : cL + i;
          rx[k] = *reinterpret_cast<const u32x4*>(P + (size_t)(rowbase + tau) * IND + C_XBC + hd * 64 + pch * 8);
        }
#pragma unroll
        for (int k = 0; k < 4; ++k) {
          const int id = tid + 256 * k, nc = id >> 6, i = id & 63;
          const int tau = sdir ? cL + 63 - i : cL + i;
          rbm[k] = *reinterpret_cast<const u32x4*>(P + (size_t)(rowbase + tau) * IND + C_BM + g * 128 + nc * 8);
        }
#pragma unroll
        for (int k = 0; k < 4; ++k) {
          const int id = tid + 256 * k, i = id >> 4, nc = id & 15;
          const int tau = sdir ? cL + 63 - i : cL + i;
          rcm[k] = *reinterpret_cast<const u32x4*>(P + (size_t)(rowbase + tau) * IND + C_CM + g * 128 + nc * 8);
        }
        rawdt = P[(size_t)(rowbase + (sdir ? cL + 63 - lane : cL + lane)) * IND + C_DT + sdir * 16 + hd];
      }
      __syncthreads();
      f32x4 gacc[4];
#pragma unroll
      for (int i = 0; i < 4; ++i) gacc[i] = f32x4{0.f, 0.f, 0.f, 0.f};
#pragma unroll
      for (int kk = 0; kk < 4; ++kk) {
        bf16x8 a = ld8(Bs + (w * 16 + fr) * 136 + kk * 32 + fq * 8);
#pragma unroll
        for (int tb = 0; tb < 4; ++tb) {
          bf16x8 bb = ld8(Cs + (tb * 16 + fr) * 136 + kk * 32 + fq * 8);
          gacc[tb] = mfma16(a, bb, gacc[tb]);
        }
      }
      asm volatile("" : "+v"(tmpv[0]), "+v"(tmpv[1]));
      __syncthreads();
#pragma unroll
      for (int tb = 0; tb < 4; ++tb) {
        const int t = tb * 16 + fr;
        const float at = acs[t];
        float mv[4];
#pragma unroll
        for (int j = 0; j < 4; ++j) {
          const int s = w * 16 + fq * 4 + j;
          mv[j] = (s <= t) ? gacc[tb][j] * __expf(at - acs[s]) : 0.f;
        }
        uint2 o; o.x = pack2(mv[0], mv[1]); o.y = pack2(mv[2], mv[3]);
        *reinterpret_cast<uint2*>(Ms + t * 72 + w * 16 + fq * 4) = o;
      }
      __syncthreads();
      f32x4 yd[4], yo[4];
#pragma unroll
      for (int i = 0; i < 4; ++i) { yd[i] = f32x4{0.f, 0.f, 0.f, 0.f}; yo[i] = f32x4{0.f, 0.f, 0.f, 0.f}; }
#pragma unroll
      for (int kk = 0; kk < 2; ++kk) {
        bf16x8 bb = ld8(xT + (w * 16 + fr) * 72 + kk * 32 + fq * 8);
#pragma unroll
        for (int tt = 0; tt < 4; ++tt) {
          bf16x8 a = ld8(Ms + (tt * 16 + fr) * 72 + kk * 32 + fq * 8);
          yd[tt] = mfma16(bb, a, yd[tt]);
        }
      }
#pragma unroll
      for (int kk = 0; kk < 4; ++kk) {
        bf16x8 hb = packacc(hacc[2 * kk], hacc[2 * kk + 1]);
#pragma unroll
        for (int tt = 0; tt < 4; ++tt) {
          const u16* cr = Cs + (tt * 16 + fr) * 136 + fq * 4;
          bf16x8 a = ld44(cr + (2 * kk) * 16, cr + (2 * kk + 1) * 16);
          yo[tt] = mfma16(hb, a, yo[tt]);
        }
      }
      const float etot = __expf(tots[0]);
#pragma unroll
      for (int nb = 0; nb < 8; ++nb) { hacc[nb][0] *= etot; hacc[nb][1] *= etot; hacc[nb][2] *= etot; hacc[nb][3] *= etot; }
#pragma unroll
      for (int kk = 0; kk < 2; ++kk) {
        bf16x8 bb = ld8(xwT + (w * 16 + fr) * 72 + kk * 32 + fq * 8);
#pragma unroll
        for (int nb = 0; nb < 8; ++nb) {
          bf16x8 a = ld8(BT + (nb * 16 + fr) * 72 + kk * 32 + fq * 8);
          hacc[nb] = mfma16(a, bb, hacc[nb]);
        }
      }
      if (mode != 0) {
        float ea[4];
#pragma unroll
        for (int tt = 0; tt < 4; ++tt) ea[tt] = __expf(acs[tt * 16 + fr]);
        if (mode == 1) {
          u32x4 o0, o1;
#pragma unroll
          for (int tt = 0; tt < 4; ++tt) {
            float v[4];
#pragma unroll
            for (int j = 0; j < 4; ++j) v[j] = yd[tt][j] + ea[tt] * yo[tt][j];
            const unsigned a2 = pack2(v[0], v[1]), b2 = pack2(v[2], v[3]);
            if (tt == 0) { o0[0] = a2; o0[1] = b2; } else if (tt == 1) { o0[2] = a2; o0[3] = b2; }
            else if (tt == 2) { o1[0] = a2; o1[1] = b2; } else { o1[2] = a2; o1[3] = b2; }
          }
          const int qs = (w * 4 + fq) * 16 + fr;
          u16* tp = Y + (size_t)(rowbase + c0 + (qs >> 2)) * MIXW + hd * 64 + (qs & 3) * 16;
          *reinterpret_cast<u32x4*>(tp) = o0; *reinterpret_cast<u32x4*>(tp + 8) = o1;
        } else {
          float xsv[16], rdt[4], val[16];
#pragma unroll
          for (int tt = 0; tt < 4; ++tt) {
            rdt[tt] = rcpf(dts[tt * 16 + fr]);
#pragma unroll
            for (int j = 0; j < 4; ++j) xsv[tt * 4 + j] = bf2f(xT[(w * 16 + fq * 4 + j) * 72 + tt * 16 + fr]);
          }
          float sq[4];
#pragma unroll
          for (int tt = 0; tt < 4; ++tt) {
            const int t = tt * 16 + fr;
            const uint2 zw = zr[tt];
            const unsigned z01 = pin(zw.x), z23 = pin(zw.y);
            const float zz[4] = {bflo(z01), bfhi(z01), bflo(z23), bfhi(z23)};
            const int et = 3 - tt;
            const unsigned p01 = tmpv[et >> 1][(et & 1) * 2], p23 = tmpv[et >> 1][(et & 1) * 2 + 1];
            const float yf[4] = {bflo(p01), bfhi(p01), bflo(p23), bfhi(p23)};
            float s2 = 0.f;
#pragma unroll
            for (int j = 0; j < 4; ++j) {
              const float yv = yd[tt][j] + ea[tt] * yo[tt][j];
              const float vv = (yf[j] + yv + Dsk * xsv[tt * 4 + j] * rdt[tt]) * siluf(zz[j]);
              val[tt * 4 + j] = vv; s2 += vv * vv;
            }
            sq[tt] = s2;
            uint2 o; o.x = pack2(val[tt * 4], val[tt * 4 + 1]); o.y = pack2(val[tt * 4 + 2], val[tt * 4 + 3]);
            const int c = w * 2 + (fq >> 1);
            *reinterpret_cast<uint2*>(ystg + t * 64 + ((c ^ ((t >> 2) & 7)) << 3) + (fq & 1) * 4) = o;
          }
#pragma unroll
          for (int tt = 0; tt < 4; ++tt) {
            sq[tt] += __shfl_xor(sq[tt], 16); sq[tt] += __shfl_xor(sq[tt], 32);
          }
          if (fq == 0) {
#pragma unroll
            for (int tt = 0; tt < 4; ++tt) ssql[w * 64 + tt * 16 + fr] = sq[tt];
          }
          __syncthreads();
#pragma unroll
          for (int k = 0; k < 2; ++k) {
            const int id = tid + 256 * k, t = id >> 3, c = id & 7;
            const u32x4 v = *reinterpret_cast<const u32x4*>(ystg + t * 64 + ((c ^ ((t >> 2) & 7)) << 3));
            const size_t row = (size_t)(rowbase + (sdir ? c0 + 63 - t : c0 + t));
            *reinterpret_cast<u32x4*>(Y + row * MIXW + hd * 64 + c * 8) = v;
          }
          if (tid < 64) {
            const size_t row = (size_t)(rowbase + (sdir ? c0 + 63 - tid : c0 + tid));
            ssq[row * 16 + hd] = ssql[tid] + ssql[64 + tid] + ssql[128 + tid] + ssql[192 + tid];
          }
        }
      }
    }
  }
  if (part == 0) {
#pragma unroll
    for (int i = 0; i < 8; ++i) *reinterpret_cast<f32x4*>(stsave + (i * 256 + tid0) * 4) = hacc[i];
  }
}

__device__ void gla_item(const Params& p, int l, int part, int item, unsigned char* smem) {
  u16* qe = (u16*)smem;
  u16* ke = (u16*)(smem + 9216);
  u16* kdT = (u16*)(smem + 18432);
  u16* vT = (u16*)(smem + 27648);
  u16* at = (u16*)(smem + 46080);
  float* gl = (float*)(smem + 55296);
  float* red = (float*)(smem + 71936);
  const int tid0 = opaque_tid();
  const int b = item >> 3, h = (item >> 1) & 3, dir = item & 1;
  u16* P = (u16*)(p.ws + WS_P);
  u16* Y = (u16*)(p.ws + WS_Y);
  float* stsave = (float*)(p.ws + WS_WIN) + (size_t)(256 + item) * 8192;
  f32x4 sacc[4][2];
  if (part == 1) {
#pragma unroll
    for (int i = 0; i < 8; ++i) sacc[i >> 1][i & 1] = *reinterpret_cast<const f32x4*>(stsave + (i * 256 + tid0) * 4);
  } else {
#pragma unroll
    for (int i = 0; i < 8; ++i) sacc[i >> 1][i & 1] = f32x4{0.f, 0.f, 0.f, 0.f};
  }
  const int nseg = part == 0 ? 3 : 1;
  for (int seg = 0; seg < nseg; ++seg) {
    bool isctx; int sdir, ci0, ci1, mode;
    if (part == 1) { isctx = false; sdir = dir; ci0 = 32; ci1 = 64; mode = 2; }
    else if (seg == 0) { if (!(dir == 0 && l == 0)) continue; isctx = true; sdir = 1; ci0 = 0; ci1 = 4; mode = 1; }
    else if (seg == 1) { isctx = true; sdir = dir; ci0 = 0; ci1 = 4; mode = (dir == 0 && l == 0) ? 2 : 0; }
    else { isctx = false; sdir = dir; ci0 = 0; ci1 = 32; mode = 1; }
    if (part == 0 && seg <= 1) {
#pragma unroll
      for (int i = 0; i < 8; ++i) sacc[i >> 1][i & 1] = f32x4{0.f, 0.f, 0.f, 0.f};
    }
    __threadfence();
    __syncthreads();
    const int nch = isctx ? 4 : 64;
    const int rowbase = isctx ? NLAT + b * 256 : b * 4096;
#pragma unroll
    for (int i = 0; i < 8; ++i) asm volatile("" : "+v"(sacc[i >> 1][i & 1]));
    u32x4 rq[2], rk[2], rv[4], rlr;
    bf16x8 Bw;
    float bl;
    {
      const int tid = tid0;
      const int dcol = h * 64 + 32 * ((tid >> 6) & 1) + (tid & 31), kb = 8 * ((tid & 63) >> 5);
      const float* wlp = p.in[opq(15)] + ((size_t)((l * 2 + sdir) * 16 + kb)) * 256 + dcol;
      u32x4 bw;
#pragma unroll
      for (int e = 0; e < 4; ++e) bw[e] = pack2(wlp[(2 * e) * 256], wlp[(2 * e + 1) * 256]);
      Bw = __builtin_bit_cast(bf16x8, bw);
      bl = p.in[opq(16)][(l * 2 + sdir) * 256 + dcol];
      asm volatile("" : "+v"(Bw), "+v"(bl));
      const int cL = (sdir ? nch - 1 - ci0 : ci0) * 64;
#pragma unroll
      for (int k = 0; k < 2; ++k) {
        const int id = tid + 256 * k, i = id >> 3, dc = id & 7;
        const int tau = sdir ? cL + 63 - i : cL + i;
        rq[k] = *reinterpret_cast<const u32x4*>(P + (size_t)(rowbase + tau) * IND + C_Q + h * 64 + dc * 8);
      }
#pragma unroll
      for (int k = 0; k < 2; ++k) {
        const int id = tid + 256 * k, dc = id >> 6, i = id & 63;
        const int tau = sdir ? cL + 63 - i : cL + i;
        rk[k] = *reinterpret_cast<const u32x4*>(P + (size_t)(rowbase + tau) * IND + C_K + h * 64 + dc * 8);
      }
#pragma unroll
      for (int k = 0; k < 4; ++k) {
        const int id = tid + 256 * k, ec = id >> 6, i = id & 63;
        const int tau = sdir ? cL + 63 - i : cL + i;
        rv[k] = *reinterpret_cast<const u32x4*>(P + (size_t)(rowbase + tau) * IND + C_V + h * 128 + ec * 8);
      }
      {
        const int i = 32 * (tid >> 7) + (tid & 31), hf = (tid & 63) >> 5;
        const int tau = sdir ? cL + 63 - i : cL + i;
        rlr = *reinterpret_cast<const u32x4*>(P + (size_t)(rowbase + tau) * IND + C_LR + sdir * 16 + hf * 8);
      }
    }
    for (int ci = ci0; ci < ci1; ++ci) {
      const int c0 = (sdir ? nch - 1 - ci : ci) * 64;
      int tid = tid0;
      asm volatile("" : "+v"(tid));
      const int lane = tid & 63, w = tid >> 6, fr = lane & 15, fq = lane >> 4, d = tid & 63, iq = tid >> 6;
      __syncthreads();
      pin4(rlr);
      {
        const int th = w >> 1, dh = w & 1;
        f32x16 z;
#pragma unroll
        for (int r = 0; r < 16; ++r) z[r] = 0.f;
        const f32x16 lg = mfma32(__builtin_bit_cast(bf16x8, rlr), Bw, z);
#pragma unroll
        for (int r = 0; r < 16; ++r) {
          const int t = 32 * th + (r & 3) + 8 * (r >> 2) + 4 * (lane >> 5);
          gl[t * 65 + 32 * dh + (lane & 31)] = logsigf(lg[r] + bl) * (1.f / 16.f);
        }
      }
      __syncthreads();
      {
        float vals[16];
#pragma unroll
        for (int ii = 0; ii < 16; ++ii) vals[ii] = gl[(iq * 16 + ii) * 65 + d];
        float run = 0.f;
#pragma unroll
        for (int ii = 0; ii < 16; ++ii) { run += vals[ii]; gl[(iq * 16 + ii) * 65 + d] = run; }
        red[iq * 64 + d] = run;
      }
      __syncthreads();
      {
        float off = 0.f;
        for (int q = 0; q < iq; ++q) off += red[q * 64 + d];
        if (iq > 0) {
#pragma unroll 4
          for (int ii = 0; ii < 16; ++ii) gl[(iq * 16 + ii) * 65 + d] += off;
        }
      }
      __syncthreads();
      pin4(rq[0]); pin4(rq[1]); pin4(rk[0]); pin4(rk[1]); pin4(rv[0]); pin4(rv[1]); pin4(rv[2]); pin4(rv[3]);
#pragma unroll
      for (int k = 0; k < 2; ++k) {
        const int id = tid + 256 * k, i = id >> 3, dc = id & 7;
        u32x4 oo;
#pragma unroll
        for (int e = 0; e < 4; ++e) {
          float b0 = gl[i * 65 + dc * 8 + 2 * e], b1 = gl[i * 65 + dc * 8 + 2 * e + 1];
          oo[e] = pack2(bflo(rq[k][e]) * 0.125f * __expf(b0), bfhi(rq[k][e]) * 0.125f * __expf(b1));
        }
        *reinterpret_cast<u32x4*>(qe + i * 72 + dc * 8) = oo;
      }
#pragma unroll
      for (int k = 0; k < 2; ++k) {
        const int id = tid + 256 * k, dc = id >> 6, i = id & 63;
        u32x4 oo;
#pragma unroll
        for (int e = 0; e < 4; ++e) {
          const int d0 = dc * 8 + 2 * e;
          float b0 = gl[i * 65 + d0], b1 = gl[i * 65 + d0 + 1];
          float l0 = gl[63 * 65 + d0], l1 = gl[63 * 65 + d0 + 1];
          float k0 = bflo(rk[k][e]), k1 = bfhi(rk[k][e]);
          oo[e] = pack2(k0 * __expf(-b0), k1 * __expf(-b1));
          kdT[d0 * 72 + i] = f2bf(k0 * __expf(l0 - b0));
          kdT[(d0 + 1) * 72 + i] = f2bf(k1 * __expf(l1 - b1));
        }
        *reinterpret_cast<u32x4*>(ke + i * 72 + dc * 8) = oo;
      }
#pragma unroll
      for (int k = 0; k < 4; ++k) {
        const int id = tid + 256 * k, ec = id >> 6, i = id & 63;
#pragma unroll
        for (int e = 0; e < 4; ++e) {
          vT[(ec * 8 + 2 * e) * 72 + i] = (u16)(rv[k][e] & 0xffffu);
          vT[(ec * 8 + 2 * e + 1) * 72 + i] = (u16)(rv[k][e] >> 16);
        }
      }
      u32x4 tmpv[4];
      unsigned ggr[16];
#pragma unroll
      for (int e = 0; e < 4; ++e) tmpv[e] = u32x4{0u, 0u, 0u, 0u};
#pragma unroll
      for (int e = 0; e < 16; ++e) ggr[e] = 0u;
      if (mode == 2) {
        const int qs = (w * 4 + (3 - fq)) * 16 + fr;
        const u16* tp = Y + (size_t)(rowbase + c0 + (qs >> 2)) * MIXW + 1024 + h * 128 + (qs & 3) * 32;
#pragma unroll
        for (int e = 0; e < 4; ++e) tmpv[e] = *reinterpret_cast<const u32x4*>(tp + e * 8);
#pragma unroll
        for (int tt = 0; tt < 4; ++tt)
#pragma unroll
          for (int j = 0; j < 4; ++j) {
            const int t = tt * 16 + fq * 4 + j;
            const size_t row = (size_t)(rowbase + (sdir ? c0 + 63 - t : c0 + t));
            ggr[tt * 4 + j] = *reinterpret_cast<const unsigned*>(P + row * IND + C_GG + h * 128 + w * 32 + 2 * fr);
          }
      }
      if (ci + 1 < ci1) {
        const int cL = (sdir ? nch - 2 - ci : ci + 1) * 64;
#pragma unroll
        for (int k = 0; k < 2; ++k) {
          const int id = tid + 256 * k, i = id >> 3, dc = id & 7;
          const int tau = sdir ? cL + 63 - i : cL + i;
          rq[k] = *reinterpret_cast<const u32x4*>(P + (size_t)(rowbase + tau) * IND + C_Q + h * 64 + dc * 8);
        }
#pragma unroll
        for (int k = 0; k < 2; ++k) {
          const int id = tid + 256 * k, dc = id >> 6, i = id & 63;
          const int tau = sdir ? cL + 63 - i : cL + i;
          rk[k] = *reinterpret_cast<const u32x4*>(P + (size_t)(rowbase + tau) * IND + C_K + h * 64 + dc * 8);
        }
#pragma unroll
        for (int k = 0; k < 4; ++k) {
          const int id = tid + 256 * k, ec = id >> 6, i = id & 63;
          const int tau = sdir ? cL + 63 - i : cL + i;
          rv[k] = *reinterpret_cast<const u32x4*>(P + (size_t)(rowbase + tau) * IND + C_V + h * 128 + ec * 8);
        }
        {
          const int i = 32 * (tid >> 7) + (tid & 31), hf = (tid & 63) >> 5;
          const int tau = sdir ? cL + 63 - i : cL + i;
          rlr = *reinterpret_cast<const u32x4*>(P + (size_t)(rowbase + tau) * IND + C_LR + sdir * 16 + hf * 8);
        }
      }
      __syncthreads();
      {
        f32x4 aacc[4];
#pragma unroll
        for (int i = 0; i < 4; ++i) aacc[i] = f32x4{0.f, 0.f, 0.f, 0.f};
#pragma unroll
        for (int kk = 0; kk < 2; ++kk) {
          bf16x8 a = ld8(ke + (w * 16 + fr) * 72 + kk * 32 + fq * 8);
#pragma unroll
          for (int tb = 0; tb < 4; ++tb) {
            bf16x8 bb = ld8(qe + (tb * 16 + fr) * 72 + kk * 32 + fq * 8);
            aacc[tb] = mfma16(a, bb, aacc[tb]);
          }
        }
#pragma unroll
        for (int tb = 0; tb < 4; ++tb) {
          const int t = tb * 16 + fr;
          float mv[4];
#pragma unroll
          for (int j = 0; j < 4; ++j) { const int s = w * 16 + fq * 4 + j; mv[j] = (s <= t) ? aacc[tb][j] : 0.f; }
          uint2 o; o.x = pack2(mv[0], mv[1]); o.y = pack2(mv[2], mv[3]);
          *reinterpret_cast<uint2*>(at + t * 72 + w * 16 + fq * 4) = o;
        }
      }
      __syncthreads();
      f32x4 oacc[4][2];
#pragma unroll
      for (int i = 0; i < 4; ++i) { oacc[i][0] = f32x4{0.f, 0.f, 0.f, 0.f}; oacc[i][1] = f32x4{0.f, 0.f, 0.f, 0.f}; }
#pragma unroll
      for (int kk = 0; kk < 2; ++kk) {
        bf16x8 b0 = ld8(vT + (w * 32 + 2 * fr) * 72 + kk * 32 + fq * 8);
        bf16x8 b1 = ld8(vT + (w * 32 + 2 * fr + 1) * 72 + kk * 32 + fq * 8);
#pragma unroll
        for (int tt = 0; tt < 4; ++tt) {
          bf16x8 a = ld8(at + (tt * 16 + fr) * 72 + kk * 32 + fq * 8);
          oacc[tt][0] = mfma16(a, b0, oacc[tt][0]);
          oacc[tt][1] = mfma16(a, b1, oacc[tt][1]);
        }
      }
#pragma unroll
      for (int kk = 0; kk < 2; ++kk) {
        bf16x8 s0 = packacc(sacc[2 * kk][0], sacc[2 * kk + 1][0]);
        bf16x8 s1 = packacc(sacc[2 * kk][1], sacc[2 * kk + 1][1]);
#pragma unroll
        for (int tt = 0; tt < 4; ++tt) {
          const u16* qr = qe + (tt * 16 + fr) * 72 + fq * 4;
          bf16x8 a = ld44(qr + (2 * kk) * 16, qr + (2 * kk + 1) * 16);
          oacc[tt][0] = mfma16(a, s0, oacc[tt][0]);
          oacc[tt][1] = mfma16(a, s1, oacc[tt][1]);
        }
      }
#pragma unroll
      for (int db = 0; db < 4; ++db)
#pragma unroll
        for (int j = 0; j < 4; ++j) {
          const float sc = __expf(gl[63 * 65 + db * 16 + fq * 4 + j]);
          sacc[db][0][j] *= sc; sacc[db][1][j] *= sc;
        }
#pragma unroll
      for (int kk = 0; kk < 2; ++kk) {
        bf16x8 b0 = ld8(vT + (w * 32 + 2 * fr) * 72 + kk * 32 + fq * 8);
        bf16x8 b1 = ld8(vT + (w * 32 + 2 * fr + 1) * 72 + kk * 32 + fq * 8);
#pragma unroll
        for (int db = 0; db < 4; ++db) {
          bf16x8 a = ld8(kdT + (db * 16 + fr) * 72 + kk * 32 + fq * 8);
          sacc[db][0] = mfma16(a, b0, sacc[db][0]);
          sacc[db][1] = mfma16(a, b1, sacc[db][1]);
        }
      }
      pin4(tmpv[0]); pin4(tmpv[1]); pin4(tmpv[2]); pin4(tmpv[3]);
      if (mode != 0) {
        const int ycol = 1024 + h * 128 + w * 32 + 2 * fr;
        if (mode == 1) {
          const int qs = (w * 4 + fq) * 16 + fr;
          u16* tp = Y + (size_t)(rowbase + c0 + (qs >> 2)) * MIXW + 1024 + h * 128 + (qs & 3) * 32;
#pragma unroll
          for (int tt = 0; tt < 4; ++tt) {
            u32x4 o;
#pragma unroll
            for (int j = 0; j < 4; ++j) o[j] = pack2(oacc[tt][0][j], oacc[tt][1][j]);
            *reinterpret_cast<u32x4*>(tp + tt * 8) = o;
          }
        } else {
#pragma unroll
          for (int tt = 0; tt < 4; ++tt)
#pragma unroll
            for (int j = 0; j < 4; ++j) {
              const int t = tt * 16 + fq * 4 + j;
              const int e = 15 - (tt * 4 + j);
              const unsigned pw = tmpv[e >> 2][e & 3];
              float o0 = oacc[tt][0][j] + bflo(pw);
              float o1 = oacc[tt][1][j] + bfhi(pw);
              oacc[tt][0][j] = o0; oacc[tt][1][j] = o1;
              const float sq = row16_sum(o0 * o0 + o1 * o1);
              if (fr == 0) red[w * 64 + t] = sq;
            }
          __syncthreads();
          const float* nwv = p.in[opq(17)] + l * 128;
          const float nw0 = nwv[w * 32 + 2 * fr], nw1 = nwv[w * 32 + 2 * fr + 1];
#pragma unroll
          for (int tt = 0; tt < 4; ++tt)
#pragma unroll
            for (int j = 0; j < 4; ++j) {
              const int t = tt * 16 + fq * 4 + j;
              const size_t row = (size_t)(rowbase + (sdir ? c0 + 63 - t : c0 + t));
              const float tot = red[t] + red[64 + t] + red[128 + t] + red[192 + t];
              const float rs = rsqrtf(tot * (1.f / 128.f) + EPSF);
              const unsigned gw = pin(ggr[tt * 4 + j]);
              const float g0 = bflo(gw), g1 = bfhi(gw);
              *reinterpret_cast<unsigned*>(Y + row * MIXW + ycol) =
                  pack2(oacc[tt][0][j] * rs * nw0 * siluf(g0), oacc[tt][1][j] * rs * nw1 * siluf(g1));
            }
        }
      }
    }
  }
  if (part == 0) {
#pragma unroll
    for (int i = 0; i < 8; ++i) *reinterpret_cast<f32x4*>(stsave + (i * 256 + tid0) * 4) = sacc[i >> 1][i & 1];
  }
}

__device__ void s5_item(const Params& p, int l, int part, int blk, unsigned char* smem) {
  const int tid = opaque_tid(), lane = tid & 63, w = tid >> 6, fr = lane & 15, fq = lane >> 4;
  const int wi = blk * 4 + w;
  const int b = wi >> 6, g = (wi >> 1) & 31, dir = wi & 1;
  u16* hb = (u16*)smem + w * (32 * 136);
  u16* ust = (u16*)(smem + 4 * 32 * 136 * 2) + w * (32 * 16);
  u16* P = (u16*)(p.ws + WS_P);
  u16* Y = (u16*)(p.ws + WS_Y);
  u16* G5C = (u16*)(p.ws + WS_G5C);
  float* stsave = (float*)(p.ws + WS_S5ST) + (size_t)wi * 128;
  const float dsk = p.in[opq(25)][l * 512 + g * 16 + fr];
  float hre = 0.f, him = 0.f;
  if (part == 1) { hre = stsave[lane * 2]; him = stsave[lane * 2 + 1]; }
  const int nseg = part == 0 ? 3 : 1;
  for (int seg = 0; seg < nseg; ++seg) {
    bool isctx; int sdir, ti0, ti1, mode;
    if (part == 1) { isctx = false; sdir = dir; ti0 = 64; ti1 = 128; mode = 2; }
    else if (seg == 0) { if (!(dir == 0 && l == 0)) continue; isctx = true; sdir = 1; ti0 = 0; ti1 = 8; mode = 1; }
    else if (seg == 1) { isctx = true; sdir = dir; ti0 = 0; ti1 = 8; mode = (dir == 0 && l == 0) ? 2 : 0; }
    else { isctx = false; sdir = dir; ti0 = 0; ti1 = 64; mode = 1; }
    if (part == 0 && seg <= 1) { hre = 0.f; him = 0.f; }
    __threadfence();
    const unsigned char* cbase = p.ws + WS_S5C + (size_t)((l * 2 + sdir) * 32 + g) * 8704;
    const u16* BbarM = (const u16*)cbase;
    const u16* CmT = (const u16*)(cbase + 4096);
    const float* lamb = (const float*)(cbase + 8192);
    bf16x8 Bf[4], Cf[4];
#pragma unroll
    for (int cb = 0; cb < 4; ++cb) Bf[cb] = ld8(BbarM + (cb * 32 + (lane & 31)) * 16 + 8 * (lane >> 5));
#pragma unroll
    for (int kk = 0; kk < 4; ++kk) Cf[kk] = ld8(CmT + fr * 128 + kk * 32 + fq * 8);
    float lre = lamb[2 * lane], lim = lamb[2 * lane + 1];
#pragma unroll
    for (int i = 0; i < 4; ++i) asm volatile("" : "+v"(Bf[i]), "+v"(Cf[i]));
    asm volatile("" : "+v"(lre), "+v"(lim), "+v"(hre), "+v"(him));
    const int nt = isctx ? 8 : 128;
    const int rowbase = isctx ? NLAT + b * 256 : b * 4096;
    bf16x8 anext;
    {
      const int c0 = (sdir ? nt - 1 - ti0 : ti0) * 32, i = lane & 31;
      anext = ld8(P + (size_t)(rowbase + (sdir ? c0 + 31 - i : c0 + i)) * IND + C_U5 + g * 16 + 8 * (lane >> 5));
    }
    for (int ti = ti0; ti < ti1; ++ti) {
      const int c0 = (sdir ? nt - 1 - ti : ti) * 32;
      const bf16x8 a = anext;
      if (ti + 1 < ti1) {
        const int c1 = (sdir ? nt - 2 - ti : ti + 1) * 32, i = lane & 31;
        anext = ld8(P + (size_t)(rowbase + (sdir ? c1 + 31 - i : c1 + i)) * IND + C_U5 + g * 16 + 8 * (lane >> 5));
      }
      u32x4 tmpv = u32x4{0u, 0u, 0u, 0u};
      if (mode == 2) {
        const int qs = (3 - fq) * 16 + fr;
        tmpv = *reinterpret_cast<const u32x4*>(Y + (size_t)(rowbase + c0 + (qs >> 1)) * MIXW + 1536 + g * 16 + (qs & 1) * 8);
      }
      wave_lds_sync();
      if (mode == 2) *reinterpret_cast<bf16x8*>(ust + (lane & 31) * 16 + 8 * (lane >> 5)) = a;
#pragma unroll
      for (int cb = 0; cb < 4; ++cb) {
        f32x16 z;
#pragma unroll
        for (int r = 0; r < 16; ++r) z[r] = 0.f;
        f32x16 acc = mfma32(a, Bf[cb], z);
#pragma unroll
        for (int r = 0; r < 16; ++r) {
          const int ii = (r & 3) + 8 * (r >> 2) + 4 * (lane >> 5);
          hb[ii * 136 + cb * 32 + (lane & 31)] = f2bf(acc[r]);
        }
      }
      wave_lds_sync();
      {
        unsigned buv[32];
#pragma unroll
        for (int i = 0; i < 32; ++i) buv[i] = *reinterpret_cast<const unsigned*>(hb + i * 136 + 2 * lane);
#pragma unroll
        for (int i = 0; i < 32; ++i) {
          const float nre = lre * hre - lim * him + bflo(buv[i]);
          const float nim = lre * him + lim * hre + bfhi(buv[i]);
          hre = nre; him = nim;
          *reinterpret_cast<unsigned*>(hb + i * 136 + 2 * lane) = pack2(hre, him);
        }
      }
      wave_lds_sync();
      f32x4 ya[2];
      ya[0] = f32x4{0.f, 0.f, 0.f, 0.f}; ya[1] = f32x4{0.f, 0.f, 0.f, 0.f};
#pragma unroll
      for (int kk = 0; kk < 4; ++kk) {
        bf16x8 a0 = ld8(hb + fr * 136 + kk * 32 + fq * 8);
        bf16x8 a1 = ld8(hb + (16 + fr) * 136 + kk * 32 + fq * 8);
        ya[0] = mfma16(a0, Cf[kk], ya[0]);
        ya[1] = mfma16(a1, Cf[kk], ya[1]);
      }
      pin4(tmpv);
      if (mode == 1) {
        u32x4 o;
        o[0] = pack2(ya[0][0], ya[0][1]); o[1] = pack2(ya[0][2], ya[0][3]); o[2] = pack2(ya[1][0], ya[1][1]); o[3] = pack2(ya[1][2], ya[1][3]);
        const int qs = fq * 16 + fr;
        *reinterpret_cast<u32x4*>(Y + (size_t)(rowbase + c0 + (qs >> 1)) * MIXW + 1536 + g * 16 + (qs & 1) * 8) = o;
      } else if (mode == 2) {
#pragma unroll
        for (int rt = 0; rt < 2; ++rt)
#pragma unroll
          for (int j = 0; j < 4; ++j) {
            const int i = rt * 16 + fq * 4 + j;
            const int tau = sdir ? c0 + 31 - i : c0 + i;
            const size_t row = (size_t)(rowbase + tau);
            const int e = 7 - (rt * 4 + j);
            const unsigned pw = tmpv[e >> 1];
            const float yf = (e & 1) ? bfhi(pw) : bflo(pw);
            const float u = bf2f(ust[i * 16 + fr]);
            const float x = yf + ya[rt][j] + dsk * u;
            const float th = 1.f - 2.f * rcpf(1.f + __expf(2.f * 0.7978845608028654f * (x + 0.044715f * x * x * x)));
            const float ge = 0.5f * x * (1.f + th);
            if (isctx) G5C[(row - NLAT) * 512 + g * 16 + fr] = f2bf(ge);
            else P[row * IND + C_U5 + g * 16 + fr] = f2bf(ge);
          }
      }
    }
  }
  if (part == 0) { stsave[lane * 2] = hre; stsave[lane * 2 + 1] = him; }
}

__device__ void ssd_norm_rows(const Params& p, int nrows) {
  const int tid = opaque_tid();
  const float* ssq = (const float*)(p.ws + WS_SSQ);
  float* rsb = (float*)(p.ws + WS_RS);
  for (int i = blockIdx.x * 256 + tid; i < nrows * 2; i += gridDim.x * 256) {
    const float* sp = ssq + (size_t)i * 8;
    const float sum = sp[0] + sp[1] + sp[2] + sp[3] + sp[4] + sp[5] + sp[6] + sp[7];
    rsb[i] = rsqrtf(sum * (1.f / 512.f) + EPSF);
  }
}

__device__ void phase_final(const Params& p) {
  const int tid = opaque_tid(), lane = tid & 63, w = tid >> 6;
  const float* nw = p.in[opq(28)];
  for (int r = blockIdx.x * 4 + w; r < NLAT; r += gridDim.x * 4) {
    float* src = p.out + (size_t)r * 1024;
    float4 v[4]; float ss = 0.f;
#pragma unroll
    for (int q = 0; q < 4; ++q) {
      v[q] = *reinterpret_cast<const float4*>(src + lane * 4 + q * 256);
      ss += v[q].x * v[q].x + v[q].y * v[q].y + v[q].z * v[q].z + v[q].w * v[q].w;
    }
#pragma unroll
    for (int o = 32; o > 0; o >>= 1) ss += __shfl_xor(ss, o);
    const float rs = rsqrtf(ss * (1.f / 1024.f) + EPSF);
#pragma unroll
    for (int q = 0; q < 4; ++q) {
      const int col = lane * 4 + q * 256;
      float4 n4 = *reinterpret_cast<const float4*>(nw + col);
      float4 o = make_float4(v[q].x * rs * n4.x, v[q].y * rs * n4.y, v[q].z * rs * n4.z, v[q].w * rs * n4.w);
      *reinterpret_cast<float4*>(src + col) = o;
    }
  }
}


#define XB_TMO      128
#define XB_XCNT(j)  (256  + 64 * (j))
#define XB_XSUB(j)  (1280 + 64 * (j))
#define XB_XGEN(j)  (2304 + 64 * (j))
#define XB_TOP      3328
#define XB_TOPGEN   3392
#define XCD_BAR_WORDS 3456
#define XB_SPIN_CAP (1u << 20)
DI unsigned xb_ld(unsigned* p) { return __hip_atomic_load(p, __ATOMIC_RELAXED, __HIP_MEMORY_SCOPE_AGENT); }
DI unsigned xb_add(unsigned* p, unsigned v) { return __hip_atomic_fetch_add(p, v, __ATOMIC_RELAXED, __HIP_MEMORY_SCOPE_AGENT); }
DI unsigned xb_xcc_id() { return (unsigned)__builtin_amdgcn_s_getreg((3 << 11) | 20) & 0xFu; }
#define XB_SPIN(cond, bar) do { unsigned _sp = 0; while (cond) { __builtin_amdgcn_s_sleep(1); \
    if ((++_sp & 255u) == 0u) { if (xb_ld(&(bar)[XB_TMO])) break; if (_sp > XB_SPIN_CAP) { atomicAdd(&(bar)[XB_TMO], 1u); break; } } } } while (0)
struct XcdBarrier { unsigned* bar; unsigned x, nloc, nx; };
DI XcdBarrier xcd_barrier_post(unsigned* bar) {
  XcdBarrier b; b.bar = bar; b.x = xb_xcc_id(); b.nloc = 0u; b.nx = 0u;
  if (threadIdx.x == 0) (void)xb_add(&bar[XB_XCNT(b.x)], 1u);
  return b;
}
DI void xcd_barrier_complete(unsigned* bar, unsigned x, unsigned& nloc, unsigned& nx) {
  const unsigned G = gridDim.x;
  unsigned sum, cnt, mine, sp = 0u;
  for (;;) {
    sum = 0u; cnt = 0u; mine = 0u;
#pragma unroll
    for (unsigned j = 0; j < 16; ++j) { const unsigned c = xb_ld(&bar[XB_XCNT(j)]); sum += c; cnt += (c > 0u) ? 1u : 0u; mine = (j == x) ? c : mine; }
    if (sum == G) break;
    __builtin_amdgcn_s_sleep(1);
    if ((++sp & 255u) == 0u) { if (xb_ld(&bar[XB_TMO])) break; if (sp > XB_SPIN_CAP) { atomicAdd(&bar[XB_TMO], 1u); break; } }
  }
  nloc = mine > 0u ? mine : 1u; nx = cnt > 0u ? cnt : 1u;
}
DI void xcd_barrier(XcdBarrier& b) {
  asm volatile("s_waitcnt vmcnt(0)" ::: "memory");
  __syncthreads();
  if (threadIdx.x == 0) {
    unsigned* bar = b.bar;
    __builtin_amdgcn_s_waitcnt(0);
    if (b.nloc == 0u) xcd_barrier_complete(bar, b.x, b.nloc, b.nx);
    const unsigned nloc = b.nloc, nx = b.nx;
    const unsigned old = xb_add(&bar[XB_XSUB(b.x)], 1u);
    const unsigned gen = old / nloc;
    if (old + 1u == (gen + 1u) * nloc) {
      __builtin_amdgcn_fence(__ATOMIC_RELEASE, "agent");
      asm volatile("s_waitcnt vmcnt(0)" ::: "memory");
      const unsigned og = xb_add(&bar[XB_TOP], 1u);
      const unsigned tg = og / nx;
      if (og + 1u == (tg + 1u) * nx) xb_add(&bar[XB_TOPGEN], 1u);
      else XB_SPIN(xb_ld(&bar[XB_TOPGEN]) == tg, bar);
      __builtin_amdgcn_fence(__ATOMIC_ACQUIRE, "agent");
      xb_add(&bar[XB_XGEN(b.x)], 1u);
      asm volatile("s_waitcnt vmcnt(0)" ::: "memory");
    } else {
      XB_SPIN(xb_ld(&bar[XB_XGEN(b.x)]) == gen, bar);
      __builtin_amdgcn_fence(__ATOMIC_ACQUIRE, "agent");
      asm volatile("s_waitcnt vmcnt(0)" ::: "memory");
    }
  }
  __syncthreads();
}

__global__ void __launch_bounds__(256, 2) fwd_megakernel(Params p) {
  extern __shared__ __attribute__((aligned(16))) unsigned char smem[];
  cg::grid_group grid = cg::this_grid();
  XcdBarrier xb = xcd_barrier_post((unsigned*)(p.ws + WS_BAR));
  const int ph_lo = p.ph_lo, ph_hi = p.ph_hi;
  for (int ph = ph_lo; ph < ph_hi; ++ph) {
    if (ph == 0) {
      phase_prep(p, smem);
    } else if (ph == NPHASE - 1) {
      phase_final(p);
    } else {
      const int l = (ph - 1) / 7, sub = (ph - 1) % 7;
      const int mt = (l == 1) ? 256 : 272;
      if (sub == 0) {
        phase_pre(p, l, smem);
      } else if (sub == 1) {
        const u16* U = (const u16*)(p.ws + WS_Y);
        const u16* W = (const u16*)(p.ws + WS_WIN);
        const int xcd = blockIdx.x & 7, slot = blockIdx.x >> 3, nslots = gridDim.x >> 3;
        bool pre = false;
        for (int u = slot; u < 918; u += nslots) {
          const int pnl = u / 306, v = u % 306;
          const int u2 = u + nslots, pnl2 = u2 / 306, v2 = u2 % 306;
          const bool hn = u2 < 918;
          gemm_tile<192, 0>(p, l, U, 1024, W, 1024, 1024, (xcd * 34 + v / 9) * 128, (pnl * 9 + v % 9) * 192, smem,
                            pre, hn, U, 1024, (xcd * 34 + v2 / 9) * 128, (pnl2 * 9 + v2 % 9) * 192);
          pre = hn;
        }
      } else if (sub == 2) {
        phase_conv(p, l);
      } else if (sub == 3 || sub == 4) {
        const int part = sub - 3;
        for (int k = 0;; ++k) {
          int it;
          if (gridDim.x == 512) {
            if (k > 0) break;
            const int blk = blockIdx.x;
            const int q = blk < 256 ? blk - 64 : 192 + (blk - 448);
            const int sit = q < 128 ? q * 2 : (q < 192 ? 2 * (q - 128) : 2 * (q - 192) + 1) * 2 + 1;
            it = blk < 64 ? 256 + blk : blk < 256 ? sit : blk < 320 ? -1 : blk < 448 ? blk : sit;
          } else {
            it = blockIdx.x + k * gridDim.x;
            if (it >= 448) break;
          }
          if (it >= 0) {
            if (it < 256) ssd_item(p, l, part, it, smem);
            else if (it < 320) gla_item(p, l, part, it - 256, smem);
            else s5_item(p, l, part, it - 320, smem);
          }
          __syncthreads();
        }
      } else if (sub == 5) {
        const u16* W = (const u16*)(p.ws + WS_GLU);
        const int xcd = blockIdx.x & 7, slot = blockIdx.x >> 3, nslots = gridDim.x >> 3, mtx = mt >> 3;
        const u16* Alat = (const u16*)(p.ws + WS_P) + C_U5;
        const u16* Actx = (const u16*)(p.ws + WS_G5C) - (size_t)NLAT * 512;
        bool pre = false;
        for (int u = slot; u < mtx * 8; u += nslots) {
          const int t = (xcd * mtx) * 8 + u, t2 = t + nslots;
          const int m0 = (t >> 3) * 128, m0n = (t2 >> 3) * 128;
          const bool hn = u + nslots < mtx * 8;
          const u16* Ac = m0 < NLAT ? Alat : Actx; const int ldc = m0 < NLAT ? IND : 512;
          const u16* An = m0n < NLAT ? Alat : Actx; const int ldn = m0n < NLAT ? IND : 512;
          gemm_tile<128, 1>(p, l, Ac, ldc, W, 512, 512, m0, (t & 7) * 128, smem, pre, hn, An, ldn, m0n, (t2 & 7) * 128);
          pre = hn;
        }
        ssd_norm_rows(p, mt * 128);
      } else {
        const u16* A = (const u16*)(p.ws + WS_Y);
        const u16* W = (const u16*)(p.ws + WS_WOUT);
        const int xcd = blockIdx.x & 7, slot = blockIdx.x >> 3, nslots = gridDim.x >> 3, mtx = mt >> 3;
        bool pre = false;
        for (int u = slot; u < mtx * 8; u += nslots) {
          const int t = (xcd * mtx) * 8 + u, t2 = t + nslots;
          const bool hn = u + nslots < mtx * 8;
          gemm_tile<128, 2>(p, l, A, MIXW, W, MIXW, MIXW, (t >> 3) * 128, (t & 7) * 128, smem, pre, hn, A, MIXW, (t2 >> 3) * 128, (t2 & 7) * 128);
          pre = hn;
        }
      }
    }
    if (ph + 1 < ph_hi) {
      if (ph_hi < 0) grid.sync();
      xcd_barrier(xb);
    }
  }
}

extern "C" void kernel_launch(void* const* d_in, const int* in_sizes, int n_in, void* d_out, int out_size, void* d_ws,
                              size_t ws_size, hipStream_t stream) {
  static int grid_blocks = 0;
  if (grid_blocks == 0) {
    if (n_in != 29 || ws_size < WS_END) { fprintf(stderr, "kernel_launch: bad n_in %d / ws %zu (need %zu)\n", n_in, ws_size, (size_t)WS_END); grid_blocks = -1; return; }
    int dev = 0, cus = 0, per_cu = 0;
    hipGetDevice(&dev);
    hipDeviceGetAttribute(&cus, hipDeviceAttributeMultiprocessorCount, dev);
    hipFuncSetAttribute((const void*)fwd_megakernel, hipFuncAttributeMaxDynamicSharedMemorySize, SMEM_BYTES);
    hipOccupancyMaxActiveBlocksPerMultiprocessor(&per_cu, (const void*)fwd_megakernel, 256, SMEM_BYTES);
    if (per_cu < 1) per_cu = 1;
    if (per_cu > 2) per_cu = 2;
    grid_blocks = cus * per_cu;
    fprintf(stderr, "kernel_launch: cus %d per_cu %d grid %d\n", cus, per_cu, grid_blocks);
  }
  if (grid_blocks < 0) return;
  Params p{};
  for (int i = 0; i < 29; ++i) p.in[i] = (const float*)d_in[i];
  p.out = (float*)d_out; p.ws = (unsigned char*)d_ws; p.ph_lo = 0; p.ph_hi = NPHASE;
  if (hipMemsetAsync((char*)d_ws + WS_BAR, 0, 16384, stream) != hipSuccess) { fprintf(stderr, "kernel_launch: memset of the barrier words failed\n"); return; }
  void* args[] = {&p};
  hipError_t e = hipLaunchCooperativeKernel((const void*)fwd_megakernel, dim3(grid_blocks), dim3(256), args, SMEM_BYTES, stream);
  if (e != hipSuccess) fprintf(stderr, "cooperative launch failed: %s (grid %d)\n", hipGetErrorString(e), grid_blocks);
}
```

```cpp
#include <hip/hip_runtime.h>
#include <hip/hip_cooperative_groups.h>
#include <cstdio>
namespace cg = cooperative_groups;

typedef unsigned short u16;
using bf16x8 = __attribute__((ext_vector_type(8))) short;
using bf16x4 = __attribute__((ext_vector_type(4))) short;
using f32x4 = __attribute__((ext_vector_type(4))) float;
using f32x16 = __attribute__((ext_vector_type(16))) float;
using u32x4 = __attribute__((ext_vector_type(4))) unsigned;
#define DI __device__ __forceinline__

constexpr int DM = 1024, NLAT = 32768, NCTX = 2048, NTOK = 34816, IND = 5184, MIXW = 2048;
constexpr int C_XBC = 1024, C_BM = 2048, C_CM = 2304, C_DT = 2560, C_Q = 2592, C_K = 2848, C_V = 3104, C_GG = 3616,
              C_LR = 4128, C_U5 = 4160, C_SG = 4672;
constexpr float EPSF = 1e-6f;
constexpr int SMEM_BYTES = 81920;
constexpr int NPHASE = 16;

constexpr size_t WS_P = 0;
constexpr size_t WS_Y = WS_P + (size_t)NTOK * IND * 2;
constexpr size_t WS_WIN = WS_Y + (size_t)NTOK * MIXW * 2;
constexpr size_t WS_WOUT = WS_WIN + (size_t)IND * DM * 2;
constexpr size_t WS_GLU = WS_WOUT + (size_t)DM * MIXW * 2;
constexpr size_t WS_HCTX = WS_GLU + (size_t)1024 * 512 * 2;
constexpr size_t WS_MOD = WS_HCTX + (size_t)NCTX * DM * 4;
constexpr size_t WS_SSQ = WS_MOD + (size_t)2 * 9 * 3072 * 4;
constexpr size_t WS_S5C = WS_SSQ + (size_t)NTOK * 16 * 4;
constexpr size_t WS_G5C = WS_S5C + (size_t)128 * 8704;
constexpr size_t WS_S5ST = WS_G5C + (size_t)NCTX * 512 * 2;
constexpr size_t WS_BAR = WS_S5ST + (size_t)512 * 128 * 4;
constexpr size_t WS_RS = WS_BAR + 16384;
constexpr size_t WS_END = WS_RS + (size_t)NTOK * 2 * 4;

struct Params {
  const float* in[29];
  float* out;
  unsigned char* ws;
  int ph_lo, ph_hi;
};

DI int opq(int i) { asm volatile("" : "+s"(i)); return i; }
DI int opaque_tid() { int t = threadIdx.x; asm volatile("" : "+v"(t)); return t; }
typedef __bf16 hbf16x2 __attribute__((ext_vector_type(2)));
typedef float hf32x2 __attribute__((ext_vector_type(2)));
DI u16 f2bf(float x) { __bf16 h = (__bf16)x; return __builtin_bit_cast(u16, h); }
DI float bf2f(u16 h) { return __uint_as_float(((unsigned)h) << 16); }
DI unsigned pack2(float a, float b) { hf32x2 v = {a, b}; return __builtin_bit_cast(unsigned, __builtin_convertvector(v, hbf16x2)); }
DI float bflo(unsigned v) { return __uint_as_float(v << 16); }
DI float bfhi(unsigned v) { return __uint_as_float(v & 0xffff0000u); }
DI float rcpf(float x) { return __builtin_amdgcn_rcpf(x); }
DI float siluf(float x) { return x * rcpf(1.f + __expf(-x)); }
DI float logsigf(float x) { return fminf(x, 0.f) - __logf(1.f + __expf(-fabsf(x))); }
DI float softplusf(float v) { return fmaxf(v, 0.f) + log1pf(__expf(-fabsf(v))); }
DI f32x4 mfma16(bf16x8 a, bf16x8 b, f32x4 c) { return __builtin_amdgcn_mfma_f32_16x16x32_bf16(a, b, c, 0, 0, 0); }
DI f32x16 mfma32(bf16x8 a, bf16x8 b, f32x16 c) { return __builtin_amdgcn_mfma_f32_32x32x16_bf16(a, b, c, 0, 0, 0); }
DI void wave_lds_sync() { asm volatile("s_waitcnt lgkmcnt(0)" ::: "memory"); }
DI unsigned pin(unsigned v) { asm volatile("" : "+v"(v)); return v; }
DI void pin4(u32x4& v) { asm volatile("" : "+v"(v)); }
#define DPPF(v, old, ctrl, rmask) __builtin_bit_cast(float, __builtin_amdgcn_update_dpp(__builtin_bit_cast(int, (float)(old)), __builtin_bit_cast(int, (float)(v)), (ctrl), (rmask), 0xf, false))
DI float row16_sum(float v) {
  v += DPPF(v, 0.f, 0xB1, 0xf);
  v += DPPF(v, 0.f, 0x4E, 0xf);
  v += DPPF(v, 0.f, 0x141, 0xf);
  v += DPPF(v, 0.f, 0x140, 0xf);
  return v;
}
DI float wave_incl_scan(float v) {
  v += DPPF(v, 0.f, 0x111, 0xf);
  v += DPPF(v, 0.f, 0x112, 0xf);
  v += DPPF(v, 0.f, 0x114, 0xf);
  v += DPPF(v, 0.f, 0x118, 0xf);
  v += DPPF(v, 0.f, 0x142, 0xa);
  v += DPPF(v, 0.f, 0x143, 0xc);
  return v;
}
DI bf16x8 ld8(const u16* p) { return *reinterpret_cast<const bf16x8*>(p); }
DI bf16x8 ld44(const u16* p0, const u16* p1) {
  bf16x4 a = *reinterpret_cast<const bf16x4*>(p0), b = *reinterpret_cast<const bf16x4*>(p1);
  return __builtin_shufflevector(a, b, 0, 1, 2, 3, 4, 5, 6, 7);
}
DI bf16x8 packacc(const f32x4& a, const f32x4& b) {
  uint4 u; u.x = pack2(a[0], a[1]); u.y = pack2(a[2], a[3]); u.z = pack2(b[0], b[1]); u.w = pack2(b[2], b[3]);
  return __builtin_bit_cast(bf16x8, u);
}

__device__ void phase_prep(const Params& p, unsigned char* smem) {
  float* sc = (float*)smem;
  float* red = sc + 9 * 1024;
  const int tid = opaque_tid();
  float* modb = (float*)(p.ws + WS_MOD);
  bool filled = false;
  for (int it = blockIdx.x; it < 96 + 128; it += gridDim.x) {
    if (it < 96) {
      if (!filled) {
        for (int idx = tid; idx < 9216; idx += 256) {
          int r = idx >> 10, k = idx & 1023;
          float v = r < 8 ? p.in[opq(1)][r * 1024 + k] : p.in[opq(3)][k];
          sc[idx] = siluf(v);
        }
        filled = true;
        __syncthreads();
      }
      const int l = it / 48, j0 = (it % 48) * 64, kg = tid >> 6, jj = tid & 63;
      float a[9];
#pragma unroll
      for (int r = 0; r < 9; ++r) a[r] = 0.f;
      const float* W = p.in[opq(5)] + (size_t)l * 1024 * 3072 + j0 + jj;
      for (int k = kg * 256; k < kg * 256 + 256; ++k) {
        float wv = W[(size_t)k * 3072];
#pragma unroll
        for (int r = 0; r < 9; ++r) a[r] += sc[r * 1024 + k] * wv;
      }
#pragma unroll
      for (int r = 0; r < 9; ++r) red[(kg * 9 + r) * 64 + jj] = a[r];
      __syncthreads();
      for (int idx = tid; idx < 576; idx += 256) {
        int r = idx >> 6, j = idx & 63;
        float s = red[(0 * 9 + r) * 64 + j] + red[(1 * 9 + r) * 64 + j] + red[(2 * 9 + r) * 64 + j] + red[(3 * 9 + r) * 64 + j];
        modb[(l * 9 + r) * 3072 + j0 + j] = s + p.in[opq(6)][l * 3072 + j0 + j];
      }
      __syncthreads();
    } else {
      const int q = it - 96, l = q >> 6, d = (q >> 5) & 1, g = q & 31;
      unsigned char* base = p.ws + WS_S5C + (size_t)q * 8704;
      u16* BbarM = (u16*)base;
      u16* CmT = (u16*)(base + 4096);
      float* lamb = (float*)(base + 8192);
      const float st = expf(p.in[opq(20)][(l * 2 + d) * 32 + g]);
      for (int idx = tid; idx < 1024; idx += 256) {
        const int pp = idx >> 4, hh = idx & 15;
        const int li = ((l * 2 + d) * 32 + g) * 64 + pp;
        const float lre = p.in[opq(18)][li], lim = p.in[opq(19)][li];
        const float a = lre * st, bb = lim * st;
        const float ea = expf(a), sn = sinf(bb), cs = cosf(bb), s2 = sinf(0.5f * bb);
        const float lbre = ea * cs, lbim = ea * sn;
        const float nre = expm1f(a) * cs - 2.f * s2 * s2, nim = lbim;
        const float den = lre * lre + lim * lim;
        const float cre = (nre * lre + nim * lim) / den, cim = (nim * lre - nre * lim) / den;
        const int bi = ((l * 32 + g) * 64 + pp) * 16 + hh;
        const float bre = p.in[opq(21)][bi], bim = p.in[opq(22)][bi];
        BbarM[(2 * pp) * 16 + hh] = f2bf(cre * bre - cim * bim);
        BbarM[(2 * pp + 1) * 16 + hh] = f2bf(cre * bim + cim * bre);
        const int cidx = (((l * 2 + d) * 32 + g) * 16 + hh) * 64 + pp;
        CmT[hh * 128 + 2 * pp] = f2bf(p.in[opq(23)][cidx]);
        CmT[hh * 128 + 2 * pp + 1] = f2bf(-p.in[opq(24)][cidx]);
        if (hh == 0) { lamb[2 * pp] = lbre; lamb[2 * pp + 1] = lbim; }
      }
    }
  }
}

__device__ void phase_pre(const Params& p, int l, unsigned char* smem) {
  const int tid = opaque_tid(), lane = tid & 63, w = tid >> 6;
  const float* hl = l == 0 ? p.in[opq(0)] : p.out;
  const float* hc = l == 0 ? p.in[opq(2)] : (const float*)(p.ws + WS_HCTX);
  const float* nw = p.in[opq(4)] + l * 1024;
  const float* modb = (const float*)(p.ws + WS_MOD) + l * 9 * 3072;
  u16* U = (u16*)(p.ws + WS_Y);
  const bool cm = (l & 1);
  for (int r = blockIdx.x * 4 + w; r < NTOK; r += gridDim.x * 4) {
    const float* src; const float* mrow;
    if (r < NLAT) {
      int b = r >> 12, sp = r & 4095;
      int s = cm ? (((sp & 63) << 6) | (sp >> 6)) : sp;
      src = hl + ((size_t)(b * 4096 + s)) * 1024; mrow = modb + b * 3072;
    } else { src = hc + (size_t)(r - NLAT) * 1024; mrow = modb + 8 * 3072; }
    float4 v[4]; float ss = 0.f;
#pragma unroll
    for (int q = 0; q < 4; ++q) {
      v[q] = *reinterpret_cast<const float4*>(src + lane * 4 + q * 256);
      ss += v[q].x * v[q].x + v[q].y * v[q].y + v[q].z * v[q].z + v[q].w * v[q].w;
    }
#pragma unroll
    for (int o = 32; o > 0; o >>= 1) ss += __shfl_xor(ss, o);
    const float rs = rsqrtf(ss * (1.f / 1024.f) + EPSF);
#pragma unroll
    for (int q = 0; q < 4; ++q) {
      const int col = lane * 4 + q * 256;
      float4 n4 = *reinterpret_cast<const float4*>(nw + col);
      float4 sh = *reinterpret_cast<const float4*>(mrow + col);
      float4 s4 = *reinterpret_cast<const float4*>(mrow + 1024 + col);
      float u0 = v[q].x * rs * n4.x * (1.f + s4.x) + sh.x;
      float u1 = v[q].y * rs * n4.y * (1.f + s4.y) + sh.y;
      float u2 = v[q].z * rs * n4.z * (1.f + s4.z) + sh.z;
      float u3 = v[q].w * rs * n4.w * (1.f + s4.w) + sh.w;
      uint2 o; o.x = pack2(u0, u1); o.y = pack2(u2, u3);
      *reinterpret_cast<uint2*>(U + (size_t)r * 1024 + col) = o;
    }
  }
  float* tile = (float*)smem;
  for (int t = blockIdx.x; t < 1296 + 512 + 128; t += gridDim.x) {
    const float* src; int sld, k0, n0, kind; u16* dst; int dld;
    if (t < 1296) { kind = 0; k0 = (t / 81) * 64; n0 = (t % 81) * 64; src = p.in[opq(7)] + (size_t)l * 1024 * IND; sld = IND; dst = (u16*)(p.ws + WS_WIN); dld = 1024; }
    else if (t < 1808) { int q = t - 1296; kind = 1; k0 = (q / 16) * 64; n0 = (q % 16) * 64; src = p.in[opq(8)] + (size_t)l * 2048 * 1024; sld = 1024; dst = (u16*)(p.ws + WS_WOUT); dld = 2048; }
    else { int q = t - 1808; kind = 2; k0 = (q / 16) * 64; n0 = (q % 16) * 64; src = p.in[opq(26)] + (size_t)l * 512 * 1024; sld = 1024; dst = (u16*)(p.ws + WS_GLU); dld = 512; }
    __syncthreads();
#pragma unroll
    for (int rr = 0; rr < 4; ++rr) {
      int i = (tid >> 4) + 16 * rr, j = (tid & 15) * 4;
      float4 v = *reinterpret_cast<const float4*>(src + (size_t)(k0 + i) * sld + n0 + j);
      if (kind == 1 && k0 + i < 1024) { float s = p.in[opq(14)][l * 1024 + k0 + i]; v.x *= s; v.y *= s; v.z *= s; v.w *= s; }
      tile[i * 65 + j] = v.x; tile[i * 65 + j + 1] = v.y; tile[i * 65 + j + 2] = v.z; tile[i * 65 + j + 3] = v.w;
    }
    __syncthreads();
#pragma unroll
    for (int rr = 0; rr < 2; ++rr) {
      int n = (tid >> 3) + 32 * rr, i0 = (tid & 7) * 8;
      uint4 o;
      o.x = pack2(tile[(i0 + 0) * 65 + n], tile[(i0 + 1) * 65 + n]);
      o.y = pack2(tile[(i0 + 2) * 65 + n], tile[(i0 + 3) * 65 + n]);
      o.z = pack2(tile[(i0 + 4) * 65 + n], tile[(i0 + 5) * 65 + n]);
      o.w = pack2(tile[(i0 + 6) * 65 + n], tile[(i0 + 7) * 65 + n]);
      int drow = n0 + n;
      if (kind == 2) { int o_ = n0 + n, half = o_ >> 9, rem = o_ & 511; drow = (rem >> 6) * 128 + ((rem & 63) >> 4) * 32 + half * 16 + (rem & 15); }
      *reinterpret_cast<uint4*>(dst + (size_t)drow * dld + k0 + i0) = o;
    }
  }
}

template <int BN, int MODE>
__device__ void gemm_tile(const Params& p, int l, const u16* __restrict__ A, int lda, const u16* __restrict__ Bt, int ldb,
                          int K, int m0, int n0, unsigned char* smem,
                          bool pre, bool has_next, const u16* __restrict__ An, int ldan, int m0n, int n0n) {
  constexpr int WN = BN / 2, NF = WN / 16, NBL = BN * 8 / 256;
  u16* As = (u16*)smem;
  u16* Bs = As + 128 * 64;
  const int tid = opaque_tid(), lane = tid & 63, w = tid >> 6, wr = w >> 1, wc = w & 1, fr = lane & 15, fq = lane >> 4;
  f32x4 acc[4][NF];
#pragma unroll
  for (int m = 0; m < 4; ++m)
#pragma unroll
    for (int n = 0; n < NF; ++n) acc[m][n] = f32x4{0.f, 0.f, 0.f, 0.f};
  constexpr int STAGE = (128 + BN) * 64;
  const int nk = K / 64;
#define GLDS(OFF, KT) do { const int k0_ = (KT) * 64; \
    _Pragma("unroll") for (int i = 0; i < 4; ++i) { const int id = tid + 256 * i, row = id >> 3, c = (id & 7) ^ ((id >> 4) & 7); \
      __builtin_amdgcn_global_load_lds((const unsigned*)(A + (size_t)(m0 + row) * lda + k0_ + c * 8), (unsigned*)(As + (OFF) + id * 8), 16, 0, 0); } \
    _Pragma("unroll") for (int i = 0; i < NBL; ++i) { const int id = tid + 256 * i, row = id >> 3, c = (id & 7) ^ ((id >> 4) & 7); \
      __builtin_amdgcn_global_load_lds((const unsigned*)(Bt + (size_t)(n0 + row) * ldb + k0_ + c * 8), (unsigned*)(Bs + (OFF) + id * 8), 16, 0, 0); } } while (0)
#define COMPUTE(OFF) do { \
    bf16x8 af[2][4], bfr[2][NF];        \
    _Pragma("unroll") for (int kk = 0; kk < 2; ++kk) { \
      _Pragma("unroll") for (int m = 0; m < 4; ++m) af[kk][m] = ld8(As + (OFF) + (wr * 64 + m * 16 + fr) * 64 + (((kk * 4 + fq) ^ (fr >> 1)) * 8)); \
      _Pragma("unroll") for (int n = 0; n < NF; ++n) bfr[kk][n] = ld8(Bs + (OFF) + (wc * WN + n * 16 + fr) * 64 + (((kk * 4 + fq) ^ (fr >> 1)) * 8)); } \
    __builtin_amdgcn_s_setprio(1); \
    _Pragma("unroll") for (int kk = 0; kk < 2; ++kk) \
      _Pragma("unroll") for (int m = 0; m < 4; ++m) \
        _Pragma("unroll") for (int n = 0; n < NF; ++n) acc[m][n] = mfma16(bfr[kk][n], af[kk][m], acc[m][n]); \
    __builtin_amdgcn_s_setprio(0); } while (0)
  float f0[4], f1[4];
  if constexpr (MODE == 2) {
    const float* rsb = (const float*)(p.ws + WS_RS);
#pragma unroll
    for (int m = 0; m < 4; ++m) {
      const float2 r2 = *reinterpret_cast<const float2*>(rsb + (size_t)(m0 + wr * 64 + m * 16 + fr) * 2);
      f0[m] = r2.x * rcpf(r2.y); f1[m] = r2.y;
    }
  }
  __syncthreads();
  if (!pre) GLDS(0, 0);
  asm volatile("s_waitcnt vmcnt(0)" ::: "memory");
  __syncthreads();
  for (int kt = 0; kt < nk; ++kt) {
    const int cur = (kt & 1) * STAGE, nxt = STAGE - cur;
    if (kt + 1 < nk) GLDS(nxt, kt + 1);
    else if (has_next) {
#pragma unroll
      for (int i = 0; i < 4; ++i) { const int id = tid + 256 * i, row = id >> 3, c = (id & 7) ^ ((id >> 4) & 7);
        __builtin_amdgcn_global_load_lds((const unsigned*)(An + (size_t)(m0n + row) * ldan + c * 8), (unsigned*)(As + id * 8), 16, 0, 0); }
#pragma unroll
      for (int i = 0; i < NBL; ++i) { const int id = tid + 256 * i, row = id >> 3, c = (id & 7) ^ ((id >> 4) & 7);
        __builtin_amdgcn_global_load_lds((const unsigned*)(Bt + (size_t)(n0n + row) * ldb + c * 8), (unsigned*)(Bs + id * 8), 16, 0, 0); }
    }
    COMPUTE(cur);
    if constexpr (MODE == 2) {
      if (kt == 7 || kt == 15) {
#pragma unroll
        for (int m = 0; m < 4; ++m)
#pragma unroll
          for (int n = 0; n < NF; ++n)
#pragma unroll
            for (int j = 0; j < 4; ++j) acc[m][n][j] *= (kt == 7) ? f0[m] : f1[m];
      }
    }
    if (kt + 1 < nk) asm volatile("s_waitcnt vmcnt(0)" ::: "memory");
    __syncthreads();
  }
#define GLOAD(x)
#define LSTORE(x)
#undef GLOAD
#undef LSTORE
#undef COMPUTE
  if constexpr (MODE == 0) {
    u16* P = (u16*)(p.ws + WS_P);
    constexpr int SLD = WN + 8;
    u16* stg = (u16*)smem + STAGE + w * 16 * SLD;
    constexpr int CPR = WN / 8;
    __syncthreads();
#pragma unroll
    for (int m = 0; m < 4; ++m) {
      wave_lds_sync();
#pragma unroll
      for (int n = 0; n < NF; ++n) {
        uint2 o; o.x = pack2(acc[m][n][0], acc[m][n][1]); o.y = pack2(acc[m][n][2], acc[m][n][3]);
        *reinterpret_cast<uint2*>(stg + fr * SLD + n * 16 + fq * 4) = o;
      }
      wave_lds_sync();
      for (int id = lane; id < 16 * CPR; id += 64) {
        int row = id / CPR, ch = id % CPR;
        uint4 v = *reinterpret_cast<const uint4*>(stg + row * SLD + ch * 8);
        __builtin_nontemporal_store(__builtin_bit_cast(u32x4, v), reinterpret_cast<u32x4*>(P + (size_t)(m0 + wr * 64 + m * 16 + row) * IND + n0 + wc * WN + ch * 8));
      }
    }
  } else if constexpr (MODE == 1) {
    const u16* P = (const u16*)(p.ws + WS_P);
    u16* Y = (u16*)(p.ws + WS_Y);
    const float* gb = p.in[opq(27)] + l * 1024;
    const int tn = n0 >> 7;
#pragma unroll
    for (int q = 0; q < 2; ++q) {
      const int oc = tn * 64 + (wc * 2 + q) * 16 + fq * 4;
      const f32x4 b0 = *reinterpret_cast<const f32x4*>(gb + oc), b1 = *reinterpret_cast<const f32x4*>(gb + 512 + oc);
#pragma unroll
      for (int m = 0; m < 4; ++m) {
        const size_t row = (size_t)(m0 + wr * 64 + m * 16 + fr);
        const uint2 sgv = *reinterpret_cast<const uint2*>(P + row * IND + C_SG + oc);
        const float sg[4] = {bflo(sgv.x), bfhi(sgv.x), bflo(sgv.y), bfhi(sgv.y)};
        float y[4];
#pragma unroll
        for (int j = 0; j < 4; ++j) {
          const float val = acc[m][2 * q][j] + b0[j], gt = acc[m][2 * q + 1][j] + b1[j];
          y[j] = val * rcpf(1.f + __expf(-gt)) * siluf(sg[j]);
        }
        uint2 o; o.x = pack2(y[0], y[1]); o.y = pack2(y[2], y[3]);
        *reinterpret_cast<uint2*>(Y + row * MIXW + 1536 + oc) = o;
      }
    }
  } else {
    const float* modb = (const float*)(p.ws + WS_MOD) + l * 9 * 3072;
    const bool cm = (l & 1);
    const float* hs = l == 0 ? p.in[opq(0)] : p.out;
    float* stg = (float*)((u16*)smem + STAGE) + w * (16 * 68);
    __syncthreads();
#pragma unroll
    for (int m = 0; m < 4; ++m) {
#pragma unroll
      for (int n = 0; n < NF; ++n) *reinterpret_cast<f32x4*>(stg + fr * 68 + n * 16 + fq * 4) = acc[m][n];
      wave_lds_sync();
#pragma unroll
      for (int k = 0; k < 4; ++k) {
        const int id = lane + 64 * k, rowi = id >> 4, ch = id & 15;
        const f32x4 a = *reinterpret_cast<const f32x4*>(stg + rowi * 68 + ch * 4);
        const int r = m0 + wr * 64 + m * 16 + rowi, col = n0 + wc * WN + ch * 4;
        const float* src; float* dst; const float* gt;
        if (r < NLAT) {
          const int b = r >> 12, sp = r & 4095;
          const int sq = cm ? (((sp & 63) << 6) | (sp >> 6)) : sp;
          const size_t idx = ((size_t)(b * 4096 + sq)) * 1024 + col;
          src = hs + idx; dst = p.out + idx; gt = modb + b * 3072 + 2048 + col;
        } else {
          const size_t idx = (size_t)(r - NLAT) * 1024 + col;
          src = p.in[opq(2)] + idx; dst = (float*)(p.ws + WS_HCTX) + idx; gt = modb + 8 * 3072 + 2048 + col;
        }
        const f32x4 h = *reinterpret_cast<const f32x4*>(src), gv = *reinterpret_cast<const f32x4*>(gt);
        f32x4 o;
        o[0] = h[0] + gv[0] * a[0]; o[1] = h[1] + gv[1] * a[1]; o[2] = h[2] + gv[2] * a[2]; o[3] = h[3] + gv[3] * a[3];
        *reinterpret_cast<f32x4*>(dst) = o;
      }
      wave_lds_sync();
    }
  }
  __syncthreads();
}

__device__ void phase_conv(const Params& p, int l) {
  u16* P = (u16*)(p.ws + WS_P);
  const float* cw = p.in[opq(9)] + (size_t)l * 5 * 1536;
  const float* cb = p.in[opq(10)] + l * 1536;
  const int tid = opaque_tid(), cq = tid & 7, sgi = tid >> 3;
  for (int it = blockIdx.x; it < 768; it += gridDim.x) {
    const bool isctx = it >= 384;
    const int q = isctx ? it - 384 : it, b = q / 48, cgp = q % 48;
    const int L = isctx ? 256 : 4096, seg = L / 32, rowbase = isctx ? NLAT + b * 256 : b * 4096;
    const int ch = cgp * 32 + cq * 4;
    float4 wk[5];
#pragma unroll
    for (int k = 0; k < 5; ++k) wk[k] = *reinterpret_cast<const float4*>(cw + k * 1536 + ch);
    const float4 bias = *reinterpret_cast<const float4*>(cb + ch);
    u16* rp = P + (size_t)rowbase * IND + C_XBC + ch;
    const int a = sgi * seg;
    auto ld = [&](int sp) -> float4 {
      float4 r = make_float4(0.f, 0.f, 0.f, 0.f);
      if (sp >= 0 && sp < L) {
        uint2 v = *reinterpret_cast<const uint2*>(rp + (size_t)sp * IND);
        r.x = bflo(v.x); r.y = bfhi(v.x); r.z = bflo(v.y); r.w = bfhi(v.y);
      }
      return r;
    };
    float4 r0 = ld(a - 2), r1 = ld(a - 1), r2 = ld(a), r3 = ld(a + 1);
    const float4 e0 = ld(a + seg), e1 = ld(a + seg + 1);
    __syncthreads();
    auto ldraw = [&](int sp) -> uint2 {
      uint2 v = make_uint2(0u, 0u);
      if (sp < a + seg) v = *reinterpret_cast<const uint2*>(rp + (size_t)sp * IND);
      return v;
    };
    uint2 nraw[8];
#pragma unroll
    for (int j = 0; j < 8; ++j) nraw[j] = ldraw(a + 2 + j);
    for (int t0 = a; t0 < a + seg; t0 += 8) {
      uint2 cur[8];
#pragma unroll
      for (int j = 0; j < 8; ++j) cur[j] = nraw[j];
      if (t0 + 8 < a + seg) {
#pragma unroll
        for (int j = 0; j < 8; ++j) nraw[j] = ldraw(t0 + 10 + j);
      }
#pragma unroll
      for (int j = 0; j < 8; ++j) {
        const int sp = t0 + 2 + j;
        float4 r4;
        if (sp < a + seg) {
          const unsigned c0_ = pin(cur[j].x), c1_ = pin(cur[j].y);
          r4 = make_float4(bflo(c0_), bfhi(c0_), bflo(c1_), bfhi(c1_));
        } else r4 = (sp == a + seg) ? e0 : e1;
        float o0 = bias.x + wk[0].x * r0.x + wk[1].x * r1.x + wk[2].x * r2.x + wk[3].x * r3.x + wk[4].x * r4.x;
        float o1 = bias.y + wk[0].y * r0.y + wk[1].y * r1.y + wk[2].y * r2.y + wk[3].y * r3.y + wk[4].y * r4.y;
        float o2 = bias.z + wk[0].z * r0.z + wk[1].z * r1.z + wk[2].z * r2.z + wk[3].z * r3.z + wk[4].z * r4.z;
        float o3 = bias.w + wk[0].w * r0.w + wk[1].w * r1.w + wk[2].w * r2.w + wk[3].w * r3.w + wk[4].w * r4.w;
        uint2 o; o.x = pack2(siluf(o0), siluf(o1)); o.y = pack2(siluf(o2), siluf(o3));
        *reinterpret_cast<uint2*>(rp + (size_t)(t0 + j) * IND) = o;
        r0 = r1; r1 = r2; r2 = r3; r3 = r4;
      }
    }
    __syncthreads();
  }
}


__device__ void ssd_item(const Params& p, int l, int part, int item, unsigned char* smem) {
  u16* Bs = (u16*)smem;
  u16* Ms = Bs;
  u16* Cs = (u16*)(smem + 17408);
  u16* BT = (u16*)(smem + 34816);
  u16* xT = (u16*)(smem + 53248);
  u16* xwT = (u16*)(smem + 62464);
  float* dts = (float*)(smem + 71680);
  float* acs = dts + 64;
  float* wts = acs + 64;
  float* ssql = wts + 64;
  float* tots = ssql + 256;
  u16* ystg = (u16*)(smem + 73600);
  const int tid0 = opaque_tid();
  const int b = item >> 5, hd = (item >> 1) & 15, dir = item & 1, g = hd >> 3;
  u16* P = (u16*)(p.ws + WS_P);
  u16* Y = (u16*)(p.ws + WS_Y);
  float* ssq = (float*)(p.ws + WS_SSQ);
  float* stsave = (float*)(p.ws + WS_WIN) + (size_t)item * 8192;
  const float Dsk = p.in[opq(13)][l * 16 + hd];
  f32x4 hacc[8];
  if (part == 1) {
#pragma unroll
    for (int i = 0; i < 8; ++i) hacc[i] = *reinterpret_cast<const f32x4*>(stsave + (i * 256 + tid0) * 4);
  } else {
#pragma unroll
    for (int i = 0; i < 8; ++i) hacc[i] = f32x4{0.f, 0.f, 0.f, 0.f};
  }
  const int nseg = part == 0 ? 3 : 1;
  for (int seg = 0; seg < nseg; ++seg) {
    bool isctx; int sdir, ci0, ci1, mode;
    if (part == 1) { isctx = false; sdir = dir; ci0 = 32; ci1 = 64; mode = 2; }
    else if (seg == 0) { if (!(dir == 0 && l == 0)) continue; isctx = true; sdir = 1; ci0 = 0; ci1 = 4; mode = 1; }
    else if (seg == 1) { isctx = true; sdir = dir; ci0 = 0; ci1 = 4; mode = (dir == 0 && l == 0) ? 2 : 0; }
    else { isctx = false; sdir = dir; ci0 = 0; ci1 = 32; mode = 1; }
    if (part == 0 && seg <= 1) {
#pragma unroll
      for (int i = 0; i < 8; ++i) hacc[i] = f32x4{0.f, 0.f, 0.f, 0.f};
    }
    __threadfence();
    __syncthreads();
    const float aneg = -expf(p.in[opq(11)][(l * 2 + sdir) * 16 + hd]);
    const float dtb = p.in[opq(12)][(l * 2 + sdir) * 16 + hd];
    const int nch = isctx ? 4 : 64;
    const int rowbase = isctx ? NLAT + b * 256 : b * 4096;
#pragma unroll
    for (int i = 0; i < 8; ++i) asm volatile("" : "+v"(hacc[i]));
    u32x4 rx[2], rbm[4], rcm[4];
    unsigned rawdt = 0u;
    {
      const int tid = tid0, lane = tid & 63, w = tid >> 6;
      const int cL = (sdir ? nch - 1 - ci0 : ci0) * 64;
#pragma unroll
      for (int k = 0; k < 2; ++k) {
        const int id = tid + 256 * k, pch = id >> 6, i = id & 63;
        const int tau = sdir ? cL + 63 - i : cL + i;
        rx[k] = *reinterpret_cast<const u32x4*>(P + (size_t)(rowbase + tau) * IND + C_XBC + hd * 64 + pch * 8);
      }
#pragma unroll
      for (int k = 0; k < 4; ++k) {
        const int id = tid + 256 * k, nc = id >> 6, i = id & 63;
        const int tau = sdir ? cL + 63 - i : cL + i;
        rbm[k] = *reinterpret_cast<const u32x4*>(P + (size_t)(rowbase + tau) * IND + C_BM + g * 128 + nc * 8);
      }
#pragma unroll
      for (int k = 0; k < 4; ++k) {
        const int id = tid + 256 * k, i = id >> 4, nc = id & 15;
        const int tau = sdir ? cL + 63 - i : cL + i;
        rcm[k] = *reinterpret_cast<const u32x4*>(P + (size_t)(rowbase + tau) * IND + C_CM + g * 128 + nc * 8);
      }
      rawdt = P[(size_t)(rowbase + (sdir ? cL + 63 - lane : cL + lane)) * IND + C_DT + sdir * 16 + hd];
    }
    for (int ci = ci0; ci < ci1; ++ci) {
      const int c0 = (sdir ? nch - 1 - ci : ci) * 64;
      int tid = tid0;
      asm volatile("" : "+v"(tid));
      const int lane = tid & 63, w = tid >> 6, fr = lane & 15, fq = lane >> 4;
      __syncthreads();
      if (w == 0) {
        float dt = softplusf(bflo(pin(rawdt)) + dtb);
        const float cs = wave_incl_scan(dt * aneg);
        const float tot = __builtin_bit_cast(float, __builtin_amdgcn_readlane(__builtin_bit_cast(int, cs), 63));
        dts[lane] = dt; acs[lane] = cs; wts[lane] = __expf(tot - cs);
        if (lane == 0) tots[0] = tot;
      }
      pin4(rbm[0]); pin4(rbm[1]); pin4(rbm[2]); pin4(rbm[3]);
#pragma unroll
      for (int k = 0; k < 4; ++k) {
        const int id = tid + 256 * k, nc = id >> 6, i = id & 63;
        *reinterpret_cast<u32x4*>(Bs + i * 136 + nc * 8) = rbm[k];
#pragma unroll
        for (int e = 0; e < 4; ++e) {
          BT[(nc * 8 + 2 * e) * 72 + i] = (u16)(rbm[k][e] & 0xffffu);
          BT[(nc * 8 + 2 * e + 1) * 72 + i] = (u16)(rbm[k][e] >> 16);
        }
      }
#pragma unroll
      for (int k = 0; k < 4; ++k) {
        const int id = tid + 256 * k, i = id >> 4, nc = id & 15;
        *reinterpret_cast<u32x4*>(Cs + i * 136 + nc * 8) = rcm[k];
      }
      __syncthreads();
      pin4(rx[0]); pin4(rx[1]);
#pragma unroll
      for (int k = 0; k < 2; ++k) {
        const int id = tid + 256 * k, pch = id >> 6, i = id & 63;
        const float dt = dts[i], wt = wts[i];
#pragma unroll
        for (int e = 0; e < 4; ++e) {
          float x0 = bflo(rx[k][e]) * dt, x1 = bfhi(rx[k][e]) * dt;
          xT[(pch * 8 + 2 * e) * 72 + i] = f2bf(x0); xT[(pch * 8 + 2 * e + 1) * 72 + i] = f2bf(x1);
          xwT[(pch * 8 + 2 * e) * 72 + i] = f2bf(x0 * wt); xwT[(pch * 8 + 2 * e + 1) * 72 + i] = f2bf(x1 * wt);
        }
      }
      u32x4 tmpv[2] = {u32x4{0u, 0u, 0u, 0u}, u32x4{0u, 0u, 0u, 0u}};
      uint2 zr[4];
#pragma unroll
      for (int e = 0; e < 4; ++e) zr[e] = make_uint2(0u, 0u);
      if (mode == 2) {
        const int qs = (w * 4 + fq) * 16 + (15 - fr);
        const u16* tp = Y + (size_t)(rowbase + c0 + (qs >> 2)) * MIXW + hd * 64 + (qs & 3) * 16;
        tmpv[0] = *reinterpret_cast<const u32x4*>(tp); tmpv[1] = *reinterpret_cast<const u32x4*>(tp + 8);
#pragma unroll
        for (int tt = 0; tt < 4; ++tt) {
          const int t = tt * 16 + fr;
          const size_t row = (size_t)(rowbase + (sdir ? c0 + 63 - t : c0 + t));
          zr[tt] = *reinterpret_cast<const uint2*>(P + row * IND + hd * 64 + w * 16 + fq * 4);
        }
      }
      if (ci + 1 < ci1) {
        const int cL = (sdir ? nch - 2 - ci : ci + 1) * 64;
#pragma unroll
        for (int k = 0; k < 2; ++k) {
          const int id = tid + 256 * k, pch = id >> 6, i = id & 63;
          const int tau = sdir ? cL + 63 - i : cL + i;
          rx[k] = *reinterpret_cast<const u32x4*>(P + (size_t)(rowbase + tau) * IND + C_XBC + hd * 64 + pch * 8);
        }
#pragma unroll
        for (int k = 0; k < 4; ++k) {
          const int id = tid + 256 * k, nc = id >> 6, i = id & 63;
          const int tau = sdir ? cL + 63 - i : cL + i;
          rbm[k] = *reinterpret_cast<const u32x4*>(P + (size_t)(rowbase + tau) * IND + C_BM + g * 128 + nc * 8);
        }
#pragma unroll
        for (int k = 0; k < 4; ++k) {
          const int id = tid + 256 * k, i = id >> 4, nc = id & 15;
          const int tau = sdir ? cL + 63 - i : cL + i;
          rcm[k] = *reinterpret_cast<const u32x4*>(P + (size_t)(rowbase + tau) * IND + C_CM + g * 128 + nc * 8);
        }
        rawdt = P[(size_t)(rowbase + (sdir ? cL + 63 - lane : cL + lane)) * IND + C_DT + sdir * 16 + hd];
      }
      __syncthreads();
      f32x4 gacc[4];
#pragma unroll
      for (int i = 0; i < 4; ++i) gacc[i] = f32x4{0.f, 0.f, 0.f, 0.f};
#pragma unroll
      for (int kk = 0; kk < 4; ++kk) {
        bf16x8 a = ld8(Bs + (w * 16 + fr) * 136 + kk * 32 + fq * 8);
#pragma unroll
        for (int tb = 0; tb < 4; ++tb) {
          bf16x8 bb = ld8(Cs + (tb * 16 + fr) * 136 + kk * 32 + fq * 8);
          gacc[tb] = mfma16(a, bb, gacc[tb]);
        }
      }
      asm volatile("" : "+v"(tmpv[0]), "+v"(tmpv[1]));
      __syncthreads();
#pragma unroll
      for (int tb = 0; tb < 4; ++tb) {
        const int t = tb * 16 + fr;
        const float at = acs[t];
        float mv[4];
#pragma unroll
        for (int j = 0; j < 4; ++j) {
          const int s = w * 16 + fq * 4 + j;
          mv[j] = (s <= t) ? gacc[tb][j] * __expf(at - acs[s]) : 0.f;
        }
        uint2 o; o.x = pack2(mv[0], mv[1]); o.y = pack2(mv[2], mv[3]);
        *reinterpret_cast<uint2*>(Ms + t * 72 + w * 16 + fq * 4) = o;
      }
      __syncthreads();
      f32x4 yd[4], yo[4];
#pragma unroll
      for (int i = 0; i < 4; ++i) { yd[i] = f32x4{0.f, 0.f, 0.f, 0.f}; yo[i] = f32x4{0.f, 0.f, 0.f, 0.f}; }
#pragma unroll
      for (int kk = 0; kk < 2; ++kk) {
        bf16x8 bb = ld8(xT + (w * 16 + fr) * 72 + kk * 32 + fq * 8);
#pragma unroll
        for (int tt = 0; tt < 4; ++tt) {
          bf16x8 a = ld8(Ms + (tt * 16 + fr) * 72 + kk * 32 + fq * 8);
          yd[tt] = mfma16(bb, a, yd[tt]);
        }
      }
#pragma unroll
      for (int kk = 0; kk < 4; ++kk) {
        bf16x8 hb = packacc(hacc[2 * kk], hacc[2 * kk + 1]);
#pragma unroll
        for (int tt = 0; tt < 4; ++tt) {
          const u16* cr = Cs + (tt * 16 + fr) * 136 + fq * 4;
          bf16x8 a = ld44(cr + (2 * kk) * 16, cr + (2 * kk + 1) * 16);
          yo[tt] = mfma16(hb, a, yo[tt]);
        }
      }
      const float etot = __expf(tots[0]);
#pragma unroll
      for (int nb = 0; nb < 8; ++nb) { hacc[nb][0] *= etot; hacc[nb][1] *= etot; hacc[nb][2] *= etot; hacc[nb][3] *= etot; }
#pragma unroll
      for (int kk = 0; kk < 2; ++kk) {
        bf16x8 bb = ld8(xwT + (w * 16 + fr) * 72 + kk * 32 + fq * 8);
#pragma unroll
        for (int nb = 0; nb < 8; ++nb) {
          bf16x8 a = ld8(BT + (nb * 16 + fr) * 72 + kk * 32 + fq * 8);
          hacc[nb] = mfma16(a, bb, hacc[nb]);
        }
      }
      if (mode != 0) {
        float ea[4];
#pragma unroll
        for (int tt = 0; tt < 4; ++tt) ea[tt] = __expf(acs[tt * 16 + fr]);
        if (mode == 1) {
          u32x4 o0, o1;
#pragma unroll
          for (int tt = 0; tt < 4; ++tt) {
            float v[4];
#pragma unroll
            for (int j = 0; j < 4; ++j) v[j] = yd[tt][j] + ea[tt] * yo[tt][j];
            const unsigned a2 = pack2(v[0], v[1]), b2 = pack2(v[2], v[3]);
            if (tt == 0) { o0[0] = a2; o0[1] = b2; } else if (tt == 1) { o0[2] = a2; o0[3] = b2; }
            else if (tt == 2) { o1[0] = a2; o1[1] = b2; } else { o1[2] = a2; o1[3] = b2; }
          }
          const int qs = (w * 4 + fq) * 16 + fr;
          u16* tp = Y + (size_t)(rowbase + c0 + (qs >> 2)) * MIXW + hd * 64 + (qs & 3) * 16;
          *reinterpret_cast<u32x4*>(tp) = o0; *reinterpret_cast<u32x4*>(tp + 8) = o1;
        } else {
          float xsv[16], rdt[4], val[16];
#pragma unroll
          for (int tt = 0; tt < 4; ++tt) {
            rdt[tt] = rcpf(dts[tt * 16 + fr]);
#pragma unroll
            for (int j = 0; j < 4; ++j) xsv[tt * 4 + j] = bf2f(xT[(w * 16 + fq * 4 + j) * 72 + tt * 16 + fr]);
          }
          float sq[4];
#pragma unroll
          for (int tt = 0; tt < 4; ++tt) {
            const int t = tt * 16 + fr;
            const uint2 zw = zr[tt];
            const unsigned z01 = pin(zw.x), z23 = pin(zw.y);
            const float zz[4] = {bflo(z01), bfhi(z01), bflo(z23), bfhi(z23)};
            const int et = 3 - tt;
            const unsigned p01 = tmpv[et >> 1][(et & 1) * 2], p23 = tmpv[et >> 1][(et & 1) * 2 + 1];
            const float yf[4] = {bflo(p01), bfhi(p01), bflo(p23), bfhi(p23)};
            float s2 = 0.f;
#pragma unroll
            for (int j = 0; j < 4; ++j) {
              const float yv = yd[tt][j] + ea[tt] * yo[tt][j];
              const float vv = (yf[j] + yv + Dsk * xsv[tt * 4 + j] * rdt[tt]) * siluf(zz[j]);
              val[tt * 4 + j] = vv; s2 += vv * vv;
            }
            sq[tt] = s2;
            uint2 o; o.x = pack2(val[tt * 4], val[tt * 4 + 1]); o.y = pack2(val[tt * 4 + 2], val[tt * 4 + 3]);
            const int c = w * 2 + (fq >> 1);
            *reinterpret_cast<uint2*>(ystg + t * 64 + ((c ^ ((t >> 2) & 7)) << 3) + (fq & 1) * 4) = o;
          }
#pragma unroll
          for (int tt = 0; tt < 4; ++tt) {
            sq[tt] += __shfl_xor(sq[tt], 16); sq[tt] += __shfl_xor(sq[tt], 32);
          }
          if (fq == 0) {
#pragma unroll
            for (int tt = 0; tt < 4; ++tt) ssql[w * 64 + tt * 16 + fr] = sq[tt];
          }
          __syncthreads();
#pragma unroll
          for (int k = 0; k < 2; ++k) {
            const int id = tid + 256 * k, t = id >> 3, c = id & 7;
            const u32x4 v = *reinterpret_cast<const u32x4*>(ystg + t * 64 + ((c ^ ((t >> 2) & 7)) << 3));
            const size_t row = (size_t)(rowbase + (sdir ? c0 + 63 - t : c0 + t));
            *reinterpret_cast<u32x4*>(Y + row * MIXW + hd * 64 + c * 8) = v;
          }
          if (tid < 64) {
            const size_t row = (size_t)(rowbase + (sdir ? c0 + 63 - tid : c0 + tid));
            ssq[row * 16 + hd] = ssql[tid] + ssql[64 + tid] + ssql[128 + tid] + ssql[192 + tid];
          }
        }
      }
    }
  }
  if (part == 0) {
#pragma unroll
    for (int i = 0; i < 8; ++i) *reinterpret_cast<f32x4*>(stsave + (i * 256 + tid0) * 4) = hacc[i];
  }
}

__device__ void gla_item(const Params& p, int l, int part, int item, unsigned char* smem) {
  u16* qe = (u16*)smem;
  u16* ke = (u16*)(smem + 9216);
  u16* kdT = (u16*)(smem + 18432);
  u16* vT = (u16*)(smem + 27648);
  u16* at = (u16*)(smem + 46080);
  float* gl = (float*)(smem + 55296);
  float* red = (float*)(smem + 71936);
  const int tid0 = opaque_tid();
  const int b = item >> 3, h = (item >> 1) & 3, dir = item & 1;
  u16* P = (u16*)(p.ws + WS_P);
  u16* Y = (u16*)(p.ws + WS_Y);
  float* stsave = (float*)(p.ws + WS_WIN) + (size_t)(256 + item) * 8192;
  f32x4 sacc[4][2];
  if (part == 1) {
#pragma unroll
    for (int i = 0; i < 8; ++i) sacc[i >> 1][i & 1] = *reinterpret_cast<const f32x4*>(stsave + (i * 256 + tid0) * 4);
  } else {
#pragma unroll
    for (int i = 0; i < 8; ++i) sacc[i >> 1][i & 1] = f32x4{0.f, 0.f, 0.f, 0.f};
  }
  const int nseg = part == 0 ? 3 : 1;
  for (int seg = 0; seg < nseg; ++seg) {
    bool isctx; int sdir, ci0, ci1, mode;
    if (part == 1) { isctx = false; sdir = dir; ci0 = 32; ci1 = 64; mode = 2; }
    else if (seg == 0) { if (!(dir == 0 && l == 0)) continue; isctx = true; sdir = 1; ci0 = 0; ci1 = 4; mode = 1; }
    else if (seg == 1) { isctx = true; sdir = dir; ci0 = 0; ci1 = 4; mode = (dir == 0 && l == 0) ? 2 : 0; }
    else { isctx = false; sdir = dir; ci0 = 0; ci1 = 32; mode = 1; }
    if (part == 0 && seg <= 1) {
#pragma unroll
      for (int i = 0; i < 8; ++i) sacc[i >> 1][i & 1] = f32x4{0.f, 0.f, 0.f, 0.f};
    }
    __threadfence();
    __syncthreads();
    const int nch = isctx ? 4 : 64;
    const int rowbase = isctx ? NLAT + b * 256 : b * 4096;
#pragma unroll
    for (int i = 0; i < 8; ++i) asm volatile("" : "+v"(sacc[i >> 1][i & 1]));
    u32x4 rq[2], rk[2], rv[4], rlr;
    bf16x8 Bw;
    float bl;
    {
      const int tid = tid0;
      const int dcol = h * 64 + 32 * ((tid >> 6) & 1) + (tid & 31), kb = 8 * ((tid & 63) >> 5);
      const float* wlp = p.in[opq(15)] + ((size_t)((l * 2 + sdir) * 16 + kb)) * 256 + dcol;
      u32x4 bw;
#pragma unroll
      for (int e = 0; e < 4; ++e) bw[e] = pack2(wlp[(2 * e) * 256], wlp[(2 * e + 1) * 256]);
      Bw = __builtin_bit_cast(bf16x8, bw);
      bl = p.in[opq(16)][(l * 2 + sdir) * 256 + dcol];
      asm volatile("" : "+v"(Bw), "+v"(bl));
      const int cL = (sdir ? nch - 1 - ci0 : ci0) * 64;
#pragma unroll
      for (int k = 0; k < 2; ++k) {
        const int id = tid + 256 * k, i = id >> 3, dc = id & 7;
        const int tau = sdir ? cL + 63 - i : cL + i;
        rq[k] = *reinterpret_cast<const u32x4*>(P + (size_t)(rowbase + tau) * IND + C_Q + h * 64 + dc * 8);
      }
#pragma unroll
      for (int k = 0; k < 2; ++k) {
        const int id = tid + 256 * k, dc = id >> 6, i = id & 63;
        const int tau = sdir ? cL + 63 - i : cL + i;
        rk[k] = *reinterpret_cast<const u32x4*>(P + (size_t)(rowbase + tau) * IND + C_K + h * 64 + dc * 8);
      }
#pragma unroll
      for (int k = 0; k < 4; ++k) {
        const int id = tid + 256 * k, ec = id >> 6, i = id & 63;
        const int tau = sdir ? cL + 63 - i : cL + i;
        rv[k] = *reinterpret_cast<const u32x4*>(P + (size_t)(rowbase + tau) * IND + C_V + h * 128 + ec * 8);
      }
      {
        const int i = 32 * (tid >> 7) + (tid & 31), hf = (tid & 63) >> 5;
        const int tau = sdir ? cL + 63 - i : cL + i;
        rlr = *reinterpret_cast<const u32x4*>(P + (size_t)(rowbase + tau) * IND + C_LR + sdir * 16 + hf * 8);
      }
    }
    for (int ci = ci0; ci < ci1; ++ci) {
      const int c0 = (sdir ? nch - 1 - ci : ci) * 64;
      int tid = tid0;
      asm volatile("" : "+v"(tid));
      const int lane = tid & 63, w = tid >> 6, fr = lane & 15, fq = lane >> 4, d = tid & 63, iq = tid >> 6;
      __syncthreads();
      pin4(rlr);
      {
        const int th = w >> 1, dh = w & 1;
        f32x16 z;
#pragma unroll
        for (int r = 0; r < 16; ++r) z[r] = 0.f;
        const f32x16 lg = mfma32(__builtin_bit_cast(bf16x8, rlr), Bw, z);
#pragma unroll
        for (int r = 0; r < 16; ++r) {
          const int t = 32 * th + (r & 3) + 8 * (r >> 2) + 4 * (lane >> 5);
          gl[t * 65 + 32 * dh + (lane & 31)] = logsigf(lg[r] + bl) * (1.f / 16.f);
        }
      }
      __syncthreads();
      {
        float vals[16];
#pragma unroll
        for (int ii = 0; ii < 16; ++ii) vals[ii] = gl[(iq * 16 + ii) * 65 + d];
        float run = 0.f;
#pragma unroll
        for (int ii = 0; ii < 16; ++ii) { run += vals[ii]; gl[(iq * 16 + ii) * 65 + d] = run; }
        red[iq * 64 + d] = run;
      }
      __syncthreads();
      {
        float off = 0.f;
        for (int q = 0; q < iq; ++q) off += red[q * 64 + d];
        if (iq > 0) {
#pragma unroll 4
          for (int ii = 0; ii < 16; ++ii) gl[(iq * 16 + ii) * 65 + d] += off;
        }
      }
      __syncthreads();
      pin4(rq[0]); pin4(rq[1]); pin4(rk[0]); pin4(rk[1]); pin4(rv[0]); pin4(rv[1]); pin4(rv[2]); pin4(rv[3]);
#pragma unroll
      for (int k = 0; k < 2; ++k) {
        const int id = tid + 256 * k, i = id >> 3, dc = id & 7;
        u32x4 oo;
#pragma unroll
        for (int e = 0; e < 4; ++e) {
          float b0 = gl[i * 65 + dc * 8 + 2 * e], b1 = gl[i * 65 + dc * 8 + 2 * e + 1];
          oo[e] = pack2(bflo(rq[k][e]) * 0.125f * __expf(b0), bfhi(rq[k][e]) * 0.125f * __expf(b1));
        }
        *reinterpret_cast<u32x4*>(qe + i * 72 + dc * 8) = oo;
      }
#pragma unroll
      for (int k = 0; k < 2; ++k) {
        const int id = tid + 256 * k, dc = id >> 6, i = id & 63;
        u32x4 oo;
#pragma unroll
        for (int e = 0; e < 4; ++e) {
          const int d0 = dc * 8 + 2 * e;
          float b0 = gl[i * 65 + d0], b1 = gl[i * 65 + d0 + 1];
          float l0 = gl[63 * 65 + d0], l1 = gl[63 * 65 + d0 + 1];
          float k0 = bflo(rk[k][e]), k1 = bfhi(rk[k][e]);
          oo[e] = pack2(k0 * __expf(-b0), k1 * __expf(-b1));
          kdT[d0 * 72 + i] = f2bf(k0 * __expf(l0 - b0));
          kdT[(d0 + 1) * 72 + i] = f2bf(k1 * __expf(l1 - b1));
        }
        *reinterpret_cast<u32x4*>(ke + i * 72 + dc * 8) = oo;
      }
#pragma unroll
      for (int k = 0; k < 4; ++k) {
        const int id = tid + 256 * k, ec = id >> 6, i = id & 63;
#pragma unroll
        for (int e = 0; e < 4; ++e) {
          vT[(ec * 8 + 2 * e) * 72 + i] = (u16)(rv[k][e] & 0xffffu);
          vT[(ec * 8 + 2 * e + 1) * 72 + i] = (u16)(rv[k][e] >> 16);
        }
      }
      u32x4 tmpv[4];
      unsigned ggr[16];
#pragma unroll
      for (int e = 0; e < 4; ++e) tmpv[e] = u32x4{0u, 0u, 0u, 0u};
#pragma unroll
      for (int e = 0; e < 16; ++e) ggr[e] = 0u;
      if (mode == 2) {
        const int qs = (w * 4 + (3 - fq)) * 16 + fr;
        const u16* tp = Y + (size_t)(rowbase + c0 + (qs >> 2)) * MIXW + 1024 + h * 128 + (qs & 3) * 32;
#pragma unroll
        for (int e = 0; e < 4; ++e) tmpv[e] = *reinterpret_cast<const u32x4*>(tp + e * 8);
#pragma unroll
        for (int tt = 0; tt < 4; ++tt)
#pragma unroll
          for (int j = 0; j < 4; ++j) {
            const int t = tt * 16 + fq * 4 + j;
            const size_t row = (size_t)(rowbase + (sdir ? c0 + 63 - t : c0 + t));
            ggr[tt * 4 + j] = *reinterpret_cast<const unsigned*>(P + row * IND + C_GG + h * 128 + w * 32 + 2 * fr);
          }
      }
      if (ci + 1 < ci1) {
        const int cL = (sdir ? nch - 2 - ci : ci + 1) * 64;
#pragma unroll
        for (int k = 0; k < 2; ++k) {
          const int id = tid + 256 * k, i = id >> 3, dc = id & 7;
          const int tau = sdir ? cL + 63 - i : cL + i;
          rq[k] = *reinterpret_cast<const u32x4*>(P + (size_t)(rowbase + tau) * IND + C_Q + h * 64 + dc * 8);
        }
#pragma unroll
        for (int k = 0; k < 2; ++k) {
          const int id = tid + 256 * k, dc = id >> 6, i = id & 63;
          const int tau = sdir ? cL + 63 - i : cL + i;
          rk[k] = *reinterpret_cast<const u32x4*>(P + (size_t)(rowbase + tau) * IND + C_K + h * 64 + dc * 8);
        }
#pragma unroll
        for (int k = 0; k < 4; ++k) {
          const int id = tid + 256 * k, ec = id >> 6, i = id & 63;
          const int tau = sdir ? cL + 63 - i : cL + i;
          rv[k] = *reinterpret_cast<const u32x4*>(P + (size_t)(rowbase + tau) * IND + C_V + h * 128 + ec * 8);
        }
        {
          const int i = 32 * (tid >> 7) + (tid & 31), hf = (tid & 63) >> 5;
          const int tau = sdir ? cL + 63 - i : cL + i;
          rlr = *reinterpret_cast<const u32x4*>(P + (size_t)(rowbase + tau) * IND + C_LR + sdir * 16 + hf * 8);
        }
      }
      __syncthreads();
      {
        f32x4 aacc[4];
#pragma unroll
        for (int i = 0; i < 4; ++i) aacc[i] = f32x4{0.f, 0.f, 0.f, 0.f};
#pragma unroll
        for (int kk = 0; kk < 2; ++kk) {
          bf16x8 a = ld8(ke + (w * 16 + fr) * 72 + kk * 32 + fq * 8);
#pragma unroll
          for (int tb = 0; tb < 4; ++tb) {
            bf16x8 bb = ld8(qe + (tb * 16 + fr) * 72 + kk * 32 + fq * 8);
            aacc[tb] = mfma16(a, bb, aacc[tb]);
          }
        }
#pragma unroll
        for (int tb = 0; tb < 4; ++tb) {
          const int t = tb * 16 + fr;
          float mv[4];
#pragma unroll
          for (int j = 0; j < 4; ++j) { const int s = w * 16 + fq * 4 + j; mv[j] = (s <= t) ? aacc[tb][j] : 0.f; }
          uint2 o; o.x = pack2(mv[0], mv[1]); o.y = pack2(mv[2], mv[3]);
          *reinterpret_cast<uint2*>(at + t * 72 + w * 16 + fq * 4) = o;
        }
      }
      __syncthreads();
      f32x4 oacc[4][2];
#pragma unroll
      for (int i = 0; i < 4; ++i) { oacc[i][0] = f32x4{0.f, 0.f, 0.f, 0.f}; oacc[i][1] = f32x4{0.f, 0.f, 0.f, 0.f}; }
#pragma unroll
      for (int kk = 0; kk < 2; ++kk) {
        bf16x8 b0 = ld8(vT + (w * 32 + 2 * fr) * 72 + kk * 32 + fq * 8);
        bf16x8 b1 = ld8(vT + (w * 32 + 2 * fr + 1) * 72 + kk * 32 + fq * 8);
#pragma unroll
        for (int tt = 0; tt < 4; ++tt) {
          bf16x8 a = ld8(at + (tt * 16 + fr) * 72 + kk * 32 + fq * 8);
          oacc[tt][0] = mfma16(a, b0, oacc[tt][0]);
          oacc[tt][1] = mfma16(a, b1, oacc[tt][1]);
        }
      }
#pragma unroll
      for (int kk = 0; kk < 2; ++kk) {
        bf16x8 s0 = packacc(sacc[2 * kk][0], sacc[2 * kk + 1][0]);
        bf16x8 s1 = packacc(sacc[2 * kk][1], sacc[2 * kk + 1][1]);
#pragma unroll
        for (int tt = 0; tt < 4; ++tt) {
          const u16* qr = qe + (tt * 16 + fr) * 72 + fq * 4;
          bf16x8 a = ld44(qr + (2 * kk) * 16, qr + (2 * kk + 1) * 16);
          oacc[tt][0] = mfma16(a, s0, oacc[tt][0]);
          oacc[tt][1] = mfma16(a, s1, oacc[tt][1]);
        }
      }
#pragma unroll
      for (int db = 0; db < 4; ++db)
#pragma unroll
        for (int j = 0; j < 4; ++j) {
          const float sc = __expf(gl[63 * 65 + db * 16 + fq * 4 + j]);
          sacc[db][0][j] *= sc; sacc[db][1][j] *= sc;
        }
#pragma unroll
      for (int kk = 0; kk < 2; ++kk) {
        bf16x8 b0 = ld8(vT + (w * 32 + 2 * fr) * 72 + kk * 32 + fq * 8);
        bf16x8 b1 = ld8(vT + (w * 32 + 2 * fr + 1) * 72 + kk * 32 + fq * 8);
#pragma unroll
        for (int db = 0; db < 4; ++db) {
          bf16x8 a = ld8(kdT + (db * 16 + fr) * 72 + kk * 32 + fq * 8);
          sacc[db][0] = mfma16(a, b0, sacc[db][0]);
          sacc[db][1] = mfma16(a, b1, sacc[db][1]);
        }
      }
      pin4(tmpv[0]); pin4(tmpv[1]); pin4(tmpv[2]); pin4(tmpv[3]);
      if (mode != 0) {
        const int ycol = 1024 + h * 128 + w * 32 + 2 * fr;
        if (mode == 1) {
          const int qs = (w * 4 + fq) * 16 + fr;
          u16* tp = Y + (size_t)(rowbase + c0 + (qs >> 2)) * MIXW + 1024 + h * 128 + (qs & 3) * 32;
#pragma unroll
          for (int tt = 0; tt < 4; ++tt) {
            u32x4 o;
#pragma unroll
            for (int j = 0; j < 4; ++j) o[j] = pack2(oacc[tt][0][j], oacc[tt][1][j]);
            *reinterpret_cast<u32x4*>(tp + tt * 8) = o;
          }
        } else {
#pragma unroll
          for (int tt = 0; tt < 4; ++tt)
#pragma unroll
            for (int j = 0; j < 4; ++j) {
              const int t = tt * 16 + fq * 4 + j;
              const int e = 15 - (tt * 4 + j);
              const unsigned pw = tmpv[e >> 2][e & 3];
              float o0 = oacc[tt][0][j] + bflo(pw);
              float o1 = oacc[tt][1][j] + bfhi(pw);
              oacc[tt][0][j] = o0; oacc[tt][1][j] = o1;
              const float sq = row16_sum(o0 * o0 + o1 * o1);
              if (fr == 0) red[w * 64 + t] = sq;
            }
          __syncthreads();
          const float* nwv = p.in[opq(17)] + l * 128;
          const float nw0 = nwv[w * 32 + 2 * fr], nw1 = nwv[w * 32 + 2 * fr + 1];
#pragma unroll
          for (int tt = 0; tt < 4; ++tt)
#pragma unroll
            for (int j = 0; j < 4; ++j) {
              const int t = tt * 16 + fq * 4 + j;
              const size_t row = (size_t)(rowbase + (sdir ? c0 + 63 - t : c0 + t));
              const float tot = red[t] + red[64 + t] + red[128 + t] + red[192 + t];
              const float rs = rsqrtf(tot * (1.f / 128.f) + EPSF);
              const unsigned gw = pin(ggr[tt * 4 + j]);
              const float g0 = bflo(gw), g1 = bfhi(gw);
              *reinterpret_cast<unsigned*>(Y + row * MIXW + ycol) =
                  pack2(oacc[tt][0][j] * rs * nw0 * siluf(g0), oacc[tt][1][j] * rs * nw1 * siluf(g1));
            }
        }
      }
    }
  }
  if (part == 0) {
#pragma unroll
    for (int i = 0; i < 8; ++i) *reinterpret_cast<f32x4*>(stsave + (i * 256 + tid0) * 4) = sacc[i >> 1][i & 1];
  }
}

__device__ void s5_item(const Params& p, int l, int part, int blk, unsigned char* smem) {
  const int tid = opaque_tid(), lane = tid & 63, w = tid >> 6, fr = lane & 15, fq = lane >> 4;
  const int wi = blk * 4 + w;
  const int b = wi >> 6, g = (wi >> 1) & 31, dir = wi & 1;
  u16* hb = (u16*)smem + w * (32 * 136);
  u16* ust = (u16*)(smem + 4 * 32 * 136 * 2) + w * (32 * 16);
  u16* P = (u16*)(p.ws + WS_P);
  u16* Y = (u16*)(p.ws + WS_Y);
  u16* G5C = (u16*)(p.ws + WS_G5C);
  float* stsave = (float*)(p.ws + WS_S5ST) + (size_t)wi * 128;
  const float dsk = p.in[opq(25)][l * 512 + g * 16 + fr];
  float hre = 0.f, him = 0.f;
  if (part == 1) { hre = stsave[lane * 2]; him = stsave[lane * 2 + 1]; }
  const int nseg = part == 0 ? 3 : 1;
  for (int seg = 0; seg < nseg; ++seg) {
    bool isctx; int sdir, ti0, ti1, mode;
    if (part == 1) { isctx = false; sdir = dir; ti0 = 64; ti1 = 128; mode = 2; }
    else if (seg == 0) { if (!(dir == 0 && l == 0)) continue; isctx = true; sdir = 1; ti0 = 0; ti1 = 8; mode = 1; }
    else if (seg == 1) { isctx = true; sdir = dir; ti0 = 0; ti1 = 8; mode = (dir == 0 && l == 0) ? 2 : 0; }
    else { isctx = false; sdir = dir; ti0 = 0; ti1 = 64; mode = 1; }
    if (part == 0 && seg <= 1) { hre = 0.f; him = 0.f; }
    __threadfence();
    const unsigned char* cbase = p.ws + WS_S5C + (size_t)((l * 2 + sdir) * 32 + g) * 8704;
    const u16* BbarM = (const u16*)cbase;
    const u16* CmT = (const u16*)(cbase + 4096);
    const float* lamb = (const float*)(cbase + 8192);
    bf16x8 Bf[4], Cf[4];
#pragma unroll
    for (int cb = 0; cb < 4; ++cb) Bf[cb] = ld8(BbarM + (cb * 32 + (lane & 31)) * 16 + 8 * (lane >> 5));
#pragma unroll
    for (int kk = 0; kk < 4; ++kk) Cf[kk] = ld8(CmT + fr * 128 + kk * 32 + fq * 8);
    float lre = lamb[2 * lane], lim = lamb[2 * lane + 1];
#pragma unroll
    for (int i = 0; i < 4; ++i) asm volatile("" : "+v"(Bf[i]), "+v"(Cf[i]));
    asm volatile("" : "+v"(lre), "+v"(lim), "+v"(hre), "+v"(him));
    const int nt = isctx ? 8 : 128;
    const int rowbase = isctx ? NLAT + b * 256 : b * 4096;
    bf16x8 anext;
    {
      const int c0 = (sdir ? nt - 1 - ti0 : ti0) * 32, i = lane & 31;
      anext = ld8(P + (size_t)(rowbase + (sdir ? c0 + 31 - i : c0 + i)) * IND + C_U5 + g * 16 + 8 * (lane >> 5));
    }
    for (int ti = ti0; ti < ti1; ++ti) {
      const int c0 = (sdir ? nt - 1 - ti : ti) * 32;
      const bf16x8 a = anext;
      if (ti + 1 < ti1) {
        const int c1 = (sdir ? nt - 2 - ti : ti + 1) * 32, i = lane & 31;
        anext = ld8(P + (size_t)(rowbase + (sdir ? c1 + 31 - i : c1 + i)) * IND + C_U5 + g * 16 + 8 * (lane >> 5));
      }
      u32x4 tmpv = u32x4{0u, 0u, 0u, 0u};
      if (mode == 2) {
        const int qs = (3 - fq) * 16 + fr;
        tmpv = *reinterpret_cast<const u32x4*>(Y + (size_t)(rowbase + c0 + (qs >> 1)) * MIXW + 1536 + g * 16 + (qs & 1) * 8);
      }
      wave_lds_sync();
      if (mode == 2) *reinterpret_cast<bf16x8*>(ust + (lane & 31) * 16 + 8 * (lane >> 5)) = a;
#pragma unroll
      for (int cb = 0; cb < 4; ++cb) {
        f32x16 z;
#pragma unroll
        for (int r = 0; r < 16; ++r) z[r] = 0.f;
        f32x16 acc = mfma32(a, Bf[cb], z);
#pragma unroll
        for (int r = 0; r < 16; ++r) {
          const int ii = (r & 3) + 8 * (r >> 2) + 4 * (lane >> 5);
          hb[ii * 136 + cb * 32 + (lane & 31)] = f2bf(acc[r]);
        }
      }
      wave_lds_sync();
      {
        unsigned buv[32];
#pragma unroll
        for (int i = 0; i < 32; ++i) buv[i] = *reinterpret_cast<const unsigned*>(hb + i * 136 + 2 * lane);
#pragma unroll
        for (int i = 0; i < 32; ++i) {
          const float nre = lre * hre - lim * him + bflo(buv[i]);
          const float nim = lre * him + lim * hre + bfhi(buv[i]);
          hre = nre; him = nim;
          *reinterpret_cast<unsigned*>(hb + i * 136 + 2 * lane) = pack2(hre, him);
        }
      }
      wave_lds_sync();
      f32x4 ya[2];
      ya[0] = f32x4{0.f, 0.f, 0.f, 0.f}; ya[1] = f32x4{0.f, 0.f, 0.f, 0.f};
#pragma unroll
      for (int kk = 0; kk < 4; ++kk) {
        bf16x8 a0 = ld8(hb + fr * 136 + kk * 32 + fq * 8);
        bf16x8 a1 = ld8(hb + (16 + fr) * 136 + kk * 32 + fq * 8);
        ya[0] = mfma16(a0, Cf[kk], ya[0]);
        ya[1] = mfma16(a1, Cf[kk], ya[1]);
      }
      pin4(tmpv);
      if (mode == 1) {
        u32x4 o;
        o[0] = pack2(ya[0][0], ya[0][1]); o[1] = pack2(ya[0][2], ya[0][3]); o[2] = pack2(ya[1][0], ya[1][1]); o[3] = pack2(ya[1][2], ya[1][3]);
        const int qs = fq * 16 + fr;
        *reinterpret_cast<u32x4*>(Y + (size_t)(rowbase + c0 + (qs >> 1)) * MIXW + 1536 + g * 16 + (qs & 1) * 8) = o;
      } else if (mode == 2) {
#pragma unroll
        for (int rt = 0; rt < 2; ++rt)
#pragma unroll
          for (int j = 0; j < 4; ++j) {
            const int i = rt * 16 + fq * 4 + j;
            const int tau = sdir ? c0 + 31 - i : c0 + i;
            const size_t row = (size_t)(rowbase + tau);
            const int e = 7 - (rt * 4 + j);
            const unsigned pw = tmpv[e >> 1];
            const float yf = (e & 1) ? bfhi(pw) : bflo(pw);
            const float u = bf2f(ust[i * 16 + fr]);
            const float x = yf + ya[rt][j] + dsk * u;
            const float th = 1.f - 2.f * rcpf(1.f + __expf(2.f * 0.7978845608028654f * (x + 0.044715f * x * x * x)));
            const float ge = 0.5f * x * (1.f + th);
            if (isctx) G5C[(row - NLAT) * 512 + g * 16 + fr] = f2bf(ge);
            else P[row * IND + C_U5 + g * 16 + fr] = f2bf(ge);
          }
      }
    }
  }
  if (part == 0) { stsave[lane * 2] = hre; stsave[lane * 2 + 1] = him; }
}

__device__ void ssd_norm_rows(const Params& p, int nrows) {
  const int tid = opaque_tid();
  const float* ssq = (const float*)(p.ws + WS_SSQ);
  float* rsb = (float*)(p.ws + WS_RS);
  for (int i = blockIdx.x * 256 + tid; i < nrows * 2; i += gridDim.x * 256) {
    const float* sp = ssq + (size_t)i * 8;
    const float sum = sp[0] + sp[1] + sp[2] + sp[3] + sp[4] + sp[5] + sp[6] + sp[7];
    rsb[i] = rsqrtf(sum * (1.f / 512.f) + EPSF);
  }
}

__device__ void phase_final(const Params& p) {
  const int tid = opaque_tid(), lane = tid & 63, w = tid >> 6;
  const float* nw = p.in[opq(28)];
  for (int r = blockIdx.x * 4 + w; r < NLAT; r += gridDim.x * 4) {
    float* src = p.out + (size_t)r * 1024;
    float4 v[4]; float ss = 0.f;
#pragma unroll
    for (int q = 0; q < 4; ++q) {
      v[q] = *reinterpret_cast<const float4*>(src + lane * 4 + q * 256);
      ss += v[q].x * v[q].x + v[q].y * v[q].y + v[q].z * v[q].z + v[q].w * v[q].w;
    }
#pragma unroll
    for (int o = 32; o > 0; o >>= 1) ss += __shfl_xor(ss, o);
    const float rs = rsqrtf(ss * (1.f / 1024.f) + EPSF);
#pragma unroll
    for (int q = 0; q < 4; ++q) {
      const int col = lane * 4 + q * 256;
      float4 n4 = *reinterpret_cast<const float4*>(nw + col);
      float4 o = make_float4(v[q].x * rs * n4.x, v[q].y * rs * n4.y, v[q].z * rs * n4.z, v[q].w * rs * n4.w);
      *reinterpret_cast<float4*>(src + col) = o;
    }
  }
}


#define XB_TMO      128
#define XB_XCNT(j)  (256  + 64 * (j))
#define XB_XSUB(j)  (1280 + 64 * (j))
#define XB_XGEN(j)  (2304 + 64 * (j))
#define XB_TOP      3328
#define XB_TOPGEN   3392
#define XCD_BAR_WORDS 3456
#define XB_SPIN_CAP (1u << 20)
DI unsigned xb_ld(unsigned* p) { return __hip_atomic_load(p, __ATOMIC_RELAXED, __HIP_MEMORY_SCOPE_AGENT); }
DI unsigned xb_add(unsigned* p, unsigned v) { return __hip_atomic_fetch_add(p, v, __ATOMIC_RELAXED, __HIP_MEMORY_SCOPE_AGENT); }
DI unsigned xb_xcc_id() { return (unsigned)__builtin_amdgcn_s_getreg((3 << 11) | 20) & 0xFu; }
#define XB_SPIN(cond, bar) do { unsigned _sp = 0; while (cond) { __builtin_amdgcn_s_sleep(1); \
    if ((++_sp & 255u) == 0u) { if (xb_ld(&(bar)[XB_TMO])) break; if (_sp > XB_SPIN_CAP) { atomicAdd(&(bar)[XB_TMO], 1u); break; } } } } while (0)
struct XcdBarrier { unsigned* bar; unsigned x, nloc, nx; };
DI XcdBarrier xcd_barrier_post(unsigned* bar) {
  XcdBarrier b; b.bar = bar; b.x = xb_xcc_id(); b.nloc = 0u; b.nx = 0u;
  if (threadIdx.x == 0) (void)xb_add(&bar[XB_XCNT(b.x)], 1u);
  return b;
}
DI void xcd_barrier_complete(unsigned* bar, unsigned x, unsigned& nloc, unsigned& nx) {
  const unsigned G = gridDim.x;
  unsigned sum, cnt, mine, sp = 0u;
  for (;;) {
    sum = 0u; cnt = 0u; mine = 0u;
#pragma unroll
    for (unsigned j = 0; j < 16; ++j) { const unsigned c = xb_ld(&bar[XB_XCNT(j)]); sum += c; cnt += (c > 0u) ? 1u : 0u; mine = (j == x) ? c : mine; }
    if (sum == G) break;
    __builtin_amdgcn_s_sleep(1);
    if ((++sp & 255u) == 0u) { if (xb_ld(&bar[XB_TMO])) break; if (sp > XB_SPIN_CAP) { atomicAdd(&bar[XB_TMO], 1u); break; } }
  }
  nloc = mine > 0u ? mine : 1u; nx = cnt > 0u ? cnt : 1u;
}
DI void xcd_barrier(XcdBarrier& b) {
  asm volatile("s_waitcnt vmcnt(0)" ::: "memory");
  __syncthreads();
  if (threadIdx.x == 0) {
    unsigned* bar = b.bar;
    __builtin_amdgcn_s_waitcnt(0);
    if (b.nloc == 0u) xcd_barrier_complete(bar, b.x, b.nloc, b.nx);
    const unsigned nloc = b.nloc, nx = b.nx;
    const unsigned old = xb_add(&bar[XB_XSUB(b.x)], 1u);
    const unsigned gen = old / nloc;
    if (old + 1u == (gen + 1u) * nloc) {
      __builtin_amdgcn_fence(__ATOMIC_RELEASE, "agent");
      asm volatile("s_waitcnt vmcnt(0)" ::: "memory");
      const unsigned og = xb_add(&bar[XB_TOP], 1u);
      const unsigned tg = og / nx;
      if (og + 1u == (tg + 1u) * nx) xb_add(&bar[XB_TOPGEN], 1u);
      else XB_SPIN(xb_ld(&bar[XB_TOPGEN]) == tg, bar);
      __builtin_amdgcn_fence(__ATOMIC_ACQUIRE, "agent");
      xb_add(&bar[XB_XGEN(b.x)], 1u);
      asm volatile("s_waitcnt vmcnt(0)" ::: "memory");
    } else {
      XB_SPIN(xb_ld(&bar[XB_XGEN(b.x)]) == gen, bar);
      __builtin_amdgcn_fence(__ATOMIC_ACQUIRE, "agent");
      asm volatile("s_waitcnt vmcnt(0)" ::: "memory");
    }
  }
  __syncthreads();
}

__global__ void __launch_bounds__(256, 2) fwd_megakernel(Params p) {
  extern __shared__ __attribute__((aligned(16))) unsigned char smem[];
  cg::grid_group grid = cg::this_grid();
  XcdBarrier xb = xcd_barrier_post((unsigned*)(p.ws + WS_BAR));
  const int ph_lo = p.ph_lo, ph_hi = p.ph_hi;
  for (int ph = ph_lo; ph < ph_hi; ++ph) {
    if (ph == 0) {
      phase_prep(p, smem);
    } else if (ph == NPHASE - 1) {
      phase_final(p);
    } else {
      const int l = (ph - 1) / 7, sub = (ph - 1) % 7;
      const int mt = (l == 1) ? 256 : 272;
      if (sub == 0) {
        phase_pre(p, l, smem);
      } else if (sub == 1) {
        const u16* U = (const u16*)(p.ws + WS_Y);
        const u16* W = (const u16*)(p.ws + WS_WIN);
        const int xcd = blockIdx.x & 7, slot = blockIdx.x >> 3, nslots = gridDim.x >> 3;
        bool pre = false;
        for (int u = slot; u < 918; u += nslots) {
          const int pnl = u / 306, v = u % 306;
          const int u2 = u + nslots, pnl2 = u2 / 306, v2 = u2 % 306;
          const bool hn = u2 < 918;
          gemm_tile<192, 0>(p, l, U, 1024, W, 1024, 1024, (xcd * 34 + v / 9) * 128, (pnl * 9 + v % 9) * 192, smem,
                            pre, hn, U, 1024, (xcd * 34 + v2 / 9) * 128, (pnl2 * 9 + v2 % 9) * 192);
          pre = hn;
        }
      } else if (sub == 2) {
        phase_conv(p, l);
      } else if (sub == 3 || sub == 4) {
        const int part = sub - 3;
        for (int k = 0;; ++k) {
          int it;
          if (gridDim.x == 512) {
            if (k > 0) break;
            const int blk = blockIdx.x;
            const int q = blk < 256 ? blk - 64 : 192 + (blk - 448);
            const int sit = q < 128 ? q * 2 : (q < 192 ? 2 * (q - 128) : 2 * (q - 192) + 1) * 2 + 1;
            it = blk < 64 ? 256 + blk : blk < 256 ? sit : blk < 320 ? -1 : blk < 448 ? blk : sit;
          } else {
            it = blockIdx.x + k * gridDim.x;
            if (it >= 448) break;
          }
          if (it >= 0) {
            if (it < 256) ssd_item(p, l, part, it, smem);
            else if (it < 320) gla_item(p, l, part, it - 256, smem);
            else s5_item(p, l, part, it - 320, smem);
          }
          __syncthreads();
        }
      } else if (sub == 5) {
        const u16* W = (const u16*)(p.ws + WS_GLU);
        const int xcd = blockIdx.x & 7, slot = blockIdx.x >> 3, nslots = gridDim.x >> 3, mtx = mt >> 3;
        const u16* Alat = (const u16*)(p.ws + WS_P) + C_U5;
        const u16* Actx = (const u16*)(p.ws + WS_G5C) - (size_t)NLAT * 512;
        bool pre = false;
        for (int u = slot; u < mtx * 8; u += nslots) {
          const int t = (xcd * mtx) * 8 + u, t2 = t + nslots;
          const int m0 = (t >> 3) * 128, m0n = (t2 >> 3) * 128;
          const bool hn = u + nslots < mtx * 8;
          const u16* Ac = m0 < NLAT ? Alat : Actx; const int ldc = m0 < NLAT ? IND : 512;
          const u16* An = m0n < NLAT ? Alat : Actx; const int ldn = m0n < NLAT ? IND : 512;
          gemm_tile<128, 1>(p, l, Ac, ldc, W, 512, 512, m0, (t & 7) * 128, smem, pre, hn, An, ldn, m0n, (t2 & 7) * 128);
          pre = hn;
        }
        ssd_norm_rows(p, mt * 128);
      } else {
        const u16* A = (const u16*)(p.ws + WS_Y);
        const u16* W = (const u16*)(p.ws + WS_WOUT);
        const int xcd = blockIdx.x & 7, slot = blockIdx.x >> 3, nslots = gridDim.x >> 3, mtx = mt >> 3;
        bool pre = false;
        for (int u = slot; u < mtx * 8; u += nslots) {
          const int t = (xcd * mtx) * 8 + u, t2 = t + nslots;
          const bool hn = u + nslots < mtx * 8;
          gemm_tile<128, 2>(p, l, A, MIXW, W, MIXW, MIXW, (t >> 3) * 128, (t & 7) * 128, smem, pre, hn, A, MIXW, (t2 >> 3) * 128, (t2 & 7) * 128);
          pre = hn;
        }
      }
    }
    if (ph + 1 < ph_hi) {
      if (ph_hi < 0) grid.sync();
      xcd_barrier(xb);
    }
  }
}

extern "C" void kernel_launch(void* const* d_in, const int* in_sizes, int n_in, void* d_out, int out_size, void* d_ws,
                              size_t ws_size, hipStream_t stream) {
  static int grid_blocks = 0;
  if (grid_blocks == 0) {
    if (n_in != 29 || ws_size < WS_END) { fprintf(stderr, "kernel_launch: bad n_in %d / ws %zu (need %zu)\n", n_in, ws_size, (size_t)WS_END); grid_blocks = -1; return; }
    int dev = 0, cus = 0, per_cu = 0;
    hipGetDevice(&dev);
    hipDeviceGetAttribute(&cus, hipDeviceAttributeMultiprocessorCount, dev);
    hipFuncSetAttribute((const void*)fwd_megakernel, hipFuncAttributeMaxDynamicSharedMemorySize, SMEM_BYTES);
    hipOccupancyMaxActiveBlocksPerMultiprocessor(&per_cu, (const void*)fwd_megakernel, 256, SMEM_BYTES);
    if (per_cu < 1) per_cu = 1;
    if (per_cu > 2) per_cu = 2;
    grid_blocks = cus * per_cu;
    fprintf(stderr, "kernel_launch: cus %d per_cu %d grid %d\n", cus, per_cu, grid_blocks);
  }
  if (grid_blocks < 0) return;
  Params p{};
  for (int i = 0; i < 29; ++i) p.in[i] = (const float*)d_in[i];
  p.out = (float*)d_out; p.ws = (unsigned char*)d_ws; p.ph_lo = 0; p.ph_hi = NPHASE;
  if (hipMemsetAsync((char*)d_ws + WS_BAR, 0, 16384, stream) != hipSuccess) { fprintf(stderr, "kernel_launch: memset of the barrier words failed\n"); return; }
  void* args[] = {&p};
  hipError_t e = hipLaunchCooperativeKernel((const void*)fwd_megakernel, dim3(grid_blocks), dim3(256), args, SMEM_BYTES, stream);
  if (e != hipSuccess) fprintf(stderr, "cooperative launch failed: %s (grid %d)\n", hipGetErrorString(e), grid_blocks);
}
```

```cpp
#include <hip/hip_runtime.h>
#include <hip/hip_cooperative_groups.h>
#include <cstdio>
namespace cg = cooperative_groups;

typedef unsigned short u16;
using bf16x8 = __attribute__((ext_vector_type(8))) short;
using bf16x4 = __attribute__((ext_vector_type(4))) short;
using f32x4 = __attribute__((ext_vector_type(4))) float;
using f32x16 = __attribute__((ext_vector_type(16))) float;
using u32x4 = __attribute__((ext_vector_type(4))) unsigned;
#define DI __device__ __forceinline__

constexpr int DM = 1024, NLAT = 32768, NCTX = 2048, NTOK = 34816, IND = 5184, MIXW = 2048;
constexpr int C_XBC = 1024, C_BM = 2048, C_CM = 2304, C_DT = 2560, C_Q = 2592, C_K = 2848, C_V = 3104, C_GG = 3616,
              C_LR = 4128, C_U5 = 4160, C_SG = 4672;
constexpr float EPSF = 1e-6f;
constexpr int SMEM_BYTES = 81920;
constexpr int NPHASE = 16;

constexpr size_t WS_P = 0;
constexpr size_t WS_Y = WS_P + (size_t)NTOK * IND * 2;
constexpr size_t WS_WIN = WS_Y + (size_t)NTOK * MIXW * 2;
constexpr size_t WS_WOUT = WS_WIN + (size_t)IND * DM * 2;
constexpr size_t WS_GLU = WS_WOUT + (size_t)DM * MIXW * 2;
constexpr size_t WS_HCTX = WS_GLU + (size_t)1024 * 512 * 2;
constexpr size_t WS_MOD = WS_HCTX + (size_t)NCTX * DM * 4;
constexpr size_t WS_SSQ = WS_MOD + (size_t)2 * 9 * 3072 * 4;
constexpr size_t WS_S5C = WS_SSQ + (size_t)NTOK * 16 * 4;
constexpr size_t WS_G5C = WS_S5C + (size_t)128 * 8704;
constexpr size_t WS_S5ST = WS_G5C + (size_t)NCTX * 512 * 2;
constexpr size_t WS_BAR = WS_S5ST + (size_t)512 * 128 * 4;
constexpr size_t WS_RS = WS_BAR + 16384;
constexpr size_t WS_END = WS_RS + (size_t)NTOK * 2 * 4;

struct Params {
  const float* in[29];
  float* out;
  unsigned char* ws;
  int ph_lo, ph_hi;
};

DI int opq(int i) { asm volatile("" : "+s"(i)); return i; }
DI int opaque_tid() { int t = threadIdx.x; asm volatile("" : "+v"(t)); return t; }
typedef __bf16 hbf16x2 __attribute__((ext_vector_type(2)));
typedef float hf32x2 __attribute__((ext_vector_type(2)));
DI u16 f2bf(float x) { __bf16 h = (__bf16)x; return __builtin_bit_cast(u16, h); }
DI float bf2f(u16 h) { return __uint_as_float(((unsigned)h) << 16); }
DI unsigned pack2(float a, float b) { hf32x2 v = {a, b}; return __builtin_bit_cast(unsigned, __builtin_convertvector(v, hbf16x2)); }
DI float bflo(unsigned v) { return __uint_as_float(v << 16); }
DI float bfhi(unsigned v) { return __uint_as_float(v & 0xffff0000u); }
DI float rcpf(float x) { return __builtin_amdgcn_rcpf(x); }
DI float siluf(float x) { return x * rcpf(1.f + __expf(-x)); }
DI float logsigf(float x) { return fminf(x, 0.f) - __logf(1.f + __expf(-fabsf(x))); }
DI float softplusf(float v) { return fmaxf(v, 0.f) + log1pf(__expf(-fabsf(v))); }
DI f32x4 mfma16(bf16x8 a, bf16x8 b, f32x4 c) { return __builtin_amdgcn_mfma_f32_16x16x32_bf16(a, b, c, 0, 0, 0); }
DI f32x16 mfma32(bf16x8 a, bf16x8 b, f32x16 c) { return __builtin_amdgcn_mfma_f32_32x32x16_bf16(a, b, c, 0, 0, 0); }
DI void wave_lds_sync() { asm volatile("s_waitcnt lgkmcnt(0)" ::: "memory"); }
DI unsigned pin(unsigned v) { asm volatile("" : "+v"(v)); return v; }
DI void pin4(u32x4& v) { asm volatile("" : "+v"(v)); }
#define DPPF(v, old, ctrl, rmask) __builtin_bit_cast(float, __builtin_amdgcn_update_dpp(__builtin_bit_cast(int, (float)(old)), __builtin_bit_cast(int, (float)(v)), (ctrl), (rmask), 0xf, false))
DI float row16_sum(float v) {
  v += DPPF(v, 0.f, 0xB1, 0xf);
  v += DPPF(v, 0.f, 0x4E, 0xf);
  v += DPPF(v, 0.f, 0x141, 0xf);
  v += DPPF(v, 0.f, 0x140, 0xf);
  return v;
}
DI float wave_incl_scan(float v) {
  v += DPPF(v, 0.f, 0x111, 0xf);
  v += DPPF(v, 0.f, 0x112, 0xf);
  v += DPPF(v, 0.f, 0x114, 0xf);
  v += DPPF(v, 0.f, 0x118, 0xf);
  v += DPPF(v, 0.f, 0x142, 0xa);
  v += DPPF(v, 0.f, 0x143, 0xc);
  return v;
}
DI bf16x8 ld8(const u16* p) { return *reinterpret_cast<const bf16x8*>(p); }
DI bf16x8 ld44(const u16* p0, const u16* p1) {
  bf16x4 a = *reinterpret_cast<const bf16x4*>(p0), b = *reinterpret_cast<const bf16x4*>(p1);
  return __builtin_shufflevector(a, b, 0, 1, 2, 3, 4, 5, 6, 7);
}
DI bf16x8 packacc(const f32x4& a, const f32x4& b) {
  uint4 u; u.x = pack2(a[0], a[1]); u.y = pack2(a[2], a[3]); u.z = pack2(b[0], b[1]); u.w = pack2(b[2], b[3]);
  return __builtin_bit_cast(bf16x8, u);
}

__device__ void phase_prep(const Params& p, unsigned char* smem) {
  float* sc = (float*)smem;
  float* red = sc + 9 * 1024;
  const int tid = opaque_tid();
  float* modb = (float*)(p.ws + WS_MOD);
  bool filled = false;
  for (int it = blockIdx.x; it < 96 + 128; it += gridDim.x) {
    if (it < 96) {
      if (!filled) {
        for (int idx = tid; idx < 9216; idx += 256) {
          int r = idx >> 10, k = idx & 1023;
          float v = r < 8 ? p.in[opq(1)][r * 1024 + k] : p.in[opq(3)][k];
          sc[idx] = siluf(v);
        }
        filled = true;
        __syncthreads();
      }
      const int l = it / 48, j0 = (it % 48) * 64, kg = tid >> 6, jj = tid & 63;
      float a[9];
#pragma unroll
      for (int r = 0; r < 9; ++r) a[r] = 0.f;
      const float* W = p.in[opq(5)] + (size_t)l * 1024 * 3072 + j0 + jj;
      for (int k = kg * 256; k < kg * 256 + 256; ++k) {
        float wv = W[(size_t)k * 3072];
#pragma unroll
        for (int r = 0; r < 9; ++r) a[r] += sc[r * 1024 + k] * wv;
      }
#pragma unroll
      for (int r = 0; r < 9; ++r) red[(kg * 9 + r) * 64 + jj] = a[r];
      __syncthreads();
      for (int idx = tid; idx < 576; idx += 256) {
        int r = idx >> 6, j = idx & 63;
        float s = red[(0 * 9 + r) * 64 + j] + red[(1 * 9 + r) * 64 + j] + red[(2 * 9 + r) * 64 + j] + red[(3 * 9 + r) * 64 + j];
        modb[(l * 9 + r) * 3072 + j0 + j] = s + p.in[opq(6)][l * 3072 + j0 + j];
      }
      __syncthreads();
    } else {
      const int q = it - 96, l = q >> 6, d = (q >> 5) & 1, g = q & 31;
      unsigned char* base = p.ws + WS_S5C + (size_t)q * 8704;
      u16* BbarM = (u16*)base;
      u16* CmT = (u16*)(base + 4096);
      float* lamb = (float*)(base + 8192);
      const float st = expf(p.in[opq(20)][(l * 2 + d) * 32 + g]);
      for (int idx = tid; idx < 1024; idx += 256) {
        const int pp = idx >> 4, hh = idx & 15;
        const int li = ((l * 2 + d) * 32 + g) * 64 + pp;
        const float lre = p.in[opq(18)][li], lim = p.in[opq(19)][li];
        const float a = lre * st, bb = lim * st;
        const float ea = expf(a), sn = sinf(bb), cs = cosf(bb), s2 = sinf(0.5f * bb);
        const float lbre = ea * cs, lbim = ea * sn;
        const float nre = expm1f(a) * cs - 2.f * s2 * s2, nim = lbim;
        const float den = lre * lre + lim * lim;
        const float cre = (nre * lre + nim * lim) / den, cim = (nim * lre - nre * lim) / den;
        const int bi = ((l * 32 + g) * 64 + pp) * 16 + hh;
        const float bre = p.in[opq(21)][bi], bim = p.in[opq(22)][bi];
        BbarM[(2 * pp) * 16 + hh] = f2bf(cre * bre - cim * bim);
        BbarM[(2 * pp + 1) * 16 + hh] = f2bf(cre * bim + cim * bre);
        const int cidx = (((l * 2 + d) * 32 + g) * 16 + hh) * 64 + pp;
        CmT[hh * 128 + 2 * pp] = f2bf(p.in[opq(23)][cidx]);
        CmT[hh * 128 + 2 * pp + 1] = f2bf(-p.in[opq(24)][cidx]);
        if (hh == 0) { lamb[2 * pp] = lbre; lamb[2 * pp + 1] = lbim; }
      }
    }
  }
}

__device__ void phase_pre(const Params& p, int l, unsigned char* smem) {
  const int tid = opaque_tid(), lane = tid & 63, w = tid >> 6;
  const float* hl = l == 0 ? p.in[opq(0)] : p.out;
  const float* hc = l == 0 ? p.in[opq(2)] : (const float*)(p.ws + WS_HCTX);
  const float* nw = p.in[opq(4)] + l * 1024;
  const float* modb = (const float*)(p.ws + WS_MOD) + l * 9 * 3072;
  u16* U = (u16*)(p.ws + WS_Y);
  const bool cm = (l & 1);
  for (int r = blockIdx.x * 4 + w; r < NTOK; r += gridDim.x * 4) {
    const float* src; const float* mrow;
    if (r < NLAT) {
      int b = r >> 12, sp = r & 4095;
      int s = cm ? (((sp & 63) << 6) | (sp >> 6)) : sp;
      src = hl + ((size_t)(b * 4096 + s)) * 1024; mrow = modb + b * 3072;
    } else { src = hc + (size_t)(r - NLAT) * 1024; mrow = modb + 8 * 3072; }
    float4 v[4]; float ss = 0.f;
#pragma unroll
    for (int q = 0; q < 4; ++q) {
      { const f32x4 t_ = __builtin_nontemporal_load(reinterpret_cast<const f32x4*>(src + lane * 4 + q * 256)); v[q] = make_float4(t_[0], t_[1], t_[2], t_[3]); }
      ss += v[q].x * v[q].x + v[q].y * v[q].y + v[q].z * v[q].z + v[q].w * v[q].w;
    }
#pragma unroll
    for (int o = 32; o > 0; o >>= 1) ss += __shfl_xor(ss, o);
    const float rs = rsqrtf(ss * (1.f / 1024.f) + EPSF);
#pragma unroll
    for (int q = 0; q < 4; ++q) {
      const int col = lane * 4 + q * 256;
      float4 n4 = *reinterpret_cast<const float4*>(nw + col);
      float4 sh = *reinterpret_cast<const float4*>(mrow + col);
      float4 s4 = *reinterpret_cast<const float4*>(mrow + 1024 + col);
      float u0 = v[q].x * rs * n4.x * (1.f + s4.x) + sh.x;
      float u1 = v[q].y * rs * n4.y * (1.f + s4.y) + sh.y;
      float u2 = v[q].z * rs * n4.z * (1.f + s4.z) + sh.z;
      float u3 = v[q].w * rs * n4.w * (1.f + s4.w) + sh.w;
      uint2 o; o.x = pack2(u0, u1); o.y = pack2(u2, u3);
      *reinterpret_cast<uint2*>(U + (size_t)r * 1024 + col) = o;
    }
  }
  float* tile = (float*)smem;
  for (int t = blockIdx.x; t < 1296 + 512 + 128; t += gridDim.x) {
    const float* src; int sld, k0, n0, kind; u16* dst; int dld;
    if (t < 1296) { kind = 0; k0 = (t / 81) * 64; n0 = (t % 81) * 64; src = p.in[opq(7)] + (size_t)l * 1024 * IND; sld = IND; dst = (u16*)(p.ws + WS_WIN); dld = 1024; }
    else if (t < 1808) { int q = t - 1296; kind = 1; k0 = (q / 16) * 64; n0 = (q % 16) * 64; src = p.in[opq(8)] + (size_t)l * 2048 * 1024; sld = 1024; dst = (u16*)(p.ws + WS_WOUT); dld = 2048; }
    else { int q = t - 1808; kind = 2; k0 = (q / 16) * 64; n0 = (q % 16) * 64; src = p.in[opq(26)] + (size_t)l * 512 * 1024; sld = 1024; dst = (u16*)(p.ws + WS_GLU); dld = 512; }
    __syncthreads();
#pragma unroll
    for (int rr = 0; rr < 4; ++rr) {
      int i = (tid >> 4) + 16 * rr, j = (tid & 15) * 4;
      float4 v; { const f32x4 t_ = __builtin_nontemporal_load(reinterpret_cast<const f32x4*>(src + (size_t)(k0 + i) * sld + n0 + j)); v = make_float4(t_[0], t_[1], t_[2], t_[3]); }
      if (kind == 1 && k0 + i < 1024) { float s = p.in[opq(14)][l * 1024 + k0 + i]; v.x *= s; v.y *= s; v.z *= s; v.w *= s; }
      tile[i * 65 + j] = v.x; tile[i * 65 + j + 1] = v.y; tile[i * 65 + j + 2] = v.z; tile[i * 65 + j + 3] = v.w;
    }
    __syncthreads();
#pragma unroll
    for (int rr = 0; rr < 2; ++rr) {
      int n = (tid >> 3) + 32 * rr, i0 = (tid & 7) * 8;
      uint4 o;
      o.x = pack2(tile[(i0 + 0) * 65 + n], tile[(i0 + 1) * 65 + n]);
      o.y = pack2(tile[(i0 + 2) * 65 + n], tile[(i0 + 3) * 65 + n]);
      o.z = pack2(tile[(i0 + 4) * 65 + n], tile[(i0 + 5) * 65 + n]);
      o.w = pack2(tile[(i0 + 6) * 65 + n], tile[(i0 + 7) * 65 + n]);
      int drow = n0 + n;
      if (kind == 2) { int o_ = n0 + n, half = o_ >> 9, rem = o_ & 511; drow = (rem >> 6) * 128 + ((rem & 63) >> 4) * 32 + half * 16 + (rem & 15); }
      *reinterpret_cast<uint4*>(dst + (size_t)drow * dld + k0 + i0) = o;
    }
  }
}

template <int BN, int MODE>
__device__ void gemm_tile(const Params& p, int l, const u16* __restrict__ A, int lda, const u16* __restrict__ Bt, int ldb,
                          int K, int m0, int n0, unsigned char* smem,
                          bool pre, bool has_next, const u16* __restrict__ An, int ldan, int m0n, int n0n) {
  constexpr int WN = BN / 2, NF = WN / 16, NBL = BN * 8 / 256;
  u16* As = (u16*)smem;
  u16* Bs = As + 128 * 64;
  const int tid = opaque_tid(), lane = tid & 63, w = tid >> 6, wr = w >> 1, wc = w & 1, fr = lane & 15, fq = lane >> 4;
  f32x4 acc[4][NF];
#pragma unroll
  for (int m = 0; m < 4; ++m)
#pragma unroll
    for (int n = 0; n < NF; ++n) acc[m][n] = f32x4{0.f, 0.f, 0.f, 0.f};
  constexpr int STAGE = (128 + BN) * 64;
  const int nk = K / 64;
#define GLDS(OFF, KT) do { const int k0_ = (KT) * 64; \
    _Pragma("unroll") for (int i = 0; i < 4; ++i) { const int id = tid + 256 * i, row = id >> 3, c = (id & 7) ^ ((id >> 4) & 7); \
      __builtin_amdgcn_global_load_lds((const unsigned*)(A + (size_t)(m0 + row) * lda + k0_ + c * 8), (unsigned*)(As + (OFF) + id * 8), 16, 0, 0); } \
    _Pragma("unroll") for (int i = 0; i < NBL; ++i) { const int id = tid + 256 * i, row = id >> 3, c = (id & 7) ^ ((id >> 4) & 7); \
      __builtin_amdgcn_global_load_lds((const unsigned*)(Bt + (size_t)(n0 + row) * ldb + k0_ + c * 8), (unsigned*)(Bs + (OFF) + id * 8), 16, 0, 0); } } while (0)
#define COMPUTE(OFF) do { \
    bf16x8 af[2][4], bfr[2][NF];        \
    _Pragma("unroll") for (int kk = 0; kk < 2; ++kk) { \
      _Pragma("unroll") for (int m = 0; m < 4; ++m) af[kk][m] = ld8(As + (OFF) + (wr * 64 + m * 16 + fr) * 64 + (((kk * 4 + fq) ^ (fr >> 1)) * 8)); \
      _Pragma("unroll") for (int n = 0; n < NF; ++n) bfr[kk][n] = ld8(Bs + (OFF) + (wc * WN + n * 16 + fr) * 64 + (((kk * 4 + fq) ^ (fr >> 1)) * 8)); } \
    __builtin_amdgcn_s_setprio(1); \
    _Pragma("unroll") for (int kk = 0; kk < 2; ++kk) \
      _Pragma("unroll") for (int m = 0; m < 4; ++m) \
        _Pragma("unroll") for (int n = 0; n < NF; ++n) acc[m][n] = mfma16(bfr[kk][n], af[kk][m], acc[m][n]); \
    __builtin_amdgcn_s_setprio(0); } while (0)
  float f0[4], f1[4];
  if constexpr (MODE == 2) {
    const float* rsb = (const float*)(p.ws + WS_RS);
#pragma unroll
    for (int m = 0; m < 4; ++m) {
      const float2 r2 = *reinterpret_cast<const float2*>(rsb + (size_t)(m0 + wr * 64 + m * 16 + fr) * 2);
      f0[m] = r2.x * rcpf(r2.y); f1[m] = r2.y;
    }
  }
  __syncthreads();
  if (!pre) GLDS(0, 0);
  asm volatile("s_waitcnt vmcnt(0)" ::: "memory");
  __syncthreads();
  for (int kt = 0; kt < nk; ++kt) {
    const int cur = (kt & 1) * STAGE, nxt = STAGE - cur;
    if (kt + 1 < nk) GLDS(nxt, kt + 1);
    else if (has_next) {
#pragma unroll
      for (int i = 0; i < 4; ++i) { const int id = tid + 256 * i, row = id >> 3, c = (id & 7) ^ ((id >> 4) & 7);
        __builtin_amdgcn_global_load_lds((const unsigned*)(An + (size_t)(m0n + row) * ldan + c * 8), (unsigned*)(As + id * 8), 16, 0, 0); }
#pragma unroll
      for (int i = 0; i < NBL; ++i) { const int id = tid + 256 * i, row = id >> 3, c = (id & 7) ^ ((id >> 4) & 7);
        __builtin_amdgcn_global_load_lds((const unsigned*)(Bt + (size_t)(n0n + row) * ldb + c * 8), (unsigned*)(Bs + id * 8), 16, 0, 0); }
    }
    COMPUTE(cur);
    if constexpr (MODE == 2) {
      if (kt == 7 || kt == 15) {
#pragma unroll
        for (int m = 0; m < 4; ++m)
#pragma unroll
          for (int n = 0; n < NF; ++n)
#pragma unroll
            for (int j = 0; j < 4; ++j) acc[m][n][j] *= (kt == 7) ? f0[m] : f1[m];
      }
    }
    if (kt + 1 < nk) asm volatile("s_waitcnt vmcnt(0)" ::: "memory");
    __syncthreads();
  }
#define GLOAD(x)
#define LSTORE(x)
#undef GLOAD
#undef LSTORE
#undef COMPUTE
  if constexpr (MODE == 0) {
    u16* P = (u16*)(p.ws + WS_P);
    constexpr int SLD = WN + 8;
    u16* stg = (u16*)smem + STAGE + w * 16 * SLD;
    constexpr int CPR = WN / 8;
    __syncthreads();
#pragma unroll
    for (int m = 0; m < 4; ++m) {
      wave_lds_sync();
#pragma unroll
      for (int n = 0; n < NF; ++n) {
        uint2 o; o.x = pack2(acc[m][n][0], acc[m][n][1]); o.y = pack2(acc[m][n][2], acc[m][n][3]);
        *reinterpret_cast<uint2*>(stg + fr * SLD + n * 16 + fq * 4) = o;
      }
      wave_lds_sync();
      for (int id = lane; id < 16 * CPR; id += 64) {
        int row = id / CPR, ch = id % CPR;
        uint4 v = *reinterpret_cast<const uint4*>(stg + row * SLD + ch * 8);
        __builtin_nontemporal_store(__builtin_bit_cast(u32x4, v), reinterpret_cast<u32x4*>(P + (size_t)(m0 + wr * 64 + m * 16 + row) * IND + n0 + wc * WN + ch * 8));
      }
    }
  } else if constexpr (MODE == 1) {
    const u16* P = (const u16*)(p.ws + WS_P);
    u16* Y = (u16*)(p.ws + WS_Y);
    const float* gb = p.in[opq(27)] + l * 1024;
    const int tn = n0 >> 7;
#pragma unroll
    for (int q = 0; q < 2; ++q) {
      const int oc = tn * 64 + (wc * 2 + q) * 16 + fq * 4;
      const f32x4 b0 = *reinterpret_cast<const f32x4*>(gb + oc), b1 = *reinterpret_cast<const f32x4*>(gb + 512 + oc);
#pragma unroll
      for (int m = 0; m < 4; ++m) {
        const size_t row = (size_t)(m0 + wr * 64 + m * 16 + fr);
        const uint2 sgv = *reinterpret_cast<const uint2*>(P + row * IND + C_SG + oc);
        const float sg[4] = {bflo(sgv.x), bfhi(sgv.x), bflo(sgv.y), bfhi(sgv.y)};
        float y[4];
#pragma unroll
        for (int j = 0; j < 4; ++j) {
          const float val = acc[m][2 * q][j] + b0[j], gt = acc[m][2 * q + 1][j] + b1[j];
          y[j] = val * rcpf(1.f + __expf(-gt)) * siluf(sg[j]);
        }
        uint2 o; o.x = pack2(y[0], y[1]); o.y = pack2(y[2], y[3]);
        *reinterpret_cast<uint2*>(Y + row * MIXW + 1536 + oc) = o;
      }
    }
  } else {
    const float* modb = (const float*)(p.ws + WS_MOD) + l * 9 * 3072;
    const bool cm = (l & 1);
    const float* hs = l == 0 ? p.in[opq(0)] : p.out;
    float* stg = (float*)((u16*)smem + STAGE) + w * (16 * 68);
    __syncthreads();
#pragma unroll
    for (int m = 0; m < 4; ++m) {
#pragma unroll
      for (int n = 0; n < NF; ++n) *reinterpret_cast<f32x4*>(stg + fr * 68 + n * 16 + fq * 4) = acc[m][n];
      wave_lds_sync();
#pragma unroll
      for (int k = 0; k < 4; ++k) {
        const int id = lane + 64 * k, rowi = id >> 4, ch = id & 15;
        const f32x4 a = *reinterpret_cast<const f32x4*>(stg + rowi * 68 + ch * 4);
        const int r = m0 + wr * 64 + m * 16 + rowi, col = n0 + wc * WN + ch * 4;
        const float* src; float* dst; const float* gt;
        if (r < NLAT) {
          const int b = r >> 12, sp = r & 4095;
          const int sq = cm ? (((sp & 63) << 6) | (sp >> 6)) : sp;
          const size_t idx = ((size_t)(b * 4096 + sq)) * 1024 + col;
          src = hs + idx; dst = p.out + idx; gt = modb + b * 3072 + 2048 + col;
        } else {
          const size_t idx = (size_t)(r - NLAT) * 1024 + col;
          src = p.in[opq(2)] + idx; dst = (float*)(p.ws + WS_HCTX) + idx; gt = modb + 8 * 3072 + 2048 + col;
        }
        const f32x4 h = __builtin_nontemporal_load(reinterpret_cast<const f32x4*>(src)), gv = *reinterpret_cast<const f32x4*>(gt);
        f32x4 o;
        o[0] = h[0] + gv[0] * a[0]; o[1] = h[1] + gv[1] * a[1]; o[2] = h[2] + gv[2] * a[2]; o[3] = h[3] + gv[3] * a[3];
        *reinterpret_cast<f32x4*>(dst) = o;
      }
      wave_lds_sync();
    }
  }
  __syncthreads();
}

__device__ void phase_conv(const Params& p, int l) {
  u16* P = (u16*)(p.ws + WS_P);
  const float* cw = p.in[opq(9)] + (size_t)l * 5 * 1536;
  const float* cb = p.in[opq(10)] + l * 1536;
  const int tid = opaque_tid(), cq = tid & 7, sgi = tid >> 3;
  for (int it = blockIdx.x; it < 768; it += gridDim.x) {
    const bool isctx = it >= 384;
    const int q = isctx ? it - 384 : it, b = q / 48, cgp = q % 48;
    const int L = isctx ? 256 : 4096, seg = L / 32, rowbase = isctx ? NLAT + b * 256 : b * 4096;
    const int ch = cgp * 32 + cq * 4;
    float4 wk[5];
#pragma unroll
    for (int k = 0; k < 5; ++k) wk[k] = *reinterpret_cast<const float4*>(cw + k * 1536 + ch);
    const float4 bias = *reinterpret_cast<const float4*>(cb + ch);
    u16* rp = P + (size_t)rowbase * IND + C_XBC + ch;
    const int a = sgi * seg;
    auto ld = [&](int sp) -> float4 {
      float4 r = make_float4(0.f, 0.f, 0.f, 0.f);
      if (sp >= 0 && sp < L) {
        uint2 v = *reinterpret_cast<const uint2*>(rp + (size_t)sp * IND);
        r.x = bflo(v.x); r.y = bfhi(v.x); r.z = bflo(v.y); r.w = bfhi(v.y);
      }
      return r;
    };
    float4 r0 = ld(a - 2), r1 = ld(a - 1), r2 = ld(a), r3 = ld(a + 1);
    const float4 e0 = ld(a + seg), e1 = ld(a + seg + 1);
    __syncthreads();
    auto ldraw = [&](int sp) -> uint2 {
      uint2 v = make_uint2(0u, 0u);
      if (sp < a + seg) v = *reinterpret_cast<const uint2*>(rp + (size_t)sp * IND);
      return v;
    };
    uint2 nraw[8];
#pragma unroll
    for (int j = 0; j < 8; ++j) nraw[j] = ldraw(a + 2 + j);
    for (int t0 = a; t0 < a + seg; t0 += 8) {
      uint2 cur[8];
#pragma unroll
      for (int j = 0; j < 8; ++j) cur[j] = nraw[j];
      if (t0 + 8 < a + seg) {
#pragma unroll
        for (int j = 0; j < 8; ++j) nraw[j] = ldraw(t0 + 10 + j);
      }
#pragma unroll
      for (int j = 0; j < 8; ++j) {
        const int sp = t0 + 2 + j;
        float4 r4;
        if (sp < a + seg) {
          const unsigned c0_ = pin(cur[j].x), c1_ = pin(cur[j].y);
          r4 = make_float4(bflo(c0_), bfhi(c0_), bflo(c1_), bfhi(c1_));
        } else r4 = (sp == a + seg) ? e0 : e1;
        float o0 = bias.x + wk[0].x * r0.x + wk[1].x * r1.x + wk[2].x * r2.x + wk[3].x * r3.x + wk[4].x * r4.x;
        float o1 = bias.y + wk[0].y * r0.y + wk[1].y * r1.y + wk[2].y * r2.y + wk[3].y * r3.y + wk[4].y * r4.y;
        float o2 = bias.z + wk[0].z * r0.z + wk[1].z * r1.z + wk[2].z * r2.z + wk[3].z * r3.z + wk[4].z * r4.z;
        float o3 = bias.w + wk[0].w * r0.w + wk[1].w * r1.w + wk[2].w * r2.w + wk[3].w * r3.w + wk[4].w * r4.w;
        uint2 o; o.x = pack2(siluf(o0), siluf(o1)); o.y = pack2(siluf(o2), siluf(o3));
        *reinterpret_cast<uint2*>(rp + (size_t)(t0 + j) * IND) = o;
        r0 = r1; r1 = r2; r2 = r3; r3 = r4;
      }
    }
    __syncthreads();
  }
}


__device__ void ssd_item(const Params& p, int l, int part, int item, unsigned char* smem) {
  u16* Bs = (u16*)smem;
  u16* Ms = Bs;
  u16* Cs = (u16*)(smem + 17408);
  u16* BT = (u16*)(smem + 34816);
  u16* xT = (u16*)(smem + 53248);
  u16* xwT = (u16*)(smem + 62464);
  float* dts = (float*)(smem + 71680);
  float* acs = dts + 64;
  float* wts = acs + 64;
  float* ssql = wts + 64;
  float* tots = ssql + 256;
  u16* ystg = (u16*)(smem + 73600);
  const int tid0 = opaque_tid();
  const int b = item >> 5, hd = (item >> 1) & 15, dir = item & 1, g = hd >> 3;
  u16* P = (u16*)(p.ws + WS_P);
  u16* Y = (u16*)(p.ws + WS_Y);
  float* ssq = (float*)(p.ws + WS_SSQ);
  float* stsave = (float*)(p.ws + WS_WIN) + (size_t)item * 8192;
  const float Dsk = p.in[opq(13)][l * 16 + hd];
  f32x4 hacc[8];
  if (part == 1) {
#pragma unroll
    for (int i = 0; i < 8; ++i) hacc[i] = *reinterpret_cast<const f32x4*>(stsave + (i * 256 + tid0) * 4);
  } else {
#pragma unroll
    for (int i = 0; i < 8; ++i) hacc[i] = f32x4{0.f, 0.f, 0.f, 0.f};
  }
  const int nseg = part == 0 ? 3 : 1;
  for (int seg = 0; seg < nseg; ++seg) {
    bool isctx; int sdir, ci0, ci1, mode;
    if (part == 1) { isctx = false; sdir = dir; ci0 = 32; ci1 = 64; mode = 2; }
    else if (seg == 0) { if (!(dir == 0 && l == 0)) continue; isctx = true; sdir = 1; ci0 = 0; ci1 = 4; mode = 1; }
    else if (seg == 1) { isctx = true; sdir = dir; ci0 = 0; ci1 = 4; mode = (dir == 0 && l == 0) ? 2 : 0; }
    else { isctx = false; sdir = dir; ci0 = 0; ci1 = 32; mode = 1; }
    if (part == 0 && seg <= 1) {
#pragma unroll
      for (int i = 0; i < 8; ++i) hacc[i] = f32x4{0.f, 0.f, 0.f, 0.f};
    }
    __threadfence();
    __syncthreads();
    const float aneg = -expf(p.in[opq(11)][(l * 2 + sdir) * 16 + hd]);
    const float dtb = p.in[opq(12)][(l * 2 + sdir) * 16 + hd];
    const int nch = isctx ? 4 : 64;
    const int rowbase = isctx ? NLAT + b * 256 : b * 4096;
#pragma unroll
    for (int i = 0; i < 8; ++i) asm volatile("" : "+v"(hacc[i]));
    u32x4 rx[2], rbm[4], rcm[4];
    unsigned rawdt = 0u;
    {
      const int tid = tid0, lane = tid & 63, w = tid >> 6;
      const int cL = (sdir ? nch - 1 - ci0 : ci0) * 64;
#pragma unroll
      for (int k = 0; k < 2; ++k) {
        const int id = tid + 256 * k, pch = id >> 6, i = id & 63;
        const int tau = sdir ? cL + 63 - i : cL + i;
        rx[k] = *reinterpret_cast<const u32x4*>(P + (size_t)(rowbase + tau) * IND + C_XBC + hd * 64 + pch * 8);
      }
#pragma unroll
      for (int k = 0; k < 4; ++k) {
        const int id = tid + 256 * k, nc = id >> 6, i = id & 63;
        const int tau = sdir ? cL + 63 - i : cL + i;
        rbm[k] = *reinterpret_cast<const u32x4*>(P + (size_t)(rowbase + tau) * IND + C_BM + g * 128 + nc * 8);
      }
#pragma unroll
      for (int k = 0; k < 4; ++k) {
        const int id = tid + 256 * k, i = id >> 4, nc = id & 15;
        const int tau = sdir ? cL + 63 - i : cL + i;
        rcm[k] = *reinterpret_cast<const u32x4*>(P + (size_t)(rowbase + tau) * IND + C_CM + g * 128 + nc * 8);
      }
      rawdt = P[(size_t)(rowbase + (sdir ? cL + 63 - lane : cL + lane)) * IND + C_DT + sdir * 16 + hd];
    }
    for (int ci = ci0; ci < ci1; ++ci) {
      const int c0 = (sdir ? nch - 1 - ci : ci) * 64;
      int tid = tid0;
      asm volatile("" : "+v"(tid));
      const int lane = tid & 63, w = tid >> 6, fr = lane & 15, fq = lane >> 4;
      __syncthreads();
      if (w == 0) {
        float dt = softplusf(bflo(pin(rawdt)) + dtb);
        const float cs = wave_incl_scan(dt * aneg);
        const float tot = __builtin_bit_cast(float, __builtin_amdgcn_readlane(__builtin_bit_cast(int, cs), 63));
        dts[lane] = dt; acs[lane] = cs; wts[lane] = __expf(tot - cs);
        if (lane == 0) tots[0] = tot;
      }
      pin4(rbm[0]); pin4(rbm[1]); pin4(rbm[2]); pin4(rbm[3]);
#pragma unroll
      for (int k = 0; k < 4; ++k) {
        const int id = tid + 256 * k, nc = id >> 6, i = id & 63;
        *reinterpret_cast<u32x4*>(Bs + i * 136 + nc * 8) = rbm[k];
#pragma unroll
        for (int e = 0; e < 4; ++e) {
          BT[(nc * 8 + 2 * e) * 72 + i] = (u16)(rbm[k][e] & 0xffffu);
          BT[(nc * 8 + 2 * e + 1) * 72 + i] = (u16)(rbm[k][e] >> 16);
        }
      }
#pragma unroll
      for (int k = 0; k < 4; ++k) {
        const int id = tid + 256 * k, i = id >> 4, nc = id & 15;
        *reinterpret_cast<u32x4*>(Cs + i * 136 + nc * 8) = rcm[k];
      }
      __syncthreads();
      pin4(rx[0]); pin4(rx[1]);
#pragma unroll
      for (int k = 0; k < 2; ++k) {
        const int id = tid + 256 * k, pch = id >> 6, i = id & 63;
        const float dt = dts[i], wt = wts[i];
#pragma unroll
        for (int e = 0; e < 4; ++e) {
          float x0 = bflo(rx[k][e]) * dt, x1 = bfhi(rx[k][e]) * dt;
          xT[(pch * 8 + 2 * e) * 72 + i] = f2bf(x0); xT[(pch * 8 + 2 * e + 1) * 72 + i] = f2bf(x1);
          xwT[(pch * 8 + 2 * e) * 72 + i] = f2bf(x0 * wt); xwT[(pch * 8 + 2 * e + 1) * 72 + i] = f2bf(x1 * wt);
        }
      }
      u32x4 tmpv[2] = {u32x4{0u, 0u, 0u, 0u}, u32x4{0u, 0u, 0u, 0u}};
      uint2 zr[4];
#pragma unroll
      for (int e = 0; e < 4; ++e) zr[e] = make_uint2(0u, 0u);
      if (mode == 2) {
        const int qs = (w * 4 + fq) * 16 + (15 - fr);
        const u16* tp = Y + (size_t)(rowbase + c0 + (qs >> 2)) * MIXW + hd * 64 + (qs & 3) * 16;
        tmpv[0] = *reinterpret_cast<const u32x4*>(tp); tmpv[1] = *reinterpret_cast<const u32x4*>(tp + 8);
#pragma unroll
        for (int tt = 0; tt < 4; ++tt) {
          const int t = tt * 16 + fr;
          const size_t row = (size_t)(rowbase + (sdir ? c0 + 63 - t : c0 + t));
          zr[tt] = *reinterpret_cast<const uint2*>(P + row * IND + hd * 64 + w * 16 + fq * 4);
        }
      }
      if (ci + 1 < ci1) {
        const int cL = (sdir ? nch - 2 - ci : ci + 1) * 64;
#pragma unroll
        for (int k = 0; k < 2; ++k) {
          const int id = tid + 256 * k, pch = id >> 6, i = id & 63;
          const int tau = sdir ? cL + 63 - i : cL + i;
          rx[k] = *reinterpret_cast<const u32x4*>(P + (size_t)(rowbase + tau) * IND + C_XBC + hd * 64 + pch * 8);
        }
#pragma unroll
        for (int k = 0; k < 4; ++k) {
          const int id = tid + 256 * k, nc = id >> 6, i = id & 63;
          const int tau = sdir ? cL + 63 - i : cL + i;
          rbm[k] = *reinterpret_cast<const u32x4*>(P + (size_t)(rowbase + tau) * IND + C_BM + g * 128 + nc * 8);
        }
#pragma unroll
        for (int k = 0; k < 4; ++k) {
          const int id = tid + 256 * k, i = id >> 4, nc = id & 15;
          const int tau = sdir ? cL + 63 - i : cL + i;
          rcm[k] = *reinterpret_cast<const u32x4*>(P + (size_t)(rowbase + tau) * IND + C_CM + g * 128 + nc * 8);
        }
        rawdt = P[(size_t)(rowbase + (sdir ? cL + 63 - lane : cL + lane)) * IND + C_DT + sdir * 16 + hd];
      }
      __syncthreads();
      f32x4 gacc[4];
#pragma unroll
      for (int i = 0; i < 4; ++i) gacc[i] = f32x4{0.f, 0.f, 0.f, 0.f};
#pragma unroll
      for (int kk = 0; kk < 4; ++kk) {
        bf16x8 a = ld8(Bs + (w * 16 + fr) * 136 + kk * 32 + fq * 8);
#pragma unroll
        for (int tb = 0; tb < 4; ++tb) {
          bf16x8 bb = ld8(Cs + (tb * 16 + fr) * 136 + kk * 32 + fq * 8);
          gacc[tb] = mfma16(a, bb, gacc[tb]);
        }
      }
      asm volatile("" : "+v"(tmpv[0]), "+v"(tmpv[1]));
      __syncthreads();
#pragma unroll
      for (int tb = 0; tb < 4; ++tb) {
        const int t = tb * 16 + fr;
        const float at = acs[t];
        float mv[4];
#pragma unroll
        for (int j = 0; j < 4; ++j) {
          const int s = w * 16 + fq * 4 + j;
          mv[j] = (s <= t) ? gacc[tb][j] * __expf(at - acs[s]) : 0.f;
        }
        uint2 o; o.x = pack2(mv[0], mv[1]); o.y = pack2(mv[2], mv[3]);
        *reinterpret_cast<uint2*>(Ms + t * 72 + w * 16 + fq * 4) = o;
      }
      __syncthreads();
      f32x4 yd[4], yo[4];
#pragma unroll
      for (int i = 0; i < 4; ++i) { yd[i] = f32x4{0.f, 0.f, 0.f, 0.f}; yo[i] = f32x4{0.f, 0.f, 0.f, 0.f}; }
#pragma unroll
      for (int kk = 0; kk < 2; ++kk) {
        bf16x8 bb = ld8(xT + (w * 16 + fr) * 72 + kk * 32 + fq * 8);
#pragma unroll
        for (int tt = 0; tt < 4; ++tt) {
          bf16x8 a = ld8(Ms + (tt * 16 + fr) * 72 + kk * 32 + fq * 8);
          yd[tt] = mfma16(bb, a, yd[tt]);
        }
      }
#pragma unroll
      for (int kk = 0; kk < 4; ++kk) {
        bf16x8 hb = packacc(hacc[2 * kk], hacc[2 * kk + 1]);
#pragma unroll
        for (int tt = 0; tt < 4; ++tt) {
          const u16* cr = Cs + (tt * 16 + fr) * 136 + fq * 4;
          bf16x8 a = ld44(cr + (2 * kk) * 16, cr + (2 * kk + 1) * 16);
          yo[tt] = mfma16(hb, a, yo[tt]);
        }
      }
      const float etot = __expf(tots[0]);
#pragma unroll
      for (int nb = 0; nb < 8; ++nb) { hacc[nb][0] *= etot; hacc[nb][1] *= etot; hacc[nb][2] *= etot; hacc[nb][3] *= etot; }
#pragma unroll
      for (int kk = 0; kk < 2; ++kk) {
        bf16x8 bb = ld8(xwT + (w * 16 + fr) * 72 + kk * 32 + fq * 8);
#pragma unroll
        for (int nb = 0; nb < 8; ++nb) {
          bf16x8 a = ld8(BT + (nb * 16 + fr) * 72 + kk * 32 + fq * 8);
          hacc[nb] = mfma16(a, bb, hacc[nb]);
        }
      }
      if (mode != 0) {
        float ea[4];
#pragma unroll
        for (int tt = 0; tt < 4; ++tt) ea[tt] = __expf(acs[tt * 16 + fr]);
        if (mode == 1) {
          u32x4 o0, o1;
#pragma unroll
          for (int tt = 0; tt < 4; ++tt) {
            float v[4];
#pragma unroll
            for (int j = 0; j < 4; ++j) v[j] = yd[tt][j] + ea[tt] * yo[tt][j];
            const unsigned a2 = pack2(v[0], v[1]), b2 = pack2(v[2], v[3]);
            if (tt == 0) { o0[0] = a2; o0[1] = b2; } else if (tt == 1) { o0[2] = a2; o0[3] = b2; }
            else if (tt == 2) { o1[0] = a2; o1[1] = b2; } else { o1[2] = a2; o1[3] = b2; }
          }
          const int qs = (w * 4 + fq) * 16 + fr;
          u16* tp = Y + (size_t)(rowbase + c0 + (qs >> 2)) * MIXW + hd * 64 + (qs & 3) * 16;
          *reinterpret_cast<u32x4*>(tp) = o0; *reinterpret_cast<u32x4*>(tp + 8) = o1;
        } else {
          float xsv[16], rdt[4], val[16];
#pragma unroll
          for (int tt = 0; tt < 4; ++tt) {
            rdt[tt] = rcpf(dts[tt * 16 + fr]);
#pragma unroll
            for (int j = 0; j < 4; ++j) xsv[tt * 4 + j] = bf2f(xT[(w * 16 + fq * 4 + j) * 72 + tt * 16 + fr]);
          }
          float sq[4];
#pragma unroll
          for (int tt = 0; tt < 4; ++tt) {
            const int t = tt * 16 + fr;
            const uint2 zw = zr[tt];
            const unsigned z01 = pin(zw.x), z23 = pin(zw.y);
            const float zz[4] = {bflo(z01), bfhi(z01), bflo(z23), bfhi(z23)};
            const int et = 3 - tt;
            const unsigned p01 = tmpv[et >> 1][(et & 1) * 2], p23 = tmpv[et >> 1][(et & 1) * 2 + 1];
            const float yf[4] = {bflo(p01), bfhi(p01), bflo(p23), bfhi(p23)};
            float s2 = 0.f;
#pragma unroll
            for (int j = 0; j < 4; ++j) {
              const float yv = yd[tt][j] + ea[tt] * yo[tt][j];
              const float vv = (yf[j] + yv + Dsk * xsv[tt * 4 + j] * rdt[tt]) * siluf(zz[j]);
              val[tt * 4 + j] = vv; s2 += vv * vv;
            }
            sq[tt] = s2;
            uint2 o; o.x = pack2(val[tt * 4], val[tt * 4 + 1]); o.y = pack2(val[tt * 4 + 2], val[tt * 4 + 3]);
            const int c = w * 2 + (fq >> 1);
            *reinterpret_cast<uint2*>(ystg + t * 64 + ((c ^ ((t >> 2) & 7)) << 3) + (fq & 1) * 4) = o;
          }
#pragma unroll
          for (int tt = 0; tt < 4; ++tt) {
            sq[tt] += __shfl_xor(sq[tt], 16); sq[tt] += __shfl_xor(sq[tt], 32);
          }
          if (fq == 0) {
#pragma unroll
            for (int tt = 0; tt < 4; ++tt) ssql[w * 64 + tt * 16 + fr] = sq[tt];
          }
          __syncthreads();
#pragma unroll
          for (int k = 0; k < 2; ++k) {
            const int id = tid + 256 * k, t = id >> 3, c = id & 7;
            const u32x4 v = *reinterpret_cast<const u32x4*>(ystg + t * 64 + ((c ^ ((t >> 2) & 7)) << 3));
            const size_t row = (size_t)(rowbase + (sdir ? c0 + 63 - t : c0 + t));
            *reinterpret_cast<u32x4*>(Y + row * MIXW + hd * 64 + c * 8) = v;
          }
          if (tid < 64) {
            const size_t row = (size_t)(rowbase + (sdir ? c0 + 63 - tid : c0 + tid));
            ssq[row * 16 + hd] = ssql[tid] + ssql[64 + tid] + ssql[128 + tid] + ssql[192 + tid];
          }
        }
      }
    }
  }
  if (part == 0) {
#pragma unroll
    for (int i = 0; i < 8; ++i) *reinterpret_cast<f32x4*>(stsave + (i * 256 + tid0) * 4) = hacc[i];
  }
}

__device__ void gla_item(const Params& p, int l, int part, int item, unsigned char* smem) {
  u16* qe = (u16*)smem;
  u16* ke = (u16*)(smem + 9216);
  u16* kdT = (u16*)(smem + 18432);
  u16* vT = (u16*)(smem + 27648);
  u16* at = (u16*)(smem + 46080);
  float* gl = (float*)(smem + 55296);
  float* red = (float*)(smem + 71936);
  const int tid0 = opaque_tid();
  const int b = item >> 3, h = (item >> 1) & 3, dir = item & 1;
  u16* P = (u16*)(p.ws + WS_P);
  u16* Y = (u16*)(p.ws + WS_Y);
  float* stsave = (float*)(p.ws + WS_WIN) + (size_t)(256 + item) * 8192;
  f32x4 sacc[4][2];
  if (part == 1) {
#pragma unroll
    for (int i = 0; i < 8; ++i) sacc[i >> 1][i & 1] = *reinterpret_cast<const f32x4*>(stsave + (i * 256 + tid0) * 4);
  } else {
#pragma unroll
    for (int i = 0; i < 8; ++i) sacc[i >> 1][i & 1] = f32x4{0.f, 0.f, 0.f, 0.f};
  }
  const int nseg = part == 0 ? 3 : 1;
  for (int seg = 0; seg < nseg; ++seg) {
    bool isctx; int sdir, ci0, ci1, mode;
    if (part == 1) { isctx = false; sdir = dir; ci0 = 32; ci1 = 64; mode = 2; }
    else if (seg == 0) { if (!(dir == 0 && l == 0)) continue; isctx = true; sdir = 1; ci0 = 0; ci1 = 4; mode = 1; }
    else if (seg == 1) { isctx = true; sdir = dir; ci0 = 0; ci1 = 4; mode = (dir == 0 && l == 0) ? 2 : 0; }
    else { isctx = false; sdir = dir; ci0 = 0; ci1 = 32; mode = 1; }
    if (part == 0 && seg <= 1) {
#pragma unroll
      for (int i = 0; i < 8; ++i) sacc[i >> 1][i & 1] = f32x4{0.f, 0.f, 0.f, 0.f};
    }
    __threadfence();
    __syncthreads();
    const int nch = isctx ? 4 : 64;
    const int rowbase = isctx ? NLAT + b * 256 : b * 4096;
#pragma unroll
    for (int i = 0; i < 8; ++i) asm volatile("" : "+v"(sacc[i >> 1][i & 1]));
    u32x4 rq[2], rk[2], rv[4], rlr;
    bf16x8 Bw;
    float bl;
    {
      const int tid = tid0;
      const int dcol = h * 64 + 32 * ((tid >> 6) & 1) + (tid & 31), kb = 8 * ((tid & 63) >> 5);
      const float* wlp = p.in[opq(15)] + ((size_t)((l * 2 + sdir) * 16 + kb)) * 256 + dcol;
      u32x4 bw;
#pragma unroll
      for (int e = 0; e < 4; ++e) bw[e] = pack2(wlp[(2 * e) * 256], wlp[(2 * e + 1) * 256]);
      Bw = __builtin_bit_cast(bf16x8, bw);
      bl = p.in[opq(16)][(l * 2 + sdir) * 256 + dcol];
      asm volatile("" : "+v"(Bw), "+v"(bl));
      const int cL = (sdir ? nch - 1 - ci0 : ci0) * 64;
#pragma unroll
      for (int k = 0; k < 2; ++k) {
        const int id = tid + 256 * k, i = id >> 3, dc = id & 7;
        const int tau = sdir ? cL + 63 - i : cL + i;
        rq[k] = *reinterpret_cast<const u32x4*>(P + (size_t)(rowbase + tau) * IND + C_Q + h * 64 + dc * 8);
      }
#pragma unroll
      for (int k = 0; k < 2; ++k) {
        const int id = tid + 256 * k, dc = id >> 6, i = id & 63;
        const int tau = sdir ? cL + 63 - i : cL + i;
        rk[k] = *reinterpret_cast<const u32x4*>(P + (size_t)(rowbase + tau) * IND + C_K + h * 64 + dc * 8);
      }
#pragma unroll
      for (int k = 0; k < 4; ++k) {
        const int id = tid + 256 * k, ec = id >> 6, i = id & 63;
        const int tau = sdir ? cL + 63 - i : cL + i;
        rv[k] = *reinterpret_cast<const u32x4*>(P + (size_t)(rowbase + tau) * IND + C_V + h * 128 + ec * 8);
      }
      {
        const int i = 32 * (tid >> 7) + (tid & 31), hf = (tid & 63) >> 5;
        const int tau = sdir ? cL + 63 - i : cL + i;
        rlr = *reinterpret_cast<const u32x4*>(P + (size_t)(rowbase + tau) * IND + C_LR + sdir * 16 + hf * 8);
      }
    }
    for (int ci = ci0; ci < ci1; ++ci) {
      const int c0 = (sdir ? nch - 1 - ci : ci) * 64;
      int tid = tid0;
      asm volatile("" : "+v"(tid));
      const int lane = tid & 63, w = tid >> 6, fr = lane & 15, fq = lane >> 4, d = tid & 63, iq = tid >> 6;
      __syncthreads();
      pin4(rlr);
      {
        const int th = w >> 1, dh = w & 1;
        f32x16 z;
#pragma unroll
        for (int r = 0; r < 16; ++r) z[r] = 0.f;
        const f32x16 lg = mfma32(__builtin_bit_cast(bf16x8, rlr), Bw, z);
#pragma unroll
        for (int r = 0; r < 16; ++r) {
          const int t = 32 * th + (r & 3) + 8 * (r >> 2) + 4 * (lane >> 5);
          gl[t * 65 + 32 * dh + (lane & 31)] = logsigf(lg[r] + bl) * (1.f / 16.f);
        }
      }
      __syncthreads();
      {
        float vals[16];
#pragma unroll
        for (int ii = 0; ii < 16; ++ii) vals[ii] = gl[(iq * 16 + ii) * 65 + d];
        float run = 0.f;
#pragma unroll
        for (int ii = 0; ii < 16; ++ii) { run += vals[ii]; gl[(iq * 16 + ii) * 65 + d] = run; }
        red[iq * 64 + d] = run;
      }
      __syncthreads();
      {
        float off = 0.f;
        for (int q = 0; q < iq; ++q) off += red[q * 64 + d];
        if (iq > 0) {
#pragma unroll 4
          for (int ii = 0; ii < 16; ++ii) gl[(iq * 16 + ii) * 65 + d] += off;
        }
      }
      __syncthreads();
      pin4(rq[0]); pin4(rq[1]); pin4(rk[0]); pin4(rk[1]); pin4(rv[0]); pin4(rv[1]); pin4(rv[2]); pin4(rv[3]);
#pragma unroll
      for (int k = 0; k < 2; ++k) {
        const int id = tid + 256 * k, i = id >> 3, dc = id & 7;
        u32x4 oo;
#pragma unroll
        for (int e = 0; e < 4; ++e) {
          float b0 = gl[i * 65 + dc * 8 + 2 * e], b1 = gl[i * 65 + dc * 8 + 2 * e + 1];
          oo[e] = pack2(bflo(rq[k][e]) * 0.125f * __expf(b0), bfhi(rq[k][e]) * 0.125f * __expf(b1));
        }
        *reinterpret_cast<u32x4*>(qe + i * 72 + dc * 8) = oo;
      }
#pragma unroll
      for (int k = 0; k < 2; ++k) {
        const int id = tid + 256 * k, dc = id >> 6, i = id & 63;
        u32x4 oo;
#pragma unroll
        for (int e = 0; e < 4; ++e) {
          const int d0 = dc * 8 + 2 * e;
          float b0 = gl[i * 65 + d0], b1 = gl[i * 65 + d0 + 1];
          float l0 = gl[63 * 65 + d0], l1 = gl[63 * 65 + d0 + 1];
          float k0 = bflo(rk[k][e]), k1 = bfhi(rk[k][e]);
          oo[e] = pack2(k0 * __expf(-b0), k1 * __expf(-b1));
          kdT[d0 * 72 + i] = f2bf(k0 * __expf(l0 - b0));
          kdT[(d0 + 1) * 72 + i] = f2bf(k1 * __expf(l1 - b1));
        }
        *reinterpret_cast<u32x4*>(ke + i * 72 + dc * 8) = oo;
      }
#pragma unroll
      for (int k = 0; k < 4; ++k) {
        const int id = tid + 256 * k, ec = id >> 6, i = id & 63;
#pragma unroll
        for (int e = 0; e < 4; ++e) {
          vT[(ec * 8 + 2 * e) * 72 + i] = (u16)(rv[k][e] & 0xffffu);
          vT[(ec * 8 + 2 * e + 1) * 72 + i] = (u16)(rv[k][e] >> 16);
        }
      }
      u32x4 tmpv[4];
      unsigned ggr[16];
#pragma unroll
      for (int e = 0; e < 4; ++e) tmpv[e] = u32x4{0u, 0u, 0u, 0u};
#pragma unroll
      for (int e = 0; e < 16; ++e) ggr[e] = 0u;
      if (mode == 2) {
        const int qs = (w * 4 + (3 - fq)) * 16 + fr;
        const u16* tp = Y + (size_t)(rowbase + c0 + (qs >> 2)) * MIXW + 1024 + h * 128 + (qs & 3) * 32;
#pragma unroll
        for (int e = 0; e < 4; ++e) tmpv[e] = *reinterpret_cast<const u32x4*>(tp + e * 8);
#pragma unroll
        for (int tt = 0; tt < 4; ++tt)
#pragma unroll
          for (int j = 0; j < 4; ++j) {
            const int t = tt * 16 + fq * 4 + j;
            const size_t row = (size_t)(rowbase + (sdir ? c0 + 63 - t : c0 + t));
            ggr[tt * 4 + j] = *reinterpret_cast<const unsigned*>(P + row * IND + C_GG + h * 128 + w * 32 + 2 * fr);
          }
      }
      if (ci + 1 < ci1) {
        const int cL = (sdir ? nch - 2 - ci : ci + 1) * 64;
#pragma unroll
        for (int k = 0; k < 2; ++k) {
          const int id = tid + 256 * k, i = id >> 3, dc = id & 7;
          const int tau = sdir ? cL + 63 - i : cL + i;
          rq[k] = *reinterpret_cast<const u32x4*>(P + (size_t)(rowbase + tau) * IND + C_Q + h * 64 + dc * 8);
        }
#pragma unroll
        for (int k = 0; k < 2; ++k) {
          const int id = tid + 256 * k, dc = id >> 6, i = id & 63;
          const int tau = sdir ? cL + 63 - i : cL + i;
          rk[k] = *reinterpret_cast<const u32x4*>(P + (size_t)(rowbase + tau) * IND + C_K + h * 64 + dc * 8);
        }
#pragma unroll
        for (int k = 0; k < 4; ++k) {
          const int id = tid + 256 * k, ec = id >> 6, i = id & 63;
          const int tau = sdir ? cL + 63 - i : cL + i;
          rv[k] = *reinterpret_cast<const u32x4*>(P + (size_t)(rowbase + tau) * IND + C_V + h * 128 + ec * 8);
        }
        {
          const int i = 32 * (tid >> 7) + (tid & 31), hf = (tid & 63) >> 5;
          const int tau = sdir ? cL + 63 - i : cL + i;
          rlr = *reinterpret_cast<const u32x4*>(P + (size_t)(rowbase + tau) * IND + C_LR + sdir * 16 + hf * 8);
        }
      }
      __syncthreads();
      {
        f32x4 aacc[4];
#pragma unroll
        for (int i = 0; i < 4; ++i) aacc[i] = f32x4{0.f, 0.f, 0.f, 0.f};
#pragma unroll
        for (int kk = 0; kk < 2; ++kk) {
          bf16x8 a = ld8(ke + (w * 16 + fr) * 72 + kk * 32 + fq * 8);
#pragma unroll
          for (int tb = 0; tb < 4; ++tb) {
            bf16x8 bb = ld8(qe + (tb * 16 + fr) * 72 + kk * 32 + fq * 8);
            aacc[tb] = mfma16(a, bb, aacc[tb]);
          }
        }
#pragma unroll
        for (int tb = 0; tb < 4; ++tb) {
          const int t = tb * 16 + fr;
          float mv[4];
#pragma unroll
          for (int j = 0; j < 4; ++j) { const int s = w * 16 + fq * 4 + j; mv[j] = (s <= t) ? aacc[tb][j] : 0.f; }
          uint2 o; o.x = pack2(mv[0], mv[1]); o.y = pack2(mv[2], mv[3]);
          *reinterpret_cast<uint2*>(at + t * 72 + w * 16 + fq * 4) = o;
        }
      }
      __syncthreads();
      f32x4 oacc[4][2];
#pragma unroll
      for (int i = 0; i < 4; ++i) { oacc[i][0] = f32x4{0.f, 0.f, 0.f, 0.f}; oacc[i][1] = f32x4{0.f, 0.f, 0.f, 0.f}; }
#pragma unroll
      for (int kk = 0; kk < 2; ++kk) {
        bf16x8 b0 = ld8(vT + (w * 32 + 2 * fr) * 72 + kk * 32 + fq * 8);
        bf16x8 b1 = ld8(vT + (w * 32 + 2 * fr + 1) * 72 + kk * 32 + fq * 8);
#pragma unroll
        for (int tt = 0; tt < 4; ++tt) {
          bf16x8 a = ld8(at + (tt * 16 + fr) * 72 + kk * 32 + fq * 8);
          oacc[tt][0] = mfma16(a, b0, oacc[tt][0]);
          oacc[tt][1] = mfma16(a, b1, oacc[tt][1]);
        }
      }
#pragma unroll
      for (int kk = 0; kk < 2; ++kk) {
        bf16x8 s0 = packacc(sacc[2 * kk][0], sacc[2 * kk + 1][0]);
        bf16x8 s1 = packacc(sacc[2 * kk][1], sacc[2 * kk + 1][1]);
#pragma unroll
        for (int tt = 0; tt < 4; ++tt) {
          const u16* qr = qe + (tt * 16 + fr) * 72 + fq * 4;
          bf16x8 a = ld44(qr + (2 * kk) * 16, qr + (2 * kk + 1) * 16);
          oacc[tt][0] = mfma16(a, s0, oacc[tt][0]);
          oacc[tt][1] = mfma16(a, s1, oacc[tt][1]);
        }
      }
#pragma unroll
      for (int db = 0; db < 4; ++db)
#pragma unroll
        for (int j = 0; j < 4; ++j) {
          const float sc = __expf(gl[63 * 65 + db * 16 + fq * 4 + j]);
          sacc[db][0][j] *= sc; sacc[db][1][j] *= sc;
        }
#pragma unroll
      for (int kk = 0; kk < 2; ++kk) {
        bf16x8 b0 = ld8(vT + (w * 32 + 2 * fr) * 72 + kk * 32 + fq * 8);
        bf16x8 b1 = ld8(vT + (w * 32 + 2 * fr + 1) * 72 + kk * 32 + fq * 8);
#pragma unroll
        for (int db = 0; db < 4; ++db) {
          bf16x8 a = ld8(kdT + (db * 16 + fr) * 72 + kk * 32 + fq * 8);
          sacc[db][0] = mfma16(a, b0, sacc[db][0]);
          sacc[db][1] = mfma16(a, b1, sacc[db][1]);
        }
      }
      pin4(tmpv[0]); pin4(tmpv[1]); pin4(tmpv[2]); pin4(tmpv[3]);
      if (mode != 0) {
        const int ycol = 1024 + h * 128 + w * 32 + 2 * fr;
        if (mode == 1) {
          const int qs = (w * 4 + fq) * 16 + fr;
          u16* tp = Y + (size_t)(rowbase + c0 + (qs >> 2)) * MIXW + 1024 + h * 128 + (qs & 3) * 32;
#pragma unroll
          for (int tt = 0; tt < 4; ++tt) {
            u32x4 o;
#pragma unroll
            for (int j = 0; j < 4; ++j) o[j] = pack2(oacc[tt][0][j], oacc[tt][1][j]);
            *reinterpret_cast<u32x4*>(tp + tt * 8) = o;
          }
        } else {
#pragma unroll
          for (int tt = 0; tt < 4; ++tt)
#pragma unroll
            for (int j = 0; j < 4; ++j) {
              const int t = tt * 16 + fq * 4 + j;
              const int e = 15 - (tt * 4 + j);
              const unsigned pw = tmpv[e >> 2][e & 3];
              float o0 = oacc[tt][0][j] + bflo(pw);
              float o1 = oacc[tt][1][j] + bfhi(pw);
              oacc[tt][0][j] = o0; oacc[tt][1][j] = o1;
              const float sq = row16_sum(o0 * o0 + o1 * o1);
              if (fr == 0) red[w * 64 + t] = sq;
            }
          __syncthreads();
          const float* nwv = p.in[opq(17)] + l * 128;
          const float nw0 = nwv[w * 32 + 2 * fr], nw1 = nwv[w * 32 + 2 * fr + 1];
#pragma unroll
          for (int tt = 0; tt < 4; ++tt)
#pragma unroll
            for (int j = 0; j < 4; ++j) {
              const int t = tt * 16 + fq * 4 + j;
              const size_t row = (size_t)(rowbase + (sdir ? c0 + 63 - t : c0 + t));
              const float tot = red[t] + red[64 + t] + red[128 + t] + red[192 + t];
              const float rs = rsqrtf(tot * (1.f / 128.f) + EPSF);
              const unsigned gw = pin(ggr[tt * 4 + j]);
              const float g0 = bflo(gw), g1 = bfhi(gw);
              *reinterpret_cast<unsigned*>(Y + row * MIXW + ycol) =
                  pack2(oacc[tt][0][j] * rs * nw0 * siluf(g0), oacc[tt][1][j] * rs * nw1 * siluf(g1));
            }
        }
      }
    }
  }
  if (part == 0) {
#pragma unroll
    for (int i = 0; i < 8; ++i) *reinterpret_cast<f32x4*>(stsave + (i * 256 + tid0) * 4) = sacc[i >> 1][i & 1];
  }
}

__device__ void s5_item(const Params& p, int l, int part, int blk, unsigned char* smem) {
  const int tid = opaque_tid(), lane = tid & 63, w = tid >> 6, fr = lane & 15, fq = lane >> 4;
  const int wi = blk * 4 + w;
  const int b = wi >> 6, g = (wi >> 1) & 31, dir = wi & 1;
  u16* hb = (u16*)smem + w * (32 * 136);
  u16* ust = (u16*)(smem + 4 * 32 * 136 * 2) + w * (32 * 16);
  u16* P = (u16*)(p.ws + WS_P);
  u16* Y = (u16*)(p.ws + WS_Y);
  u16* G5C = (u16*)(p.ws + WS_G5C);
  float* stsave = (float*)(p.ws + WS_S5ST) + (size_t)wi * 128;
  const float dsk = p.in[opq(25)][l * 512 + g * 16 + fr];
  float hre = 0.f, him = 0.f;
  if (part == 1) { hre = stsave[lane * 2]; him = stsave[lane * 2 + 1]; }
  const int nseg = part == 0 ? 3 : 1;
  for (int seg = 0; seg < nseg; ++seg) {
    bool isctx; int sdir, ti0, ti1, mode;
    if (part == 1) { isctx = false; sdir = dir; ti0 = 64; ti1 = 128; mode = 2; }
    else if (seg == 0) { if (!(dir == 0 && l == 0)) continue; isctx = true; sdir = 1; ti0 = 0; ti1 = 8; mode = 1; }
    else if (seg == 1) { isctx = true; sdir = dir; ti0 = 0; ti1 = 8; mode = (dir == 0 && l == 0) ? 2 : 0; }
    else { isctx = false; sdir = dir; ti0 = 0; ti1 = 64; mode = 1; }
    if (part == 0 && seg <= 1) { hre = 0.f; him = 0.f; }
    __threadfence();
    const unsigned char* cbase = p.ws + WS_S5C + (size_t)((l * 2 + sdir) * 32 + g) * 8704;
    const u16* BbarM = (const u16*)cbase;
    const u16* CmT = (const u16*)(cbase + 4096);
    const float* lamb = (const float*)(cbase + 8192);
    bf16x8 Bf[4], Cf[4];
#pragma unroll
    for (int cb = 0; cb < 4; ++cb) Bf[cb] = ld8(BbarM + (cb * 32 + (lane & 31)) * 16 + 8 * (lane >> 5));
#pragma unroll
    for (int kk = 0; kk < 4; ++kk) Cf[kk] = ld8(CmT + fr * 128 + kk * 32 + fq * 8);
    float lre = lamb[2 * lane], lim = lamb[2 * lane + 1];
#pragma unroll
    for (int i = 0; i < 4; ++i) asm volatile("" : "+v"(Bf[i]), "+v"(Cf[i]));
    asm volatile("" : "+v"(lre), "+v"(lim), "+v"(hre), "+v"(him));
    const int nt = isctx ? 8 : 128;
    const int rowbase = isctx ? NLAT + b * 256 : b * 4096;
    bf16x8 anext;
    {
      const int c0 = (sdir ? nt - 1 - ti0 : ti0) * 32, i = lane & 31;
      anext = ld8(P + (size_t)(rowbase + (sdir ? c0 + 31 - i : c0 + i)) * IND + C_U5 + g * 16 + 8 * (lane >> 5));
    }
    for (int ti = ti0; ti < ti1; ++ti) {
      const int c0 = (sdir ? nt - 1 - ti : ti) * 32;
      const bf16x8 a = anext;
      if (ti + 1 < ti1) {
        const int c1 = (sdir ? nt - 2 - ti : ti + 1) * 32, i = lane & 31;
        anext = ld8(P + (size_t)(rowbase + (sdir ? c1 + 31 - i : c1 + i)) * IND + C_U5 + g * 16 + 8 * (lane >> 5));
      }
      u32x4 tmpv = u32x4{0u, 0u, 0u, 0u};
      if (mode == 2) {
        const int qs = (3 - fq) * 16 + fr;
        tmpv = *reinterpret_cast<const u32x4*>(Y + (size_t)(rowbase + c0 + (qs >> 1)) * MIXW + 1536 + g * 16 + (qs & 1) * 8);
      }
      wave_lds_sync();
      if (mode == 2) *reinterpret_cast<bf16x8*>(ust + (lane & 31) * 16 + 8 * (lane >> 5)) = a;
#pragma unroll
      for (int cb = 0; cb < 4; ++cb) {
        f32x16 z;
#pragma unroll
        for (int r = 0; r < 16; ++r) z[r] = 0.f;
        f32x16 acc = mfma32(a, Bf[cb], z);
#pragma unroll
        for (int r = 0; r < 16; ++r) {
          const int ii = (r & 3) + 8 * (r >> 2) + 4 * (lane >> 5);
          hb[ii * 136 + cb * 32 + (lane & 31)] = f2bf(acc[r]);
        }
      }
      wave_lds_sync();
      {
        unsigned buv[32];
#pragma unroll
        for (int i = 0; i < 32; ++i) buv[i] = *reinterpret_cast<const unsigned*>(hb + i * 136 + 2 * lane);
#pragma unroll
        for (int i = 0; i < 32; ++i) {
          const float nre = lre * hre - lim * him + bflo(buv[i]);
          const float nim = lre * him + lim * hre + bfhi(buv[i]);
          hre = nre; him = nim;
          *reinterpret_cast<unsigned*>(hb + i * 136 + 2 * lane) = pack2(hre, him);
        }
      }
      wave_lds_sync();
      f32x4 ya[2];
      ya[0] = f32x4{0.f, 0.f, 0.f, 0.f}; ya[1] = f32x4{0.f, 0.f, 0.f, 0.f};
#pragma unroll
      for (int kk = 0; kk < 4; ++kk) {
        bf16x8 a0 = ld8(hb + fr * 136 + kk * 32 + fq * 8);
        bf16x8 a1 = ld8(hb + (16 + fr) * 136 + kk * 32 + fq * 8);
        ya[0] = mfma16(a0, Cf[kk], ya[0]);
        ya[1] = mfma16(a1, Cf[kk], ya[1]);
      }
      pin4(tmpv);
      if (mode == 1) {
        u32x4 o;
        o[0] = pack2(ya[0][0], ya[0][1]); o[1] = pack2(ya[0][2], ya[0][3]); o[2] = pack2(ya[1][0], ya[1][1]); o[3] = pack2(ya[1][2], ya[1][3]);
        const int qs = fq * 16 + fr;
        *reinterpret_cast<u32x4*>(Y + (size_t)(rowbase + c0 + (qs >> 1)) * MIXW + 1536 + g * 16 + (qs & 1) * 8) = o;
      } else if (mode == 2) {
#pragma unroll
        for (int rt = 0; rt < 2; ++rt)
#pragma unroll
          for (int j = 0; j < 4; ++j) {
            const int i = rt * 16 + fq * 4 + j;
            const int tau = sdir ? c0 + 31 - i : c0 + i;
            const size_t row = (size_t)(rowbase + tau);
            const int e = 7 - (rt * 4 + j);
            const unsigned pw = tmpv[e >> 1];
            const float yf = (e & 1) ? bfhi(pw) : bflo(pw);
            const float u = bf2f(ust[i * 16 + fr]);
            const float x = yf + ya[rt][j] + dsk * u;
            const float th = 1.f - 2.f * rcpf(1.f + __expf(2.f * 0.7978845608028654f * (x + 0.044715f * x * x * x)));
            const float ge = 0.5f * x * (1.f + th);
            if (isctx) G5C[(row - NLAT) * 512 + g * 16 + fr] = f2bf(ge);
            else P[row * IND + C_U5 + g * 16 + fr] = f2bf(ge);
          }
      }
    }
  }
  if (part == 0) { stsave[lane * 2] = hre; stsave[lane * 2 + 1] = him; }
}

__device__ void ssd_norm_rows(const Params& p, int nrows) {
  const int tid = opaque_tid();
  const float* ssq = (const float*)(p.ws + WS_SSQ);
  float* rsb = (float*)(p.ws + WS_RS);
  for (int i = blockIdx.x * 256 + tid; i < nrows * 2; i += gridDim.x * 256) {
    const float* sp = ssq + (size_t)i * 8;
    const float sum = sp[0] + sp[1] + sp[2] + sp[3] + sp[4] + sp[5] + sp[6] + sp[7];
    rsb[i] = rsqrtf(sum * (1.f / 512.f) + EPSF);
  }
}

__device__ void phase_final(const Params& p) {
  const int tid = opaque_tid(), lane = tid & 63, w = tid >> 6;
  const float* nw = p.in[opq(28)];
  for (int r = blockIdx.x * 4 + w; r < NLAT; r += gridDim.x * 4) {
    float* src = p.out + (size_t)r * 1024;
    float4 v[4]; float ss = 0.f;
#pragma unroll
    for (int q = 0; q < 4; ++q) {
      { const f32x4 t_ = __builtin_nontemporal_load(reinterpret_cast<const f32x4*>(src + lane * 4 + q * 256)); v[q] = make_float4(t_[0], t_[1], t_[2], t_[3]); }
      ss += v[q].x * v[q].x + v[q].y * v[q].y + v[q].z * v[q].z + v[q].w * v[q].w;
    }
#pragma unroll
    for (int o = 32; o > 0; o >>= 1) ss += __shfl_xor(ss, o);
    const float rs = rsqrtf(ss * (1.f / 1024.f) + EPSF);
#pragma unroll
    for (int q = 0; q < 4; ++q) {
      const int col = lane * 4 + q * 256;
      float4 n4 = *reinterpret_cast<const float4*>(nw + col);
      float4 o = make_float4(v[q].x * rs * n4.x, v[q].y * rs * n4.y, v[q].z * rs * n4.z, v[q].w * rs * n4.w);
      __builtin_nontemporal_store(f32x4{o.x, o.y, o.z, o.w}, reinterpret_cast<f32x4*>(src + col));
    }
  }
}


#define XB_TMO      128
#define XB_XCNT(j)  (256  + 64 * (j))
#define XB_XSUB(j)  (1280 + 64 * (j))
#define XB_XGEN(j)  (2304 + 64 * (j))
#define XB_TOP      3328
#define XB_TOPGEN   3392
#define XCD_BAR_WORDS 3456
#define XB_SPIN_CAP (1u << 20)
DI unsigned xb_ld(unsigned* p) { return __hip_atomic_load(p, __ATOMIC_RELAXED, __HIP_MEMORY_SCOPE_AGENT); }
DI unsigned xb_add(unsigned* p, unsigned v) { return __hip_atomic_fetch_add(p, v, __ATOMIC_RELAXED, __HIP_MEMORY_SCOPE_AGENT); }
DI unsigned xb_xcc_id() { return (unsigned)__builtin_amdgcn_s_getreg((3 << 11) | 20) & 0xFu; }
#define XB_SPIN(cond, bar) do { unsigned _sp = 0; while (cond) { __builtin_amdgcn_s_sleep(1); \
    if ((++_sp & 255u) == 0u) { if (xb_ld(&(bar)[XB_TMO])) break; if (_sp > XB_SPIN_CAP) { atomicAdd(&(bar)[XB_TMO], 1u); break; } } } } while (0)
struct XcdBarrier { unsigned* bar; unsigned x, nloc, nx; };
DI XcdBarrier xcd_barrier_post(unsigned* bar) {
  XcdBarrier b; b.bar = bar; b.x = xb_xcc_id(); b.nloc = 0u; b.nx = 0u;
  if (threadIdx.x == 0) (void)xb_add(&bar[XB_XCNT(b.x)], 1u);
  return b;
}
DI void xcd_barrier_complete(unsigned* bar, unsigned x, unsigned& nloc, unsigned& nx) {
  const unsigned G = gridDim.x;
  unsigned sum, cnt, mine, sp = 0u;
  for (;;) {
    sum = 0u; cnt = 0u; mine = 0u;
#pragma unroll
    for (unsigned j = 0; j < 16; ++j) { const unsigned c = xb_ld(&bar[XB_XCNT(j)]); sum += c; cnt += (c > 0u) ? 1u : 0u; mine = (j == x) ? c : mine; }
    if (sum == G) break;
    __builtin_amdgcn_s_sleep(1);
    if ((++sp & 255u) == 0u) { if (xb_ld(&bar[XB_TMO])) break; if (sp > XB_SPIN_CAP) { atomicAdd(&bar[XB_TMO], 1u); break; } }
  }
  nloc = mine > 0u ? mine : 1u; nx = cnt > 0u ? cnt : 1u;
}
DI void xcd_barrier(XcdBarrier& b) {
  asm volatile("s_waitcnt vmcnt(0)" ::: "memory");
  __syncthreads();
  if (threadIdx.x == 0) {
    unsigned* bar = b.bar;
    __builtin_amdgcn_s_waitcnt(0);
    if (b.nloc == 0u) xcd_barrier_complete(bar, b.x, b.nloc, b.nx);
    const unsigned nloc = b.nloc, nx = b.nx;
    const unsigned old = xb_add(&bar[XB_XSUB(b.x)], 1u);
    const unsigned gen = old / nloc;
    if (old + 1u == (gen + 1u) * nloc) {
      __builtin_amdgcn_fence(__ATOMIC_RELEASE, "agent");
      asm volatile("s_waitcnt vmcnt(0)" ::: "memory");
      const unsigned og = xb_add(&bar[XB_TOP], 1u);
      const unsigned tg = og / nx;
      if (og + 1u == (tg + 1u) * nx) xb_add(&bar[XB_TOPGEN], 1u);
      else XB_SPIN(xb_ld(&bar[XB_TOPGEN]) == tg, bar);
      __builtin_amdgcn_fence(__ATOMIC_ACQUIRE, "agent");
      xb_add(&bar[XB_XGEN(b.x)], 1u);
      asm volatile("s_waitcnt vmcnt(0)" ::: "memory");
    } else {
      XB_SPIN(xb_ld(&bar[XB_XGEN(b.x)]) == gen, bar);
      __builtin_amdgcn_fence(__ATOMIC_ACQUIRE, "agent");
      asm volatile("s_waitcnt vmcnt(0)" ::: "memory");
    }
  }
  __syncthreads();
}

__global__ void __launch_bounds__(256, 2) fwd_megakernel(Params p) {
  extern __shared__ __attribute__((aligned(16))) unsigned char smem[];
  cg::grid_group grid = cg::this_grid();
  XcdBarrier xb = xcd_barrier_post((unsigned*)(p.ws + WS_BAR));
  const int ph_lo = p.ph_lo, ph_hi = p.ph_hi;
  for (int ph = ph_lo; ph < ph_hi; ++ph) {
    if (ph == 0) {
      phase_prep(p, smem);
    } else if (ph == NPHASE - 1) {
      phase_final(p);
    } else {
      const int l = (ph - 1) / 7, sub = (ph - 1) % 7;
      const int mt = (l == 1) ? 256 : 272;
      if (sub == 0) {
        phase_pre(p, l, smem);
      } else if (sub == 1) {
        const u16* U = (const u16*)(p.ws + WS_Y);
        const u16* W = (const u16*)(p.ws + WS_WIN);
        const int xcd = blockIdx.x & 7, slot = blockIdx.x >> 3, nslots = gridDim.x >> 3;
        bool pre = false;
        for (int u = slot; u < 918; u += nslots) {
          const int pnl = u / 306, v = u % 306;
          const int u2 = u + nslots, pnl2 = u2 / 306, v2 = u2 % 306;
          const bool hn = u2 < 918;
          gemm_tile<192, 0>(p, l, U, 1024, W, 1024, 1024, (xcd * 34 + v / 9) * 128, (pnl * 9 + v % 9) * 192, smem,
                            pre, hn, U, 1024, (xcd * 34 + v2 / 9) * 128, (pnl2 * 9 + v2 % 9) * 192);
          pre = hn;
        }
      } else if (sub == 2) {
        phase_conv(p, l);
      } else if (sub == 3 || sub == 4) {
        const int part = sub - 3;
        for (int k = 0;; ++k) {
          int it;
          if (gridDim.x == 512) {
            if (k > 0) break;
            const int blk = blockIdx.x;
            const int q = blk < 256 ? blk - 64 : 192 + (blk - 448);
            const int sit = q < 128 ? q * 2 : (q < 192 ? 2 * (q - 128) : 2 * (q - 192) + 1) * 2 + 1;
            it = blk < 64 ? 256 + blk : blk < 256 ? sit : blk < 320 ? -1 : blk < 448 ? blk : sit;
          } else {
            it = blockIdx.x + k * gridDim.x;
            if (it >= 448) break;
          }
          if (it >= 0) {
            if (it < 256) ssd_item(p, l, part, it, smem);
            else if (it < 320) gla_item(p, l, part, it - 256, smem);
            else s5_item(p, l, part, it - 320, smem);
          }
          __syncthreads();
        }
      } else if (sub == 5) {
        const u16* W = (const u16*)(p.ws + WS_GLU);
        const int xcd = blockIdx.x & 7, slot = blockIdx.x >> 3, nslots = gridDim.x >> 3, mtx = mt >> 3;
        const u16* Alat = (const u16*)(p.ws + WS_P) + C_U5;
        const u16* Actx = (const u16*)(p.ws + WS_G5C) - (size_t)NLAT * 512;
        bool pre = false;
        for (int u = slot; u < mtx * 8; u += nslots) {
          const int t = (xcd * mtx) * 8 + u, t2 = t + nslots;
          const int m0 = (t >> 3) * 128, m0n = (t2 >> 3) * 128;
          const bool hn = u + nslots < mtx * 8;
          const u16* Ac = m0 < NLAT ? Alat : Actx; const int ldc = m0 < NLAT ? IND : 512;
          const u16* An = m0n < NLAT ? Alat : Actx; const int ldn = m0n < NLAT ? IND : 512;
          gemm_tile<128, 1>(p, l, Ac, ldc, W, 512, 512, m0, (t & 7) * 128, smem, pre, hn, An, ldn, m0n, (t2 & 7) * 128);
          pre = hn;
        }
        ssd_norm_rows(p, mt * 128);
      } else {
        const u16* A = (const u16*)(p.ws + WS_Y);
        const u16* W = (const u16*)(p.ws + WS_WOUT);
        const int xcd = blockIdx.x & 7, slot = blockIdx.x >> 3, nslots = gridDim.x >> 3, mtx = mt >> 3;
        bool pre = false;
        for (int u = slot; u < mtx * 8; u += nslots) {
          const int t = (xcd * mtx) * 8 + u, t2 = t + nslots;
          const bool hn = u + nslots < mtx * 8;
          gemm_tile<128, 2>(p, l, A, MIXW, W, MIXW, MIXW, (t >> 3) * 128, (t & 7) * 128, smem, pre, hn, A, MIXW, (t2 >> 3) * 128, (t2 & 7) * 128);
          pre = hn;
        }
      }
    }
    if (ph + 1 < ph_hi) {
      if (ph_hi < 0) grid.sync();
      xcd_barrier(xb);
    }
  }
}

extern "C" void kernel_launch(void* const* d_in, const int* in_sizes, int n_in, void* d_out, int out_size, void* d_ws,
                              size_t ws_size, hipStream_t stream) {
  static int grid_blocks = 0;
  if (grid_blocks == 0) {
    if (n_in != 29 || ws_size < WS_END) { fprintf(stderr, "kernel_launch: bad n_in %d / ws %zu (need %zu)\n", n_in, ws_size, (size_t)WS_END); grid_blocks = -1; return; }
    int dev = 0, cus = 0, per_cu = 0;
    hipGetDevice(&dev);
    hipDeviceGetAttribute(&cus, hipDeviceAttributeMultiprocessorCount, dev);
    hipFuncSetAttribute((const void*)fwd_megakernel, hipFuncAttributeMaxDynamicSharedMemorySize, SMEM_BYTES);
    hipOccupancyMaxActiveBlocksPerMultiprocessor(&per_cu, (const void*)fwd_megakernel, 256, SMEM_BYTES);
    if (per_cu < 1) per_cu = 1;
    if (per_cu > 2) per_cu = 2;
    grid_blocks = cus * per_cu;
    fprintf(stderr, "kernel_launch: cus %d per_cu %d grid %d\n", cus, per_cu, grid_blocks);
  }
  if (grid_blocks < 0) return;
  Params p{};
  for (int i = 0; i < 29; ++i) p.in[i] = (const float*)d_in[i];
  p.out = (float*)d_out; p.ws = (unsigned char*)d_ws; p.ph_lo = 0; p.ph_hi = NPHASE;
  if (hipMemsetAsync((char*)d_ws + WS_BAR, 0, 16384, stream) != hipSuccess) { fprintf(stderr, "kernel_launch: memset of the barrier words failed\n"); return; }
  void* args[] = {&p};
  hipError_t e = hipLaunchCooperativeKernel((const void*)fwd_megakernel, dim3(grid_blocks), dim3(256), args, SMEM_BYTES, stream);
  if (e != hipSuccess) fprintf(stderr, "cooperative launch failed: %s (grid %d)\n", hipGetErrorString(e), grid_blocks);
}
```

```cpp
#include <hip/hip_runtime.h>
#include <hip/hip_cooperative_groups.h>
#include <cstdio>
namespace cg = cooperative_groups;

typedef unsigned short u16;
using bf16x8 = __attribute__((ext_vector_type(8))) short;
using bf16x4 = __attribute__((ext_vector_type(4))) short;
using f32x4 = __attribute__((ext_vector_type(4))) float;
using f32x16 = __attribute__((ext_vector_type(16))) float;
using u32x4 = __attribute__((ext_vector_type(4))) unsigned;
using u32x2 = __attribute__((ext_vector_type(2))) unsigned;
#define DI __device__ __forceinline__

constexpr int DM = 1024, NLAT = 32768, NCTX = 2048, NTOK = 34816, IND = 5184, MIXW = 2048;
constexpr int C_XBC = 1024, C_BM = 2048, C_CM = 2304, C_DT = 2560, C_Q = 2592, C_K = 2848, C_V = 3104, C_GG = 3616,
              C_LR = 4128, C_U5 = 4160, C_SG = 4672;
constexpr float EPSF = 1e-6f;
constexpr int SMEM_BYTES = 81920;
constexpr int NPHASE = 16;

constexpr size_t WS_P = 0;
constexpr size_t WS_Y = WS_P + (size_t)NTOK * IND * 2;
constexpr size_t WS_WIN = WS_Y + (size_t)NTOK * MIXW * 2;
constexpr size_t WS_WOUT = WS_WIN + (size_t)IND * DM * 2;
constexpr size_t WS_GLU = WS_WOUT + (size_t)DM * MIXW * 2;
constexpr size_t WS_HCTX = WS_GLU + (size_t)1024 * 512 * 2;
constexpr size_t WS_MOD = WS_HCTX + (size_t)NCTX * DM * 4;
constexpr size_t WS_SSQ = WS_MOD + (size_t)2 * 9 * 3072 * 4;
constexpr size_t WS_S5C = WS_SSQ + (size_t)NTOK * 16 * 4;
constexpr size_t WS_G5C = WS_S5C + (size_t)128 * 8704;
constexpr size_t WS_S5ST = WS_G5C + (size_t)NCTX * 512 * 2;
constexpr size_t WS_BAR = WS_S5ST + (size_t)512 * 128 * 4;
constexpr size_t WS_RS = WS_BAR + 16384;
constexpr size_t WS_END = WS_RS + (size_t)NTOK * 2 * 4;

struct Params {
  const float* in[29];
  float* out;
  unsigned char* ws;
  int ph_lo, ph_hi;
};

DI int opq(int i) { asm volatile("" : "+s"(i)); return i; }
DI int opaque_tid() { int t = threadIdx.x; asm volatile("" : "+v"(t)); return t; }
typedef __bf16 hbf16x2 __attribute__((ext_vector_type(2)));
typedef float hf32x2 __attribute__((ext_vector_type(2)));
DI u16 f2bf(float x) { __bf16 h = (__bf16)x; return __builtin_bit_cast(u16, h); }
DI float bf2f(u16 h) { return __uint_as_float(((unsigned)h) << 16); }
DI unsigned pack2(float a, float b) { hf32x2 v = {a, b}; return __builtin_bit_cast(unsigned, __builtin_convertvector(v, hbf16x2)); }
DI float bflo(unsigned v) { return __uint_as_float(v << 16); }
DI float bfhi(unsigned v) { return __uint_as_float(v & 0xffff0000u); }
DI float rcpf(float x) { return __builtin_amdgcn_rcpf(x); }
DI float siluf(float x) { return x * rcpf(1.f + __expf(-x)); }
DI float logsigf(float x) { return fminf(x, 0.f) - __logf(1.f + __expf(-fabsf(x))); }
DI float softplusf(float v) { return fmaxf(v, 0.f) + log1pf(__expf(-fabsf(v))); }
DI f32x4 mfma16(bf16x8 a, bf16x8 b, f32x4 c) { return __builtin_amdgcn_mfma_f32_16x16x32_bf16(a, b, c, 0, 0, 0); }
DI f32x16 mfma32(bf16x8 a, bf16x8 b, f32x16 c) { return __builtin_amdgcn_mfma_f32_32x32x16_bf16(a, b, c, 0, 0, 0); }
DI void wave_lds_sync() { asm volatile("s_waitcnt lgkmcnt(0)" ::: "memory"); }
DI unsigned pin(unsigned v) { asm volatile("" : "+v"(v)); return v; }
DI void pin4(u32x4& v) { asm volatile("" : "+v"(v)); }
#define DPPF(v, old, ctrl, rmask) __builtin_bit_cast(float, __builtin_amdgcn_update_dpp(__builtin_bit_cast(int, (float)(old)), __builtin_bit_cast(int, (float)(v)), (ctrl), (rmask), 0xf, false))
DI float row16_sum(float v) {
  v += DPPF(v, 0.f, 0xB1, 0xf);
  v += DPPF(v, 0.f, 0x4E, 0xf);
  v += DPPF(v, 0.f, 0x141, 0xf);
  v += DPPF(v, 0.f, 0x140, 0xf);
  return v;
}
DI float wave_incl_scan(float v) {
  v += DPPF(v, 0.f, 0x111, 0xf);
  v += DPPF(v, 0.f, 0x112, 0xf);
  v += DPPF(v, 0.f, 0x114, 0xf);
  v += DPPF(v, 0.f, 0x118, 0xf);
  v += DPPF(v, 0.f, 0x142, 0xa);
  v += DPPF(v, 0.f, 0x143, 0xc);
  return v;
}
DI bf16x8 ld8(const u16* p) { return *reinterpret_cast<const bf16x8*>(p); }
DI bf16x8 ld44(const u16* p0, const u16* p1) {
  bf16x4 a = *reinterpret_cast<const bf16x4*>(p0), b = *reinterpret_cast<const bf16x4*>(p1);
  return __builtin_shufflevector(a, b, 0, 1, 2, 3, 4, 5, 6, 7);
}
DI bf16x8 packacc(const f32x4& a, const f32x4& b) {
  uint4 u; u.x = pack2(a[0], a[1]); u.y = pack2(a[2], a[3]); u.z = pack2(b[0], b[1]); u.w = pack2(b[2], b[3]);
  return __builtin_bit_cast(bf16x8, u);
}

__device__ void phase_prep(const Params& p, unsigned char* smem) {
  float* sc = (float*)smem;
  float* red = sc + 9 * 1024;
  const int tid = opaque_tid();
  float* modb = (float*)(p.ws + WS_MOD);
  bool filled = false;
  for (int it = blockIdx.x; it < 96 + 128; it += gridDim.x) {
    if (it < 96) {
      if (!filled) {
        for (int idx = tid; idx < 9216; idx += 256) {
          int r = idx >> 10, k = idx & 1023;
          float v = r < 8 ? p.in[opq(1)][r * 1024 + k] : p.in[opq(3)][k];
          sc[idx] = siluf(v);
        }
        filled = true;
        __syncthreads();
      }
      const int l = it / 48, j0 = (it % 48) * 64, kg = tid >> 6, jj = tid & 63;
      float a[9];
#pragma unroll
      for (int r = 0; r < 9; ++r) a[r] = 0.f;
      const float* W = p.in[opq(5)] + (size_t)l * 1024 * 3072 + j0 + jj;
      for (int k = kg * 256; k < kg * 256 + 256; ++k) {
        float wv = W[(size_t)k * 3072];
#pragma unroll
        for (int r = 0; r < 9; ++r) a[r] += sc[r * 1024 + k] * wv;
      }
#pragma unroll
      for (int r = 0; r < 9; ++r) red[(kg * 9 + r) * 64 + jj] = a[r];
      __syncthreads();
      for (int idx = tid; idx < 576; idx += 256) {
        int r = idx >> 6, j = idx & 63;
        float s = red[(0 * 9 + r) * 64 + j] + red[(1 * 9 + r) * 64 + j] + red[(2 * 9 + r) * 64 + j] + red[(3 * 9 + r) * 64 + j];
        modb[(l * 9 + r) * 3072 + j0 + j] = s + p.in[opq(6)][l * 3072 + j0 + j];
      }
      __syncthreads();
    } else {
      const int q = it - 96, l = q >> 6, d = (q >> 5) & 1, g = q & 31;
      unsigned char* base = p.ws + WS_S5C + (size_t)q * 8704;
      u16* BbarM = (u16*)base;
      u16* CmT = (u16*)(base + 4096);
      float* lamb = (float*)(base + 8192);
      const float st = expf(p.in[opq(20)][(l * 2 + d) * 32 + g]);
      for (int idx = tid; idx < 1024; idx += 256) {
        const int pp = idx >> 4, hh = idx & 15;
        const int li = ((l * 2 + d) * 32 + g) * 64 + pp;
        const float lre = p.in[opq(18)][li], lim = p.in[opq(19)][li];
        const float a = lre * st, bb = lim * st;
        const float ea = expf(a), sn = sinf(bb), cs = cosf(bb), s2 = sinf(0.5f * bb);
        const float lbre = ea * cs, lbim = ea * sn;
        const float nre = expm1f(a) * cs - 2.f * s2 * s2, nim = lbim;
        const float den = lre * lre + lim * lim;
        const float cre = (nre * lre + nim * lim) / den, cim = (nim * lre - nre * lim) / den;
        const int bi = ((l * 32 + g) * 64 + pp) * 16 + hh;
        const float bre = p.in[opq(21)][bi], bim = p.in[opq(22)][bi];
        BbarM[(2 * pp) * 16 + hh] = f2bf(cre * bre - cim * bim);
        BbarM[(2 * pp + 1) * 16 + hh] = f2bf(cre * bim + cim * bre);
        const int cidx = (((l * 2 + d) * 32 + g) * 16 + hh) * 64 + pp;
        CmT[hh * 128 + 2 * pp] = f2bf(p.in[opq(23)][cidx]);
        CmT[hh * 128 + 2 * pp + 1] = f2bf(-p.in[opq(24)][cidx]);
        if (hh == 0) { lamb[2 * pp] = lbre; lamb[2 * pp + 1] = lbim; }
      }
    }
  }
}

__device__ void phase_pre(const Params& p, int l, unsigned char* smem) {
  const int tid = opaque_tid(), lane = tid & 63, w = tid >> 6;
  const float* hl = l == 0 ? p.in[opq(0)] : p.out;
  const float* hc = l == 0 ? p.in[opq(2)] : (const float*)(p.ws + WS_HCTX);
  const float* nw = p.in[opq(4)] + l * 1024;
  const float* modb = (const float*)(p.ws + WS_MOD) + l * 9 * 3072;
  u16* U = (u16*)(p.ws + WS_Y);
  const bool cm = (l & 1);
  for (int r = blockIdx.x * 4 + w; r < NTOK; r += gridDim.x * 4) {
    const float* src; const float* mrow;
    if (r < NLAT) {
      int b = r >> 12, sp = r & 4095;
      int s = cm ? (((sp & 63) << 6) | (sp >> 6)) : sp;
      src = hl + ((size_t)(b * 4096 + s)) * 1024; mrow = modb + b * 3072;
    } else { src = hc + (size_t)(r - NLAT) * 1024; mrow = modb + 8 * 3072; }
    float4 v[4]; float ss = 0.f;
#pragma unroll
    for (int q = 0; q < 4; ++q) {
      { const f32x4 t_ = __builtin_nontemporal_load(reinterpret_cast<const f32x4*>(src + lane * 4 + q * 256)); v[q] = make_float4(t_[0], t_[1], t_[2], t_[3]); }
      ss += v[q].x * v[q].x + v[q].y * v[q].y + v[q].z * v[q].z + v[q].w * v[q].w;
    }
#pragma unroll
    for (int o = 32; o > 0; o >>= 1) ss += __shfl_xor(ss, o);
    const float rs = rsqrtf(ss * (1.f / 1024.f) + EPSF);
#pragma unroll
    for (int q = 0; q < 4; ++q) {
      const int col = lane * 4 + q * 256;
      float4 n4 = *reinterpret_cast<const float4*>(nw + col);
      float4 sh = *reinterpret_cast<const float4*>(mrow + col);
      float4 s4 = *reinterpret_cast<const float4*>(mrow + 1024 + col);
      float u0 = v[q].x * rs * n4.x * (1.f + s4.x) + sh.x;
      float u1 = v[q].y * rs * n4.y * (1.f + s4.y) + sh.y;
      float u2 = v[q].z * rs * n4.z * (1.f + s4.z) + sh.z;
      float u3 = v[q].w * rs * n4.w * (1.f + s4.w) + sh.w;
      uint2 o; o.x = pack2(u0, u1); o.y = pack2(u2, u3);
      *reinterpret_cast<uint2*>(U + (size_t)r * 1024 + col) = o;
    }
  }
  float* tile = (float*)smem;
  for (int t = blockIdx.x; t < 1296 + 512 + 128; t += gridDim.x) {
    const float* src; int sld, k0, n0, kind; u16* dst; int dld;
    if (t < 1296) { kind = 0; k0 = (t / 81) * 64; n0 = (t % 81) * 64; src = p.in[opq(7)] + (size_t)l * 1024 * IND; sld = IND; dst = (u16*)(p.ws + WS_WIN); dld = 1024; }
    else if (t < 1808) { int q = t - 1296; kind = 1; k0 = (q / 16) * 64; n0 = (q % 16) * 64; src = p.in[opq(8)] + (size_t)l * 2048 * 1024; sld = 1024; dst = (u16*)(p.ws + WS_WOUT); dld = 2048; }
    else { int q = t - 1808; kind = 2; k0 = (q / 16) * 64; n0 = (q % 16) * 64; src = p.in[opq(26)] + (size_t)l * 512 * 1024; sld = 1024; dst = (u16*)(p.ws + WS_GLU); dld = 512; }
    __syncthreads();
#pragma unroll
    for (int rr = 0; rr < 4; ++rr) {
      int i = (tid >> 4) + 16 * rr, j = (tid & 15) * 4;
      float4 v; { const f32x4 t_ = __builtin_nontemporal_load(reinterpret_cast<const f32x4*>(src + (size_t)(k0 + i) * sld + n0 + j)); v = make_float4(t_[0], t_[1], t_[2], t_[3]); }
      if (kind == 1 && k0 + i < 1024) { float s = p.in[opq(14)][l * 1024 + k0 + i]; v.x *= s; v.y *= s; v.z *= s; v.w *= s; }
      tile[i * 65 + j] = v.x; tile[i * 65 + j + 1] = v.y; tile[i * 65 + j + 2] = v.z; tile[i * 65 + j + 3] = v.w;
    }
    __syncthreads();
#pragma unroll
    for (int rr = 0; rr < 2; ++rr) {
      int n = (tid >> 3) + 32 * rr, i0 = (tid & 7) * 8;
      uint4 o;
      o.x = pack2(tile[(i0 + 0) * 65 + n], tile[(i0 + 1) * 65 + n]);
      o.y = pack2(tile[(i0 + 2) * 65 + n], tile[(i0 + 3) * 65 + n]);
      o.z = pack2(tile[(i0 + 4) * 65 + n], tile[(i0 + 5) * 65 + n]);
      o.w = pack2(tile[(i0 + 6) * 65 + n], tile[(i0 + 7) * 65 + n]);
      int drow = n0 + n;
      if (kind == 2) { int o_ = n0 + n, half = o_ >> 9, rem = o_ & 511; drow = (rem >> 6) * 128 + ((rem & 63) >> 4) * 32 + half * 16 + (rem & 15); }
      *reinterpret_cast<uint4*>(dst + (size_t)drow * dld + k0 + i0) = o;
    }
  }
}

template <int BN, int MODE>
__device__ void gemm_tile(const Params& p, int l, const u16* __restrict__ A, int lda, const u16* __restrict__ Bt, int ldb,
                          int K, int m0, int n0, unsigned char* smem,
                          bool pre, bool has_next, const u16* __restrict__ An, int ldan, int m0n, int n0n) {
  constexpr int WN = BN / 2, NF = WN / 16, NBL = BN * 8 / 256;
  u16* As = (u16*)smem;
  u16* Bs = As + 128 * 64;
  const int tid = opaque_tid(), lane = tid & 63, w = tid >> 6, wr = w >> 1, wc = w & 1, fr = lane & 15, fq = lane >> 4;
  f32x4 acc[4][NF];
#pragma unroll
  for (int m = 0; m < 4; ++m)
#pragma unroll
    for (int n = 0; n < NF; ++n) acc[m][n] = f32x4{0.f, 0.f, 0.f, 0.f};
  constexpr int STAGE = (128 + BN) * 64;
  const int nk = K / 64;
#define GLDS(OFF, KT) do { const int k0_ = (KT) * 64; \
    _Pragma("unroll") for (int i = 0; i < 4; ++i) { const int id = tid + 256 * i, row = id >> 3, c = (id & 7) ^ ((id >> 4) & 7); \
      __builtin_amdgcn_global_load_lds((const unsigned*)(A + (size_t)(m0 + row) * lda + k0_ + c * 8), (unsigned*)(As + (OFF) + id * 8), 16, 0, 0); } \
    _Pragma("unroll") for (int i = 0; i < NBL; ++i) { const int id = tid + 256 * i, row = id >> 3, c = (id & 7) ^ ((id >> 4) & 7); \
      __builtin_amdgcn_global_load_lds((const unsigned*)(Bt + (size_t)(n0 + row) * ldb + k0_ + c * 8), (unsigned*)(Bs + (OFF) + id * 8), 16, 0, 0); } } while (0)
#define COMPUTE(OFF) do { \
    bf16x8 af[2][4], bfr[2][NF];        \
    _Pragma("unroll") for (int kk = 0; kk < 2; ++kk) { \
      _Pragma("unroll") for (int m = 0; m < 4; ++m) af[kk][m] = ld8(As + (OFF) + (wr * 64 + m * 16 + fr) * 64 + (((kk * 4 + fq) ^ (fr >> 1)) * 8)); \
      _Pragma("unroll") for (int n = 0; n < NF; ++n) bfr[kk][n] = ld8(Bs + (OFF) + (wc * WN + n * 16 + fr) * 64 + (((kk * 4 + fq) ^ (fr >> 1)) * 8)); } \
    __builtin_amdgcn_s_setprio(1); \
    _Pragma("unroll") for (int kk = 0; kk < 2; ++kk) \
      _Pragma("unroll") for (int m = 0; m < 4; ++m) \
        _Pragma("unroll") for (int n = 0; n < NF; ++n) acc[m][n] = mfma16(bfr[kk][n], af[kk][m], acc[m][n]); \
    __builtin_amdgcn_s_setprio(0); } while (0)
  float f0[4], f1[4];
  if constexpr (MODE == 2) {
    const float* rsb = (const float*)(p.ws + WS_RS);
#pragma unroll
    for (int m = 0; m < 4; ++m) {
      const float2 r2 = *reinterpret_cast<const float2*>(rsb + (size_t)(m0 + wr * 64 + m * 16 + fr) * 2);
      f0[m] = r2.x * rcpf(r2.y); f1[m] = r2.y;
    }
  }
  __syncthreads();
  if (!pre) GLDS(0, 0);
  asm volatile("s_waitcnt vmcnt(0)" ::: "memory");
  __syncthreads();
  for (int kt = 0; kt < nk; ++kt) {
    const int cur = (kt & 1) * STAGE, nxt = STAGE - cur;
    if (kt + 1 < nk) GLDS(nxt, kt + 1);
    else if (has_next) {
#pragma unroll
      for (int i = 0; i < 4; ++i) { const int id = tid + 256 * i, row = id >> 3, c = (id & 7) ^ ((id >> 4) & 7);
        __builtin_amdgcn_global_load_lds((const unsigned*)(An + (size_t)(m0n + row) * ldan + c * 8), (unsigned*)(As + id * 8), 16, 0, 0); }
#pragma unroll
      for (int i = 0; i < NBL; ++i) { const int id = tid + 256 * i, row = id >> 3, c = (id & 7) ^ ((id >> 4) & 7);
        __builtin_amdgcn_global_load_lds((const unsigned*)(Bt + (size_t)(n0n + row) * ldb + c * 8), (unsigned*)(Bs + id * 8), 16, 0, 0); }
    }
    COMPUTE(cur);
    if constexpr (MODE == 2) {
      if (kt == 7 || kt == 15) {
#pragma unroll
        for (int m = 0; m < 4; ++m)
#pragma unroll
          for (int n = 0; n < NF; ++n)
#pragma unroll
            for (int j = 0; j < 4; ++j) acc[m][n][j] *= (kt == 7) ? f0[m] : f1[m];
      }
    }
    if (kt + 1 < nk) asm volatile("s_waitcnt vmcnt(0)" ::: "memory");
    __syncthreads();
  }
#define GLOAD(x)
#define LSTORE(x)
#undef GLOAD
#undef LSTORE
#undef COMPUTE
  if constexpr (MODE == 0) {
    u16* P = (u16*)(p.ws + WS_P);
    constexpr int SLD = WN + 8;
    u16* stg = (u16*)smem + STAGE + w * 16 * SLD;
    constexpr int CPR = WN / 8;
    __syncthreads();
#pragma unroll
    for (int m = 0; m < 4; ++m) {
      wave_lds_sync();
#pragma unroll
      for (int n = 0; n < NF; ++n) {
        uint2 o; o.x = pack2(acc[m][n][0], acc[m][n][1]); o.y = pack2(acc[m][n][2], acc[m][n][3]);
        *reinterpret_cast<uint2*>(stg + fr * SLD + n * 16 + fq * 4) = o;
      }
      wave_lds_sync();
      for (int id = lane; id < 16 * CPR; id += 64) {
        int row = id / CPR, ch = id % CPR;
        uint4 v = *reinterpret_cast<const uint4*>(stg + row * SLD + ch * 8);
        __builtin_nontemporal_store(__builtin_bit_cast(u32x4, v), reinterpret_cast<u32x4*>(P + (size_t)(m0 + wr * 64 + m * 16 + row) * IND + n0 + wc * WN + ch * 8));
      }
    }
  } else if constexpr (MODE == 1) {
    const u16* P = (const u16*)(p.ws + WS_P);
    u16* Y = (u16*)(p.ws + WS_Y);
    const float* gb = p.in[opq(27)] + l * 1024;
    const int tn = n0 >> 7;
#pragma unroll
    for (int q = 0; q < 2; ++q) {
      const int oc = tn * 64 + (wc * 2 + q) * 16 + fq * 4;
      const f32x4 b0 = *reinterpret_cast<const f32x4*>(gb + oc), b1 = *reinterpret_cast<const f32x4*>(gb + 512 + oc);
#pragma unroll
      for (int m = 0; m < 4; ++m) {
        const size_t row = (size_t)(m0 + wr * 64 + m * 16 + fr);
        const uint2 sgv = *reinterpret_cast<const uint2*>(P + row * IND + C_SG + oc);
        const float sg[4] = {bflo(sgv.x), bfhi(sgv.x), bflo(sgv.y), bfhi(sgv.y)};
        float y[4];
#pragma unroll
        for (int j = 0; j < 4; ++j) {
          const float val = acc[m][2 * q][j] + b0[j], gt = acc[m][2 * q + 1][j] + b1[j];
          y[j] = val * rcpf(1.f + __expf(-gt)) * siluf(sg[j]);
        }
        uint2 o; o.x = pack2(y[0], y[1]); o.y = pack2(y[2], y[3]);
        *reinterpret_cast<uint2*>(Y + row * MIXW + 1536 + oc) = o;
      }
    }
  } else {
    const float* modb = (const float*)(p.ws + WS_MOD) + l * 9 * 3072;
    const bool cm = (l & 1);
    const float* hs = l == 0 ? p.in[opq(0)] : p.out;
    float* stg = (float*)((u16*)smem + STAGE) + w * (16 * 68);
    __syncthreads();
#pragma unroll
    for (int m = 0; m < 4; ++m) {
#pragma unroll
      for (int n = 0; n < NF; ++n) *reinterpret_cast<f32x4*>(stg + fr * 68 + n * 16 + fq * 4) = acc[m][n];
      wave_lds_sync();
#pragma unroll
      for (int k = 0; k < 4; ++k) {
        const int id = lane + 64 * k, rowi = id >> 4, ch = id & 15;
        const f32x4 a = *reinterpret_cast<const f32x4*>(stg + rowi * 68 + ch * 4);
        const int r = m0 + wr * 64 + m * 16 + rowi, col = n0 + wc * WN + ch * 4;
        const float* src; float* dst; const float* gt;
        if (r < NLAT) {
          const int b = r >> 12, sp = r & 4095;
          const int sq = cm ? (((sp & 63) << 6) | (sp >> 6)) : sp;
          const size_t idx = ((size_t)(b * 4096 + sq)) * 1024 + col;
          src = hs + idx; dst = p.out + idx; gt = modb + b * 3072 + 2048 + col;
        } else {
          const size_t idx = (size_t)(r - NLAT) * 1024 + col;
          src = p.in[opq(2)] + idx; dst = (float*)(p.ws + WS_HCTX) + idx; gt = modb + 8 * 3072 + 2048 + col;
        }
        const f32x4 h = __builtin_nontemporal_load(reinterpret_cast<const f32x4*>(src)), gv = *reinterpret_cast<const f32x4*>(gt);
        f32x4 o;
        o[0] = h[0] + gv[0] * a[0]; o[1] = h[1] + gv[1] * a[1]; o[2] = h[2] + gv[2] * a[2]; o[3] = h[3] + gv[3] * a[3];
        __builtin_nontemporal_store(o, reinterpret_cast<f32x4*>(dst));
      }
      wave_lds_sync();
    }
  }
  __syncthreads();
}

__device__ void phase_conv(const Params& p, int l) {
  u16* P = (u16*)(p.ws + WS_P);
  const float* cw = p.in[opq(9)] + (size_t)l * 5 * 1536;
  const float* cb = p.in[opq(10)] + l * 1536;
  const int tid = opaque_tid(), cq = tid & 7, sgi = tid >> 3;
  for (int it = blockIdx.x; it < 768; it += gridDim.x) {
    const bool isctx = it >= 384;
    const int q = isctx ? it - 384 : it, b = q / 48, cgp = q % 48;
    const int L = isctx ? 256 : 4096, seg = L / 32, rowbase = isctx ? NLAT + b * 256 : b * 4096;
    const int ch = cgp * 32 + cq * 4;
    float4 wk[5];
#pragma unroll
    for (int k = 0; k < 5; ++k) wk[k] = *reinterpret_cast<const float4*>(cw + k * 1536 + ch);
    const float4 bias = *reinterpret_cast<const float4*>(cb + ch);
    u16* rp = P + (size_t)rowbase * IND + C_XBC + ch;
    const int a = sgi * seg;
    auto ld = [&](int sp) -> float4 {
      float4 r = make_float4(0.f, 0.f, 0.f, 0.f);
      if (sp >= 0 && sp < L) {
        uint2 v = *reinterpret_cast<const uint2*>(rp + (size_t)sp * IND);
        r.x = bflo(v.x); r.y = bfhi(v.x); r.z = bflo(v.y); r.w = bfhi(v.y);
      }
      return r;
    };
    float4 r0 = ld(a - 2), r1 = ld(a - 1), r2 = ld(a), r3 = ld(a + 1);
    const float4 e0 = ld(a + seg), e1 = ld(a + seg + 1);
    __syncthreads();
    auto ldraw = [&](int sp) -> uint2 {
      uint2 v = make_uint2(0u, 0u);
      if (sp < a + seg) v = *reinterpret_cast<const uint2*>(rp + (size_t)sp * IND);
      return v;
    };
    uint2 nraw[8];
#pragma unroll
    for (int j = 0; j < 8; ++j) nraw[j] = ldraw(a + 2 + j);
    for (int t0 = a; t0 < a + seg; t0 += 8) {
      uint2 cur[8];
#pragma unroll
      for (int j = 0; j < 8; ++j) cur[j] = nraw[j];
      if (t0 + 8 < a + seg) {
#pragma unroll
        for (int j = 0; j < 8; ++j) nraw[j] = ldraw(t0 + 10 + j);
      }
#pragma unroll
      for (int j = 0; j < 8; ++j) {
        const int sp = t0 + 2 + j;
        float4 r4;
        if (sp < a + seg) {
          const unsigned c0_ = pin(cur[j].x), c1_ = pin(cur[j].y);
          r4 = make_float4(bflo(c0_), bfhi(c0_), bflo(c1_), bfhi(c1_));
        } else r4 = (sp == a + seg) ? e0 : e1;
        float o0 = bias.x + wk[0].x * r0.x + wk[1].x * r1.x + wk[2].x * r2.x + wk[3].x * r3.x + wk[4].x * r4.x;
        float o1 = bias.y + wk[0].y * r0.y + wk[1].y * r1.y + wk[2].y * r2.y + wk[3].y * r3.y + wk[4].y * r4.y;
        float o2 = bias.z + wk[0].z * r0.z + wk[1].z * r1.z + wk[2].z * r2.z + wk[3].z * r3.z + wk[4].z * r4.z;
        float o3 = bias.w + wk[0].w * r0.w + wk[1].w * r1.w + wk[2].w * r2.w + wk[3].w * r3.w + wk[4].w * r4.w;
        uint2 o; o.x = pack2(siluf(o0), siluf(o1)); o.y = pack2(siluf(o2), siluf(o3));
        __builtin_nontemporal_store(u32x2{o.x, o.y}, reinterpret_cast<u32x2*>(rp + (size_t)(t0 + j) * IND));
        r0 = r1; r1 = r2; r2 = r3; r3 = r4;
      }
    }
    __syncthreads();
  }
}


__device__ void ssd_item(const Params& p, int l, int part, int item, unsigned char* smem) {
  u16* Bs = (u16*)smem;
  u16* Ms = Bs;
  u16* Cs = (u16*)(smem + 17408);
  u16* BT = (u16*)(smem + 34816);
  u16* xT = (u16*)(smem + 53248);
  u16* xwT = (u16*)(smem + 62464);
  float* dts = (float*)(smem + 71680);
  float* acs = dts + 64;
  float* wts = acs + 64;
  float* ssql = wts + 64;
  float* tots = ssql + 256;
  u16* ystg = (u16*)(smem + 73600);
  const int tid0 = opaque_tid();
  const int b = item >> 5, hd = (item >> 1) & 15, dir = item & 1, g = hd >> 3;
  u16* P = (u16*)(p.ws + WS_P);
  u16* Y = (u16*)(p.ws + WS_Y);
  float* ssq = (float*)(p.ws + WS_SSQ);
  float* stsave = (float*)(p.ws + WS_WIN) + (size_t)item * 8192;
  const float Dsk = p.in[opq(13)][l * 16 + hd];
  f32x4 hacc[8];
  if (part == 1) {
#pragma unroll
    for (int i = 0; i < 8; ++i) hacc[i] = *reinterpret_cast<const f32x4*>(stsave + (i * 256 + tid0) * 4);
  } else {
#pragma unroll
    for (int i = 0; i < 8; ++i) hacc[i] = f32x4{0.f, 0.f, 0.f, 0.f};
  }
  const int nseg = part == 0 ? 3 : 1;
  for (int seg = 0; seg < nseg; ++seg) {
    bool isctx; int sdir, ci0, ci1, mode;
    if (part == 1) { isctx = false; sdir = dir; ci0 = 32; ci1 = 64; mode = 2; }
    else if (seg == 0) { if (!(dir == 0 && l == 0)) continue; isctx = true; sdir = 1; ci0 = 0; ci1 = 4; mode = 1; }
    else if (seg == 1) { isctx = true; sdir = dir; ci0 = 0; ci1 = 4; mode = (dir == 0 && l == 0) ? 2 : 0; }
    else { isctx = false; sdir = dir; ci0 = 0; ci1 = 32; mode = 1; }
    if (part == 0 && seg <= 1) {
#pragma unroll
      for (int i = 0; i < 8; ++i) hacc[i] = f32x4{0.f, 0.f, 0.f, 0.f};
    }
    __threadfence();
    __syncthreads();
    const float aneg = -expf(p.in[opq(11)][(l * 2 + sdir) * 16 + hd]);
    const float dtb = p.in[opq(12)][(l * 2 + sdir) * 16 + hd];
    const int nch = isctx ? 4 : 64;
    const int rowbase = isctx ? NLAT + b * 256 : b * 4096;
#pragma unroll
    for (int i = 0; i < 8; ++i) asm volatile("" : "+v"(hacc[i]));
    u32x4 rx[2], rbm[4], rcm[4];
    unsigned rawdt = 0u;
    {
      const int tid = tid0, lane = tid & 63, w = tid >> 6;
      const int cL = (sdir ? nch - 1 - ci0 : ci0) * 64;
#pragma unroll
      for (int k = 0; k < 2; ++k) {
        const int id = tid + 256 * k, pch = id >> 6, i = id & 63;
        const int tau = sdir ? cL + 63 - i : cL + i;
        rx[k] = *reinterpret_cast<const u32x4*>(P + (size_t)(rowbase + tau) * IND + C_XBC + hd * 64 + pch * 8);
      }
#pragma unroll
      for (int k = 0; k < 4; ++k) {
        const int id = tid + 256 * k, nc = id >> 6, i = id & 63;
        const int tau = sdir ? cL + 63 - i : cL + i;
        rbm[k] = *reinterpret_cast<const u32x4*>(P + (size_t)(rowbase + tau) * IND + C_BM + g * 128 + nc * 8);
      }
#pragma unroll
      for (int k = 0; k < 4; ++k) {
        const int id = tid + 256 * k, i = id >> 4, nc = id & 15;
        const int tau = sdir ? cL + 63 - i : cL + i;
        rcm[k] = *reinterpret_cast<const u32x4*>(P + (size_t)(rowbase + tau) * IND + C_CM + g * 128 + nc * 8);
      }
      rawdt = P[(size_t)(rowbase + (sdir ? cL + 63 - lane : cL + lane)) * IND + C_DT + sdir * 16 + hd];
    }
    for (int ci = ci0; ci < ci1; ++ci) {
      const int c0 = (sdir ? nch - 1 - ci : ci) * 64;
      int tid = tid0;
      asm volatile("" : "+v"(tid));
      const int lane = tid & 63, w = tid >> 6, fr = lane & 15, fq = lane >> 4;
      __syncthreads();
      if (w == 0) {
        float dt = softplusf(bflo(pin(rawdt)) + dtb);
        const float cs = wave_incl_scan(dt * aneg);
        const float tot = __builtin_bit_cast(float, __builtin_amdgcn_readlane(__builtin_bit_cast(int, cs), 63));
        dts[lane] = dt; acs[lane] = cs; wts[lane] = __expf(tot - cs);
        if (lane == 0) tots[0] = tot;
      }
      pin4(rbm[0]); pin4(rbm[1]); pin4(rbm[2]); pin4(rbm[3]);
#pragma unroll
      for (int k = 0; k < 4; ++k) {
        const int id = tid + 256 * k, nc = id >> 6, i = id & 63;
        *reinterpret_cast<u32x4*>(Bs + i * 136 + nc * 8) = rbm[k];
#pragma unroll
        for (int e = 0; e < 4; ++e) {
          BT[(nc * 8 + 2 * e) * 72 + i] = (u16)(rbm[k][e] & 0xffffu);
          BT[(nc * 8 + 2 * e + 1) * 72 + i] = (u16)(rbm[k][e] >> 16);
        }
      }
#pragma unroll
      for (int k = 0; k < 4; ++k) {
        const int id = tid + 256 * k, i = id >> 4, nc = id & 15;
        *reinterpret_cast<u32x4*>(Cs + i * 136 + nc * 8) = rcm[k];
      }
      __syncthreads();
      pin4(rx[0]); pin4(rx[1]);
#pragma unroll
      for (int k = 0; k < 2; ++k) {
        const int id = tid + 256 * k, pch = id >> 6, i = id & 63;
        const float dt = dts[i], wt = wts[i];
#pragma unroll
        for (int e = 0; e < 4; ++e) {
          float x0 = bflo(rx[k][e]) * dt, x1 = bfhi(rx[k][e]) * dt;
          xT[(pch * 8 + 2 * e) * 72 + i] = f2bf(x0); xT[(pch * 8 + 2 * e + 1) * 72 + i] = f2bf(x1);
          xwT[(pch * 8 + 2 * e) * 72 + i] = f2bf(x0 * wt); xwT[(pch * 8 + 2 * e + 1) * 72 + i] = f2bf(x1 * wt);
        }
      }
      u32x4 tmpv[2] = {u32x4{0u, 0u, 0u, 0u}, u32x4{0u, 0u, 0u, 0u}};
      uint2 zr[4];
#pragma unroll
      for (int e = 0; e < 4; ++e) zr[e] = make_uint2(0u, 0u);
      if (mode == 2) {
        const int qs = (w * 4 + fq) * 16 + (15 - fr);
        const u16* tp = Y + (size_t)(rowbase + c0 + (qs >> 2)) * MIXW + hd * 64 + (qs & 3) * 16;
        tmpv[0] = *reinterpret_cast<const u32x4*>(tp); tmpv[1] = *reinterpret_cast<const u32x4*>(tp + 8);
#pragma unroll
        for (int tt = 0; tt < 4; ++tt) {
          const int t = tt * 16 + fr;
          const size_t row = (size_t)(rowbase + (sdir ? c0 + 63 - t : c0 + t));
          zr[tt] = *reinterpret_cast<const uint2*>(P + row * IND + hd * 64 + w * 16 + fq * 4);
        }
      }
      if (ci + 1 < ci1) {
        const int cL = (sdir ? nch - 2 - ci : ci + 1) * 64;
#pragma unroll
        for (int k = 0; k < 2; ++k) {
          const int id = tid + 256 * k, pch = id >> 6, i = id & 63;
          const int tau = sdir ? cL + 63 - i : cL + i;
          rx[k] = *reinterpret_cast<const u32x4*>(P + (size_t)(rowbase + tau) * IND + C_XBC + hd * 64 + pch * 8);
        }
#pragma unroll
        for (int k = 0; k < 4; ++k) {
          const int id = tid + 256 * k, nc = id >> 6, i = id & 63;
          const int tau = sdir ? cL + 63 - i : cL + i;
          rbm[k] = *reinterpret_cast<const u32x4*>(P + (size_t)(rowbase + tau) * IND + C_BM + g * 128 + nc * 8);
        }
#pragma unroll
        for (int k = 0; k < 4; ++k) {
          const int id = tid + 256 * k, i = id >> 4, nc = id & 15;
          const int tau = sdir ? cL + 63 - i : cL + i;
          rcm[k] = *reinterpret_cast<const u32x4*>(P + (size_t)(rowbase + tau) * IND + C_CM + g * 128 + nc * 8);
        }
        rawdt = P[(size_t)(rowbase + (sdir ? cL + 63 - lane : cL + lane)) * IND + C_DT + sdir * 16 + hd];
      }
      __syncthreads();
      f32x4 gacc[4];
#pragma unroll
      for (int i = 0; i < 4; ++i) gacc[i] = f32x4{0.f, 0.f, 0.f, 0.f};
#pragma unroll
      for (int kk = 0; kk < 4; ++kk) {
        bf16x8 a = ld8(Bs + (w * 16 + fr) * 136 + kk * 32 + fq * 8);
#pragma unroll
        for (int tb = 0; tb < 4; ++tb) {
          bf16x8 bb = ld8(Cs + (tb * 16 + fr) * 136 + kk * 32 + fq * 8);
          gacc[tb] = mfma16(a, bb, gacc[tb]);
        }
      }
      asm volatile("" : "+v"(tmpv[0]), "+v"(tmpv[1]));
      __syncthreads();
#pragma unroll
      for (int tb = 0; tb < 4; ++tb) {
        const int t = tb * 16 + fr;
        const float at = acs[t];
        float mv[4];
#pragma unroll
        for (int j = 0; j < 4; ++j) {
          const int s = w * 16 + fq * 4 + j;
          mv[j] = (s <= t) ? gacc[tb][j] * __expf(at - acs[s]) : 0.f;
        }
        uint2 o; o.x = pack2(mv[0], mv[1]); o.y = pack2(mv[2], mv[3]);
        *reinterpret_cast<uint2*>(Ms + t * 72 + w * 16 + fq * 4) = o;
      }
      __syncthreads();
      f32x4 yd[4], yo[4];
#pragma unroll
      for (int i = 0; i < 4; ++i) { yd[i] = f32x4{0.f, 0.f, 0.f, 0.f}; yo[i] = f32x4{0.f, 0.f, 0.f, 0.f}; }
#pragma unroll
      for (int kk = 0; kk < 2; ++kk) {
        bf16x8 bb = ld8(xT + (w * 16 + fr) * 72 + kk * 32 + fq * 8);
#pragma unroll
        for (int tt = 0; tt < 4; ++tt) {
          bf16x8 a = ld8(Ms + (tt * 16 + fr) * 72 + kk * 32 + fq * 8);
          yd[tt] = mfma16(bb, a, yd[tt]);
        }
      }
#pragma unroll
      for (int kk = 0; kk < 4; ++kk) {
        bf16x8 hb = packacc(hacc[2 * kk], hacc[2 * kk + 1]);
#pragma unroll
        for (int tt = 0; tt < 4; ++tt) {
          const u16* cr = Cs + (tt * 16 + fr) * 136 + fq * 4;
          bf16x8 a = ld44(cr + (2 * kk) * 16, cr + (2 * kk + 1) * 16);
          yo[tt] = mfma16(hb, a, yo[tt]);
        }
      }
      const float etot = __expf(tots[0]);
#pragma unroll
      for (int nb = 0; nb < 8; ++nb) { hacc[nb][0] *= etot; hacc[nb][1] *= etot; hacc[nb][2] *= etot; hacc[nb][3] *= etot; }
#pragma unroll
      for (int kk = 0; kk < 2; ++kk) {
        bf16x8 bb = ld8(xwT + (w * 16 + fr) * 72 + kk * 32 + fq * 8);
#pragma unroll
        for (int nb = 0; nb < 8; ++nb) {
          bf16x8 a = ld8(BT + (nb * 16 + fr) * 72 + kk * 32 + fq * 8);
          hacc[nb] = mfma16(a, bb, hacc[nb]);
        }
      }
      if (mode != 0) {
        float ea[4];
#pragma unroll
        for (int tt = 0; tt < 4; ++tt) ea[tt] = __expf(acs[tt * 16 + fr]);
        if (mode == 1) {
          u32x4 o0, o1;
#pragma unroll
          for (int tt = 0; tt < 4; ++tt) {
            float v[4];
#pragma unroll
            for (int j = 0; j < 4; ++j) v[j] = yd[tt][j] + ea[tt] * yo[tt][j];
            const unsigned a2 = pack2(v[0], v[1]), b2 = pack2(v[2], v[3]);
            if (tt == 0) { o0[0] = a2; o0[1] = b2; } else if (tt == 1) { o0[2] = a2; o0[3] = b2; }
            else if (tt == 2) { o1[0] = a2; o1[1] = b2; } else { o1[2] = a2; o1[3] = b2; }
          }
          const int qs = (w * 4 + fq) * 16 + fr;
          u16* tp = Y + (size_t)(rowbase + c0 + (qs >> 2)) * MIXW + hd * 64 + (qs & 3) * 16;
          *reinterpret_cast<u32x4*>(tp) = o0; *reinterpret_cast<u32x4*>(tp + 8) = o1;
        } else {
          float xsv[16], rdt[4], val[16];
#pragma unroll
          for (int tt = 0; tt < 4; ++tt) {
            rdt[tt] = rcpf(dts[tt * 16 + fr]);
#pragma unroll
            for (int j = 0; j < 4; ++j) xsv[tt * 4 + j] = bf2f(xT[(w * 16 + fq * 4 + j) * 72 + tt * 16 + fr]);
          }
          float sq[4];
#pragma unroll
          for (int tt = 0; tt < 4; ++tt) {
            const int t = tt * 16 + fr;
            const uint2 zw = zr[tt];
            const unsigned z01 = pin(zw.x), z23 = pin(zw.y);
            const float zz[4] = {bflo(z01), bfhi(z01), bflo(z23), bfhi(z23)};
            const int et = 3 - tt;
            const unsigned p01 = tmpv[et >> 1][(et & 1) * 2], p23 = tmpv[et >> 1][(et & 1) * 2 + 1];
            const float yf[4] = {bflo(p01), bfhi(p01), bflo(p23), bfhi(p23)};
            float s2 = 0.f;
#pragma unroll
            for (int j = 0; j < 4; ++j) {
              const float yv = yd[tt][j] + ea[tt] * yo[tt][j];
              const float vv = (yf[j] + yv + Dsk * xsv[tt * 4 + j] * rdt[tt]) * siluf(zz[j]);
              val[tt * 4 + j] = vv; s2 += vv * vv;
            }
            sq[tt] = s2;
            uint2 o; o.x = pack2(val[tt * 4], val[tt * 4 + 1]); o.y = pack2(val[tt * 4 + 2], val[tt * 4 + 3]);
            const int c = w * 2 + (fq >> 1);
            *reinterpret_cast<uint2*>(ystg + t * 64 + ((c ^ ((t >> 2) & 7)) << 3) + (fq & 1) * 4) = o;
          }
#pragma unroll
          for (int tt = 0; tt < 4; ++tt) {
            sq[tt] += __shfl_xor(sq[tt], 16); sq[tt] += __shfl_xor(sq[tt], 32);
          }
          if (fq == 0) {
#pragma unroll
            for (int tt = 0; tt < 4; ++tt) ssql[w * 64 + tt * 16 + fr] = sq[tt];
          }
          __syncthreads();
#pragma unroll
          for (int k = 0; k < 2; ++k) {
            const int id = tid + 256 * k, t = id >> 3, c = id & 7;
            const u32x4 v = *reinterpret_cast<const u32x4*>(ystg + t * 64 + ((c ^ ((t >> 2) & 7)) << 3));
            const size_t row = (size_t)(rowbase + (sdir ? c0 + 63 - t : c0 + t));
            *reinterpret_cast<u32x4*>(Y + row * MIXW + hd * 64 + c * 8) = v;
          }
          if (tid < 64) {
            const size_t row = (size_t)(rowbase + (sdir ? c0 + 63 - tid : c0 + tid));
            ssq[row * 16 + hd] = ssql[tid] + ssql[64 + tid] + ssql[128 + tid] + ssql[192 + tid];
          }
        }
      }
    }
  }
  if (part == 0) {
#pragma unroll
    for (int i = 0; i < 8; ++i) *reinterpret_cast<f32x4*>(stsave + (i * 256 + tid0) * 4) = hacc[i];
  }
}

__device__ void gla_item(const Params& p, int l, int part, int item, unsigned char* smem) {
  u16* qe = (u16*)smem;
  u16* ke = (u16*)(smem + 9216);
  u16* kdT = (u16*)(smem + 18432);
  u16* vT = (u16*)(smem + 27648);
  u16* at = (u16*)(smem + 46080);
  float* gl = (float*)(smem + 55296);
  float* red = (float*)(smem + 71936);
  const int tid0 = opaque_tid();
  const int b = item >> 3, h = (item >> 1) & 3, dir = item & 1;
  u16* P = (u16*)(p.ws + WS_P);
  u16* Y = (u16*)(p.ws + WS_Y);
  float* stsave = (float*)(p.ws + WS_WIN) + (size_t)(256 + item) * 8192;
  f32x4 sacc[4][2];
  if (part == 1) {
#pragma unroll
    for (int i = 0; i < 8; ++i) sacc[i >> 1][i & 1] = *reinterpret_cast<const f32x4*>(stsave + (i * 256 + tid0) * 4);
  } else {
#pragma unroll
    for (int i = 0; i < 8; ++i) sacc[i >> 1][i & 1] = f32x4{0.f, 0.f, 0.f, 0.f};
  }
  const int nseg = part == 0 ? 3 : 1;
  for (int seg = 0; seg < nseg; ++seg) {
    bool isctx; int sdir, ci0, ci1, mode;
    if (part == 1) { isctx = false; sdir = dir; ci0 = 32; ci1 = 64; mode = 2; }
    else if (seg == 0) { if (!(dir == 0 && l == 0)) continue; isctx = true; sdir = 1; ci0 = 0; ci1 = 4; mode = 1; }
    else if (seg == 1) { isctx = true; sdir = dir; ci0 = 0; ci1 = 4; mode = (dir == 0 && l == 0) ? 2 : 0; }
    else { isctx = false; sdir = dir; ci0 = 0; ci1 = 32; mode = 1; }
    if (part == 0 && seg <= 1) {
#pragma unroll
      for (int i = 0; i < 8; ++i) sacc[i >> 1][i & 1] = f32x4{0.f, 0.f, 0.f, 0.f};
    }
    __threadfence();
    __syncthreads();
    const int nch = isctx ? 4 : 64;
    const int rowbase = isctx ? NLAT + b * 256 : b * 4096;
#pragma unroll
    for (int i = 0; i < 8; ++i) asm volatile("" : "+v"(sacc[i >> 1][i & 1]));
    u32x4 rq[2], rk[2], rv[4], rlr;
    bf16x8 Bw;
    float bl;
    {
      const int tid = tid0;
      const int dcol = h * 64 + 32 * ((tid >> 6) & 1) + (tid & 31), kb = 8 * ((tid & 63) >> 5);
      const float* wlp = p.in[opq(15)] + ((size_t)((l * 2 + sdir) * 16 + kb)) * 256 + dcol;
      u32x4 bw;
#pragma unroll
      for (int e = 0; e < 4; ++e) bw[e] = pack2(wlp[(2 * e) * 256], wlp[(2 * e + 1) * 256]);
      Bw = __builtin_bit_cast(bf16x8, bw);
      bl = p.in[opq(16)][(l * 2 + sdir) * 256 + dcol];
      asm volatile("" : "+v"(Bw), "+v"(bl));
      const int cL = (sdir ? nch - 1 - ci0 : ci0) * 64;
#pragma unroll
      for (int k = 0; k < 2; ++k) {
        const int id = tid + 256 * k, i = id >> 3, dc = id & 7;
        const int tau = sdir ? cL + 63 - i : cL + i;
        rq[k] = *reinterpret_cast<const u32x4*>(P + (size_t)(rowbase + tau) * IND + C_Q + h * 64 + dc * 8);
      }
#pragma unroll
      for (int k = 0; k < 2; ++k) {
        const int id = tid + 256 * k, dc = id >> 6, i = id & 63;
        const int tau = sdir ? cL + 63 - i : cL + i;
        rk[k] = *reinterpret_cast<const u32x4*>(P + (size_t)(rowbase + tau) * IND + C_K + h * 64 + dc * 8);
      }
#pragma unroll
      for (int k = 0; k < 4; ++k) {
        const int id = tid + 256 * k, ec = id >> 6, i = id & 63;
        const int tau = sdir ? cL + 63 - i : cL + i;
        rv[k] = *reinterpret_cast<const u32x4*>(P + (size_t)(rowbase + tau) * IND + C_V + h * 128 + ec * 8);
      }
      {
        const int i = 32 * (tid >> 7) + (tid & 31), hf = (tid & 63) >> 5;
        const int tau = sdir ? cL + 63 - i : cL + i;
        rlr = *reinterpret_cast<const u32x4*>(P + (size_t)(rowbase + tau) * IND + C_LR + sdir * 16 + hf * 8);
      }
    }
    for (int ci = ci0; ci < ci1; ++ci) {
      const int c0 = (sdir ? nch - 1 - ci : ci) * 64;
      int tid = tid0;
      asm volatile("" : "+v"(tid));
      const int lane = tid & 63, w = tid >> 6, fr = lane & 15, fq = lane >> 4, d = tid & 63, iq = tid >> 6;
      __syncthreads();
      pin4(rlr);
      {
        const int th = w >> 1, dh = w & 1;
        f32x16 z;
#pragma unroll
        for (int r = 0; r < 16; ++r) z[r] = 0.f;
        const f32x16 lg = mfma32(__builtin_bit_cast(bf16x8, rlr), Bw, z);
#pragma unroll
        for (int r = 0; r < 16; ++r) {
          const int t = 32 * th + (r & 3) + 8 * (r >> 2) + 4 * (lane >> 5);
          gl[t * 65 + 32 * dh + (lane & 31)] = logsigf(lg[r] + bl) * (1.f / 16.f);
        }
      }
      __syncthreads();
      {
        float vals[16];
#pragma unroll
        for (int ii = 0; ii < 16; ++ii) vals[ii] = gl[(iq * 16 + ii) * 65 + d];
        float run = 0.f;
#pragma unroll
        for (int ii = 0; ii < 16; ++ii) { run += vals[ii]; gl[(iq * 16 + ii) * 65 + d] = run; }
        red[iq * 64 + d] = run;
      }
      __syncthreads();
      {
        float off = 0.f;
        for (int q = 0; q < iq; ++q) off += red[q * 64 + d];
        if (iq > 0) {
#pragma unroll 4
          for (int ii = 0; ii < 16; ++ii) gl[(iq * 16 + ii) * 65 + d] += off;
        }
      }
      __syncthreads();
      pin4(rq[0]); pin4(rq[1]); pin4(rk[0]); pin4(rk[1]); pin4(rv[0]); pin4(rv[1]); pin4(rv[2]); pin4(rv[3]);
#pragma unroll
      for (int k = 0; k < 2; ++k) {
        const int id = tid + 256 * k, i = id >> 3, dc = id & 7;
        u32x4 oo;
#pragma unroll
        for (int e = 0; e < 4; ++e) {
          float b0 = gl[i * 65 + dc * 8 + 2 * e], b1 = gl[i * 65 + dc * 8 + 2 * e + 1];
          oo[e] = pack2(bflo(rq[k][e]) * 0.125f * __expf(b0), bfhi(rq[k][e]) * 0.125f * __expf(b1));
        }
        *reinterpret_cast<u32x4*>(qe + i * 72 + dc * 8) = oo;
      }
#pragma unroll
      for (int k = 0; k < 2; ++k) {
        const int id = tid + 256 * k, dc = id >> 6, i = id & 63;
        u32x4 oo;
#pragma unroll
        for (int e = 0; e < 4; ++e) {
          const int d0 = dc * 8 + 2 * e;
          float b0 = gl[i * 65 + d0], b1 = gl[i * 65 + d0 + 1];
          float l0 = gl[63 * 65 + d0], l1 = gl[63 * 65 + d0 + 1];
          float k0 = bflo(rk[k][e]), k1 = bfhi(rk[k][e]);
          oo[e] = pack2(k0 * __expf(-b0), k1 * __expf(-b1));
          kdT[d0 * 72 + i] = f2bf(k0 * __expf(l0 - b0));
          kdT[(d0 + 1) * 72 + i] = f2bf(k1 * __expf(l1 - b1));
        }
        *reinterpret_cast<u32x4*>(ke + i * 72 + dc * 8) = oo;
      }
#pragma unroll
      for (int k = 0; k < 4; ++k) {
        const int id = tid + 256 * k, ec = id >> 6, i = id & 63;
#pragma unroll
        for (int e = 0; e < 4; ++e) {
          vT[(ec * 8 + 2 * e) * 72 + i] = (u16)(rv[k][e] & 0xffffu);
          vT[(ec * 8 + 2 * e + 1) * 72 + i] = (u16)(rv[k][e] >> 16);
        }
      }
      u32x4 tmpv[4];
      unsigned ggr[16];
#pragma unroll
      for (int e = 0; e < 4; ++e) tmpv[e] = u32x4{0u, 0u, 0u, 0u};
#pragma unroll
      for (int e = 0; e < 16; ++e) ggr[e] = 0u;
      if (mode == 2) {
        const int qs = (w * 4 + (3 - fq)) * 16 + fr;
        const u16* tp = Y + (size_t)(rowbase + c0 + (qs >> 2)) * MIXW + 1024 + h * 128 + (qs & 3) * 32;
#pragma unroll
        for (int e = 0; e < 4; ++e) tmpv[e] = *reinterpret_cast<const u32x4*>(tp + e * 8);
#pragma unroll
        for (int tt = 0; tt < 4; ++tt)
#pragma unroll
          for (int j = 0; j < 4; ++j) {
            const int t = tt * 16 + fq * 4 + j;
            const size_t row = (size_t)(rowbase + (sdir ? c0 + 63 - t : c0 + t));
            ggr[tt * 4 + j] = *reinterpret_cast<const unsigned*>(P + row * IND + C_GG + h * 128 + w * 32 + 2 * fr);
          }
      }
      if (ci + 1 < ci1) {
        const int cL = (sdir ? nch - 2 - ci : ci + 1) * 64;
#pragma unroll
        for (int k = 0; k < 2; ++k) {
          const int id = tid + 256 * k, i = id >> 3, dc = id & 7;
          const int tau = sdir ? cL + 63 - i : cL + i;
          rq[k] = *reinterpret_cast<const u32x4*>(P + (size_t)(rowbase + tau) * IND + C_Q + h * 64 + dc * 8);
        }
#pragma unroll
        for (int k = 0; k < 2; ++k) {
          const int id = tid + 256 * k, dc = id >> 6, i = id & 63;
          const int tau = sdir ? cL + 63 - i : cL + i;
          rk[k] = *reinterpret_cast<const u32x4*>(P + (size_t)(rowbase + tau) * IND + C_K + h * 64 + dc * 8);
        }
#pragma unroll
        for (int k = 0; k < 4; ++k) {
          const int id = tid + 256 * k, ec = id >> 6, i = id & 63;
          const int tau = sdir ? cL + 63 - i : cL + i;
          rv[k] = *reinterpret_cast<const u32x4*>(P + (size_t)(rowbase + tau) * IND + C_V + h * 128 + ec * 8);
        }
        {
          const int i = 32 * (tid >> 7) + (tid & 31), hf = (tid & 63) >> 5;
          const int tau = sdir ? cL + 63 - i : cL + i;
          rlr = *reinterpret_cast<const u32x4*>(P + (size_t)(rowbase + tau) * IND + C_LR + sdir * 16 + hf * 8);
        }
      }
      __syncthreads();
      {
        f32x4 aacc[4];
#pragma unroll
        for (int i = 0; i < 4; ++i) aacc[i] = f32x4{0.f, 0.f, 0.f, 0.f};
#pragma unroll
        for (int kk = 0; kk < 2; ++kk) {
          bf16x8 a = ld8(ke + (w * 16 + fr) * 72 + kk * 32 + fq * 8);
#pragma unroll
          for (int tb = 0; tb < 4; ++tb) {
            bf16x8 bb = ld8(qe + (tb * 16 + fr) * 72 + kk * 32 + fq * 8);
            aacc[tb] = mfma16(a, bb, aacc[tb]);
          }
        }
#pragma unroll
        for (int tb = 0; tb < 4; ++tb) {
          const int t = tb * 16 + fr;
          float mv[4];
#pragma unroll
          for (int j = 0; j < 4; ++j) { const int s = w * 16 + fq * 4 + j; mv[j] = (s <= t) ? aacc[tb][j] : 0.f; }
          uint2 o; o.x = pack2(mv[0], mv[1]); o.y = pack2(mv[2], mv[3]);
          *reinterpret_cast<uint2*>(at + t * 72 + w * 16 + fq * 4) = o;
        }
      }
      __syncthreads();
      f32x4 oacc[4][2];
#pragma unroll
      for (int i = 0; i < 4; ++i) { oacc[i][0] = f32x4{0.f, 0.f, 0.f, 0.f}; oacc[i][1] = f32x4{0.f, 0.f, 0.f, 0.f}; }
#pragma unroll
      for (int kk = 0; kk < 2; ++kk) {
        bf16x8 b0 = ld8(vT + (w * 32 + 2 * fr) * 72 + kk * 32 + fq * 8);
        bf16x8 b1 = ld8(vT + (w * 32 + 2 * fr + 1) * 72 + kk * 32 + fq * 8);
#pragma unroll
        for (int tt = 0; tt < 4; ++tt) {
          bf16x8 a = ld8(at + (tt * 16 + fr) * 72 + kk * 32 + fq * 8);
          oacc[tt][0] = mfma16(a, b0, oacc[tt][0]);
          oacc[tt][1] = mfma16(a, b1, oacc[tt][1]);
        }
      }
#pragma unroll
      for (int kk = 0; kk < 2; ++kk) {
        bf16x8 s0 = packacc(sacc[2 * kk][0], sacc[2 * kk + 1][0]);
        bf16x8 s1 = packacc(sacc[2 * kk][1], sacc[2 * kk + 1][1]);
#pragma unroll
        for (int tt = 0; tt < 4; ++tt) {
          const u16* qr = qe + (tt * 16 + fr) * 72 + fq * 4;
          bf16x8 a = ld44(qr + (2 * kk) * 16, qr + (2 * kk + 1) * 16);
          oacc[tt][0] = mfma16(a, s0, oacc[tt][0]);
          oacc[tt][1] = mfma16(a, s1, oacc[tt][1]);
        }
      }
#pragma unroll
      for (int db = 0; db < 4; ++db)
#pragma unroll
        for (int j = 0; j < 4; ++j) {
          const float sc = __expf(gl[63 * 65 + db * 16 + fq * 4 + j]);
          sacc[db][0][j] *= sc; sacc[db][1][j] *= sc;
        }
#pragma unroll
      for (int kk = 0; kk < 2; ++kk) {
        bf16x8 b0 = ld8(vT + (w * 32 + 2 * fr) * 72 + kk * 32 + fq * 8);
        bf16x8 b1 = ld8(vT + (w * 32 + 2 * fr + 1) * 72 + kk * 32 + fq * 8);
#pragma unroll
        for (int db = 0; db < 4; ++db) {
          bf16x8 a = ld8(kdT + (db * 16 + fr) * 72 + kk * 32 + fq * 8);
          sacc[db][0] = mfma16(a, b0, sacc[db][0]);
          sacc[db][1] = mfma16(a, b1, sacc[db][1]);
        }
      }
      pin4(tmpv[0]); pin4(tmpv[1]); pin4(tmpv[2]); pin4(tmpv[3]);
      if (mode != 0) {
        const int ycol = 1024 + h * 128 + w * 32 + 2 * fr;
        if (mode == 1) {
          const int qs = (w * 4 + fq) * 16 + fr;
          u16* tp = Y + (size_t)(rowbase + c0 + (qs >> 2)) * MIXW + 1024 + h * 128 + (qs & 3) * 32;
#pragma unroll
          for (int tt = 0; tt < 4; ++tt) {
            u32x4 o;
#pragma unroll
            for (int j = 0; j < 4; ++j) o[j] = pack2(oacc[tt][0][j], oacc[tt][1][j]);
            *reinterpret_cast<u32x4*>(tp + tt * 8) = o;
          }
        } else {
#pragma unroll
          for (int tt = 0; tt < 4; ++tt)
#pragma unroll
            for (int j = 0; j < 4; ++j) {
              const int t = tt * 16 + fq * 4 + j;
              const int e = 15 - (tt * 4 + j);
              const unsigned pw = tmpv[e >> 2][e & 3];
              float o0 = oacc[tt][0][j] + bflo(pw);
              float o1 = oacc[tt][1][j] + bfhi(pw);
              oacc[tt][0][j] = o0; oacc[tt][1][j] = o1;
              const float sq = row16_sum(o0 * o0 + o1 * o1);
              if (fr == 0) red[w * 64 + t] = sq;
            }
          __syncthreads();
          const float* nwv = p.in[opq(17)] + l * 128;
          const float nw0 = nwv[w * 32 + 2 * fr], nw1 = nwv[w * 32 + 2 * fr + 1];
#pragma unroll
          for (int tt = 0; tt < 4; ++tt)
#pragma unroll
            for (int j = 0; j < 4; ++j) {
              const int t = tt * 16 + fq * 4 + j;
              const size_t row = (size_t)(rowbase + (sdir ? c0 + 63 - t : c0 + t));
              const float tot = red[t] + red[64 + t] + red[128 + t] + red[192 + t];
              const float rs = rsqrtf(tot * (1.f / 128.f) + EPSF);
              const unsigned gw = pin(ggr[tt * 4 + j]);
              const float g0 = bflo(gw), g1 = bfhi(gw);
              *reinterpret_cast<unsigned*>(Y + row * MIXW + ycol) =
                  pack2(oacc[tt][0][j] * rs * nw0 * siluf(g0), oacc[tt][1][j] * rs * nw1 * siluf(g1));
            }
        }
      }
    }
  }
  if (part == 0) {
#pragma unroll
    for (int i = 0; i < 8; ++i) *reinterpret_cast<f32x4*>(stsave + (i * 256 + tid0) * 4) = sacc[i >> 1][i & 1];
  }
}

__device__ void s5_item(const Params& p, int l, int part, int blk, unsigned char* smem) {
  const int tid = opaque_tid(), lane = tid & 63, w = tid >> 6, fr = lane & 15, fq = lane >> 4;
  const int wi = blk * 4 + w;
  const int b = wi >> 6, g = (wi >> 1) & 31, dir = wi & 1;
  u16* hb = (u16*)smem + w * (32 * 136);
  u16* ust = (u16*)(smem + 4 * 32 * 136 * 2) + w * (32 * 16);
  u16* P = (u16*)(p.ws + WS_P);
  u16* Y = (u16*)(p.ws + WS_Y);
  u16* G5C = (u16*)(p.ws + WS_G5C);
  float* stsave = (float*)(p.ws + WS_S5ST) + (size_t)wi * 128;
  const float dsk = p.in[opq(25)][l * 512 + g * 16 + fr];
  float hre = 0.f, him = 0.f;
  if (part == 1) { hre = stsave[lane * 2]; him = stsave[lane * 2 + 1]; }
  const int nseg = part == 0 ? 3 : 1;
  for (int seg = 0; seg < nseg; ++seg) {
    bool isctx; int sdir, ti0, ti1, mode;
    if (part == 1) { isctx = false; sdir = dir; ti0 = 64; ti1 = 128; mode = 2; }
    else if (seg == 0) { if (!(dir == 0 && l == 0)) continue; isctx = true; sdir = 1; ti0 = 0; ti1 = 8; mode = 1; }
    else if (seg == 1) { isctx = true; sdir = dir; ti0 = 0; ti1 = 8; mode = (dir == 0 && l == 0) ? 2 : 0; }
    else { isctx = false; sdir = dir; ti0 = 0; ti1 = 64; mode = 1; }
    if (part == 0 && seg <= 1) { hre = 0.f; him = 0.f; }
    __threadfence();
    const unsigned char* cbase = p.ws + WS_S5C + (size_t)((l * 2 + sdir) * 32 + g) * 8704;
    const u16* BbarM = (const u16*)cbase;
    const u16* CmT = (const u16*)(cbase + 4096);
    const float* lamb = (const float*)(cbase + 8192);
    bf16x8 Bf[4], Cf[4];
#pragma unroll
    for (int cb = 0; cb < 4; ++cb) Bf[cb] = ld8(BbarM + (cb * 32 + (lane & 31)) * 16 + 8 * (lane >> 5));
#pragma unroll
    for (int kk = 0; kk < 4; ++kk) Cf[kk] = ld8(CmT + fr * 128 + kk * 32 + fq * 8);
    float lre = lamb[2 * lane], lim = lamb[2 * lane + 1];
#pragma unroll
    for (int i = 0; i < 4; ++i) asm volatile("" : "+v"(Bf[i]), "+v"(Cf[i]));
    asm volatile("" : "+v"(lre), "+v"(lim), "+v"(hre), "+v"(him));
    const int nt = isctx ? 8 : 128;
    const int rowbase = isctx ? NLAT + b * 256 : b * 4096;
    bf16x8 anext;
    {
      const int c0 = (sdir ? nt - 1 - ti0 : ti0) * 32, i = lane & 31;
      anext = ld8(P + (size_t)(rowbase + (sdir ? c0 + 31 - i : c0 + i)) * IND + C_U5 + g * 16 + 8 * (lane >> 5));
    }
    for (int ti = ti0; ti < ti1; ++ti) {
      const int c0 = (sdir ? nt - 1 - ti : ti) * 32;
      const bf16x8 a = anext;
      if (ti + 1 < ti1) {
        const int c1 = (sdir ? nt - 2 - ti : ti + 1) * 32, i = lane & 31;
        anext = ld8(P + (size_t)(rowbase + (sdir ? c1 + 31 - i : c1 + i)) * IND + C_U5 + g * 16 + 8 * (lane >> 5));
      }
      u32x4 tmpv = u32x4{0u, 0u, 0u, 0u};
      if (mode == 2) {
        const int qs = (3 - fq) * 16 + fr;
        tmpv = *reinterpret_cast<const u32x4*>(Y + (size_t)(rowbase + c0 + (qs >> 1)) * MIXW + 1536 + g * 16 + (qs & 1) * 8);
      }
      wave_lds_sync();
      if (mode == 2) *reinterpret_cast<bf16x8*>(ust + (lane & 31) * 16 + 8 * (lane >> 5)) = a;
#pragma unroll
      for (int cb = 0; cb < 4; ++cb) {
        f32x16 z;
#pragma unroll
        for (int r = 0; r < 16; ++r) z[r] = 0.f;
        f32x16 acc = mfma32(a, Bf[cb], z);
#pragma unroll
        for (int r = 0; r < 16; ++r) {
          const int ii = (r & 3) + 8 * (r >> 2) + 4 * (lane >> 5);
          hb[ii * 136 + cb * 32 + (lane & 31)] = f2bf(acc[r]);
        }
      }
      wave_lds_sync();
      {
        unsigned buv[32];
#pragma unroll
        for (int i = 0; i < 32; ++i) buv[i] = *reinterpret_cast<const unsigned*>(hb + i * 136 + 2 * lane);
#pragma unroll
        for (int i = 0; i < 32; ++i) {
          const float nre = lre * hre - lim * him + bflo(buv[i]);
          const float nim = lre * him + lim * hre + bfhi(buv[i]);
          hre = nre; him = nim;
          *reinterpret_cast<unsigned*>(hb + i * 136 + 2 * lane) = pack2(hre, him);
        }
      }
      wave_lds_sync();
      f32x4 ya[2];
      ya[0] = f32x4{0.f, 0.f, 0.f, 0.f}; ya[1] = f32x4{0.f, 0.f, 0.f, 0.f};
#pragma unroll
      for (int kk = 0; kk < 4; ++kk) {
        bf16x8 a0 = ld8(hb + fr * 136 + kk * 32 + fq * 8);
        bf16x8 a1 = ld8(hb + (16 + fr) * 136 + kk * 32 + fq * 8);
        ya[0] = mfma16(a0, Cf[kk], ya[0]);
        ya[1] = mfma16(a1, Cf[kk], ya[1]);
      }
      pin4(tmpv);
      if (mode == 1) {
        u32x4 o;
        o[0] = pack2(ya[0][0], ya[0][1]); o[1] = pack2(ya[0][2], ya[0][3]); o[2] = pack2(ya[1][0], ya[1][1]); o[3] = pack2(ya[1][2], ya[1][3]);
        const int qs = fq * 16 + fr;
        *reinterpret_cast<u32x4*>(Y + (size_t)(rowbase + c0 + (qs >> 1)) * MIXW + 1536 + g * 16 + (qs & 1) * 8) = o;
      } else if (mode == 2) {
#pragma unroll
        for (int rt = 0; rt < 2; ++rt)
#pragma unroll
          for (int j = 0; j < 4; ++j) {
            const int i = rt * 16 + fq * 4 + j;
            const int tau = sdir ? c0 + 31 - i : c0 + i;
            const size_t row = (size_t)(rowbase + tau);
            const int e = 7 - (rt * 4 + j);
            const unsigned pw = tmpv[e >> 1];
            const float yf = (e & 1) ? bfhi(pw) : bflo(pw);
            const float u = bf2f(ust[i * 16 + fr]);
            const float x = yf + ya[rt][j] + dsk * u;
            const float th = 1.f - 2.f * rcpf(1.f + __expf(2.f * 0.7978845608028654f * (x + 0.044715f * x * x * x)));
            const float ge = 0.5f * x * (1.f + th);
            if (isctx) G5C[(row - NLAT) * 512 + g * 16 + fr] = f2bf(ge);
            else P[row * IND + C_U5 + g * 16 + fr] = f2bf(ge);
          }
      }
    }
  }
  if (part == 0) { stsave[lane * 2] = hre; stsave[lane * 2 + 1] = him; }
}

__device__ void ssd_norm_rows(const Params& p, int nrows) {
  const int tid = opaque_tid();
  const float* ssq = (const float*)(p.ws + WS_SSQ);
  float* rsb = (float*)(p.ws + WS_RS);
  for (int i = blockIdx.x * 256 + tid; i < nrows * 2; i += gridDim.x * 256) {
    const float* sp = ssq + (size_t)i * 8;
    const float sum = sp[0] + sp[1] + sp[2] + sp[3] + sp[4] + sp[5] + sp[6] + sp[7];
    rsb[i] = rsqrtf(sum * (1.f / 512.f) + EPSF);
  }
}

__device__ void phase_final(const Params& p) {
  const int tid = opaque_tid(), lane = tid & 63, w = tid >> 6;
  const float* nw = p.in[opq(28)];
  for (int r = blockIdx.x * 4 + w; r < NLAT; r += gridDim.x * 4) {
    float* src = p.out + (size_t)r * 1024;
    float4 v[4]; float ss = 0.f;
#pragma unroll
    for (int q = 0; q < 4; ++q) {
      { const f32x4 t_ = __builtin_nontemporal_load(reinterpret_cast<const f32x4*>(src + lane * 4 + q * 256)); v[q] = make_float4(t_[0], t_[1], t_[2], t_[3]); }
      ss += v[q].x * v[q].x + v[q].y * v[q].y + v[q].z * v[q].z + v[q].w * v[q].w;
    }
#pragma unroll
    for (int o = 32; o > 0; o >>= 1) ss += __shfl_xor(ss, o);
    const float rs = rsqrtf(ss * (1.f / 1024.f) + EPSF);
#pragma unroll
    for (int q = 0; q < 4; ++q) {
      const int col = lane * 4 + q * 256;
      float4 n4 = *reinterpret_cast<const float4*>(nw + col);
      float4 o = make_float4(v[q].x * rs * n4.x, v[q].y * rs * n4.y, v[q].z * rs * n4.z, v[q].w * rs * n4.w);
      __builtin_nontemporal_store(f32x4{o.x, o.y, o.z, o.w}, reinterpret_cast<f32x4*>(src + col));
    }
  }
}


#define XB_TMO      128
#define XB_XCNT(j)  (256  + 64 * (j))
#define XB_XSUB(j)  (1280 + 64 * (j))
#define XB_XGEN(j)  (2304 + 64 * (j))
#define XB_TOP      3328
#define XB_TOPGEN   3392
#define XCD_BAR_WORDS 3456
#define XB_SPIN_CAP (1u << 20)
DI unsigned xb_ld(unsigned* p) { return __hip_atomic_load(p, __ATOMIC_RELAXED, __HIP_MEMORY_SCOPE_AGENT); }
DI unsigned xb_add(unsigned* p, unsigned v) { return __hip_atomic_fetch_add(p, v, __ATOMIC_RELAXED, __HIP_MEMORY_SCOPE_AGENT); }
DI unsigned xb_xcc_id() { return (unsigned)__builtin_amdgcn_s_getreg((3 << 11) | 20) & 0xFu; }
#define XB_SPIN(cond, bar) do { unsigned _sp = 0; while (cond) { __builtin_amdgcn_s_sleep(1); \
    if ((++_sp & 255u) == 0u) { if (xb_ld(&(bar)[XB_TMO])) break; if (_sp > XB_SPIN_CAP) { atomicAdd(&(bar)[XB_TMO], 1u); break; } } } } while (0)
struct XcdBarrier { unsigned* bar; unsigned x, nloc, nx; };
DI XcdBarrier xcd_barrier_post(unsigned* bar) {
  XcdBarrier b; b.bar = bar; b.x = xb_xcc_id(); b.nloc = 0u; b.nx = 0u;
  if (threadIdx.x == 0) (void)xb_add(&bar[XB_XCNT(b.x)], 1u);
  return b;
}
DI void xcd_barrier_complete(unsigned* bar, unsigned x, unsigned& nloc, unsigned& nx) {
  const unsigned G = gridDim.x;
  unsigned sum, cnt, mine, sp = 0u;
  for (;;) {
    sum = 0u; cnt = 0u; mine = 0u;
#pragma unroll
    for (unsigned j = 0; j < 16; ++j) { const unsigned c = xb_ld(&bar[XB_XCNT(j)]); sum += c; cnt += (c > 0u) ? 1u : 0u; mine = (j == x) ? c : mine; }
    if (sum == G) break;
    __builtin_amdgcn_s_sleep(1);
    if ((++sp & 255u) == 0u) { if (xb_ld(&bar[XB_TMO])) break; if (sp > XB_SPIN_CAP) { atomicAdd(&bar[XB_TMO], 1u); break; } }
  }
  nloc = mine > 0u ? mine : 1u; nx = cnt > 0u ? cnt : 1u;
}
DI void xcd_barrier(XcdBarrier& b) {
  asm volatile("s_waitcnt vmcnt(0)" ::: "memory");
  __syncthreads();
  if (threadIdx.x == 0) {
    unsigned* bar = b.bar;
    __builtin_amdgcn_s_waitcnt(0);
    if (b.nloc == 0u) xcd_barrier_complete(bar, b.x, b.nloc, b.nx);
    const unsigned nloc = b.nloc, nx = b.nx;
    const unsigned old = xb_add(&bar[XB_XSUB(b.x)], 1u);
    const unsigned gen = old / nloc;
    if (old + 1u == (gen + 1u) * nloc) {
      __builtin_amdgcn_fence(__ATOMIC_RELEASE, "agent");
      asm volatile("s_waitcnt vmcnt(0)" ::: "memory");
      const unsigned og = xb_add(&bar[XB_TOP], 1u);
      const unsigned tg = og / nx;
      if (og + 1u == (tg + 1u) * nx) xb_add(&bar[XB_TOPGEN], 1u);
      else XB_SPIN(xb_ld(&bar[XB_TOPGEN]) == tg, bar);
      __builtin_amdgcn_fence(__ATOMIC_ACQUIRE, "agent");
      xb_add(&bar[XB_XGEN(b.x)], 1u);
      asm volatile("s_waitcnt vmcnt(0)" ::: "memory");
    } else {
      XB_SPIN(xb_ld(&bar[XB_XGEN(b.x)]) == gen, bar);
      __builtin_amdgcn_fence(__ATOMIC_ACQUIRE, "agent");
      asm volatile("s_waitcnt vmcnt(0)" ::: "memory");
    }
  }
  __syncthreads();
}

__global__ void __launch_bounds__(256, 2) fwd_megakernel(Params p) {
  extern __shared__ __attribute__((aligned(16))) unsigned char smem[];
  cg::grid_group grid = cg::this_grid();
  XcdBarrier xb = xcd_barrier_post((unsigned*)(p.ws + WS_BAR));
  const int ph_lo = p.ph_lo, ph_hi = p.ph_hi;
  for (int ph = ph_lo; ph < ph_hi; ++ph) {
    if (ph == 0) {
      phase_prep(p, smem);
    } else if (ph == NPHASE - 1) {
      phase_final(p);
    } else {
      const int l = (ph - 1) / 7, sub = (ph - 1) % 7;
      const int mt = (l == 1) ? 256 : 272;
      if (sub == 0) {
        phase_pre(p, l, smem);
      } else if (sub == 1) {
        const u16* U = (const u16*)(p.ws + WS_Y);
        const u16* W = (const u16*)(p.ws + WS_WIN);
        const int xcd = blockIdx.x & 7, slot = blockIdx.x >> 3, nslots = gridDim.x >> 3;
        bool pre = false;
        for (int u = slot; u < 918; u += nslots) {
          const int pnl = u / 306, v = u % 306;
          const int u2 = u + nslots, pnl2 = u2 / 306, v2 = u2 % 306;
          const bool hn = u2 < 918;
          gemm_tile<192, 0>(p, l, U, 1024, W, 1024, 1024, (xcd * 34 + v / 9) * 128, (pnl * 9 + v % 9) * 192, smem,
                            pre, hn, U, 1024, (xcd * 34 + v2 / 9) * 128, (pnl2 * 9 + v2 % 9) * 192);
          pre = hn;
        }
      } else if (sub == 2) {
        phase_conv(p, l);
      } else if (sub == 3 || sub == 4) {
        const int part = sub - 3;
        for (int k = 0;; ++k) {
          int it;
          if (gridDim.x == 512) {
            if (k > 0) break;
            const int blk = blockIdx.x;
            const int q = blk < 256 ? blk - 64 : 192 + (blk - 448);
            const int sit = q < 128 ? q * 2 : (q < 192 ? 2 * (q - 128) : 2 * (q - 192) + 1) * 2 + 1;
            it = blk < 64 ? 256 + blk : blk < 256 ? sit : blk < 320 ? -1 : blk < 448 ? blk : sit;
          } else {
            it = blockIdx.x + k * gridDim.x;
            if (it >= 448) break;
          }
          if (it >= 0) {
            if (it < 256) ssd_item(p, l, part, it, smem);
            else if (it < 320) gla_item(p, l, part, it - 256, smem);
            else s5_item(p, l, part, it - 320, smem);
          }
          __syncthreads();
        }
      } else if (sub == 5) {
        const u16* W = (const u16*)(p.ws + WS_GLU);
        const int xcd = blockIdx.x & 7, slot = blockIdx.x >> 3, nslots = gridDim.x >> 3, mtx = mt >> 3;
        const u16* Alat = (const u16*)(p.ws + WS_P) + C_U5;
        const u16* Actx = (const u16*)(p.ws + WS_G5C) - (size_t)NLAT * 512;
        bool pre = false;
        for (int u = slot; u < mtx * 8; u += nslots) {
          const int t = (xcd * mtx) * 8 + u, t2 = t + nslots;
          const int m0 = (t >> 3) * 128, m0n = (t2 >> 3) * 128;
          const bool hn = u + nslots < mtx * 8;
          const u16* Ac = m0 < NLAT ? Alat : Actx; const int ldc = m0 < NLAT ? IND : 512;
          const u16* An = m0n < NLAT ? Alat : Actx; const int ldn = m0n < NLAT ? IND : 512;
          gemm_tile<128, 1>(p, l, Ac, ldc, W, 512, 512, m0, (t & 7) * 128, smem, pre, hn, An, ldn, m0n, (t2 & 7) * 128);
          pre = hn;
        }
        ssd_norm_rows(p, mt * 128);
      } else {
        const u16* A = (const u16*)(p.ws + WS_Y);
        const u16* W = (const u16*)(p.ws + WS_WOUT);
        const int xcd = blockIdx.x & 7, slot = blockIdx.x >> 3, nslots = gridDim.x >> 3, mtx = mt >> 3;
        bool pre = false;
        for (int u = slot; u < mtx * 8; u += nslots) {
          const int t = (xcd * mtx) * 8 + u, t2 = t + nslots;
          const bool hn = u + nslots < mtx * 8;
          gemm_tile<128, 2>(p, l, A, MIXW, W, MIXW, MIXW, (t >> 3) * 128, (t & 7) * 128, smem, pre, hn, A, MIXW, (t2 >> 3) * 128, (t2 & 7) * 128);
          pre = hn;
        }
      }
    }
    if (ph + 1 < ph_hi) {
      if (ph_hi < 0) grid.sync();
      xcd_barrier(xb);
    }
  }
}

extern "C" void kernel_launch(void* const* d_in, const int* in_sizes, int n_in, void* d_out, int out_size, void* d_ws,
                              size_t ws_size, hipStream_t stream) {
  static int grid_blocks = 0;
  if (grid_blocks == 0) {
    if (n_in != 29 || ws_size < WS_END) { fprintf(stderr, "kernel_launch: bad n_in %d / ws %zu (need %zu)\n", n_in, ws_size, (size_t)WS_END); grid_blocks = -1; return; }
    int dev = 0, cus = 0, per_cu = 0;
    hipGetDevice(&dev);
    hipDeviceGetAttribute(&cus, hipDeviceAttributeMultiprocessorCount, dev);
    hipFuncSetAttribute((const void*)fwd_megakernel, hipFuncAttributeMaxDynamicSharedMemorySize, SMEM_BYTES);
    hipOccupancyMaxActiveBlocksPerMultiprocessor(&per_cu, (const void*)fwd_megakernel, 256, SMEM_BYTES);
    if (per_cu < 1) per_cu = 1;
    if (per_cu > 2) per_cu = 2;
    grid_blocks = cus * per_cu;
    fprintf(stderr, "kernel_launch: cus %d per_cu %d grid %d\n", cus, per_cu, grid_blocks);
  }
  if (grid_blocks < 0) return;
  Params p{};
  for (int i = 0; i < 29; ++i) p.in[i] = (const float*)d_in[i];
  p.out = (float*)d_out; p.ws = (unsigned char*)d_ws; p.ph_lo = 0; p.ph_hi = NPHASE;
  if (hipMemsetAsync((char*)d_ws + WS_BAR, 0, 16384, stream) != hipSuccess) { fprintf(stderr, "kernel_launch: memset of the barrier words failed\n"); return; }
  void* args[] = {&p};
  hipError_t e = hipLaunchCooperativeKernel((const void*)fwd_megakernel, dim3(grid_blocks), dim3(256), args, SMEM_BYTES, stream);
  if (e != hipSuccess) fprintf(stderr, "cooperative launch failed: %s (grid %d)\n", hipGetErrorString(e), grid_blocks);
}
```

```cpp
#include <hip/hip_runtime.h>
#include <hip/hip_cooperative_groups.h>
#include <cstdio>
namespace cg = cooperative_groups;

typedef unsigned short u16;
using bf16x8 = __attribute__((ext_vector_type(8))) short;
using bf16x4 = __attribute__((ext_vector_type(4))) short;
using f32x4 = __attribute__((ext_vector_type(4))) float;
using f32x16 = __attribute__((ext_vector_type(16))) float;
using u32x4 = __attribute__((ext_vector_type(4))) unsigned;
using u32x2 = __attribute__((ext_vector_type(2))) unsigned;
#define DI __device__ __forceinline__

constexpr int DM = 1024, NLAT = 32768, NCTX = 2048, NTOK = 34816, IND = 5184, MIXW = 2048;
constexpr int C_XBC = 1024, C_BM = 2048, C_CM = 2304, C_DT = 2560, C_Q = 2592, C_K = 2848, C_V = 3104, C_GG = 3616,
              C_LR = 4128, C_U5 = 4160, C_SG = 4672;
constexpr float EPSF = 1e-6f;
constexpr int SMEM_BYTES = 81920;
constexpr int NPHASE = 16;

constexpr size_t WS_P = 0;
constexpr size_t WS_Y = WS_P + (size_t)NTOK * IND * 2;
constexpr size_t WS_WIN = WS_Y + (size_t)NTOK * MIXW * 2;
constexpr size_t WS_WOUT = WS_WIN + (size_t)IND * DM * 2;
constexpr size_t WS_GLU = WS_WOUT + (size_t)DM * MIXW * 2;
constexpr size_t WS_HCTX = WS_GLU + (size_t)1024 * 512 * 2;
constexpr size_t WS_MOD = WS_HCTX + (size_t)NCTX * DM * 4;
constexpr size_t WS_SSQ = WS_MOD + (size_t)2 * 9 * 3072 * 4;
constexpr size_t WS_S5C = WS_SSQ + (size_t)NTOK * 16 * 4;
constexpr size_t WS_G5C = WS_S5C + (size_t)128 * 8704;
constexpr size_t WS_S5ST = WS_G5C + (size_t)NCTX * 512 * 2;
constexpr size_t WS_BAR = WS_S5ST + (size_t)512 * 128 * 4;
constexpr size_t WS_RS = WS_BAR + 16384;
constexpr size_t WS_END = WS_RS + (size_t)NTOK * 2 * 4;

struct Params {
  const float* in[29];
  float* out;
  unsigned char* ws;
  int ph_lo, ph_hi;
};

DI int opq(int i) { asm volatile("" : "+s"(i)); return i; }
DI int opaque_tid() { int t = threadIdx.x; asm volatile("" : "+v"(t)); return t; }
typedef __bf16 hbf16x2 __attribute__((ext_vector_type(2)));
typedef float hf32x2 __attribute__((ext_vector_type(2)));
DI u16 f2bf(float x) { __bf16 h = (__bf16)x; return __builtin_bit_cast(u16, h); }
DI float bf2f(u16 h) { return __uint_as_float(((unsigned)h) << 16); }
DI unsigned pack2(float a, float b) { hf32x2 v = {a, b}; return __builtin_bit_cast(unsigned, __builtin_convertvector(v, hbf16x2)); }
DI float bflo(unsigned v) { return __uint_as_float(v << 16); }
DI float bfhi(unsigned v) { return __uint_as_float(v & 0xffff0000u); }
DI float rcpf(float x) { return __builtin_amdgcn_rcpf(x); }
DI float siluf(float x) { return x * rcpf(1.f + __expf(-x)); }
DI float logsigf(float x) { return fminf(x, 0.f) - __logf(1.f + __expf(-fabsf(x))); }
DI float softplusf(float v) { return fmaxf(v, 0.f) + log1pf(__expf(-fabsf(v))); }
DI f32x4 mfma16(bf16x8 a, bf16x8 b, f32x4 c) { return __builtin_amdgcn_mfma_f32_16x16x32_bf16(a, b, c, 0, 0, 0); }
DI f32x16 mfma32(bf16x8 a, bf16x8 b, f32x16 c) { return __builtin_amdgcn_mfma_f32_32x32x16_bf16(a, b, c, 0, 0, 0); }
DI void wave_lds_sync() { asm volatile("s_waitcnt lgkmcnt(0)" ::: "memory"); }
DI unsigned pin(unsigned v) { asm volatile("" : "+v"(v)); return v; }
DI void pin4(u32x4& v) { asm volatile("" : "+v"(v)); }
#define DPPF(v, old, ctrl, rmask) __builtin_bit_cast(float, __builtin_amdgcn_update_dpp(__builtin_bit_cast(int, (float)(old)), __builtin_bit_cast(int, (float)(v)), (ctrl), (rmask), 0xf, false))
DI float row16_sum(float v) {
  v += DPPF(v, 0.f, 0xB1, 0xf);
  v += DPPF(v, 0.f, 0x4E, 0xf);
  v += DPPF(v, 0.f, 0x141, 0xf);
  v += DPPF(v, 0.f, 0x140, 0xf);
  return v;
}
DI float wave_incl_scan(float v) {
  v += DPPF(v, 0.f, 0x111, 0xf);
  v += DPPF(v, 0.f, 0x112, 0xf);
  v += DPPF(v, 0.f, 0x114, 0xf);
  v += DPPF(v, 0.f, 0x118, 0xf);
  v += DPPF(v, 0.f, 0x142, 0xa);
  v += DPPF(v, 0.f, 0x143, 0xc);
  return v;
}
DI bf16x8 ld8(const u16* p) { return *reinterpret_cast<const bf16x8*>(p); }
DI bf16x8 ld44(const u16* p0, const u16* p1) {
  bf16x4 a = *reinterpret_cast<const bf16x4*>(p0), b = *reinterpret_cast<const bf16x4*>(p1);
  return __builtin_shufflevector(a, b, 0, 1, 2, 3, 4, 5, 6, 7);
}
DI bf16x8 packacc(const f32x4& a, const f32x4& b) {
  uint4 u; u.x = pack2(a[0], a[1]); u.y = pack2(a[2], a[3]); u.z = pack2(b[0], b[1]); u.w = pack2(b[2], b[3]);
  return __builtin_bit_cast(bf16x8, u);
}

__device__ void phase_prep(const Params& p, unsigned char* smem) {
  float* sc = (float*)smem;
  float* red = sc + 9 * 1024;
  const int tid = opaque_tid();
  float* modb = (float*)(p.ws + WS_MOD);
  bool filled = false;
  for (int it = blockIdx.x; it < 96 + 128; it += gridDim.x) {
    if (it < 96) {
      if (!filled) {
        for (int idx = tid; idx < 9216; idx += 256) {
          int r = idx >> 10, k = idx & 1023;
          float v = r < 8 ? p.in[opq(1)][r * 1024 + k] : p.in[opq(3)][k];
          sc[idx] = siluf(v);
        }
        filled = true;
        __syncthreads();
      }
      const int l = it / 48, j0 = (it % 48) * 64, kg = tid >> 6, jj = tid & 63;
      float a[9];
#pragma unroll
      for (int r = 0; r < 9; ++r) a[r] = 0.f;
      const float* W = p.in[opq(5)] + (size_t)l * 1024 * 3072 + j0 + jj;
      for (int k = kg * 256; k < kg * 256 + 256; ++k) {
        float wv = W[(size_t)k * 3072];
#pragma unroll
        for (int r = 0; r < 9; ++r) a[r] += sc[r * 1024 + k] * wv;
      }
#pragma unroll
      for (int r = 0; r < 9; ++r) red[(kg * 9 + r) * 64 + jj] = a[r];
      __syncthreads();
      for (int idx = tid; idx < 576; idx += 256) {
        int r = idx >> 6, j = idx & 63;
        float s = red[(0 * 9 + r) * 64 + j] + red[(1 * 9 + r) * 64 + j] + red[(2 * 9 + r) * 64 + j] + red[(3 * 9 + r) * 64 + j];
        modb[(l * 9 + r) * 3072 + j0 + j] = s + p.in[opq(6)][l * 3072 + j0 + j];
      }
      __syncthreads();
    } else {
      const int q = it - 96, l = q >> 6, d = (q >> 5) & 1, g = q & 31;
      unsigned char* base = p.ws + WS_S5C + (size_t)q * 8704;
      u16* BbarM = (u16*)base;
      u16* CmT = (u16*)(base + 4096);
      float* lamb = (float*)(base + 8192);
      const float st = expf(p.in[opq(20)][(l * 2 + d) * 32 + g]);
      for (int idx = tid; idx < 1024; idx += 256) {
        const int pp = idx >> 4, hh = idx & 15;
        const int li = ((l * 2 + d) * 32 + g) * 64 + pp;
        const float lre = p.in[opq(18)][li], lim = p.in[opq(19)][li];
        const float a = lre * st, bb = lim * st;
        const float ea = expf(a), sn = sinf(bb), cs = cosf(bb), s2 = sinf(0.5f * bb);
        const float lbre = ea * cs, lbim = ea * sn;
        const float nre = expm1f(a) * cs - 2.f * s2 * s2, nim = lbim;
        const float den = lre * lre + lim * lim;
        const float cre = (nre * lre + nim * lim) / den, cim = (nim * lre - nre * lim) / den;
        const int bi = ((l * 32 + g) * 64 + pp) * 16 + hh;
        const float bre = p.in[opq(21)][bi], bim = p.in[opq(22)][bi];
        BbarM[(2 * pp) * 16 + hh] = f2bf(cre * bre - cim * bim);
        BbarM[(2 * pp + 1) * 16 + hh] = f2bf(cre * bim + cim * bre);
        const int cidx = (((l * 2 + d) * 32 + g) * 16 + hh) * 64 + pp;
        CmT[hh * 128 + 2 * pp] = f2bf(p.in[opq(23)][cidx]);
        CmT[hh * 128 + 2 * pp + 1] = f2bf(-p.in[opq(24)][cidx]);
        if (hh == 0) { lamb[2 * pp] = lbre; lamb[2 * pp + 1] = lbim; }
      }
    }
  }
}

__device__ void phase_pre(const Params& p, int l, unsigned char* smem) {
  const int tid = opaque_tid(), lane = tid & 63, w = tid >> 6;
  const float* hl = l == 0 ? p.in[opq(0)] : p.out;
  const float* hc = l == 0 ? p.in[opq(2)] : (const float*)(p.ws + WS_HCTX);
  const float* nw = p.in[opq(4)] + l * 1024;
  const float* modb = (const float*)(p.ws + WS_MOD) + l * 9 * 3072;
  u16* U = (u16*)(p.ws + WS_Y);
  const bool cm = (l & 1);
  for (int r = blockIdx.x * 4 + w; r < NTOK; r += gridDim.x * 4) {
    const float* src; const float* mrow;
    if (r < NLAT) {
      int b = r >> 12, sp = r & 4095;
      int s = cm ? (((sp & 63) << 6) | (sp >> 6)) : sp;
      src = hl + ((size_t)(b * 4096 + s)) * 1024; mrow = modb + b * 3072;
    } else { src = hc + (size_t)(r - NLAT) * 1024; mrow = modb + 8 * 3072; }
    float4 v[4]; float ss = 0.f;
#pragma unroll
    for (int q = 0; q < 4; ++q) {
      { const f32x4 t_ = __builtin_nontemporal_load(reinterpret_cast<const f32x4*>(src + lane * 4 + q * 256)); v[q] = make_float4(t_[0], t_[1], t_[2], t_[3]); }
      ss += v[q].x * v[q].x + v[q].y * v[q].y + v[q].z * v[q].z + v[q].w * v[q].w;
    }
#pragma unroll
    for (int o = 32; o > 0; o >>= 1) ss += __shfl_xor(ss, o);
    const float rs = rsqrtf(ss * (1.f / 1024.f) + EPSF);
#pragma unroll
    for (int q = 0; q < 4; ++q) {
      const int col = lane * 4 + q * 256;
      float4 n4 = *reinterpret_cast<const float4*>(nw + col);
      float4 sh = *reinterpret_cast<const float4*>(mrow + col);
      float4 s4 = *reinterpret_cast<const float4*>(mrow + 1024 + col);
      float u0 = v[q].x * rs * n4.x * (1.f + s4.x) + sh.x;
      float u1 = v[q].y * rs * n4.y * (1.f + s4.y) + sh.y;
      float u2 = v[q].z * rs * n4.z * (1.f + s4.z) + sh.z;
      float u3 = v[q].w * rs * n4.w * (1.f + s4.w) + sh.w;
      uint2 o; o.x = pack2(u0, u1); o.y = pack2(u2, u3);
      *reinterpret_cast<uint2*>(U + (size_t)r * 1024 + col) = o;
    }
  }
  float* tile = (float*)smem;
  for (int t = blockIdx.x; t < 1296 + 512 + 128; t += gridDim.x) {
    const float* src; int sld, k0, n0, kind; u16* dst; int dld;
    if (t < 1296) { kind = 0; k0 = (t / 81) * 64; n0 = (t % 81) * 64; src = p.in[opq(7)] + (size_t)l * 1024 * IND; sld = IND; dst = (u16*)(p.ws + WS_WIN); dld = 1024; }
    else if (t < 1808) { int q = t - 1296; kind = 1; k0 = (q / 16) * 64; n0 = (q % 16) * 64; src = p.in[opq(8)] + (size_t)l * 2048 * 1024; sld = 1024; dst = (u16*)(p.ws + WS_WOUT); dld = 2048; }
    else { int q = t - 1808; kind = 2; k0 = (q / 16) * 64; n0 = (q % 16) * 64; src = p.in[opq(26)] + (size_t)l * 512 * 1024; sld = 1024; dst = (u16*)(p.ws + WS_GLU); dld = 512; }
    __syncthreads();
#pragma unroll
    for (int rr = 0; rr < 4; ++rr) {
      int i = (tid >> 4) + 16 * rr, j = (tid & 15) * 4;
      float4 v; { const f32x4 t_ = __builtin_nontemporal_load(reinterpret_cast<const f32x4*>(src + (size_t)(k0 + i) * sld + n0 + j)); v = make_float4(t_[0], t_[1], t_[2], t_[3]); }
      if (kind == 1 && k0 + i < 1024) { float s = p.in[opq(14)][l * 1024 + k0 + i]; v.x *= s; v.y *= s; v.z *= s; v.w *= s; }
      tile[i * 65 + j] = v.x; tile[i * 65 + j + 1] = v.y; tile[i * 65 + j + 2] = v.z; tile[i * 65 + j + 3] = v.w;
    }
    __syncthreads();
#pragma unroll
    for (int rr = 0; rr < 2; ++rr) {
      int n = (tid >> 3) + 32 * rr, i0 = (tid & 7) * 8;
      uint4 o;
      o.x = pack2(tile[(i0 + 0) * 65 + n], tile[(i0 + 1) * 65 + n]);
      o.y = pack2(tile[(i0 + 2) * 65 + n], tile[(i0 + 3) * 65 + n]);
      o.z = pack2(tile[(i0 + 4) * 65 + n], tile[(i0 + 5) * 65 + n]);
      o.w = pack2(tile[(i0 + 6) * 65 + n], tile[(i0 + 7) * 65 + n]);
      int drow = n0 + n;
      if (kind == 2) { int o_ = n0 + n, half = o_ >> 9, rem = o_ & 511; drow = (rem >> 6) * 128 + ((rem & 63) >> 4) * 32 + half * 16 + (rem & 15); }
      *reinterpret_cast<uint4*>(dst + (size_t)drow * dld + k0 + i0) = o;
    }
  }
}

template <int BN, int MODE>
__device__ void gemm_tile(const Params& p, int l, const u16* __restrict__ A, int lda, const u16* __restrict__ Bt, int ldb,
                          int K, int m0, int n0, unsigned char* smem,
                          bool pre, bool has_next, const u16* __restrict__ An, int ldan, int m0n, int n0n) {
  constexpr int WN = BN / 2, NF = WN / 16, NBL = BN * 8 / 256;
  u16* As = (u16*)smem;
  u16* Bs = As + 128 * 64;
  const int tid = opaque_tid(), lane = tid & 63, w = tid >> 6, wr = w >> 1, wc = w & 1, fr = lane & 15, fq = lane >> 4;
  f32x4 acc[4][NF];
#pragma unroll
  for (int m = 0; m < 4; ++m)
#pragma unroll
    for (int n = 0; n < NF; ++n) acc[m][n] = f32x4{0.f, 0.f, 0.f, 0.f};
  constexpr int STAGE = (128 + BN) * 64;
  const int nk = K / 64;
#define GLDS(OFF, KT) do { const int k0_ = (KT) * 64; \
    _Pragma("unroll") for (int i = 0; i < 4; ++i) { const int id = tid + 256 * i, row = id >> 3, c = (id & 7) ^ ((id >> 4) & 7); \
      __builtin_amdgcn_global_load_lds((const unsigned*)(A + (size_t)(m0 + row) * lda + k0_ + c * 8), (unsigned*)(As + (OFF) + id * 8), 16, 0, 0); } \
    _Pragma("unroll") for (int i = 0; i < NBL; ++i) { const int id = tid + 256 * i, row = id >> 3, c = (id & 7) ^ ((id >> 4) & 7); \
      __builtin_amdgcn_global_load_lds((const unsigned*)(Bt + (size_t)(n0 + row) * ldb + k0_ + c * 8), (unsigned*)(Bs + (OFF) + id * 8), 16, 0, 0); } } while (0)
#define COMPUTE(OFF) do { \
    bf16x8 af[2][4], bfr[2][NF];        \
    _Pragma("unroll") for (int kk = 0; kk < 2; ++kk) { \
      _Pragma("unroll") for (int m = 0; m < 4; ++m) af[kk][m] = ld8(As + (OFF) + (wr * 64 + m * 16 + fr) * 64 + (((kk * 4 + fq) ^ (fr >> 1)) * 8)); \
      _Pragma("unroll") for (int n = 0; n < NF; ++n) bfr[kk][n] = ld8(Bs + (OFF) + (wc * WN + n * 16 + fr) * 64 + (((kk * 4 + fq) ^ (fr >> 1)) * 8)); } \
    __builtin_amdgcn_s_setprio(1); \
    _Pragma("unroll") for (int kk = 0; kk < 2; ++kk) \
      _Pragma("unroll") for (int m = 0; m < 4; ++m) \
        _Pragma("unroll") for (int n = 0; n < NF; ++n) acc[m][n] = mfma16(bfr[kk][n], af[kk][m], acc[m][n]); \
    __builtin_amdgcn_s_setprio(0); } while (0)
  float f0[4], f1[4];
  if constexpr (MODE == 2) {
    const float* rsb = (const float*)(p.ws + WS_RS);
#pragma unroll
    for (int m = 0; m < 4; ++m) {
      const float2 r2 = *reinterpret_cast<const float2*>(rsb + (size_t)(m0 + wr * 64 + m * 16 + fr) * 2);
      f0[m] = r2.x * rcpf(r2.y); f1[m] = r2.y;
    }
  }
  __syncthreads();
  if (!pre) GLDS(0, 0);
  asm volatile("s_waitcnt vmcnt(0)" ::: "memory");
  __syncthreads();
  for (int kt = 0; kt < nk; ++kt) {
    const int cur = (kt & 1) * STAGE, nxt = STAGE - cur;
    if (kt + 1 < nk) GLDS(nxt, kt + 1);
    else if (has_next) {
#pragma unroll
      for (int i = 0; i < 4; ++i) { const int id = tid + 256 * i, row = id >> 3, c = (id & 7) ^ ((id >> 4) & 7);
        __builtin_amdgcn_global_load_lds((const unsigned*)(An + (size_t)(m0n + row) * ldan + c * 8), (unsigned*)(As + id * 8), 16, 0, 0); }
#pragma unroll
      for (int i = 0; i < NBL; ++i) { const int id = tid + 256 * i, row = id >> 3, c = (id & 7) ^ ((id >> 4) & 7);
        __builtin_amdgcn_global_load_lds((const unsigned*)(Bt + (size_t)(n0n + row) * ldb + c * 8), (unsigned*)(Bs + id * 8), 16, 0, 0); }
    }
    COMPUTE(cur);
    if constexpr (MODE == 2) {
      if (kt == 7 || kt == 15) {
#pragma unroll
        for (int m = 0; m < 4; ++m)
#pragma unroll
          for (int n = 0; n < NF; ++n)
#pragma unroll
            for (int j = 0; j < 4; ++j) acc[m][n][j] *= (kt == 7) ? f0[m] : f1[m];
      }
    }
    if (kt + 1 < nk) asm volatile("s_waitcnt vmcnt(0)" ::: "memory");
    __syncthreads();
  }
#define GLOAD(x)
#define LSTORE(x)
#undef GLOAD
#undef LSTORE
#undef COMPUTE
  if constexpr (MODE == 0) {
    u16* P = (u16*)(p.ws + WS_P);
    constexpr int SLD = WN + 8;
    u16* stg = (u16*)smem + STAGE + w * 16 * SLD;
    constexpr int CPR = WN / 8;
    __syncthreads();
#pragma unroll
    for (int m = 0; m < 4; ++m) {
      wave_lds_sync();
#pragma unroll
      for (int n = 0; n < NF; ++n) {
        uint2 o; o.x = pack2(acc[m][n][0], acc[m][n][1]); o.y = pack2(acc[m][n][2], acc[m][n][3]);
        *reinterpret_cast<uint2*>(stg + fr * SLD + n * 16 + fq * 4) = o;
      }
      wave_lds_sync();
      for (int id = lane; id < 16 * CPR; id += 64) {
        int row = id / CPR, ch = id % CPR;
        uint4 v = *reinterpret_cast<const uint4*>(stg + row * SLD + ch * 8);
        __builtin_nontemporal_store(__builtin_bit_cast(u32x4, v), reinterpret_cast<u32x4*>(P + (size_t)(m0 + wr * 64 + m * 16 + row) * IND + n0 + wc * WN + ch * 8));
      }
    }
  } else if constexpr (MODE == 1) {
    const u16* P = (const u16*)(p.ws + WS_P);
    u16* Y = (u16*)(p.ws + WS_Y);
    const float* gb = p.in[opq(27)] + l * 1024;
    const int tn = n0 >> 7;
#pragma unroll
    for (int q = 0; q < 2; ++q) {
      const int oc = tn * 64 + (wc * 2 + q) * 16 + fq * 4;
      const f32x4 b0 = *reinterpret_cast<const f32x4*>(gb + oc), b1 = *reinterpret_cast<const f32x4*>(gb + 512 + oc);
#pragma unroll
      for (int m = 0; m < 4; ++m) {
        const size_t row = (size_t)(m0 + wr * 64 + m * 16 + fr);
        const uint2 sgv = *reinterpret_cast<const uint2*>(P + row * IND + C_SG + oc);
        const float sg[4] = {bflo(sgv.x), bfhi(sgv.x), bflo(sgv.y), bfhi(sgv.y)};
        float y[4];
#pragma unroll
        for (int j = 0; j < 4; ++j) {
          const float val = acc[m][2 * q][j] + b0[j], gt = acc[m][2 * q + 1][j] + b1[j];
          y[j] = val * rcpf(1.f + __expf(-gt)) * siluf(sg[j]);
        }
        uint2 o; o.x = pack2(y[0], y[1]); o.y = pack2(y[2], y[3]);
        *reinterpret_cast<uint2*>(Y + row * MIXW + 1536 + oc) = o;
      }
    }
  } else {
    const float* modb = (const float*)(p.ws + WS_MOD) + l * 9 * 3072;
    const bool cm = (l & 1);
    const float* hs = l == 0 ? p.in[opq(0)] : p.out;
    float* stg = (float*)((u16*)smem + STAGE) + w * (16 * 68);
    __syncthreads();
#pragma unroll
    for (int m = 0; m < 4; ++m) {
#pragma unroll
      for (int n = 0; n < NF; ++n) *reinterpret_cast<f32x4*>(stg + fr * 68 + n * 16 + fq * 4) = acc[m][n];
      wave_lds_sync();
#pragma unroll
      for (int k = 0; k < 4; ++k) {
        const int id = lane + 64 * k, rowi = id >> 4, ch = id & 15;
        const f32x4 a = *reinterpret_cast<const f32x4*>(stg + rowi * 68 + ch * 4);
        const int r = m0 + wr * 64 + m * 16 + rowi, col = n0 + wc * WN + ch * 4;
        const float* src; float* dst; const float* gt;
        if (r < NLAT) {
          const int b = r >> 12, sp = r & 4095;
          const int sq = cm ? (((sp & 63) << 6) | (sp >> 6)) : sp;
          const size_t idx = ((size_t)(b * 4096 + sq)) * 1024 + col;
          src = hs + idx; dst = p.out + idx; gt = modb + b * 3072 + 2048 + col;
        } else {
          const size_t idx = (size_t)(r - NLAT) * 1024 + col;
          src = p.in[opq(2)] + idx; dst = (float*)(p.ws + WS_HCTX) + idx; gt = modb + 8 * 3072 + 2048 + col;
        }
        const f32x4 h = __builtin_nontemporal_load(reinterpret_cast<const f32x4*>(src)), gv = *reinterpret_cast<const f32x4*>(gt);
        f32x4 o;
        o[0] = h[0] + gv[0] * a[0]; o[1] = h[1] + gv[1] * a[1]; o[2] = h[2] + gv[2] * a[2]; o[3] = h[3] + gv[3] * a[3];
        __builtin_nontemporal_store(o, reinterpret_cast<f32x4*>(dst));
      }
      wave_lds_sync();
    }
  }
  __syncthreads();
}

__device__ void phase_conv(const Params& p, int l) {
  u16* P = (u16*)(p.ws + WS_P);
  const float* cw = p.in[opq(9)] + (size_t)l * 5 * 1536;
  const float* cb = p.in[opq(10)] + l * 1536;
  const int tid = opaque_tid(), cq = tid & 7, sgi = tid >> 3;
  for (int it = blockIdx.x; it < 768; it += gridDim.x) {
    const bool isctx = it >= 384;
    const int q = isctx ? it - 384 : it, b = q / 48, cgp = q % 48;
    const int L = isctx ? 256 : 4096, seg = L / 32, rowbase = isctx ? NLAT + b * 256 : b * 4096;
    const int ch = cgp * 32 + cq * 4;
    float4 wk[5];
#pragma unroll
    for (int k = 0; k < 5; ++k) wk[k] = *reinterpret_cast<const float4*>(cw + k * 1536 + ch);
    const float4 bias = *reinterpret_cast<const float4*>(cb + ch);
    u16* rp = P + (size_t)rowbase * IND + C_XBC + ch;
    const int a = sgi * seg;
    auto ld = [&](int sp) -> float4 {
      float4 r = make_float4(0.f, 0.f, 0.f, 0.f);
      if (sp >= 0 && sp < L) {
        uint2 v = *reinterpret_cast<const uint2*>(rp + (size_t)sp * IND);
        r.x = bflo(v.x); r.y = bfhi(v.x); r.z = bflo(v.y); r.w = bfhi(v.y);
      }
      return r;
    };
    float4 r0 = ld(a - 2), r1 = ld(a - 1), r2 = ld(a), r3 = ld(a + 1);
    const float4 e0 = ld(a + seg), e1 = ld(a + seg + 1);
    __syncthreads();
    auto ldraw = [&](int sp) -> uint2 {
      uint2 v = make_uint2(0u, 0u);
      if (sp < a + seg) v = *reinterpret_cast<const uint2*>(rp + (size_t)sp * IND);
      return v;
    };
    uint2 nraw[8];
#pragma unroll
    for (int j = 0; j < 8; ++j) nraw[j] = ldraw(a + 2 + j);
    for (int t0 = a; t0 < a + seg; t0 += 8) {
      uint2 cur[8];
#pragma unroll
      for (int j = 0; j < 8; ++j) cur[j] = nraw[j];
      if (t0 + 8 < a + seg) {
#pragma unroll
        for (int j = 0; j < 8; ++j) nraw[j] = ldraw(t0 + 10 + j);
      }
#pragma unroll
      for (int j = 0; j < 8; ++j) {
        const int sp = t0 + 2 + j;
        float4 r4;
        if (sp < a + seg) {
          const unsigned c0_ = pin(cur[j].x), c1_ = pin(cur[j].y);
          r4 = make_float4(bflo(c0_), bfhi(c0_), bflo(c1_), bfhi(c1_));
        } else r4 = (sp == a + seg) ? e0 : e1;
        float o0 = bias.x + wk[0].x * r0.x + wk[1].x * r1.x + wk[2].x * r2.x + wk[3].x * r3.x + wk[4].x * r4.x;
        float o1 = bias.y + wk[0].y * r0.y + wk[1].y * r1.y + wk[2].y * r2.y + wk[3].y * r3.y + wk[4].y * r4.y;
        float o2 = bias.z + wk[0].z * r0.z + wk[1].z * r1.z + wk[2].z * r2.z + wk[3].z * r3.z + wk[4].z * r4.z;
        float o3 = bias.w + wk[0].w * r0.w + wk[1].w * r1.w + wk[2].w * r2.w + wk[3].w * r3.w + wk[4].w * r4.w;
        uint2 o; o.x = pack2(siluf(o0), siluf(o1)); o.y = pack2(siluf(o2), siluf(o3));
        __builtin_nontemporal_store(u32x2{o.x, o.y}, reinterpret_cast<u32x2*>(rp + (size_t)(t0 + j) * IND));
        r0 = r1; r1 = r2; r2 = r3; r3 = r4;
      }
    }
    __syncthreads();
  }
}


__device__ void ssd_item(const Params& p, int l, int part, int item, unsigned char* smem) {
  u16* Bs = (u16*)smem;
  u16* Ms = Bs;
  u16* Cs = (u16*)(smem + 17408);
  u16* BT = (u16*)(smem + 34816);
  u16* xT = (u16*)(smem + 53248);
  u16* xwT = (u16*)(smem + 62464);
  float* dts = (float*)(smem + 71680);
  float* acs = dts + 64;
  float* wts = acs + 64;
  float* ssql = wts + 64;
  float* tots = ssql + 256;
  u16* ystg = (u16*)(smem + 73600);
  const int tid0 = opaque_tid();
  const int b = item >> 5, hd = (item >> 1) & 15, dir = item & 1, g = hd >> 3;
  u16* P = (u16*)(p.ws + WS_P);
  u16* Y = (u16*)(p.ws + WS_Y);
  float* ssq = (float*)(p.ws + WS_SSQ);
  float* stsave = (float*)(p.ws + WS_WIN) + (size_t)item * 8192;
  const float Dsk = p.in[opq(13)][l * 16 + hd];
  f32x4 hacc[8];
  if (part == 1) {
#pragma unroll
    for (int i = 0; i < 8; ++i) hacc[i] = *reinterpret_cast<const f32x4*>(stsave + (i * 256 + tid0) * 4);
  } else {
#pragma unroll
    for (int i = 0; i < 8; ++i) hacc[i] = f32x4{0.f, 0.f, 0.f, 0.f};
  }
  const int nseg = part == 0 ? 3 : 1;
  for (int seg = 0; seg < nseg; ++seg) {
    bool isctx; int sdir, ci0, ci1, mode;
    if (part == 1) { isctx = false; sdir = dir; ci0 = 32; ci1 = 64; mode = 2; }
    else if (seg == 0) { if (!(dir == 0 && l == 0)) continue; isctx = true; sdir = 1; ci0 = 0; ci1 = 4; mode = 1; }
    else if (seg == 1) { isctx = true; sdir = dir; ci0 = 0; ci1 = 4; mode = (dir == 0 && l == 0) ? 2 : 0; }
    else { isctx = false; sdir = dir; ci0 = 0; ci1 = 32; mode = 1; }
    if (part == 0 && seg <= 1) {
#pragma unroll
      for (int i = 0; i < 8; ++i) hacc[i] = f32x4{0.f, 0.f, 0.f, 0.f};
    }
    __threadfence();
    __syncthreads();
    const float aneg = -expf(p.in[opq(11)][(l * 2 + sdir) * 16 + hd]);
    const float dtb = p.in[opq(12)][(l * 2 + sdir) * 16 + hd];
    const int nch = isctx ? 4 : 64;
    const int rowbase = isctx ? NLAT + b * 256 : b * 4096;
#pragma unroll
    for (int i = 0; i < 8; ++i) asm volatile("" : "+v"(hacc[i]));
    u32x4 rx[2], rbm[4], rcm[4];
    unsigned rawdt = 0u;
    {
      const int tid = tid0, lane = tid & 63, w = tid >> 6;
      const int cL = (sdir ? nch - 1 - ci0 : ci0) * 64;
#pragma unroll
      for (int k = 0; k < 2; ++k) {
        const int id = tid + 256 * k, pch = id >> 6, i = id & 63;
        const int tau = sdir ? cL + 63 - i : cL + i;
        rx[k] = *reinterpret_cast<const u32x4*>(P + (size_t)(rowbase + tau) * IND + C_XBC + hd * 64 + pch * 8);
      }
#pragma unroll
      for (int k = 0; k < 4; ++k) {
        const int id = tid + 256 * k, nc = id >> 6, i = id & 63;
        const int tau = sdir ? cL + 63 - i : cL + i;
        rbm[k] = *reinterpret_cast<const u32x4*>(P + (size_t)(rowbase + tau) * IND + C_BM + g * 128 + nc * 8);
      }
#pragma unroll
      for (int k = 0; k < 4; ++k) {
        const int id = tid + 256 * k, i = id >> 4, nc = id & 15;
        const int tau = sdir ? cL + 63 - i : cL + i;
        rcm[k] = *reinterpret_cast<const u32x4*>(P + (size_t)(rowbase + tau) * IND + C_CM + g * 128 + nc * 8);
      }
      rawdt = P[(size_t)(rowbase + (sdir ? cL + 63 - lane : cL + lane)) * IND + C_DT + sdir * 16 + hd];
    }
    for (int ci = ci0; ci < ci1; ++ci) {
      const int c0 = (sdir ? nch - 1 - ci : ci) * 64;
      int tid = tid0;
      asm volatile("" : "+v"(tid));
      const int lane = tid & 63, w = tid >> 6, fr = lane & 15, fq = lane >> 4;
      __syncthreads();
      if (w == 0) {
        float dt = softplusf(bflo(pin(rawdt)) + dtb);
        const float cs = wave_incl_scan(dt * aneg);
        const float tot = __builtin_bit_cast(float, __builtin_amdgcn_readlane(__builtin_bit_cast(int, cs), 63));
        dts[lane] = dt; acs[lane] = cs; wts[lane] = __expf(tot - cs);
        if (lane == 0) tots[0] = tot;
      }
      pin4(rbm[0]); pin4(rbm[1]); pin4(rbm[2]); pin4(rbm[3]);
#pragma unroll
      for (int k = 0; k < 4; ++k) {
        const int id = tid + 256 * k, nc = id >> 6, i = id & 63;
        *reinterpret_cast<u32x4*>(Bs + i * 136 + nc * 8) = rbm[k];
#pragma unroll
        for (int e = 0; e < 4; ++e) {
          BT[(nc * 8 + 2 * e) * 72 + i] = (u16)(rbm[k][e] & 0xffffu);
          BT[(nc * 8 + 2 * e + 1) * 72 + i] = (u16)(rbm[k][e] >> 16);
        }
      }
#pragma unroll
      for (int k = 0; k < 4; ++k) {
        const int id = tid + 256 * k, i = id >> 4, nc = id & 15;
        *reinterpret_cast<u32x4*>(Cs + i * 136 + nc * 8) = rcm[k];
      }
      __syncthreads();
      pin4(rx[0]); pin4(rx[1]);
#pragma unroll
      for (int k = 0; k < 2; ++k) {
        const int id = tid + 256 * k, pch = id >> 6, i = id & 63;
        const float dt = dts[i], wt = wts[i];
#pragma unroll
        for (int e = 0; e < 4; ++e) {
          float x0 = bflo(rx[k][e]) * dt, x1 = bfhi(rx[k][e]) * dt;
          xT[(pch * 8 + 2 * e) * 72 + i] = f2bf(x0); xT[(pch * 8 + 2 * e + 1) * 72 + i] = f2bf(x1);
          xwT[(pch * 8 + 2 * e) * 72 + i] = f2bf(x0 * wt); xwT[(pch * 8 + 2 * e + 1) * 72 + i] = f2bf(x1 * wt);
        }
      }
      u32x4 tmpv[2] = {u32x4{0u, 0u, 0u, 0u}, u32x4{0u, 0u, 0u, 0u}};
      uint2 zr[4];
#pragma unroll
      for (int e = 0; e < 4; ++e) zr[e] = make_uint2(0u, 0u);
      if (mode == 2) {
        const int qs = (w * 4 + fq) * 16 + (15 - fr);
        const u16* tp = Y + (size_t)(rowbase + c0 + (qs >> 2)) * MIXW + hd * 64 + (qs & 3) * 16;
        tmpv[0] = *reinterpret_cast<const u32x4*>(tp); tmpv[1] = *reinterpret_cast<const u32x4*>(tp + 8);
#pragma unroll
        for (int tt = 0; tt < 4; ++tt) {
          const int t = tt * 16 + fr;
          const size_t row = (size_t)(rowbase + (sdir ? c0 + 63 - t : c0 + t));
          zr[tt] = *reinterpret_cast<const uint2*>(P + row * IND + hd * 64 + w * 16 + fq * 4);
        }
      }
      if (ci + 1 < ci1) {
        const int cL = (sdir ? nch - 2 - ci : ci + 1) * 64;
#pragma unroll
        for (int k = 0; k < 2; ++k) {
          const int id = tid + 256 * k, pch = id >> 6, i = id & 63;
          const int tau = sdir ? cL + 63 - i : cL + i;
          rx[k] = *reinterpret_cast<const u32x4*>(P + (size_t)(rowbase + tau) * IND + C_XBC + hd * 64 + pch * 8);
        }
#pragma unroll
        for (int k = 0; k < 4; ++k) {
          const int id = tid + 256 * k, nc = id >> 6, i = id & 63;
          const int tau = sdir ? cL + 63 - i : cL + i;
          rbm[k] = *reinterpret_cast<const u32x4*>(P + (size_t)(rowbase + tau) * IND + C_BM + g * 128 + nc * 8);
        }
#pragma unroll
        for (int k = 0; k < 4; ++k) {
          const int id = tid + 256 * k, i = id >> 4, nc = id & 15;
          const int tau = sdir ? cL + 63 - i : cL + i;
          rcm[k] = *reinterpret_cast<const u32x4*>(P + (size_t)(rowbase + tau) * IND + C_CM + g * 128 + nc * 8);
        }
        rawdt = P[(size_t)(rowbase + (sdir ? cL + 63 - lane : cL + lane)) * IND + C_DT + sdir * 16 + hd];
      }
      __syncthreads();
      __builtin_amdgcn_s_setprio(1);
      f32x4 gacc[4];
#pragma unroll
      for (int i = 0; i < 4; ++i) gacc[i] = f32x4{0.f, 0.f, 0.f, 0.f};
#pragma unroll
      for (int kk = 0; kk < 4; ++kk) {
        bf16x8 a = ld8(Bs + (w * 16 + fr) * 136 + kk * 32 + fq * 8);
#pragma unroll
        for (int tb = 0; tb < 4; ++tb) {
          bf16x8 bb = ld8(Cs + (tb * 16 + fr) * 136 + kk * 32 + fq * 8);
          gacc[tb] = mfma16(a, bb, gacc[tb]);
        }
      }
      __builtin_amdgcn_s_setprio(0);
      asm volatile("" : "+v"(tmpv[0]), "+v"(tmpv[1]));
      __syncthreads();
#pragma unroll
      for (int tb = 0; tb < 4; ++tb) {
        const int t = tb * 16 + fr;
        const float at = acs[t];
        float mv[4];
#pragma unroll
        for (int j = 0; j < 4; ++j) {
          const int s = w * 16 + fq * 4 + j;
          mv[j] = (s <= t) ? gacc[tb][j] * __expf(at - acs[s]) : 0.f;
        }
        uint2 o; o.x = pack2(mv[0], mv[1]); o.y = pack2(mv[2], mv[3]);
        *reinterpret_cast<uint2*>(Ms + t * 72 + w * 16 + fq * 4) = o;
      }
      __syncthreads();
      __builtin_amdgcn_s_setprio(1);
      f32x4 yd[4], yo[4];
#pragma unroll
      for (int i = 0; i < 4; ++i) { yd[i] = f32x4{0.f, 0.f, 0.f, 0.f}; yo[i] = f32x4{0.f, 0.f, 0.f, 0.f}; }
#pragma unroll
      for (int kk = 0; kk < 2; ++kk) {
        bf16x8 bb = ld8(xT + (w * 16 + fr) * 72 + kk * 32 + fq * 8);
#pragma unroll
        for (int tt = 0; tt < 4; ++tt) {
          bf16x8 a = ld8(Ms + (tt * 16 + fr) * 72 + kk * 32 + fq * 8);
          yd[tt] = mfma16(bb, a, yd[tt]);
        }
      }
#pragma unroll
      for (int kk = 0; kk < 4; ++kk) {
        bf16x8 hb = packacc(hacc[2 * kk], hacc[2 * kk + 1]);
#pragma unroll
        for (int tt = 0; tt < 4; ++tt) {
          const u16* cr = Cs + (tt * 16 + fr) * 136 + fq * 4;
          bf16x8 a = ld44(cr + (2 * kk) * 16, cr + (2 * kk + 1) * 16);
          yo[tt] = mfma16(hb, a, yo[tt]);
        }
      }
      const float etot = __expf(tots[0]);
#pragma unroll
      for (int nb = 0; nb < 8; ++nb) { hacc[nb][0] *= etot; hacc[nb][1] *= etot; hacc[nb][2] *= etot; hacc[nb][3] *= etot; }
#pragma unroll
      for (int kk = 0; kk < 2; ++kk) {
        bf16x8 bb = ld8(xwT + (w * 16 + fr) * 72 + kk * 32 + fq * 8);
#pragma unroll
        for (int nb = 0; nb < 8; ++nb) {
          bf16x8 a = ld8(BT + (nb * 16 + fr) * 72 + kk * 32 + fq * 8);
          hacc[nb] = mfma16(a, bb, hacc[nb]);
        }
      }
      __builtin_amdgcn_s_setprio(0);
      if (mode != 0) {
        float ea[4];
#pragma unroll
        for (int tt = 0; tt < 4; ++tt) ea[tt] = __expf(acs[tt * 16 + fr]);
        if (mode == 1) {
          u32x4 o0, o1;
#pragma unroll
          for (int tt = 0; tt < 4; ++tt) {
            float v[4];
#pragma unroll
            for (int j = 0; j < 4; ++j) v[j] = yd[tt][j] + ea[tt] * yo[tt][j];
            const unsigned a2 = pack2(v[0], v[1]), b2 = pack2(v[2], v[3]);
            if (tt == 0) { o0[0] = a2; o0[1] = b2; } else if (tt == 1) { o0[2] = a2; o0[3] = b2; }
            else if (tt == 2) { o1[0] = a2; o1[1] = b2; } else { o1[2] = a2; o1[3] = b2; }
          }
          const int qs = (w * 4 + fq) * 16 + fr;
          u16* tp = Y + (size_t)(rowbase + c0 + (qs >> 2)) * MIXW + hd * 64 + (qs & 3) * 16;
          *reinterpret_cast<u32x4*>(tp) = o0; *reinterpret_cast<u32x4*>(tp + 8) = o1;
        } else {
          float xsv[16], rdt[4], val[16];
#pragma unroll
          for (int tt = 0; tt < 4; ++tt) {
            rdt[tt] = rcpf(dts[tt * 16 + fr]);
#pragma unroll
            for (int j = 0; j < 4; ++j) xsv[tt * 4 + j] = bf2f(xT[(w * 16 + fq * 4 + j) * 72 + tt * 16 + fr]);
          }
          float sq[4];
#pragma unroll
          for (int tt = 0; tt < 4; ++tt) {
            const int t = tt * 16 + fr;
            const uint2 zw = zr[tt];
            const unsigned z01 = pin(zw.x), z23 = pin(zw.y);
            const float zz[4] = {bflo(z01), bfhi(z01), bflo(z23), bfhi(z23)};
            const int et = 3 - tt;
            const unsigned p01 = tmpv[et >> 1][(et & 1) * 2], p23 = tmpv[et >> 1][(et & 1) * 2 + 1];
            const float yf[4] = {bflo(p01), bfhi(p01), bflo(p23), bfhi(p23)};
            float s2 = 0.f;
#pragma unroll
            for (int j = 0; j < 4; ++j) {
              const float yv = yd[tt][j] + ea[tt] * yo[tt][j];
              const float vv = (yf[j] + yv + Dsk * xsv[tt * 4 + j] * rdt[tt]) * siluf(zz[j]);
              val[tt * 4 + j] = vv; s2 += vv * vv;
            }
            sq[tt] = s2;
            uint2 o; o.x = pack2(val[tt * 4], val[tt * 4 + 1]); o.y = pack2(val[tt * 4 + 2], val[tt * 4 + 3]);
            const int c = w * 2 + (fq >> 1);
            *reinterpret_cast<uint2*>(ystg + t * 64 + ((c ^ ((t >> 2) & 7)) << 3) + (fq & 1) * 4) = o;
          }
#pragma unroll
          for (int tt = 0; tt < 4; ++tt) {
            sq[tt] += __shfl_xor(sq[tt], 16); sq[tt] += __shfl_xor(sq[tt], 32);
          }
          if (fq == 0) {
#pragma unroll
            for (int tt = 0; tt < 4; ++tt) ssql[w * 64 + tt * 16 + fr] = sq[tt];
          }
          __syncthreads();
#pragma unroll
          for (int k = 0; k < 2; ++k) {
            const int id = tid + 256 * k, t = id >> 3, c = id & 7;
            const u32x4 v = *reinterpret_cast<const u32x4*>(ystg + t * 64 + ((c ^ ((t >> 2) & 7)) << 3));
            const size_t row = (size_t)(rowbase + (sdir ? c0 + 63 - t : c0 + t));
            *reinterpret_cast<u32x4*>(Y + row * MIXW + hd * 64 + c * 8) = v;
          }
          if (tid < 64) {
            const size_t row = (size_t)(rowbase + (sdir ? c0 + 63 - tid : c0 + tid));
            ssq[row * 16 + hd] = ssql[tid] + ssql[64 + tid] + ssql[128 + tid] + ssql[192 + tid];
          }
        }
      }
    }
  }
  if (part == 0) {
#pragma unroll
    for (int i = 0; i < 8; ++i) *reinterpret_cast<f32x4*>(stsave + (i * 256 + tid0) * 4) = hacc[i];
  }
}

__device__ void gla_item(const Params& p, int l, int part, int item, unsigned char* smem) {
  u16* qe = (u16*)smem;
  u16* ke = (u16*)(smem + 9216);
  u16* kdT = (u16*)(smem + 18432);
  u16* vT = (u16*)(smem + 27648);
  u16* at = (u16*)(smem + 46080);
  float* gl = (float*)(smem + 55296);
  float* red = (float*)(smem + 71936);
  const int tid0 = opaque_tid();
  const int b = item >> 3, h = (item >> 1) & 3, dir = item & 1;
  u16* P = (u16*)(p.ws + WS_P);
  u16* Y = (u16*)(p.ws + WS_Y);
  float* stsave = (float*)(p.ws + WS_WIN) + (size_t)(256 + item) * 8192;
  f32x4 sacc[4][2];
  if (part == 1) {
#pragma unroll
    for (int i = 0; i < 8; ++i) sacc[i >> 1][i & 1] = *reinterpret_cast<const f32x4*>(stsave + (i * 256 + tid0) * 4);
  } else {
#pragma unroll
    for (int i = 0; i < 8; ++i) sacc[i >> 1][i & 1] = f32x4{0.f, 0.f, 0.f, 0.f};
  }
  const int nseg = part == 0 ? 3 : 1;
  for (int seg = 0; seg < nseg; ++seg) {
    bool isctx; int sdir, ci0, ci1, mode;
    if (part == 1) { isctx = false; sdir = dir; ci0 = 32; ci1 = 64; mode = 2; }
    else if (seg == 0) { if (!(dir == 0 && l == 0)) continue; isctx = true; sdir = 1; ci0 = 0; ci1 = 4; mode = 1; }
    else if (seg == 1) { isctx = true; sdir = dir; ci0 = 0; ci1 = 4; mode = (dir == 0 && l == 0) ? 2 : 0; }
    else { isctx = false; sdir = dir; ci0 = 0; ci1 = 32; mode = 1; }
    if (part == 0 && seg <= 1) {
#pragma unroll
      for (int i = 0; i < 8; ++i) sacc[i >> 1][i & 1] = f32x4{0.f, 0.f, 0.f, 0.f};
    }
    __threadfence();
    __syncthreads();
    const int nch = isctx ? 4 : 64;
    const int rowbase = isctx ? NLAT + b * 256 : b * 4096;
#pragma unroll
    for (int i = 0; i < 8; ++i) asm volatile("" : "+v"(sacc[i >> 1][i & 1]));
    u32x4 rq[2], rk[2], rv[4], rlr;
    bf16x8 Bw;
    float bl;
    {
      const int tid = tid0;
      const int dcol = h * 64 + 32 * ((tid >> 6) & 1) + (tid & 31), kb = 8 * ((tid & 63) >> 5);
      const float* wlp = p.in[opq(15)] + ((size_t)((l * 2 + sdir) * 16 + kb)) * 256 + dcol;
      u32x4 bw;
#pragma unroll
      for (int e = 0; e < 4; ++e) bw[e] = pack2(wlp[(2 * e) * 256], wlp[(2 * e + 1) * 256]);
      Bw = __builtin_bit_cast(bf16x8, bw);
      bl = p.in[opq(16)][(l * 2 + sdir) * 256 + dcol];
      asm volatile("" : "+v"(Bw), "+v"(bl));
      const int cL = (sdir ? nch - 1 - ci0 : ci0) * 64;
#pragma unroll
      for (int k = 0; k < 2; ++k) {
        const int id = tid + 256 * k, i = id >> 3, dc = id & 7;
        const int tau = sdir ? cL + 63 - i : cL + i;
        rq[k] = *reinterpret_cast<const u32x4*>(P + (size_t)(rowbase + tau) * IND + C_Q + h * 64 + dc * 8);
      }
#pragma unroll
      for (int k = 0; k < 2; ++k) {
        const int id = tid + 256 * k, dc = id >> 6, i = id & 63;
        const int tau = sdir ? cL + 63 - i : cL + i;
        rk[k] = *reinterpret_cast<const u32x4*>(P + (size_t)(rowbase + tau) * IND + C_K + h * 64 + dc * 8);
      }
#pragma unroll
      for (int k = 0; k < 4; ++k) {
        const int id = tid + 256 * k, ec = id >> 6, i = id & 63;
        const int tau = sdir ? cL + 63 - i : cL + i;
        rv[k] = *reinterpret_cast<const u32x4*>(P + (size_t)(rowbase + tau) * IND + C_V + h * 128 + ec * 8);
      }
      {
        const int i = 32 * (tid >> 7) + (tid & 31), hf = (tid & 63) >> 5;
        const int tau = sdir ? cL + 63 - i : cL + i;
        rlr = *reinterpret_cast<const u32x4*>(P + (size_t)(rowbase + tau) * IND + C_LR + sdir * 16 + hf * 8);
      }
    }
    for (int ci = ci0; ci < ci1; ++ci) {
      const int c0 = (sdir ? nch - 1 - ci : ci) * 64;
      int tid = tid0;
      asm volatile("" : "+v"(tid));
      const int lane = tid & 63, w = tid >> 6, fr = lane & 15, fq = lane >> 4, d = tid & 63, iq = tid >> 6;
      __syncthreads();
      pin4(rlr);
      {
        const int th = w >> 1, dh = w & 1;
        f32x16 z;
#pragma unroll
        for (int r = 0; r < 16; ++r) z[r] = 0.f;
        const f32x16 lg = mfma32(__builtin_bit_cast(bf16x8, rlr), Bw, z);
#pragma unroll
        for (int r = 0; r < 16; ++r) {
          const int t = 32 * th + (r & 3) + 8 * (r >> 2) + 4 * (lane >> 5);
          gl[t * 65 + 32 * dh + (lane & 31)] = logsigf(lg[r] + bl) * (1.f / 16.f);
        }
      }
      __syncthreads();
      {
        float vals[16];
#pragma unroll
        for (int ii = 0; ii < 16; ++ii) vals[ii] = gl[(iq * 16 + ii) * 65 + d];
        float run = 0.f;
#pragma unroll
        for (int ii = 0; ii < 16; ++ii) { run += vals[ii]; gl[(iq * 16 + ii) * 65 + d] = run; }
        red[iq * 64 + d] = run;
      }
      __syncthreads();
      {
        float off = 0.f;
        for (int q = 0; q < iq; ++q) off += red[q * 64 + d];
        if (iq > 0) {
#pragma unroll 4
          for (int ii = 0; ii < 16; ++ii) gl[(iq * 16 + ii) * 65 + d] += off;
        }
      }
      __syncthreads();
      pin4(rq[0]); pin4(rq[1]); pin4(rk[0]); pin4(rk[1]); pin4(rv[0]); pin4(rv[1]); pin4(rv[2]); pin4(rv[3]);
#pragma unroll
      for (int k = 0; k < 2; ++k) {
        const int id = tid + 256 * k, i = id >> 3, dc = id & 7;
        u32x4 oo;
#pragma unroll
        for (int e = 0; e < 4; ++e) {
          float b0 = gl[i * 65 + dc * 8 + 2 * e], b1 = gl[i * 65 + dc * 8 + 2 * e + 1];
          oo[e] = pack2(bflo(rq[k][e]) * 0.125f * __expf(b0), bfhi(rq[k][e]) * 0.125f * __expf(b1));
        }
        *reinterpret_cast<u32x4*>(qe + i * 72 + dc * 8) = oo;
      }
#pragma unroll
      for (int k = 0; k < 2; ++k) {
        const int id = tid + 256 * k, dc = id >> 6, i = id & 63;
        u32x4 oo;
#pragma unroll
        for (int e = 0; e < 4; ++e) {
          const int d0 = dc * 8 + 2 * e;
          float b0 = gl[i * 65 + d0], b1 = gl[i * 65 + d0 + 1];
          float l0 = gl[63 * 65 + d0], l1 = gl[63 * 65 + d0 + 1];
          float k0 = bflo(rk[k][e]), k1 = bfhi(rk[k][e]);
          oo[e] = pack2(k0 * __expf(-b0), k1 * __expf(-b1));
          kdT[d0 * 72 + i] = f2bf(k0 * __expf(l0 - b0));
          kdT[(d0 + 1) * 72 + i] = f2bf(k1 * __expf(l1 - b1));
        }
        *reinterpret_cast<u32x4*>(ke + i * 72 + dc * 8) = oo;
      }
#pragma unroll
      for (int k = 0; k < 4; ++k) {
        const int id = tid + 256 * k, ec = id >> 6, i = id & 63;
#pragma unroll
        for (int e = 0; e < 4; ++e) {
          vT[(ec * 8 + 2 * e) * 72 + i] = (u16)(rv[k][e] & 0xffffu);
          vT[(ec * 8 + 2 * e + 1) * 72 + i] = (u16)(rv[k][e] >> 16);
        }
      }
      u32x4 tmpv[4];
      unsigned ggr[16];
#pragma unroll
      for (int e = 0; e < 4; ++e) tmpv[e] = u32x4{0u, 0u, 0u, 0u};
#pragma unroll
      for (int e = 0; e < 16; ++e) ggr[e] = 0u;
      if (mode == 2) {
        const int qs = (w * 4 + (3 - fq)) * 16 + fr;
        const u16* tp = Y + (size_t)(rowbase + c0 + (qs >> 2)) * MIXW + 1024 + h * 128 + (qs & 3) * 32;
#pragma unroll
        for (int e = 0; e < 4; ++e) tmpv[e] = *reinterpret_cast<const u32x4*>(tp + e * 8);
#pragma unroll
        for (int tt = 0; tt < 4; ++tt)
#pragma unroll
          for (int j = 0; j < 4; ++j) {
            const int t = tt * 16 + fq * 4 + j;
            const size_t row = (size_t)(rowbase + (sdir ? c0 + 63 - t : c0 + t));
            ggr[tt * 4 + j] = *reinterpret_cast<const unsigned*>(P + row * IND + C_GG + h * 128 + w * 32 + 2 * fr);
          }
      }
      if (ci + 1 < ci1) {
        const int cL = (sdir ? nch - 2 - ci : ci + 1) * 64;
#pragma unroll
        for (int k = 0; k < 2; ++k) {
          const int id = tid + 256 * k, i = id >> 3, dc = id & 7;
          const int tau = sdir ? cL + 63 - i : cL + i;
          rq[k] = *reinterpret_cast<const u32x4*>(P + (size_t)(rowbase + tau) * IND + C_Q + h * 64 + dc * 8);
        }
#pragma unroll
        for (int k = 0; k < 2; ++k) {
          const int id = tid + 256 * k, dc = id >> 6, i = id & 63;
          const int tau = sdir ? cL + 63 - i : cL + i;
          rk[k] = *reinterpret_cast<const u32x4*>(P + (size_t)(rowbase + tau) * IND + C_K + h * 64 + dc * 8);
        }
#pragma unroll
        for (int k = 0; k < 4; ++k) {
          const int id = tid + 256 * k, ec = id >> 6, i = id & 63;
          const int tau = sdir ? cL + 63 - i : cL + i;
          rv[k] = *reinterpret_cast<const u32x4*>(P + (size_t)(rowbase + tau) * IND + C_V + h * 128 + ec * 8);
        }
        {
          const int i = 32 * (tid >> 7) + (tid & 31), hf = (tid & 63) >> 5;
          const int tau = sdir ? cL + 63 - i : cL + i;
          rlr = *reinterpret_cast<const u32x4*>(P + (size_t)(rowbase + tau) * IND + C_LR + sdir * 16 + hf * 8);
        }
      }
      __syncthreads();
      {
        f32x4 aacc[4];
#pragma unroll
        for (int i = 0; i < 4; ++i) aacc[i] = f32x4{0.f, 0.f, 0.f, 0.f};
#pragma unroll
        for (int kk = 0; kk < 2; ++kk) {
          bf16x8 a = ld8(ke + (w * 16 + fr) * 72 + kk * 32 + fq * 8);
#pragma unroll
          for (int tb = 0; tb < 4; ++tb) {
            bf16x8 bb = ld8(qe + (tb * 16 + fr) * 72 + kk * 32 + fq * 8);
            aacc[tb] = mfma16(a, bb, aacc[tb]);
          }
        }
#pragma unroll
        for (int tb = 0; tb < 4; ++tb) {
          const int t = tb * 16 + fr;
          float mv[4];
#pragma unroll
          for (int j = 0; j < 4; ++j) { const int s = w * 16 + fq * 4 + j; mv[j] = (s <= t) ? aacc[tb][j] : 0.f; }
          uint2 o; o.x = pack2(mv[0], mv[1]); o.y = pack2(mv[2], mv[3]);
          *reinterpret_cast<uint2*>(at + t * 72 + w * 16 + fq * 4) = o;
        }
      }
      __syncthreads();
      f32x4 oacc[4][2];
#pragma unroll
      for (int i = 0; i < 4; ++i) { oacc[i][0] = f32x4{0.f, 0.f, 0.f, 0.f}; oacc[i][1] = f32x4{0.f, 0.f, 0.f, 0.f}; }
#pragma unroll
      for (int kk = 0; kk < 2; ++kk) {
        bf16x8 b0 = ld8(vT + (w * 32 + 2 * fr) * 72 + kk * 32 + fq * 8);
        bf16x8 b1 = ld8(vT + (w * 32 + 2 * fr + 1) * 72 + kk * 32 + fq * 8);
#pragma unroll
        for (int tt = 0; tt < 4; ++tt) {
          bf16x8 a = ld8(at + (tt * 16 + fr) * 72 + kk * 32 + fq * 8);
          oacc[tt][0] = mfma16(a, b0, oacc[tt][0]);
          oacc[tt][1] = mfma16(a, b1, oacc[tt][1]);
        }
      }
#pragma unroll
      for (int kk = 0; kk < 2; ++kk) {
        bf16x8 s0 = packacc(sacc[2 * kk][0], sacc[2 * kk + 1][0]);
        bf16x8 s1 = packacc(sacc[2 * kk][1], sacc[2 * kk + 1][1]);
#pragma unroll
        for (int tt = 0; tt < 4; ++tt) {
          const u16* qr = qe + (tt * 16 + fr) * 72 + fq * 4;
          bf16x8 a = ld44(qr + (2 * kk) * 16, qr + (2 * kk + 1) * 16);
          oacc[tt][0] = mfma16(a, s0, oacc[tt][0]);
          oacc[tt][1] = mfma16(a, s1, oacc[tt][1]);
        }
      }
#pragma unroll
      for (int db = 0; db < 4; ++db)
#pragma unroll
        for (int j = 0; j < 4; ++j) {
          const float sc = __expf(gl[63 * 65 + db * 16 + fq * 4 + j]);
          sacc[db][0][j] *= sc; sacc[db][1][j] *= sc;
        }
#pragma unroll
      for (int kk = 0; kk < 2; ++kk) {
        bf16x8 b0 = ld8(vT + (w * 32 + 2 * fr) * 72 + kk * 32 + fq * 8);
        bf16x8 b1 = ld8(vT + (w * 32 + 2 * fr + 1) * 72 + kk * 32 + fq * 8);
#pragma unroll
        for (int db = 0; db < 4; ++db) {
          bf16x8 a = ld8(kdT + (db * 16 + fr) * 72 + kk * 32 + fq * 8);
          sacc[db][0] = mfma16(a, b0, sacc[db][0]);
          sacc[db][1] = mfma16(a, b1, sacc[db][1]);
        }
      }
      pin4(tmpv[0]); pin4(tmpv[1]); pin4(tmpv[2]); pin4(tmpv[3]);
      if (mode != 0) {
        const int ycol = 1024 + h * 128 + w * 32 + 2 * fr;
        if (mode == 1) {
          const int qs = (w * 4 + fq) * 16 + fr;
          u16* tp = Y + (size_t)(rowbase + c0 + (qs >> 2)) * MIXW + 1024 + h * 128 + (qs & 3) * 32;
#pragma unroll
          for (int tt = 0; tt < 4; ++tt) {
            u32x4 o;
#pragma unroll
            for (int j = 0; j < 4; ++j) o[j] = pack2(oacc[tt][0][j], oacc[tt][1][j]);
            *reinterpret_cast<u32x4*>(tp + tt * 8) = o;
          }
        } else {
#pragma unroll
          for (int tt = 0; tt < 4; ++tt)
#pragma unroll
            for (int j = 0; j < 4; ++j) {
              const int t = tt * 16 + fq * 4 + j;
              const int e = 15 - (tt * 4 + j);
              const unsigned pw = tmpv[e >> 2][e & 3];
              float o0 = oacc[tt][0][j] + bflo(pw);
              float o1 = oacc[tt][1][j] + bfhi(pw);
              oacc[tt][0][j] = o0; oacc[tt][1][j] = o1;
              const float sq = row16_sum(o0 * o0 + o1 * o1);
              if (fr == 0) red[w * 64 + t] = sq;
            }
          __syncthreads();
          const float* nwv = p.in[opq(17)] + l * 128;
          const float nw0 = nwv[w * 32 + 2 * fr], nw1 = nwv[w * 32 + 2 * fr + 1];
#pragma unroll
          for (int tt = 0; tt < 4; ++tt)
#pragma unroll
            for (int j = 0; j < 4; ++j) {
              const int t = tt * 16 + fq * 4 + j;
              const size_t row = (size_t)(rowbase + (sdir ? c0 + 63 - t : c0 + t));
              const float tot = red[t] + red[64 + t] + red[128 + t] + red[192 + t];
              const float rs = rsqrtf(tot * (1.f / 128.f) + EPSF);
              const unsigned gw = pin(ggr[tt * 4 + j]);
              const float g0 = bflo(gw), g1 = bfhi(gw);
              *reinterpret_cast<unsigned*>(Y + row * MIXW + ycol) =
                  pack2(oacc[tt][0][j] * rs * nw0 * siluf(g0), oacc[tt][1][j] * rs * nw1 * siluf(g1));
            }
        }
      }
    }
  }
  if (part == 0) {
#pragma unroll
    for (int i = 0; i < 8; ++i) *reinterpret_cast<f32x4*>(stsave + (i * 256 + tid0) * 4) = sacc[i >> 1][i & 1];
  }
}

__device__ void s5_item(const Params& p, int l, int part, int blk, unsigned char* smem) {
  const int tid = opaque_tid(), lane = tid & 63, w = tid >> 6, fr = lane & 15, fq = lane >> 4;
  const int wi = blk * 4 + w;
  const int b = wi >> 6, g = (wi >> 1) & 31, dir = wi & 1;
  u16* hb = (u16*)smem + w * (32 * 136);
  u16* ust = (u16*)(smem + 4 * 32 * 136 * 2) + w * (32 * 16);
  u16* P = (u16*)(p.ws + WS_P);
  u16* Y = (u16*)(p.ws + WS_Y);
  u16* G5C = (u16*)(p.ws + WS_G5C);
  float* stsave = (float*)(p.ws + WS_S5ST) + (size_t)wi * 128;
  const float dsk = p.in[opq(25)][l * 512 + g * 16 + fr];
  float hre = 0.f, him = 0.f;
  if (part == 1) { hre = stsave[lane * 2]; him = stsave[lane * 2 + 1]; }
  const int nseg = part == 0 ? 3 : 1;
  for (int seg = 0; seg < nseg; ++seg) {
    bool isctx; int sdir, ti0, ti1, mode;
    if (part == 1) { isctx = false; sdir = dir; ti0 = 64; ti1 = 128; mode = 2; }
    else if (seg == 0) { if (!(dir == 0 && l == 0)) continue; isctx = true; sdir = 1; ti0 = 0; ti1 = 8; mode = 1; }
    else if (seg == 1) { isctx = true; sdir = dir; ti0 = 0; ti1 = 8; mode = (dir == 0 && l == 0) ? 2 : 0; }
    else { isctx = false; sdir = dir; ti0 = 0; ti1 = 64; mode = 1; }
    if (part == 0 && seg <= 1) { hre = 0.f; him = 0.f; }
    __threadfence();
    const unsigned char* cbase = p.ws + WS_S5C + (size_t)((l * 2 + sdir) * 32 + g) * 8704;
    const u16* BbarM = (const u16*)cbase;
    const u16* CmT = (const u16*)(cbase + 4096);
    const float* lamb = (const float*)(cbase + 8192);
    bf16x8 Bf[4], Cf[4];
#pragma unroll
    for (int cb = 0; cb < 4; ++cb) Bf[cb] = ld8(BbarM + (cb * 32 + (lane & 31)) * 16 + 8 * (lane >> 5));
#pragma unroll
    for (int kk = 0; kk < 4; ++kk) Cf[kk] = ld8(CmT + fr * 128 + kk * 32 + fq * 8);
    float lre = lamb[2 * lane], lim = lamb[2 * lane + 1];
#pragma unroll
    for (int i = 0; i < 4; ++i) asm volatile("" : "+v"(Bf[i]), "+v"(Cf[i]));
    asm volatile("" : "+v"(lre), "+v"(lim), "+v"(hre), "+v"(him));
    const int nt = isctx ? 8 : 128;
    const int rowbase = isctx ? NLAT + b * 256 : b * 4096;
    bf16x8 anext;
    {
      const int c0 = (sdir ? nt - 1 - ti0 : ti0) * 32, i = lane & 31;
      anext = ld8(P + (size_t)(rowbase + (sdir ? c0 + 31 - i : c0 + i)) * IND + C_U5 + g * 16 + 8 * (lane >> 5));
    }
    for (int ti = ti0; ti < ti1; ++ti) {
      const int c0 = (sdir ? nt - 1 - ti : ti) * 32;
      const bf16x8 a = anext;
      if (ti + 1 < ti1) {
        const int c1 = (sdir ? nt - 2 - ti : ti + 1) * 32, i = lane & 31;
        anext = ld8(P + (size_t)(rowbase + (sdir ? c1 + 31 - i : c1 + i)) * IND + C_U5 + g * 16 + 8 * (lane >> 5));
      }
      u32x4 tmpv = u32x4{0u, 0u, 0u, 0u};
      if (mode == 2) {
        const int qs = (3 - fq) * 16 + fr;
        tmpv = *reinterpret_cast<const u32x4*>(Y + (size_t)(rowbase + c0 + (qs >> 1)) * MIXW + 1536 + g * 16 + (qs & 1) * 8);
      }
      wave_lds_sync();
      if (mode == 2) *reinterpret_cast<bf16x8*>(ust + (lane & 31) * 16 + 8 * (lane >> 5)) = a;
#pragma unroll
      for (int cb = 0; cb < 4; ++cb) {
        f32x16 z;
#pragma unroll
        for (int r = 0; r < 16; ++r) z[r] = 0.f;
        f32x16 acc = mfma32(a, Bf[cb], z);
#pragma unroll
        for (int r = 0; r < 16; ++r) {
          const int ii = (r & 3) + 8 * (r >> 2) + 4 * (lane >> 5);
          hb[ii * 136 + cb * 32 + (lane & 31)] = f2bf(acc[r]);
        }
      }
      wave_lds_sync();
      {
        unsigned buv[32];
#pragma unroll
        for (int i = 0; i < 32; ++i) buv[i] = *reinterpret_cast<const unsigned*>(hb + i * 136 + 2 * lane);
#pragma unroll
        for (int i = 0; i < 32; ++i) {
          const float nre = lre * hre - lim * him + bflo(buv[i]);
          const float nim = lre * him + lim * hre + bfhi(buv[i]);
          hre = nre; him = nim;
          *reinterpret_cast<unsigned*>(hb + i * 136 + 2 * lane) = pack2(hre, him);
        }
      }
      wave_lds_sync();
      f32x4 ya[2];
      ya[0] = f32x4{0.f, 0.f, 0.f, 0.f}; ya[1] = f32x4{0.f, 0.f, 0.f, 0.f};
#pragma unroll
      for (int kk = 0; kk < 4; ++kk) {
        bf16x8 a0 = ld8(hb + fr * 136 + kk * 32 + fq * 8);
        bf16x8 a1 = ld8(hb + (16 + fr) * 136 + kk * 32 + fq * 8);
        ya[0] = mfma16(a0, Cf[kk], ya[0]);
        ya[1] = mfma16(a1, Cf[kk], ya[1]);
      }
      pin4(tmpv);
      if (mode == 1) {
        u32x4 o;
        o[0] = pack2(ya[0][0], ya[0][1]); o[1] = pack2(ya[0][2], ya[0][3]); o[2] = pack2(ya[1][0], ya[1][1]); o[3] = pack2(ya[1][2], ya[1][3]);
        const int qs = fq * 16 + fr;
        *reinterpret_cast<u32x4*>(Y + (size_t)(rowbase + c0 + (qs >> 1)) * MIXW + 1536 + g * 16 + (qs & 1) * 8) = o;
      } else if (mode == 2) {
#pragma unroll
        for (int rt = 0; rt < 2; ++rt)
#pragma unroll
          for (int j = 0; j < 4; ++j) {
            const int i = rt * 16 + fq * 4 + j;
            const int tau = sdir ? c0 + 31 - i : c0 + i;
            const size_t row = (size_t)(rowbase + tau);
            const int e = 7 - (rt * 4 + j);
            const unsigned pw = tmpv[e >> 1];
            const float yf = (e & 1) ? bfhi(pw) : bflo(pw);
            const float u = bf2f(ust[i * 16 + fr]);
            const float x = yf + ya[rt][j] + dsk * u;
            const float th = 1.f - 2.f * rcpf(1.f + __expf(2.f * 0.7978845608028654f * (x + 0.044715f * x * x * x)));
            const float ge = 0.5f * x * (1.f + th);
            if (isctx) G5C[(row - NLAT) * 512 + g * 16 + fr] = f2bf(ge);
            else P[row * IND + C_U5 + g * 16 + fr] = f2bf(ge);
          }
      }
    }
  }
  if (part == 0) { stsave[lane * 2] = hre; stsave[lane * 2 + 1] = him; }
}

__device__ void ssd_norm_rows(const Params& p, int nrows) {
  const int tid = opaque_tid();
  const float* ssq = (const float*)(p.ws + WS_SSQ);
  float* rsb = (float*)(p.ws + WS_RS);
  for (int i = blockIdx.x * 256 + tid; i < nrows * 2; i += gridDim.x * 256) {
    const float* sp = ssq + (size_t)i * 8;
    const float sum = sp[0] + sp[1] + sp[2] + sp[3] + sp[4] + sp[5] + sp[6] + sp[7];
    rsb[i] = rsqrtf(sum * (1.f / 512.f) + EPSF);
  }
}

__device__ void phase_final(const Params& p) {
  const int tid = opaque_tid(), lane = tid & 63, w = tid >> 6;
  const float* nw = p.in[opq(28)];
  for (int r = blockIdx.x * 4 + w; r < NLAT; r += gridDim.x * 4) {
    float* src = p.out + (size_t)r * 1024;
    float4 v[4]; float ss = 0.f;
#pragma unroll
    for (int q = 0; q < 4; ++q) {
      { const f32x4 t_ = __builtin_nontemporal_load(reinterpret_cast<const f32x4*>(src + lane * 4 + q * 256)); v[q] = make_float4(t_[0], t_[1], t_[2], t_[3]); }
      ss += v[q].x * v[q].x + v[q].y * v[q].y + v[q].z * v[q].z + v[q].w * v[q].w;
    }
#pragma unroll
    for (int o = 32; o > 0; o >>= 1) ss += __shfl_xor(ss, o);
    const float rs = rsqrtf(ss * (1.f / 1024.f) + EPSF);
#pragma unroll
    for (int q = 0; q < 4; ++q) {
      const int col = lane * 4 + q * 256;
      float4 n4 = *reinterpret_cast<const float4*>(nw + col);
      float4 o = make_float4(v[q].x * rs * n4.x, v[q].y * rs * n4.y, v[q].z * rs * n4.z, v[q].w * rs * n4.w);
      __builtin_nontemporal_store(f32x4{o.x, o.y, o.z, o.w}, reinterpret_cast<f32x4*>(src + col));
    }
  }
}


#define XB_TMO      128
#define XB_XCNT(j)  (256  + 64 * (j))
#define XB_XSUB(j)  (1280 + 64 * (j))
#define XB_XGEN(j)  (2304 + 64 * (j))
#define XB_TOP      3328
#define XB_TOPGEN   3392
#define XCD_BAR_WORDS 3456
#define XB_SPIN_CAP (1u << 20)
DI unsigned xb_ld(unsigned* p) { return __hip_atomic_load(p, __ATOMIC_RELAXED, __HIP_MEMORY_SCOPE_AGENT); }
DI unsigned xb_add(unsigned* p, unsigned v) { return __hip_atomic_fetch_add(p, v, __ATOMIC_RELAXED, __HIP_MEMORY_SCOPE_AGENT); }
DI unsigned xb_xcc_id() { return (unsigned)__builtin_amdgcn_s_getreg((3 << 11) | 20) & 0xFu; }
#define XB_SPIN(cond, bar) do { unsigned _sp = 0; while (cond) { __builtin_amdgcn_s_sleep(1); \
    if ((++_sp & 255u) == 0u) { if (xb_ld(&(bar)[XB_TMO])) break; if (_sp > XB_SPIN_CAP) { atomicAdd(&(bar)[XB_TMO], 1u); break; } } } } while (0)
struct XcdBarrier { unsigned* bar; unsigned x, nloc, nx; };
DI XcdBarrier xcd_barrier_post(unsigned* bar) {
  XcdBarrier b; b.bar = bar; b.x = xb_xcc_id(); b.nloc = 0u; b.nx = 0u;
  if (threadIdx.x == 0) (void)xb_add(&bar[XB_XCNT(b.x)], 1u);
  return b;
}
DI void xcd_barrier_complete(unsigned* bar, unsigned x, unsigned& nloc, unsigned& nx) {
  const unsigned G = gridDim.x;
  unsigned sum, cnt, mine, sp = 0u;
  for (;;) {
    sum = 0u; cnt = 0u; mine = 0u;
#pragma unroll
    for (unsigned j = 0; j < 16; ++j) { const unsigned c = xb_ld(&bar[XB_XCNT(j)]); sum += c; cnt += (c > 0u) ? 1u : 0u; mine = (j == x) ? c : mine; }
    if (sum == G) break;
    __builtin_amdgcn_s_sleep(1);
    if ((++sp & 255u) == 0u) { if (xb_ld(&bar[XB_TMO])) break; if (sp > XB_SPIN_CAP) { atomicAdd(&bar[XB_TMO], 1u); break; } }
  }
  nloc = mine > 0u ? mine : 1u; nx = cnt > 0u ? cnt : 1u;
}
DI void xcd_barrier(XcdBarrier& b) {
  asm volatile("s_waitcnt vmcnt(0)" ::: "memory");
  __syncthreads();
  if (threadIdx.x == 0) {
    unsigned* bar = b.bar;
    __builtin_amdgcn_s_waitcnt(0);
    if (b.nloc == 0u) xcd_barrier_complete(bar, b.x, b.nloc, b.nx);
    const unsigned nloc = b.nloc, nx = b.nx;
    const unsigned old = xb_add(&bar[XB_XSUB(b.x)], 1u);
    const unsigned gen = old / nloc;
    if (old + 1u == (gen + 1u) * nloc) {
      __builtin_amdgcn_fence(__ATOMIC_RELEASE, "agent");
      asm volatile("s_waitcnt vmcnt(0)" ::: "memory");
      const unsigned og = xb_add(&bar[XB_TOP], 1u);
      const unsigned tg = og / nx;
      if (og + 1u == (tg + 1u) * nx) xb_add(&bar[XB_TOPGEN], 1u);
      else XB_SPIN(xb_ld(&bar[XB_TOPGEN]) == tg, bar);
      __builtin_amdgcn_fence(__ATOMIC_ACQUIRE, "agent");
      xb_add(&bar[XB_XGEN(b.x)], 1u);
      asm volatile("s_waitcnt vmcnt(0)" ::: "memory");
    } else {
      XB_SPIN(xb_ld(&bar[XB_XGEN(b.x)]) == gen, bar);
      __builtin_amdgcn_fence(__ATOMIC_ACQUIRE, "agent");
      asm volatile("s_waitcnt vmcnt(0)" ::: "memory");
    }
  }
  __syncthreads();
}

__global__ void __launch_bounds__(256, 2) fwd_megakernel(Params p) {
  extern __shared__ __attribute__((aligned(16))) unsigned char smem[];
  cg::grid_group grid = cg::this_grid();
  XcdBarrier xb = xcd_barrier_post((unsigned*)(p.ws + WS_BAR));
  const int ph_lo = p.ph_lo, ph_hi = p.ph_hi;
  for (int ph = ph_lo; ph < ph_hi; ++ph) {
    if (ph == 0) {
      phase_prep(p, smem);
    } else if (ph == NPHASE - 1) {
      phase_final(p);
    } else {
      const int l = (ph - 1) / 7, sub = (ph - 1) % 7;
      const int mt = (l == 1) ? 256 : 272;
      if (sub == 0) {
        phase_pre(p, l, smem);
      } else if (sub == 1) {
        const u16* U = (const u16*)(p.ws + WS_Y);
        const u16* W = (const u16*)(p.ws + WS_WIN);
        const int xcd = blockIdx.x & 7, slot = blockIdx.x >> 3, nslots = gridDim.x >> 3;
        bool pre = false;
        for (int u = slot; u < 918; u += nslots) {
          const int pnl = u / 306, v = u % 306;
          const int u2 = u + nslots, pnl2 = u2 / 306, v2 = u2 % 306;
          const bool hn = u2 < 918;
          gemm_tile<192, 0>(p, l, U, 1024, W, 1024, 1024, (xcd * 34 + v / 9) * 128, (pnl * 9 + v % 9) * 192, smem,
                            pre, hn, U, 1024, (xcd * 34 + v2 / 9) * 128, (pnl2 * 9 + v2 % 9) * 192);
          pre = hn;
        }
      } else if (sub == 2) {
        phase_conv(p, l);
      } else if (sub == 3 || sub == 4) {
        const int part = sub - 3;
        for (int k = 0;; ++k) {
          int it;
          if (gridDim.x == 512) {
            if (k > 0) break;
            const int blk = blockIdx.x;
            const int q = blk < 256 ? blk - 64 : 192 + (blk - 448);
            const int sit = q < 128 ? q * 2 : (q < 192 ? 2 * (q - 128) : 2 * (q - 192) + 1) * 2 + 1;
            it = blk < 64 ? 256 + blk : blk < 256 ? sit : blk < 320 ? -1 : blk < 448 ? blk : sit;
          } else {
            it = blockIdx.x + k * gridDim.x;
            if (it >= 448) break;
          }
          if (it >= 0) {
            if (it < 256) ssd_item(p, l, part, it, smem);
            else if (it < 320) gla_item(p, l, part, it - 256, smem);
            else s5_item(p, l, part, it - 320, smem);
          }
          __syncthreads();
        }
      } else if (sub == 5) {
        const u16* W = (const u16*)(p.ws + WS_GLU);
        const int xcd = blockIdx.x & 7, slot = blockIdx.x >> 3, nslots = gridDim.x >> 3, mtx = mt >> 3;
        const u16* Alat = (const u16*)(p.ws + WS_P) + C_U5;
        const u16* Actx = (const u16*)(p.ws + WS_G5C) - (size_t)NLAT * 512;
        bool pre = false;
        for (int u = slot; u < mtx * 8; u += nslots) {
          const int t = (xcd * mtx) * 8 + u, t2 = t + nslots;
          const int m0 = (t >> 3) * 128, m0n = (t2 >> 3) * 128;
          const bool hn = u + nslots < mtx * 8;
          const u16* Ac = m0 < NLAT ? Alat : Actx; const int ldc = m0 < NLAT ? IND : 512;
          const u16* An = m0n < NLAT ? Alat : Actx; const int ldn = m0n < NLAT ? IND : 512;
          gemm_tile<128, 1>(p, l, Ac, ldc, W, 512, 512, m0, (t & 7) * 128, smem, pre, hn, An, ldn, m0n, (t2 & 7) * 128);
          pre = hn;
        }
        ssd_norm_rows(p, mt * 128);
      } else {
        const u16* A = (const u16*)(p.ws + WS_Y);
        const u16* W = (const u16*)(p.ws + WS_WOUT);
        const int xcd = blockIdx.x & 7, slot = blockIdx.x >> 3, nslots = gridDim.x >> 3, mtx = mt >> 3;
        bool pre = false;
        for (int u = slot; u < mtx * 8; u += nslots) {
          const int t = (xcd * mtx) * 8 + u, t2 = t + nslots;
          const bool hn = u + nslots < mtx * 8;
          gemm_tile<128, 2>(p, l, A, MIXW, W, MIXW, MIXW, (t >> 3) * 128, (t & 7) * 128, smem, pre, hn, A, MIXW, (t2 >> 3) * 128, (t2 & 7) * 128);
          pre = hn;
        }
      }
    }
    if (ph + 1 < ph_hi) {
      if (ph_hi < 0) grid.sync();
      xcd_barrier(xb);
    }
  }
}

extern "C" void kernel_launch(void* const* d_in, const int* in_sizes, int n_in, void* d_out, int out_size, void* d_ws,
                              size_t ws_size, hipStream_t stream) {
  static int grid_blocks = 0;
  if (grid_blocks == 0) {
    if (n_in != 29 || ws_size < WS_END) { fprintf(stderr, "kernel_launch: bad n_in %d / ws %zu (need %zu)\n", n_in, ws_size, (size_t)WS_END); grid_blocks = -1; return; }
    int dev = 0, cus = 0, per_cu = 0;
    hipGetDevice(&dev);
    hipDeviceGetAttribute(&cus, hipDeviceAttributeMultiprocessorCount, dev);
    hipFuncSetAttribute((const void*)fwd_megakernel, hipFuncAttributeMaxDynamicSharedMemorySize, SMEM_BYTES);
    hipOccupancyMaxActiveBlocksPerMultiprocessor(&per_cu, (const void*)fwd_megakernel, 256, SMEM_BYTES);
    if (per_cu < 1) per_cu = 1;
    if (per_cu > 2) per_cu = 2;
    grid_blocks = cus * per_cu;
    fprintf(stderr, "kernel_launch: cus %d per_cu %d grid %d\n", cus, per_cu, grid_blocks);
  }
  if (grid_blocks < 0) return;
  Params p{};
  for (int i = 0; i < 29; ++i) p.in[i] = (const float*)d_in[i];
  p.out = (float*)d_out; p.ws = (unsigned char*)d_ws; p.ph_lo = 0; p.ph_hi = NPHASE;
  if (hipMemsetAsync((char*)d_ws + WS_BAR, 0, 16384, stream) != hipSuccess) { fprintf(stderr, "kernel_launch: memset of the barrier words failed\n"); return; }
  void* args[] = {&p};
  hipError_t e = hipLaunchCooperativeKernel((const void*)fwd_megakernel, dim3(grid_blocks), dim3(256), args, SMEM_BYTES, stream);
  if (e != hipSuccess) fprintf(stderr, "cooperative launch failed: %s (grid %d)\n", hipGetErrorString(e), grid_blocks);
}
```
